# Optimizing an MI355X kernel written in HIP

```python
import math
import jax, jax.numpy as jnp
from jax import lax
import numpy as np

D_MODEL = 1024
BATCH = 4
SEQ = 4096
DEPTH = 4

HEAD_DIM = 64
ROPE_THETA = 10000.0
A_Q_HEADS = 6
A_KV_HEADS = 2
A_GROUP = A_Q_HEADS // A_KV_HEADS
A_HALF_WINDOW = 128
DIL_GROUPS = ((128, 1), (512, 4), (2048, 16))
N_DIL = len(DIL_GROUPS)
B_HEADS_PER_GROUP = 2
B_HEADS = B_HEADS_PER_GROUP * N_DIL
C_HEADS = 4
GRID_W = 64
NA_ROWS = 8
NA_COLS = 16
N_BRANCH = 3
N_EXPERTS = 16
EXPERT_FF = 2048
EC_CAPACITY = 2
RMS_EPS = 1e-6
NEG_INF = -1e30

A_Q_W = A_Q_HEADS * HEAD_DIM
A_KV_W = A_KV_HEADS * HEAD_DIM
B_W = B_HEADS * HEAD_DIM
B_OUT_W = B_HEADS_PER_GROUP * HEAD_DIM
C_W = C_HEADS * HEAD_DIM
PROJ_WIDTHS = (A_Q_W, A_KV_W, A_KV_W, B_W, B_W, B_W, C_W, C_W, C_W, N_BRANCH * D_MODEL)
PROJ_DIM = sum(PROJ_WIDTHS)

kernel_name = 'hybrid_gated_sparse_attn_ec_moe_encoder'


def _rmsnorm(x, g):
    xf = x.astype(jnp.float32)
    y = xf * lax.rsqrt(jnp.mean(xf * xf, axis=-1, keepdims=True) + RMS_EPS)
    return (y * g.astype(jnp.float32)).astype(x.dtype)


def _rope(x):
    s, hd = x.shape[1], x.shape[-1]
    half = hd // 2
    inv_freq = ROPE_THETA ** (-jnp.arange(half, dtype=jnp.float32) * (2.0 / hd))
    ang = jnp.arange(s, dtype=jnp.float32)[:, None] * inv_freq[None, :]
    cos = jnp.cos(ang)[None, :, None, :]
    sin = jnp.sin(ang)[None, :, None, :]
    xf = x.astype(jnp.float32)
    x1, x2 = xf[..., :half], xf[..., half:]
    return jnp.concatenate([x1 * cos - x2 * sin, x2 * cos + x1 * sin], axis=-1).astype(x.dtype)


def _key_windows(t, nb, blk, lp):
    n, L, h, hd = t.shape
    tp = jnp.pad(t, ((0, 0), (blk, lp - L + blk), (0, 0), (0, 0))).reshape(n, nb + 2, blk, h, hd)
    return jnp.concatenate([tp[:, :-2], tp[:, 1:-1], tp[:, 2:]], axis=2)


def _banded_attn(q, k, v, half_w, sink=None):
    n, L, hk, g, hd = q.shape
    blk = half_w
    nb = -(-L // blk)
    lp = nb * blk
    qb = jnp.pad(q, ((0, 0), (0, lp - L), (0, 0), (0, 0), (0, 0))).reshape(n, nb, blk, hk, g, hd)
    kw = _key_windows(k, nb, blk, lp)
    vw = _key_windows(v, nb, blk, lp)
    s = jnp.einsum('nbqhgd,nbkhd->nbhgqk', qb, kw, preferred_element_type=jnp.float32) * (hd ** -0.5)
    qpos = jnp.arange(nb)[:, None] * blk + jnp.arange(blk)[None, :]
    kpos = jnp.arange(nb)[:, None] * blk - blk + jnp.arange(3 * blk)[None, :]
    rel = kpos[:, None, :] - qpos[:, :, None]
    valid = (jnp.abs(rel) <= half_w) & (kpos[:, None, :] >= 0) & (kpos[:, None, :] < L)
    s = jnp.where(valid[None, :, None, None], s, NEG_INF)
    m = jnp.max(s, axis=-1)
    if sink is not None:
        sk = sink.astype(jnp.float32)[None, None, :, :, None]
        m = jnp.maximum(m, sk)
    p = jnp.exp(s - m[..., None])
    den = jnp.sum(p, axis=-1)
    if sink is not None:
        den = den + jnp.exp(sk - m)
    o = jnp.einsum('nbhgqk,nbkhd->nbqhgd', p.astype(v.dtype), vw, preferred_element_type=jnp.float32)
    o = o / jnp.moveaxis(den, -1, 2)[..., None]
    o = o.reshape(n, lp, hk, g, hd)[:, :L].astype(q.dtype)
    lse = jnp.moveaxis(m + jnp.log(den), -1, 2).reshape(n, lp, hk, g)[:, :L]
    return o, lse


def _dilated_group(q, k, v, dil, half_w):
    b, s, h, hd = q.shape
    L = s // dil

    def to_res(t):
        return t.reshape(b, L, dil, h, hd).transpose(0, 2, 1, 3, 4).reshape(b * dil, L, h, hd)

    o, lse = _banded_attn(to_res(q)[:, :, :, None, :], to_res(k), to_res(v), half_w)
    o = o[:, :, :, 0].reshape(b, dil, L, h, hd).transpose(0, 2, 1, 3, 4).reshape(b, s, h, hd)
    lse = lse[..., 0].reshape(b, dil, L, h).transpose(0, 2, 1, 3).reshape(b, s, h)
    return o, lse


def _dilated_mixture(q, k, v):
    outs, lses = [], []
    for gi, (w, d) in enumerate(DIL_GROUPS):
        o, lse = _dilated_group(q[:, :, gi], k[:, :, gi], v[:, :, gi], d, w // (2 * d))
        outs.append(o)
        lses.append(lse)
    alpha = jax.nn.softmax(jnp.stack(lses, axis=0), axis=0)
    o = jnp.sum(alpha[..., None] * jnp.stack(outs, axis=0).astype(jnp.float32), axis=0)
    b, s = q.shape[0], q.shape[1]
    return o.reshape(b, s, B_OUT_W).astype(q.dtype)


def _neighbourhood_attn(q, k, v, rpb):
    b, s, h, hd = q.shape
    rows = s // GRID_W
    kr = min(NA_ROWS, rows)
    kc = NA_COLS
    r = jnp.arange(rows)
    start_r = jnp.clip(r - kr // 2, 0, rows - kr)
    row_idx = start_r[:, None] + jnp.arange(kr)[None, :]
    c = jnp.arange(GRID_W)
    start_c = jnp.clip(c - kc // 2, 0, GRID_W - kc)
    col_ok = (c[None, :] >= start_c[:, None]) & (c[None, :] < start_c[:, None] + kc)
    qg = q.reshape(b, rows, GRID_W, h, hd)
    kg = k.reshape(b, rows, GRID_W, h, hd)[:, row_idx]
    vg = v.reshape(b, rows, GRID_W, h, hd)[:, row_idx]
    sc = jnp.einsum('brqhd,brjkhd->bhrqjk', qg, kg, preferred_element_type=jnp.float32) * (hd ** -0.5)
    dr_idx = row_idx - r[:, None] + (NA_ROWS - 1)
    dc_idx = jnp.clip(c[None, :] - c[:, None] + (NA_COLS - 1), 0, 2 * NA_COLS - 2)
    bias = rpb.astype(jnp.float32)[:, dr_idx][:, :, :, dc_idx]
    sc = sc + bias.transpose(0, 1, 3, 2, 4)[None]
    sc = jnp.where(col_ok[:, None, :], sc, NEG_INF)
    p = jax.nn.softmax(sc.reshape(b, h, rows, GRID_W, kr * GRID_W), axis=-1)
    p = p.reshape(b, h, rows, GRID_W, kr, GRID_W).astype(v.dtype)
    o = jnp.einsum('bhrqjk,brjkhd->brqhd', p, vg, preferred_element_type=jnp.float32)
    return o.reshape(b, s, h * hd).astype(q.dtype)


def _ec_moe(xn, w_router, w_gate, w_up, w_down):
    b, s, d = xn.shape
    cap = EC_CAPACITY * s // N_EXPERTS
    aff = jax.nn.softmax(jnp.einsum('bsd,de->bse', xn, w_router, preferred_element_type=jnp.float32), axis=-1)
    vals, idx = lax.top_k(jnp.swapaxes(aff, 1, 2), cap)
    bi = jnp.arange(b)[:, None, None]
    xe = xn[bi, idx]
    hid = jax.nn.silu(jnp.einsum('becd,edf->becf', xe, w_gate)) * jnp.einsum('becd,edf->becf', xe, w_up)
    ye = jnp.einsum('becf,efd->becd', hid, w_down) * vals[..., None].astype(xn.dtype)
    return jnp.zeros_like(xn).at[bi, idx].add(ye)


def setup_inputs(seed: int = 0) -> dict:
    key = jax.random.key(seed)
    ks = jax.random.split(key, 16)
    f32 = jnp.float32
    nrm = jax.random.normal
    return {
        'x': nrm(ks[0], (BATCH, SEQ, D_MODEL), f32),
        'w_in': nrm(ks[1], (DEPTH, D_MODEL, PROJ_DIM), f32) * D_MODEL ** -0.5,
        'b_gate': nrm(ks[2], (DEPTH, N_BRANCH * D_MODEL), f32) * 0.1,
        'sink': nrm(ks[3], (DEPTH, A_Q_HEADS), f32) * 0.5,
        'rpb': nrm(ks[4], (DEPTH, C_HEADS, 2 * NA_ROWS - 1, 2 * NA_COLS - 1), f32) * 0.1,
        'w_a': nrm(ks[5], (DEPTH, A_Q_W, D_MODEL), f32) * A_Q_W ** -0.5,
        'w_b': nrm(ks[6], (DEPTH, B_OUT_W, D_MODEL), f32) * B_OUT_W ** -0.5,
        'w_c': nrm(ks[7], (DEPTH, C_W, D_MODEL), f32) * C_W ** -0.5,
        'w_out': nrm(ks[8], (DEPTH, D_MODEL, D_MODEL), f32) * D_MODEL ** -0.5,
        'norm_mix': 1.0 + 0.05 * nrm(ks[9], (DEPTH, D_MODEL), f32),
        'norm_ffn': 1.0 + 0.05 * nrm(ks[10], (DEPTH, D_MODEL), f32),
        'w_router': nrm(ks[11], (DEPTH, D_MODEL, N_EXPERTS), f32) * D_MODEL ** -0.5,
        'w_gate_e': nrm(ks[12], (DEPTH, N_EXPERTS, D_MODEL, EXPERT_FF), f32) * D_MODEL ** -0.5,
        'w_up_e': nrm(ks[13], (DEPTH, N_EXPERTS, D_MODEL, EXPERT_FF), f32) * D_MODEL ** -0.5,
        'w_down_e': nrm(ks[14], (DEPTH, N_EXPERTS, EXPERT_FF, D_MODEL), f32) * EXPERT_FF ** -0.5,
        'norm_final': 1.0 + 0.05 * nrm(ks[15], (D_MODEL,), f32),
    }


def reference(x, w_in, b_gate, sink, rpb, w_a, w_b, w_c, w_out, norm_mix, norm_ffn,
              w_router, w_gate_e, w_up_e, w_down_e, norm_final):
    b, s = x.shape[0], x.shape[1]
    splits = [int(i) for i in np.cumsum(PROJ_WIDTHS)[:-1]]
    for l in range(DEPTH):
        xn = _rmsnorm(x, norm_mix[l])
        proj = jnp.einsum('bsd,dp->bsp', xn, w_in[l])
        qa, ka, va, qb, kb, vb, qc, kc, vc, gl = jnp.split(proj, splits, axis=-1)
        qa = _rope(qa.reshape(b, s, A_Q_HEADS, HEAD_DIM)).reshape(b, s, A_KV_HEADS, A_GROUP, HEAD_DIM)
        ka = _rope(ka.reshape(b, s, A_KV_HEADS, HEAD_DIM))
        va = va.reshape(b, s, A_KV_HEADS, HEAD_DIM)
        oa = _banded_attn(qa, ka, va, A_HALF_WINDOW, sink[l].reshape(A_KV_HEADS, A_GROUP))[0]
        oa = oa.reshape(b, s, A_Q_W)
        qb = _rope(qb.reshape(b, s, B_HEADS, HEAD_DIM)).reshape(b, s, N_DIL, B_HEADS_PER_GROUP, HEAD_DIM)
        kb = _rope(kb.reshape(b, s, B_HEADS, HEAD_DIM)).reshape(b, s, N_DIL, B_HEADS_PER_GROUP, HEAD_DIM)
        vb = vb.reshape(b, s, N_DIL, B_HEADS_PER_GROUP, HEAD_DIM)
        ob = _dilated_mixture(qb, kb, vb)
        oc = _neighbourhood_attn(qc.reshape(b, s, C_HEADS, HEAD_DIM), kc.reshape(b, s, C_HEADS, HEAD_DIM),
                                 vc.reshape(b, s, C_HEADS, HEAD_DIM), rpb[l])
        gates = jax.nn.sigmoid((gl + b_gate[l]).astype(jnp.float32)).astype(x.dtype)
        gates = gates.reshape(b, s, N_BRANCH, D_MODEL)
        merged = (gates[:, :, 0] * (oa @ w_a[l]) + gates[:, :, 1] * (ob @ w_b[l])
                  + gates[:, :, 2] * (oc @ w_c[l]))
        x = x + merged @ w_out[l]
        x = x + _ec_moe(_rmsnorm(x, norm_ffn[l]), w_router[l], w_gate_e[l], w_up_e[l], w_down_e[l])
    return _rmsnorm(x, norm_final)
```

```cpp
#include <hip/hip_runtime.h>
#include <stdint.h>

#define DI __device__ __forceinline__
#define LAS __attribute__((address_space(3)))
typedef unsigned short bf16_t;
typedef short bf16x8 __attribute__((ext_vector_type(8)));
typedef float f32x2 __attribute__((ext_vector_type(2)));
typedef float f32x4 __attribute__((ext_vector_type(4)));
typedef float f32x16 __attribute__((ext_vector_type(16)));
typedef unsigned u32x2 __attribute__((ext_vector_type(2)));
typedef unsigned u32x4 __attribute__((ext_vector_type(4)));

constexpr int NTOK = 16384, DM = 1024, SEQ = 4096, NBATCH = 4, NLAYER = 4, NEXP = 16, FF = 2048, CAP = 512, PROJ = 5632;
constexpr int QKW = 1792;
constexpr int VCH = 768;
constexpr int OCW = 768;
constexpr int NROWS_E = NBATCH * CAP * NEXP;

constexpr size_t OFF_CTL = 0;
constexpr size_t OFF_COS = 65536;
constexpr size_t OFF_SIN = OFF_COS + (size_t)SEQ * 32 * 4;
constexpr size_t OFF_W   = 2u << 20;
constexpr size_t WIN_B = (size_t)4864 * 1024 * 2, WV_B = (size_t)768 * 1024 * 2, WM_B = (size_t)1024 * 768 * 2, WO_B = (size_t)1024 * 1024 * 2;
constexpr size_t WGU_B = (size_t)NEXP * 4096 * 1024 * 2, WD_B = (size_t)NEXP * 1024 * 2048 * 2;
constexpr size_t LW_WIN = 0, LW_WV = LW_WIN + WIN_B, LW_WM = LW_WV + WV_B, LW_WO = LW_WM + WM_B, LW_WGU = LW_WO + WO_B, LW_WD = LW_WGU + WGU_B, LW = LW_WD + WD_B;
constexpr size_t OFF_X   = OFF_W + NLAYER * LW;
constexpr size_t OFF_XN  = OFF_X + (size_t)NTOK * DM * 4;
constexpr size_t OFF_QK  = OFF_XN + (size_t)NTOK * DM * 2;
constexpr size_t OFF_VT  = OFF_QK + (size_t)NTOK * QKW * 2;
constexpr size_t OFF_G   = OFF_VT + (size_t)VCH * NTOK * 2;
constexpr size_t OFF_OC  = OFF_G + (size_t)NTOK * 3072 * 2;
constexpr size_t OFF_OB3 = OFF_OC + (size_t)NTOK * OCW * 2;
constexpr size_t OFF_LSE = OFF_OB3 + (size_t)3 * NTOK * 128 * 2;
constexpr size_t OFF_MG  = OFF_LSE + (size_t)3 * NTOK * 2 * 4;
constexpr size_t OFF_AFF = OFF_MG + (size_t)NTOK * DM * 2;
constexpr size_t OFF_IDX = OFF_AFF + (size_t)NTOK * NEXP * 4;
constexpr size_t OFF_VAL = OFF_IDX + (size_t)NROWS_E * 4;
constexpr size_t OFF_INV = OFF_VAL + (size_t)NROWS_E * 4;
constexpr size_t OFF_HID = OFF_INV + (size_t)NTOK * NEXP * 4;
constexpr size_t OFF_Y   = OFF_HID + (size_t)NROWS_E * FF * 2;
constexpr size_t OFF_END = OFF_Y + (size_t)NROWS_E * DM * 2;

struct Params {
    const float *x, *w_in, *b_gate, *sink, *rpb, *w_a, *w_b, *w_c, *w_out, *norm_mix, *norm_ffn, *w_router, *w_gate_e, *w_up_e, *w_down_e, *norm_final;
    float* out; unsigned char* ws;
};
DI float*  P_COS(const Params& p) { return (float*)(p.ws + OFF_COS); }
DI float*  P_SIN(const Params& p) { return (float*)(p.ws + OFF_SIN); }
DI bf16_t* P_W(const Params& p, int l, size_t off) { return (bf16_t*)(p.ws + OFF_W + (size_t)l * LW + off); }
DI float*  P_X(const Params& p) { return (float*)(p.ws + OFF_X); }
DI bf16_t* P_XN(const Params& p) { return (bf16_t*)(p.ws + OFF_XN); }
DI bf16_t* P_QK(const Params& p) { return (bf16_t*)(p.ws + OFF_QK); }
DI bf16_t* P_VT(const Params& p) { return (bf16_t*)(p.ws + OFF_VT); }
DI bf16_t* P_G(const Params& p) { return (bf16_t*)(p.ws + OFF_G); }
DI bf16_t* P_OC(const Params& p) { return (bf16_t*)(p.ws + OFF_OC); }
DI bf16_t* P_OB3(const Params& p) { return (bf16_t*)(p.ws + OFF_OB3); }
DI float*  P_LSE(const Params& p) { return (float*)(p.ws + OFF_LSE); }
DI bf16_t* P_MG(const Params& p) { return (bf16_t*)(p.ws + OFF_MG); }
DI float*  P_AFF(const Params& p) { return (float*)(p.ws + OFF_AFF); }
DI int*    P_IDX(const Params& p) { return (int*)(p.ws + OFF_IDX); }
DI float*  P_VAL(const Params& p) { return (float*)(p.ws + OFF_VAL); }
DI int*    P_INV(const Params& p) { return (int*)(p.ws + OFF_INV); }
DI bf16_t* P_HID(const Params& p) { return (bf16_t*)(p.ws + OFF_HID); }
DI bf16_t* P_Y(const Params& p) { return (bf16_t*)(p.ws + OFF_Y); }

DI unsigned f2bf(float f) { unsigned u = __float_as_uint(f); return (u + 0x7fffu + ((u >> 16) & 1u)) >> 16; }
DI unsigned pk2(float lo, float hi) { return f2bf(lo) | (f2bf(hi) << 16); }
DI float bf2f(unsigned b) { return __uint_as_float(b << 16); }
DI float bflo(unsigned w) { return __uint_as_float(w << 16); }
DI float bfhi(unsigned w) { return __uint_as_float(w & 0xffff0000u); }
DI float wave_sum(float v) {
#pragma unroll
    for (int d = 32; d >= 1; d >>= 1) v += __shfl_xor(v, d);
    return v;
}
DI int pos16(int t) { return ((t & 15) << 8) | (t >> 4); }

constexpr int JOBS_PER_LAYER = 26432;
DI void prep_job(const Params& p, int l, int j, const float*& src, int& src_ld, bf16_t*& dst, int& dst_ld) {
    if (j < 1216) {
        const int nblk = j >> 3, kc = j & 7; int sc;
        if (nblk < 40) { const int t = nblk >> 3, sb = nblk & 7, bj = sb >> 2, wc = sb & 3, hr = 4 * t + wc;
            const int base = hr < 6 ? 64 * hr : hr < 8 ? 384 + 64 * (hr - 6) : hr < 14 ? 640 + 64 * (hr - 8) : 1024 + 64 * (hr - 14);
            sc = base + 32 * bj; }
        else if (nblk < 56) { const int c = 32 * (nblk - 40); sc = c < 256 ? 1792 + c : 2048 + (c - 256); }
        else sc = 2560 + 32 * (nblk - 56);
        src = p.w_in + (size_t)l * DM * PROJ + (size_t)(128 * kc) * PROJ + sc; src_ld = PROJ;
        dst = P_W(p, l, LW_WIN) + (size_t)(32 * nblk) * 1024 + 128 * kc; dst_ld = 1024; return;
    }
    j -= 1216;
    if (j < 192) {
        const int nblk = j >> 3, kc = j & 7, ch = 32 * nblk;
        const int sc = ch < 128 ? 512 + ch : ch < 256 ? 1408 + (ch - 128) : ch < 512 ? 2304 + (ch - 256) : 1536 + (ch - 512);
        src = p.w_in + (size_t)l * DM * PROJ + (size_t)(128 * kc) * PROJ + sc; src_ld = PROJ;
        dst = P_W(p, l, LW_WV) + (size_t)ch * 1024 + 128 * kc; dst_ld = 1024; return;
    }
    j -= 192;
    if (j < 192) {
        bf16_t* wm = P_W(p, l, LW_WM); src_ld = 1024; dst_ld = 768;
        if (j < 96) { const int nblk = j / 3, kc = j % 3; src = p.w_a + (size_t)l * 384 * 1024 + (size_t)(128 * kc) * 1024 + 32 * nblk; dst = wm + (size_t)(32 * nblk) * 768 + 128 * kc; }
        else if (j < 128) { const int nblk = j - 96; src = p.w_b + (size_t)l * 128 * 1024 + 32 * nblk; dst = wm + (size_t)(32 * nblk) * 768 + 384; }
        else { const int jj = j - 128, nblk = jj >> 1, kc = jj & 1; src = p.w_c + (size_t)l * 256 * 1024 + (size_t)(128 * kc) * 1024 + 32 * nblk; dst = wm + (size_t)(32 * nblk) * 768 + 512 + 128 * kc; }
        return;
    }
    j -= 192;
    if (j < 256) {
        const int nblk = j >> 3, kc = j & 7;
        src = p.w_out + (size_t)l * 1024 * 1024 + (size_t)(128 * kc) * 1024 + 32 * nblk; src_ld = 1024;
        dst = P_W(p, l, LW_WO) + (size_t)(32 * nblk) * 1024 + 128 * kc; dst_ld = 1024; return;
    }
    j -= 256;
    if (j < 16384) {
        const int e = j >> 10, r = j & 1023, nblk = r >> 3, kc = r & 7, row0 = 32 * nblk, pp = row0 >> 8, s = row0 & 255;
        const float* w = s < 128 ? p.w_gate_e : p.w_up_e; const int col = 128 * pp + (s & 127);
        src = w + ((size_t)(l * NEXP + e) * 1024 + 128 * kc) * 2048 + col; src_ld = 2048;
        dst = P_W(p, l, LW_WGU) + ((size_t)e * 4096 + row0) * 1024 + 128 * kc; dst_ld = 1024; return;
    }
    j -= 16384;
    {
        const int e = j >> 9, r = j & 511, nblk = r >> 4, kc = r & 15;
        src = p.w_down_e + ((size_t)(l * NEXP + e) * 2048 + 128 * kc) * 1024 + 32 * nblk; src_ld = 1024;
        dst = P_W(p, l, LW_WD) + ((size_t)e * 1024 + 32 * nblk) * 2048 + 128 * kc; dst_ld = 2048;
    }
}
DI void sincos_d(double a, double& s, double& c) {
    const double q = rint(a * 0.63661977236758134308);
    double r = fma(-q, 1.57079632679489655800e+00, a); r = fma(-q, 6.12323399573676603587e-17, r);
    const double r2 = r * r;
    double sp = 1.58969099521155010221e-10; sp = fma(sp, r2, -2.50507602534068634195e-08); sp = fma(sp, r2, 2.75573137070700676789e-06); sp = fma(sp, r2, -1.98412698298579493134e-04);
    sp = fma(sp, r2, 8.33333333332248946124e-03); sp = fma(sp, r2, -1.66666666666666324348e-01); const double sr = fma(r * r2, sp, r);
    double cp = -1.13596475577881948265e-11; cp = fma(cp, r2, 2.08757232129817482790e-09); cp = fma(cp, r2, -2.75573143513906633035e-07); cp = fma(cp, r2, 2.48015872894767294178e-05);
    cp = fma(cp, r2, -1.38888888888741095749e-03); cp = fma(cp, r2, 4.16666666666666019037e-02); const double cr = fma(r2 * r2, cp, fma(-0.5, r2, 1.0));
    const int qi = ((int)q) & 3;
    s = qi == 0 ? sr : qi == 1 ? cr : qi == 2 ? -sr : -cr;
    c = qi == 0 ? cr : qi == 1 ? -sr : qi == 2 ? -cr : sr;
}
DI void prep_phase(const Params& p, LAS float* scr) {
    const int tid = threadIdx.x;
    for (int i = blockIdx.x * 512 + tid; i < SEQ * 32; i += gridDim.x * 512) {
        const int pos = i >> 5, j = i & 31;
        double fr = 1.0; for (int jj = 0; jj < j; ++jj) fr *= 0.7498942093324559;
        const float invf = (float)fr;
        const float ang = (float)pos * invf; double s, c; sincos_d((double)ang, s, c);
        P_COS(p)[i] = (float)c; P_SIN(p)[i] = (float)s;
    }
    for (int u = blockIdx.x; u < NLAYER * JOBS_PER_LAYER; u += gridDim.x) {
        const int l = u / JOBS_PER_LAYER, j = u - l * JOBS_PER_LAYER;
        const float* src; bf16_t* dst; int src_ld, dst_ld;
        prep_job(p, l, j, src, src_ld, dst, dst_ld);
#pragma unroll
        for (int i = 0; i < 2; ++i) { const int idx = tid + 512 * i, k = idx >> 3, c4 = idx & 7;
            const f32x4 v = *(const f32x4*)(src + (size_t)k * src_ld + 4 * c4);
            scr[k * 33 + 4 * c4 + 0] = v[0]; scr[k * 33 + 4 * c4 + 1] = v[1]; scr[k * 33 + 4 * c4 + 2] = v[2]; scr[k * 33 + 4 * c4 + 3] = v[3]; }
        __syncthreads();
        { const int n = tid >> 4, k8 = (tid & 15) * 8; u32x4 w;
            w[0] = pk2(scr[(k8 + 0) * 33 + n], scr[(k8 + 1) * 33 + n]); w[1] = pk2(scr[(k8 + 2) * 33 + n], scr[(k8 + 3) * 33 + n]);
            w[2] = pk2(scr[(k8 + 4) * 33 + n], scr[(k8 + 5) * 33 + n]); w[3] = pk2(scr[(k8 + 6) * 33 + n], scr[(k8 + 7) * 33 + n]);
            *(u32x4*)(dst + (size_t)n * dst_ld + k8) = w; }
        __syncthreads();
    }
}

template <int MODE> DI void norm1_phase(const Params& p, int l) {
    const int lane = threadIdx.x & 63, wid = threadIdx.x >> 6;
    const float* gain = MODE == 2 ? p.norm_final : p.norm_mix + (size_t)l * DM;
    f32x4 g[4];
#pragma unroll
    for (int i = 0; i < 4; ++i) g[i] = *(const f32x4*)(gain + 4 * lane + 256 * i);
    for (int row = blockIdx.x * 8 + wid; row < NTOK; row += gridDim.x * 8) {
        const float* xr = (MODE == 0 ? p.x : P_X(p)) + (size_t)row * DM;
        f32x4 v[4];
#pragma unroll
        for (int i = 0; i < 4; ++i) v[i] = *(const f32x4*)(xr + 4 * lane + 256 * i);
        if (MODE != 0) {
            const int b = row >> 12; const int* inv = P_INV(p) + (size_t)row * NEXP;
#pragma unroll 4
            for (int e = 0; e < NEXP; ++e) {
                const int c = __builtin_amdgcn_readfirstlane(inv[e]);
                if (c >= 0) { const bf16_t* yr = P_Y(p) + (size_t)((e * NBATCH + b) * CAP + c) * DM;
#pragma unroll
                    for (int i = 0; i < 4; ++i) { const u32x2 w = *(const u32x2*)(yr + 4 * lane + 256 * i);
                        v[i][0] += bflo(w[0]); v[i][1] += bfhi(w[0]); v[i][2] += bflo(w[1]); v[i][3] += bfhi(w[1]); } }
            }
        }
        if (MODE != 2) {
#pragma unroll
            for (int i = 0; i < 4; ++i) *(f32x4*)(P_X(p) + (size_t)row * DM + 4 * lane + 256 * i) = v[i];
        }
        float ss = 0.f;
#pragma unroll
        for (int i = 0; i < 4; ++i) ss += v[i][0] * v[i][0] + v[i][1] * v[i][1] + v[i][2] * v[i][2] + v[i][3] * v[i][3];
        ss = wave_sum(ss);
        const float rstd = rsqrtf(ss * (1.0f / DM) + 1e-6f);
#pragma unroll
        for (int i = 0; i < 4; ++i) {
            const f32x4 o = v[i] * rstd * g[i];
            if (MODE == 2) *(f32x4*)(p.out + (size_t)row * DM + 4 * lane + 256 * i) = o;
            else { u32x2 w; w[0] = pk2(o[0], o[1]); w[1] = pk2(o[2], o[3]); *(u32x2*)(P_XN(p) + (size_t)row * DM + 4 * lane + 256 * i) = w; }
        }
    }
}

DI void norm2_router_phase(const Params& p, int l, LAS float* wr) {
    const int tid = threadIdx.x, lane = tid & 63, wid = tid >> 6;
    for (int i = tid; i < DM * NEXP; i += 512) wr[(i & 15) * DM + (i >> 4)] = p.w_router[(size_t)l * DM * NEXP + i];
    __syncthreads();
    const float* gain = p.norm_ffn + (size_t)l * DM;
    f32x4 g[4];
#pragma unroll
    for (int i = 0; i < 4; ++i) g[i] = *(const f32x4*)(gain + 4 * lane + 256 * i);
    for (int row = blockIdx.x * 8 + wid; row < NTOK; row += gridDim.x * 8) {
        const float* xr = P_X(p) + (size_t)row * DM;
        f32x4 v[4]; float ss = 0.f;
#pragma unroll
        for (int i = 0; i < 4; ++i) { v[i] = *(const f32x4*)(xr + 4 * lane + 256 * i); ss += v[i][0] * v[i][0] + v[i][1] * v[i][1] + v[i][2] * v[i][2] + v[i][3] * v[i][3]; }
        ss = wave_sum(ss);
        const float rstd = rsqrtf(ss * (1.0f / DM) + 1e-6f);
#pragma unroll
        for (int i = 0; i < 4; ++i) { v[i] = v[i] * rstd * g[i];
            u32x2 w; w[0] = pk2(v[i][0], v[i][1]); w[1] = pk2(v[i][2], v[i][3]); *(u32x2*)(P_XN(p) + (size_t)row * DM + 4 * lane + 256 * i) = w; }
        float mine = -1e30f;
#pragma unroll 1
        for (int e = 0; e < NEXP; ++e) { float a = 0.f;
#pragma unroll
            for (int i = 0; i < 4; ++i) { const f32x4 w = *(const LAS f32x4*)(wr + e * DM + 4 * lane + 256 * i); a += v[i][0] * w[0] + v[i][1] * w[1] + v[i][2] * w[2] + v[i][3] * w[3]; }
            a = wave_sum(a); mine = lane == e ? a : mine; }
        float m = mine;
#pragma unroll
        for (int d = 8; d >= 1; d >>= 1) m = fmaxf(m, __shfl_xor(m, d));
        const float pe = __expf(mine - m); float den = pe;
#pragma unroll
        for (int d = 8; d >= 1; d >>= 1) den += __shfl_xor(den, d);
        mine = pe / den;
        if (lane < NEXP) P_AFF(p)[((size_t)((row >> 12) * NEXP + lane)) * SEQ + (row & 4095)] = mine;
    }
}

DI void topk_phase(const Params& p, LAS unsigned* lds) {
    const int tid = threadIdx.x, lane = tid & 63, wid = tid >> 6;
    LAS unsigned* hist = lds; LAS unsigned* sh = lds + 256; LAS unsigned* wtot = lds + 272;
    for (int be = blockIdx.x; be < NBATCH * NEXP; be += gridDim.x) {
        const int b = be >> 4, e = be & 15;
        const float* aff = P_AFF(p) + (size_t)be * SEQ + tid * 8;
        const f32x4 a0 = *(const f32x4*)aff, a1 = *(const f32x4*)(aff + 4);
        unsigned key[8];
#pragma unroll
        for (int i = 0; i < 4; ++i) { key[i] = __float_as_uint(a0[i]); key[4 + i] = __float_as_uint(a1[i]); }
        unsigned prefix = 0u, mask = 0u, krem = CAP;
        for (int pass = 3; pass >= 0; --pass) {
            const int shift = 8 * pass;
            if (tid < 256) hist[tid] = 0u;
            __syncthreads();
#pragma unroll
            for (int i = 0; i < 8; ++i) if ((key[i] & mask) == prefix) atomicAdd((unsigned*)&hist[(key[i] >> shift) & 255u], 1u);
            __syncthreads();
            if (wid == 0) {
                const unsigned h0 = hist[4 * lane], h1 = hist[4 * lane + 1], h2 = hist[4 * lane + 2], h3 = hist[4 * lane + 3], s = h0 + h1 + h2 + h3;
                unsigned suf = s;
#pragma unroll
                for (int d = 1; d < 64; d <<= 1) { const unsigned t = __shfl_down(suf, d); if (lane + d < 64) suf += t; }
                const unsigned above = suf - s;
                if (above < krem && krem <= suf) {
                    unsigned a = above; unsigned bin, nk;
                    if (a + h3 >= krem) { bin = 4 * lane + 3; nk = krem - a; }
                    else { a += h3; if (a + h2 >= krem) { bin = 4 * lane + 2; nk = krem - a; }
                        else { a += h2; if (a + h1 >= krem) { bin = 4 * lane + 1; nk = krem - a; } else { a += h1; bin = 4 * lane; nk = krem - a; } } }
                    sh[0] = prefix | (bin << shift); sh[1] = nk;
                }
            }
            __syncthreads();
            prefix = sh[0]; krem = sh[1]; mask |= 0xFFu << shift;
            __syncthreads();
        }
        unsigned cg = 0u, ce = 0u;
#pragma unroll
        for (int i = 0; i < 8; ++i) { cg += key[i] > prefix ? 1u : 0u; ce += key[i] == prefix ? 1u : 0u; }
        unsigned pk = cg | (ce << 16), incl = pk;
#pragma unroll
        for (int d = 1; d < 64; d <<= 1) { const unsigned t = __shfl_up(incl, d); if (lane >= d) incl += t; }
        if (lane == 63) wtot[wid] = incl;
        __syncthreads();
        unsigned woff = 0u;
#pragma unroll
        for (int w = 0; w < 8; ++w) woff += w < wid ? wtot[w] : 0u;
        const unsigned excl = woff + incl - pk;
        unsigned gtb = excl & 0xffffu, eqb = excl >> 16;
        int* idxo = P_IDX(p) + (size_t)(e * NBATCH + b) * CAP; float* valo = P_VAL(p) + (size_t)(e * NBATCH + b) * CAP;
        int* inv = P_INV(p) + ((size_t)b * SEQ + tid * 8) * NEXP + e;
#pragma unroll
        for (int i = 0; i < 8; ++i) {
            int slot = -1;
            if (key[i] > prefix) { slot = (int)(gtb + (eqb < krem ? eqb : krem)); ++gtb; }
            else if (key[i] == prefix) { if (eqb < krem) slot = (int)(gtb + eqb); ++eqb; }
            if (slot >= 0) { idxo[slot] = tid * 8 + i; valo[slot] = __uint_as_float(key[i]); }
            inv[(size_t)i * NEXP] = slot;
        }
        __syncthreads();
    }
}

DI f32x16 zero16() { f32x16 z; for (int i = 0; i < 16; ++i) z[i] = 0.f; return z; }
DI void rgemm2(const bf16_t* ap, const bf16_t* b0p, const bf16_t* b1p, int K, f32x16& c0, f32x16& c1) {
#pragma unroll 4
    for (int k = 0; k < K; k += 16) {
        const bf16x8 a = *(const bf16x8*)(ap + k), b0 = *(const bf16x8*)(b0p + k), b1 = *(const bf16x8*)(b1p + k);
        c0 = __builtin_amdgcn_mfma_f32_32x32x16_bf16(a, b0, c0, 0, 0, 0);
        c1 = __builtin_amdgcn_mfma_f32_32x32x16_bf16(a, b1, c1, 0, 0, 0);
    }
}
DI int crow(int i, int h) { return (i & 3) + 8 * (i >> 2) + 4 * h; }
DI float sigmoidf_(float x) { return 1.0f / (1.0f + __expf(-x)); }

__global__ void __launch_bounds__(512) rk_inproj(Params p, int l) {
    const int lane = threadIdx.x & 63, r = lane & 31, h = lane >> 5;
    const bf16_t* WIN = P_W(p, l, LW_WIN); const bf16_t* WV = P_W(p, l, LW_WV);
    const int nw = gridDim.x * 8;
    for (int wt = blockIdx.x * 8 + (threadIdx.x >> 6); wt < 512 * 88; wt += nw) {
        const int job = wt % 88, m0 = (wt / 88) * 32;
        const bf16_t* ap = P_XN(p) + (size_t)(m0 + r) * DM + 8 * h;
        const bf16_t *b0, *b1;
        if (job < 20) { const int t = job >> 2, wc = job & 3; b0 = WIN + (size_t)(256 * t + 32 * wc + r) * DM + 8 * h; b1 = b0 + (size_t)128 * DM; }
        else if (job < 28) { b0 = WIN + (size_t)(1280 + 64 * (job - 20) + r) * DM + 8 * h; b1 = b0 + (size_t)32 * DM; }
        else if (job < 40) { b0 = WV + (size_t)(64 * (job - 28) + r) * DM + 8 * h; b1 = b0 + (size_t)32 * DM; }
        else { b0 = WIN + (size_t)(1792 + 64 * (job - 40) + r) * DM + 8 * h; b1 = b0 + (size_t)32 * DM; }
        f32x16 c0 = zero16(), c1 = zero16();
        rgemm2(ap, b0, b1, DM, c0, c1);
#pragma unroll
        for (int i = 0; i < 16; ++i) {
            const int row = m0 + crow(i, h), pos = row & 4095;
            if (job < 20) {
                const float cs = P_COS(p)[pos * 32 + r], sn = P_SIN(p)[pos * 32 + r];
                float o1 = c0[i] * cs - c1[i] * sn, o2 = c1[i] * cs + c0[i] * sn;
                if (job < 6 || (job >= 8 && job < 14)) { o1 *= 0.125f; o2 *= 0.125f; }
                P_QK(p)[(size_t)row * QKW + 64 * job + r] = (bf16_t)f2bf(o1); P_QK(p)[(size_t)row * QKW + 64 * job + 32 + r] = (bf16_t)f2bf(o2);
            } else if (job < 28) {
                const float sc = job < 24 ? 0.125f : 1.0f; const int col = 1280 + 64 * (job - 20) + r;
                P_QK(p)[(size_t)row * QKW + col] = (bf16_t)f2bf(c0[i] * sc); P_QK(p)[(size_t)row * QKW + col + 32] = (bf16_t)f2bf(c1[i] * sc);
            } else if (job < 40) {
                const int ch = 64 * (job - 28) + r; const int slot = ch < 512 ? row : (row & ~4095) + pos16(pos);
                P_VT(p)[(size_t)ch * NTOK + slot] = (bf16_t)f2bf(c0[i]); P_VT(p)[(size_t)(ch + 32) * NTOK + slot] = (bf16_t)f2bf(c1[i]);
            } else {
                const int col = 64 * (job - 40) + r; const float* bg = p.b_gate + (size_t)l * 3072;
                P_G(p)[(size_t)row * 3072 + col] = (bf16_t)f2bf(sigmoidf_(c0[i] + bg[col])); P_G(p)[(size_t)row * 3072 + col + 32] = (bf16_t)f2bf(sigmoidf_(c1[i] + bg[col + 32]));
            }
        }
    }
}
__global__ void __launch_bounds__(512) rk_merge(Params p, int l) {
    const int lane = threadIdx.x & 63, r = lane & 31, h = lane >> 5;
    const bf16_t* WM = P_W(p, l, LW_WM);
    for (int wt = blockIdx.x * 8 + (threadIdx.x >> 6); wt < 512 * 16; wt += gridDim.x * 8) {
        const int n0 = (wt & 15) * 64, m0 = (wt >> 4) * 32;
        float m0a[16], m1a[16];
#pragma unroll
        for (int i = 0; i < 16; ++i) { m0a[i] = 0.f; m1a[i] = 0.f; }
#pragma unroll 1
        for (int br = 0; br < 3; ++br) {
            const int k0 = br == 0 ? 0 : br == 1 ? 384 : 512, K = br == 0 ? 384 : br == 1 ? 128 : 256;
            f32x16 c0 = zero16(), c1 = zero16();
            rgemm2(P_OC(p) + (size_t)(m0 + r) * OCW + k0 + 8 * h, WM + (size_t)(n0 + r) * 768 + k0 + 8 * h, WM + (size_t)(n0 + 32 + r) * 768 + k0 + 8 * h, K, c0, c1);
#pragma unroll
            for (int i = 0; i < 16; ++i) { const int row = m0 + crow(i, h); const bf16_t* gp = P_G(p) + (size_t)row * 3072 + 1024 * br + n0 + r;
                m0a[i] += bf2f(gp[0]) * c0[i]; m1a[i] += bf2f(gp[32]) * c1[i]; }
        }
#pragma unroll
        for (int i = 0; i < 16; ++i) { const int row = m0 + crow(i, h); P_MG(p)[(size_t)row * DM + n0 + r] = (bf16_t)f2bf(m0a[i]); P_MG(p)[(size_t)row * DM + n0 + 32 + r] = (bf16_t)f2bf(m1a[i]); }
    }
}
__global__ void __launch_bounds__(512) rk_out(Params p, int l) {
    const int lane = threadIdx.x & 63, r = lane & 31, h = lane >> 5;
    const bf16_t* WO = P_W(p, l, LW_WO);
    for (int wt = blockIdx.x * 8 + (threadIdx.x >> 6); wt < 512 * 16; wt += gridDim.x * 8) {
        const int n0 = (wt & 15) * 64, m0 = (wt >> 4) * 32;
        f32x16 c0 = zero16(), c1 = zero16();
        rgemm2(P_MG(p) + (size_t)(m0 + r) * DM + 8 * h, WO + (size_t)(n0 + r) * DM + 8 * h, WO + (size_t)(n0 + 32 + r) * DM + 8 * h, DM, c0, c1);
#pragma unroll
        for (int i = 0; i < 16; ++i) { float* xp = P_X(p) + (size_t)(m0 + crow(i, h)) * DM + n0 + r; xp[0] += c0[i]; xp[32] += c1[i]; }
    }
}
__global__ void __launch_bounds__(512) rk_moe1(Params p, int l) {
    const int lane = threadIdx.x & 63, r = lane & 31, h = lane >> 5;
    const bf16_t* WGU = P_W(p, l, LW_WGU);
    for (int wt = blockIdx.x * 8 + (threadIdx.x >> 6); wt < 1024 * 64; wt += gridDim.x * 8) {
        const int j0 = (wt & 63) * 32, m0 = (wt >> 6) * 32, e = m0 >> 11, b = (m0 >> 9) & 3;
        const int tok = b * SEQ + P_IDX(p)[m0 + r];
        const bf16_t* b0 = WGU + ((size_t)e * 4096 + 256 * (j0 >> 7) + (j0 & 127) + r) * DM + 8 * h;
        f32x16 c0 = zero16(), c1 = zero16();
        rgemm2(P_XN(p) + (size_t)tok * DM + 8 * h, b0, b0 + (size_t)128 * DM, DM, c0, c1);
#pragma unroll
        for (int i = 0; i < 16; ++i) { const float g = c0[i], u = c1[i]; P_HID(p)[(size_t)(m0 + crow(i, h)) * FF + j0 + r] = (bf16_t)f2bf(g * sigmoidf_(g) * u); }
    }
}
__global__ void __launch_bounds__(512) rk_moe2(Params p, int l) {
    const int lane = threadIdx.x & 63, r = lane & 31, h = lane >> 5;
    const bf16_t* WD = P_W(p, l, LW_WD);
    for (int wt = blockIdx.x * 8 + (threadIdx.x >> 6); wt < 1024 * 16; wt += gridDim.x * 8) {
        const int n0 = (wt & 15) * 64, m0 = (wt >> 4) * 32, e = m0 >> 11;
        const bf16_t* b0 = WD + ((size_t)e * 1024 + n0 + r) * FF + 8 * h;
        f32x16 c0 = zero16(), c1 = zero16();
        rgemm2(P_HID(p) + (size_t)(m0 + r) * FF + 8 * h, b0, b0 + (size_t)32 * FF, FF, c0, c1);
#pragma unroll
        for (int i = 0; i < 16; ++i) { const int row = m0 + crow(i, h); const float v = P_VAL(p)[row];
            P_Y(p)[(size_t)row * DM + n0 + r] = (bf16_t)f2bf(c0[i] * v); P_Y(p)[(size_t)row * DM + n0 + 32 + r] = (bf16_t)f2bf(c1[i] * v); }
    }
}

DI void ld64(const bf16_t* src, float (&q)[64]) {
#pragma unroll
    for (int c = 0; c < 8; ++c) { const u32x4 w = *(const u32x4*)(src + 8 * c);
#pragma unroll
        for (int j = 0; j < 4; ++j) { q[8 * c + 2 * j] = bflo(w[j]); q[8 * c + 2 * j + 1] = bfhi(w[j]); } }
}
DI float dot64(const bf16_t* kp, const float (&q)[64]) {
    float s = 0.f;
#pragma unroll
    for (int c = 0; c < 8; ++c) { const u32x4 w = *(const u32x4*)(kp + 8 * c);
#pragma unroll
        for (int j = 0; j < 4; ++j) { s += q[8 * c + 2 * j] * bflo(w[j]); s += q[8 * c + 2 * j + 1] * bfhi(w[j]); } }
    return s;
}
__global__ void __launch_bounds__(256) rk_attn(Params p, int l) {
    const int item = blockIdx.x * 256 + threadIdx.x;
    const int hd16 = item >> 14, tok = item & 16383, b = tok >> 12, t = tok & 4095;
    const bf16_t* QK = P_QK(p); const bf16_t* VT = P_VT(p);
    float q[64], o[64];
#pragma unroll
    for (int d = 0; d < 64; ++d) o[d] = 0.f;
    float m = -1e30f, den = 0.f;
    int qcol, kcol, vch; bool perm = false;
    if (hd16 < 6) { qcol = 64 * hd16; kcol = 384 + 64 * (hd16 / 3); vch = 64 * (hd16 / 3); }
    else if (hd16 < 12) { const int g = (hd16 - 6) >> 1, hs = (hd16 - 6) & 1; qcol = 512 + 128 * g + 64 * hs; kcol = 896 + 128 * g + 64 * hs;
        vch = g == 0 ? 128 + 64 * hs : g == 1 ? 512 + 64 * hs : 640 + 64 * hs; perm = g > 0; }
    else { const int hh = hd16 - 12; qcol = 1280 + 64 * hh; kcol = 1536 + 64 * hh; vch = 256 + 64 * hh; }
    ld64(QK + (size_t)tok * QKW + qcol, q);
    auto visit = [&](int t2, float bias) {
        const float s = dot64(QK + (size_t)(b * SEQ + t2) * QKW + kcol, q) + bias;
        const float mn = fmaxf(m, s), al = __expf(m - mn), pe = __expf(s - mn);
        den = den * al + pe; m = mn;
        const bf16_t* vp = VT + (size_t)vch * NTOK + b * SEQ + (perm ? pos16(t2) : t2);
#pragma unroll
        for (int d = 0; d < 64; ++d) o[d] = o[d] * al + pe * bf2f(vp[(size_t)d * NTOK]);
    };
    if (hd16 < 6) {
        const int lo = t - 128 < 0 ? 0 : t - 128, hi = t + 128 > 4095 ? 4095 : t + 128;
        for (int t2 = lo; t2 <= hi; ++t2) visit(t2, 0.f);
        const float sk = p.sink[l * 6 + hd16], mn = fmaxf(m, sk), al = __expf(m - mn);
        den = den * al + __expf(sk - mn);
#pragma unroll
        for (int d = 0; d < 64; ++d) o[d] *= al;
        m = mn;
    } else if (hd16 < 12) {
        const int g = (hd16 - 6) >> 1, dil = g == 0 ? 1 : g == 1 ? 4 : 16;
        for (int rr = -64; rr <= 64; ++rr) { const int t2 = t + dil * rr; if (t2 >= 0 && t2 < SEQ) visit(t2, 0.f); }
    } else {
        const int hh = hd16 - 12, qr = t >> 6, qc = t & 63;
        const int sr = qr - 4 < 0 ? 0 : qr - 4 > 56 ? 56 : qr - 4, sc = qc - 8 < 0 ? 0 : qc - 8 > 48 ? 48 : qc - 8;
        const float* rp = p.rpb + (size_t)(l * 4 + hh) * 15 * 31;
        for (int j = 0; j < 8; ++j) for (int k = 0; k < 16; ++k) { const int kr = sr + j, kc = sc + k; visit(kr * 64 + kc, rp[(kr - qr + 7) * 31 + (kc - qc + 15)]); }
    }
    const float rd = 1.0f / den;
    if (hd16 >= 6 && hd16 < 12) {
        const int g = (hd16 - 6) >> 1, hs = (hd16 - 6) & 1;
        bf16_t* op = P_OB3(p) + ((size_t)g * NTOK + tok) * 128 + 64 * hs;
#pragma unroll
        for (int d = 0; d < 64; d += 2) *(unsigned*)(op + d) = pk2(o[d] * rd, o[d + 1] * rd);
        P_LSE(p)[((size_t)g * NTOK + tok) * 2 + hs] = m + __logf(den);
    } else {
        bf16_t* op = P_OC(p) + (size_t)tok * OCW + (hd16 < 6 ? 64 * hd16 : 512 + 64 * (hd16 - 12));
#pragma unroll
        for (int d = 0; d < 64; d += 2) *(unsigned*)(op + d) = pk2(o[d] * rd, o[d + 1] * rd);
    }
}
DI void bcombine_phase(const Params& p) {
    for (int i = blockIdx.x * 512 + threadIdx.x; i < NTOK * 16; i += gridDim.x * 512) {
        const int tok = i >> 4, part = i & 15, hs = part >> 3, d0 = (part & 7) * 8;
        const float l0 = P_LSE(p)[((size_t)0 * NTOK + tok) * 2 + hs], l1 = P_LSE(p)[((size_t)1 * NTOK + tok) * 2 + hs], l2 = P_LSE(p)[((size_t)2 * NTOK + tok) * 2 + hs];
        const float mx = fmaxf(l0, fmaxf(l1, l2)), e0 = __expf(l0 - mx), e1 = __expf(l1 - mx), e2 = __expf(l2 - mx), rs = 1.0f / (e0 + e1 + e2);
        const float a0 = e0 * rs, a1 = e1 * rs, a2 = e2 * rs;
        const u32x4 w0 = *(const u32x4*)(P_OB3(p) + ((size_t)0 * NTOK + tok) * 128 + 64 * hs + d0);
        const u32x4 w1 = *(const u32x4*)(P_OB3(p) + ((size_t)1 * NTOK + tok) * 128 + 64 * hs + d0);
        const u32x4 w2 = *(const u32x4*)(P_OB3(p) + ((size_t)2 * NTOK + tok) * 128 + 64 * hs + d0);
        u32x4 o;
#pragma unroll
        for (int j = 0; j < 4; ++j) o[j] = pk2(a0 * bflo(w0[j]) + a1 * bflo(w1[j]) + a2 * bflo(w2[j]), a0 * bfhi(w0[j]) + a1 * bfhi(w1[j]) + a2 * bfhi(w2[j]));
        *(u32x4*)(P_OC(p) + (size_t)tok * OCW + 384 + 64 * hs + d0) = o;
    }
}

__global__ void __launch_bounds__(512) k_prep(Params p) { __shared__ float scr[128 * 33]; prep_phase(p, (LAS float*)scr); }
__global__ void __launch_bounds__(512) k_norm1_0(Params p, int l) { norm1_phase<0>(p, l); }
__global__ void __launch_bounds__(512) k_norm1_1(Params p, int l) { norm1_phase<1>(p, l); }
__global__ void __launch_bounds__(512) k_norm1_2(Params p, int l) { norm1_phase<2>(p, l); }
__global__ void __launch_bounds__(512) k_norm2(Params p, int l) { __shared__ float wr[DM * NEXP]; norm2_router_phase(p, l, (LAS float*)wr); }
__global__ void __launch_bounds__(512) k_topk(Params p) { __shared__ unsigned sm[512]; topk_phase(p, (LAS unsigned*)sm); }
__global__ void __launch_bounds__(512) k_bcomb(Params p) { bcombine_phase(p); }

extern "C" void kernel_launch(void* const* d_in, const int* in_sizes, int n_in, void* d_out, int out_size, void* d_ws, size_t ws_size, hipStream_t stream) {
    (void)in_sizes; (void)n_in; (void)out_size; (void)ws_size;
    Params p{};
    p.x = (const float*)d_in[0]; p.w_in = (const float*)d_in[1]; p.b_gate = (const float*)d_in[2]; p.sink = (const float*)d_in[3]; p.rpb = (const float*)d_in[4];
    p.w_a = (const float*)d_in[5]; p.w_b = (const float*)d_in[6]; p.w_c = (const float*)d_in[7]; p.w_out = (const float*)d_in[8]; p.norm_mix = (const float*)d_in[9];
    p.norm_ffn = (const float*)d_in[10]; p.w_router = (const float*)d_in[11]; p.w_gate_e = (const float*)d_in[12]; p.w_up_e = (const float*)d_in[13]; p.w_down_e = (const float*)d_in[14];
    p.norm_final = (const float*)d_in[15]; p.out = (float*)d_out; p.ws = (unsigned char*)d_ws;
    const dim3 blk(512);
    k_prep<<<1024, blk, 0, stream>>>(p);
    for (int l = 0; l < NLAYER; ++l) {
        if (l == 0) k_norm1_0<<<512, blk, 0, stream>>>(p, l); else k_norm1_1<<<512, blk, 0, stream>>>(p, l);
        rk_inproj<<<1024, blk, 0, stream>>>(p, l);
        rk_attn<<<16 * NTOK / 256, 256, 0, stream>>>(p, l);
        k_bcomb<<<256, blk, 0, stream>>>(p);
        rk_merge<<<1024, blk, 0, stream>>>(p, l);
        rk_out<<<1024, blk, 0, stream>>>(p, l);
        k_norm2<<<256, blk, 0, stream>>>(p, l);
        k_topk<<<64, blk, 0, stream>>>(p);
        rk_moe1<<<1024, blk, 0, stream>>>(p, l);
        rk_moe2<<<1024, blk, 0, stream>>>(p, l);
    }
    k_norm1_2<<<512, blk, 0, stream>>>(p, 0);
}
```

```cpp
#include <hip/hip_runtime.h>
#include <stdint.h>

#define DI __device__ __forceinline__
#define LAS __attribute__((address_space(3)))
typedef unsigned short bf16_t;
typedef short bf16x8 __attribute__((ext_vector_type(8)));
typedef float f32x2 __attribute__((ext_vector_type(2)));
typedef float f32x4 __attribute__((ext_vector_type(4)));
typedef float f32x16 __attribute__((ext_vector_type(16)));
typedef unsigned u32x2 __attribute__((ext_vector_type(2)));
typedef unsigned u32x4 __attribute__((ext_vector_type(4)));

constexpr int NTOK = 16384, DM = 1024, SEQ = 4096, NBATCH = 4, NLAYER = 4, NEXP = 16, FF = 2048, CAP = 512, PROJ = 5632;
constexpr int QKW = 1792;
constexpr int VCH = 768;
constexpr int OCW = 768;
constexpr int NROWS_E = NBATCH * CAP * NEXP;

constexpr size_t OFF_CTL = 0;
constexpr size_t OFF_COS = 65536;
constexpr size_t OFF_SIN = OFF_COS + (size_t)SEQ * 32 * 4;
constexpr size_t OFF_W   = 2u << 20;
constexpr size_t WIN_B = (size_t)4864 * 1024 * 2, WV_B = (size_t)768 * 1024 * 2, WM_B = (size_t)1024 * 768 * 2, WO_B = (size_t)1024 * 1024 * 2;
constexpr size_t WGU_B = (size_t)NEXP * 4096 * 1024 * 2, WD_B = (size_t)NEXP * 1024 * 2048 * 2;
constexpr size_t LW_WIN = 0, LW_WV = LW_WIN + WIN_B, LW_WM = LW_WV + WV_B, LW_WO = LW_WM + WM_B, LW_WGU = LW_WO + WO_B, LW_WD = LW_WGU + WGU_B, LW = LW_WD + WD_B;
constexpr size_t OFF_X   = OFF_W + NLAYER * LW;
constexpr size_t OFF_XN  = OFF_X + (size_t)NTOK * DM * 4;
constexpr size_t OFF_QK  = OFF_XN + (size_t)NTOK * DM * 2;
constexpr size_t OFF_VT  = OFF_QK + (size_t)NTOK * QKW * 2;
constexpr size_t OFF_G   = OFF_VT + (size_t)VCH * NTOK * 2;
constexpr size_t OFF_OC  = OFF_G + (size_t)NTOK * 3072 * 2;
constexpr size_t OFF_OB3 = OFF_OC + (size_t)NTOK * OCW * 2;
constexpr size_t OFF_LSE = OFF_OB3 + (size_t)3 * NTOK * 128 * 2;
constexpr size_t OFF_MG  = OFF_LSE + (size_t)3 * NTOK * 2 * 4;
constexpr size_t OFF_AFF = OFF_MG + (size_t)NTOK * DM * 2;
constexpr size_t OFF_IDX = OFF_AFF + (size_t)NTOK * NEXP * 4;
constexpr size_t OFF_VAL = OFF_IDX + (size_t)NROWS_E * 4;
constexpr size_t OFF_INV = OFF_VAL + (size_t)NROWS_E * 4;
constexpr size_t OFF_HID = OFF_INV + (size_t)NTOK * NEXP * 4;
constexpr size_t OFF_Y   = OFF_HID + (size_t)NROWS_E * FF * 2;
constexpr size_t OFF_XN8 = OFF_Y + (size_t)NROWS_E * DM * 2;
constexpr size_t OFF_END = OFF_XN8 + (size_t)NTOK * DM;

struct Params {
    const float *x, *w_in, *b_gate, *sink, *rpb, *w_a, *w_b, *w_c, *w_out, *norm_mix, *norm_ffn, *w_router, *w_gate_e, *w_up_e, *w_down_e, *norm_final;
    float* out; unsigned char* ws;
};
DI float*  P_COS(const Params& p) { return (float*)(p.ws + OFF_COS); }
DI float*  P_SIN(const Params& p) { return (float*)(p.ws + OFF_SIN); }
DI bf16_t* P_W(const Params& p, int l, size_t off) { return (bf16_t*)(p.ws + OFF_W + (size_t)l * LW + off); }
DI float*  P_X(const Params& p) { return (float*)(p.ws + OFF_X); }
DI bf16_t* P_XN(const Params& p) { return (bf16_t*)(p.ws + OFF_XN); }
DI bf16_t* P_QK(const Params& p) { return (bf16_t*)(p.ws + OFF_QK); }
DI bf16_t* P_VT(const Params& p) { return (bf16_t*)(p.ws + OFF_VT); }
DI bf16_t* P_G(const Params& p) { return (bf16_t*)(p.ws + OFF_G); }
DI bf16_t* P_OC(const Params& p) { return (bf16_t*)(p.ws + OFF_OC); }
DI bf16_t* P_OB3(const Params& p) { return (bf16_t*)(p.ws + OFF_OB3); }
DI float*  P_LSE(const Params& p) { return (float*)(p.ws + OFF_LSE); }
DI bf16_t* P_MG(const Params& p) { return (bf16_t*)(p.ws + OFF_MG); }
DI float*  P_AFF(const Params& p) { return (float*)(p.ws + OFF_AFF); }
DI int*    P_IDX(const Params& p) { return (int*)(p.ws + OFF_IDX); }
DI float*  P_VAL(const Params& p) { return (float*)(p.ws + OFF_VAL); }
DI int*    P_INV(const Params& p) { return (int*)(p.ws + OFF_INV); }
DI bf16_t* P_HID(const Params& p) { return (bf16_t*)(p.ws + OFF_HID); }
DI bf16_t* P_Y(const Params& p) { return (bf16_t*)(p.ws + OFF_Y); }
DI unsigned char* P_XN8(const Params& p) { return p.ws + OFF_XN8; }

DI unsigned f2bf(float f) { unsigned u = __float_as_uint(f); return (u + 0x7fffu + ((u >> 16) & 1u)) >> 16; }
DI unsigned pk2(float lo, float hi) { return f2bf(lo) | (f2bf(hi) << 16); }
constexpr float W8_SCALE = 32.0f, H8_SCALE = 4.0f;
DI unsigned pk4_fp8(float a, float b, float c, float d) { unsigned w = 0u; w = __builtin_amdgcn_cvt_pk_fp8_f32(a, b, w, false); w = __builtin_amdgcn_cvt_pk_fp8_f32(c, d, w, true); return w; }
DI float bf2f(unsigned b) { return __uint_as_float(b << 16); }
DI float bflo(unsigned w) { return __uint_as_float(w << 16); }
DI float bfhi(unsigned w) { return __uint_as_float(w & 0xffff0000u); }
DI float shx(float v, int d, int lane) { return __uint_as_float((unsigned)__builtin_amdgcn_ds_bpermute((lane ^ d) << 2, (int)__float_as_uint(v))); }
DI unsigned shl_abs(unsigned v, int src_lane) { return (unsigned)__builtin_amdgcn_ds_bpermute(src_lane << 2, (int)v); }
DI int otid() { int t = threadIdx.x; asm volatile("" : "+v"(t)); return t; }
DI int pos16(int t) { return ((t & 15) << 8) | (t >> 4); }

constexpr int JOBS_PER_LAYER = 26432;
DI void prep_job(const Params& p, int l, int j, const float*& src, int& src_ld, bf16_t*& dst, int& dst_ld) {
    if (j < 1216) {
        const int nblk = j >> 3, kc = j & 7; int sc;
        if (nblk < 40) { const int t = nblk >> 3, sb = nblk & 7, bj = sb >> 2, wc = sb & 3, hr = 4 * t + wc;
            const int base = hr < 6 ? 64 * hr : hr < 8 ? 384 + 64 * (hr - 6) : hr < 14 ? 640 + 64 * (hr - 8) : 1024 + 64 * (hr - 14);
            sc = base + 32 * bj; }
        else if (nblk < 56) { const int c = 32 * (nblk - 40); sc = c < 256 ? 1792 + c : 2048 + (c - 256); }
        else sc = 2560 + 32 * (nblk - 56);
        src = p.w_in + (size_t)l * DM * PROJ + (size_t)(128 * kc) * PROJ + sc; src_ld = PROJ;
        dst = P_W(p, l, LW_WIN) + (size_t)(32 * nblk) * 1024 + 128 * kc; dst_ld = 1024; return;
    }
    j -= 1216;
    if (j < 192) {
        const int nblk = j >> 3, kc = j & 7, ch = 32 * nblk;
        const int sc = ch < 128 ? 512 + ch : ch < 256 ? 1408 + (ch - 128) : ch < 512 ? 2304 + (ch - 256) : 1536 + (ch - 512);
        src = p.w_in + (size_t)l * DM * PROJ + (size_t)(128 * kc) * PROJ + sc; src_ld = PROJ;
        dst = P_W(p, l, LW_WV) + (size_t)ch * 1024 + 128 * kc; dst_ld = 1024; return;
    }
    j -= 192;
    if (j < 192) {
        bf16_t* wm = P_W(p, l, LW_WM); src_ld = 1024; dst_ld = 768;
        if (j < 96) { const int nblk = j / 3, kc = j % 3; src = p.w_a + (size_t)l * 384 * 1024 + (size_t)(128 * kc) * 1024 + 32 * nblk; dst = wm + (size_t)(32 * nblk) * 768 + 128 * kc; }
        else if (j < 128) { const int nblk = j - 96; src = p.w_b + (size_t)l * 128 * 1024 + 32 * nblk; dst = wm + (size_t)(32 * nblk) * 768 + 384; }
        else { const int jj = j - 128, nblk = jj >> 1, kc = jj & 1; src = p.w_c + (size_t)l * 256 * 1024 + (size_t)(128 * kc) * 1024 + 32 * nblk; dst = wm + (size_t)(32 * nblk) * 768 + 512 + 128 * kc; }
        return;
    }
    j -= 192;
    if (j < 256) {
        const int nblk = j >> 3, kc = j & 7;
        src = p.w_out + (size_t)l * 1024 * 1024 + (size_t)(128 * kc) * 1024 + 32 * nblk; src_ld = 1024;
        dst = P_W(p, l, LW_WO) + (size_t)(32 * nblk) * 1024 + 128 * kc; dst_ld = 1024; return;
    }
    j -= 256;
    if (j < 16384) {
        const int e = j >> 10, r = j & 1023, nblk = r >> 3, kc = r & 7, row0 = 32 * nblk, pp = row0 >> 8, s = row0 & 255;
        const float* w = s < 128 ? p.w_gate_e : p.w_up_e; const int col = 128 * pp + (s & 127);
        src = w + ((size_t)(l * NEXP + e) * 1024 + 128 * kc) * 2048 + col; src_ld = 2048;
        dst = (bf16_t*)((unsigned char*)P_W(p, l, LW_WGU) + ((size_t)e * 4096 + row0) * 1024 + 128 * kc); dst_ld = 1024; return;
    }
    j -= 16384;
    {
        const int e = j >> 9, r = j & 511, nblk = r >> 4, kc = r & 15;
        src = p.w_down_e + ((size_t)(l * NEXP + e) * 2048 + 128 * kc) * 1024 + 32 * nblk; src_ld = 1024;
        dst = (bf16_t*)((unsigned char*)P_W(p, l, LW_WD) + ((size_t)e * 1024 + 32 * nblk) * 2048 + 128 * kc); dst_ld = 2048;
    }
}
DI void sincos_d(double a, double& s, double& c) {
    const double q = rint(a * 0.63661977236758134308);
    double r = fma(-q, 1.57079632679489655800e+00, a); r = fma(-q, 6.12323399573676603587e-17, r);
    const double r2 = r * r;
    double sp = 1.58969099521155010221e-10; sp = fma(sp, r2, -2.50507602534068634195e-08); sp = fma(sp, r2, 2.75573137070700676789e-06); sp = fma(sp, r2, -1.98412698298579493134e-04);
    sp = fma(sp, r2, 8.33333333332248946124e-03); sp = fma(sp, r2, -1.66666666666666324348e-01); const double sr = fma(r * r2, sp, r);
    double cp = -1.13596475577881948265e-11; cp = fma(cp, r2, 2.08757232129817482790e-09); cp = fma(cp, r2, -2.75573143513906633035e-07); cp = fma(cp, r2, 2.48015872894767294178e-05);
    cp = fma(cp, r2, -1.38888888888741095749e-03); cp = fma(cp, r2, 4.16666666666666019037e-02); const double cr = fma(r2 * r2, cp, fma(-0.5, r2, 1.0));
    const int qi = ((int)q) & 3;
    s = qi == 0 ? sr : qi == 1 ? cr : qi == 2 ? -sr : -cr;
    c = qi == 0 ? cr : qi == 1 ? -sr : qi == 2 ? -cr : sr;
}
DI void prep_phase(const Params& p, LAS float* scr) {
    const int tid = otid();
    for (int i = blockIdx.x * 512 + tid; i < SEQ * 32; i += gridDim.x * 512) {
        const int pos = i >> 5, j = i & 31;
        double fr = 1.0; for (int jj = 0; jj < j; ++jj) fr *= 0.7498942093324559;
        const float invf = (float)fr;
        const float ang = (float)pos * invf; double s, c; sincos_d((double)ang, s, c);
        P_COS(p)[i] = (float)c; P_SIN(p)[i] = (float)s;
    }
    const int total = NLAYER * JOBS_PER_LAYER;
    int u = blockIdx.x;
    const float* src; bf16_t* dst; int src_ld, dst_ld, j = 0;
    f32x4 r0, r1;
    if (u < total) { const int l = u / JOBS_PER_LAYER; j = u - l * JOBS_PER_LAYER; prep_job(p, l, j, src, src_ld, dst, dst_ld);
        r0 = *(const f32x4*)(src + (size_t)(tid >> 3) * src_ld + 4 * (tid & 7)); r1 = *(const f32x4*)(src + (size_t)((tid + 512) >> 3) * src_ld + 4 * (tid & 7)); }
    int buf = 0;
    for (; u < total; u += gridDim.x) {
        LAS float* sc = scr + buf * (128 * 33);
        { const int k = tid >> 3, c4 = tid & 7;
          sc[k * 33 + 4 * c4 + 0] = r0[0]; sc[k * 33 + 4 * c4 + 1] = r0[1]; sc[k * 33 + 4 * c4 + 2] = r0[2]; sc[k * 33 + 4 * c4 + 3] = r0[3];
          sc[(k + 64) * 33 + 4 * c4 + 0] = r1[0]; sc[(k + 64) * 33 + 4 * c4 + 1] = r1[1]; sc[(k + 64) * 33 + 4 * c4 + 2] = r1[2]; sc[(k + 64) * 33 + 4 * c4 + 3] = r1[3]; }
        bf16_t* dcur = dst; const int dld = dst_ld, jcur = j;
        const int un = u + gridDim.x;
        if (un < total) { const int l = un / JOBS_PER_LAYER; j = un - l * JOBS_PER_LAYER; prep_job(p, l, j, src, src_ld, dst, dst_ld);
            r0 = *(const f32x4*)(src + (size_t)(tid >> 3) * src_ld + 4 * (tid & 7)); r1 = *(const f32x4*)(src + (size_t)((tid + 512) >> 3) * src_ld + 4 * (tid & 7)); }
        __syncthreads();
        { const int n = tid >> 4, k8 = (tid & 15) * 8;
          if (jcur >= 1856) {
            u32x2 w; w[0] = pk4_fp8(sc[(k8 + 0) * 33 + n] * W8_SCALE, sc[(k8 + 1) * 33 + n] * W8_SCALE, sc[(k8 + 2) * 33 + n] * W8_SCALE, sc[(k8 + 3) * 33 + n] * W8_SCALE);
            w[1] = pk4_fp8(sc[(k8 + 4) * 33 + n] * W8_SCALE, sc[(k8 + 5) * 33 + n] * W8_SCALE, sc[(k8 + 6) * 33 + n] * W8_SCALE, sc[(k8 + 7) * 33 + n] * W8_SCALE);
            *(u32x2*)((unsigned char*)dcur + (size_t)n * dld + k8) = w;
          } else { u32x4 w;
            w[0] = pk2(sc[(k8 + 0) * 33 + n], sc[(k8 + 1) * 33 + n]); w[1] = pk2(sc[(k8 + 2) * 33 + n], sc[(k8 + 3) * 33 + n]);
            w[2] = pk2(sc[(k8 + 4) * 33 + n], sc[(k8 + 5) * 33 + n]); w[3] = pk2(sc[(k8 + 6) * 33 + n], sc[(k8 + 7) * 33 + n]);
            *(u32x4*)(dcur + (size_t)n * dld + k8) = w; } }
        buf ^= 1;
    }
    __syncthreads();
}

template <int MODE> DI void norm1_phase(const Params& p, int l) {
    const int tid = otid(), lane = tid & 63, wid = tid >> 6;
    const float* gain = MODE == 2 ? p.norm_final : p.norm_mix + (size_t)l * DM;
    f32x4 g[4];
#pragma unroll
    for (int i = 0; i < 4; ++i) g[i] = *(const f32x4*)(gain + 4 * lane + 256 * i);
    const float* xin = MODE == 0 ? p.x : P_X(p);
    const int nw = gridDim.x * 8;
    for (int row0 = blockIdx.x * 8 + wid; row0 < NTOK; row0 += 2 * nw) {
        const int row1 = row0 + nw;
        f32x4 v0[4], v1[4];
#pragma unroll
        for (int i = 0; i < 4; ++i) { v0[i] = *(const f32x4*)(xin + (size_t)row0 * DM + 4 * lane + 256 * i); v1[i] = *(const f32x4*)(xin + (size_t)row1 * DM + 4 * lane + 256 * i); }
        if (MODE != 0) {
            const int c0 = lane < NEXP ? P_INV(p)[(size_t)row0 * NEXP + lane] : -1, c1 = lane < NEXP ? P_INV(p)[(size_t)row1 * NEXP + lane] : -1;
            unsigned long long m0 = __ballot(c0 >= 0), m1 = __ballot(c1 >= 0);
            const bf16_t* ybase0 = P_Y(p) + (size_t)((row0 >> 12) * CAP) * DM; const bf16_t* ybase1 = P_Y(p) + (size_t)((row1 >> 12) * CAP) * DM;
            while (m0 | m1) {
                u32x2 w0[4], w1[4]; const bool h0 = m0 != 0ull, h1 = m1 != 0ull;
                if (h0) { const int e = __builtin_ctzll(m0); m0 &= m0 - 1ull; const int c = __builtin_amdgcn_readlane(c0, e); const bf16_t* yr = ybase0 + (size_t)(e * NBATCH * CAP + c) * DM;
#pragma unroll
                    for (int i = 0; i < 4; ++i) w0[i] = *(const u32x2*)(yr + 4 * lane + 256 * i); }
                if (h1) { const int e = __builtin_ctzll(m1); m1 &= m1 - 1ull; const int c = __builtin_amdgcn_readlane(c1, e); const bf16_t* yr = ybase1 + (size_t)(e * NBATCH * CAP + c) * DM;
#pragma unroll
                    for (int i = 0; i < 4; ++i) w1[i] = *(const u32x2*)(yr + 4 * lane + 256 * i); }
                if (h0) {
#pragma unroll
                    for (int i = 0; i < 4; ++i) { v0[i][0] += bflo(w0[i][0]); v0[i][1] += bfhi(w0[i][0]); v0[i][2] += bflo(w0[i][1]); v0[i][3] += bfhi(w0[i][1]); } }
                if (h1) {
#pragma unroll
                    for (int i = 0; i < 4; ++i) { v1[i][0] += bflo(w1[i][0]); v1[i][1] += bfhi(w1[i][0]); v1[i][2] += bflo(w1[i][1]); v1[i][3] += bfhi(w1[i][1]); } }
            }
        }
        if (MODE != 2) {
#pragma unroll
            for (int i = 0; i < 4; ++i) { *(f32x4*)(P_X(p) + (size_t)row0 * DM + 4 * lane + 256 * i) = v0[i]; *(f32x4*)(P_X(p) + (size_t)row1 * DM + 4 * lane + 256 * i) = v1[i]; }
        }
        float s0 = 0.f, s1 = 0.f;
#pragma unroll
        for (int i = 0; i < 4; ++i) { s0 += v0[i][0] * v0[i][0] + v0[i][1] * v0[i][1] + v0[i][2] * v0[i][2] + v0[i][3] * v0[i][3]; s1 += v1[i][0] * v1[i][0] + v1[i][1] * v1[i][1] + v1[i][2] * v1[i][2] + v1[i][3] * v1[i][3]; }
#pragma unroll
        for (int d = 32; d >= 1; d >>= 1) { s0 += shx(s0, d, lane); s1 += shx(s1, d, lane); }
        const float r0 = rsqrtf(s0 * (1.0f / DM) + 1e-6f), r1 = rsqrtf(s1 * (1.0f / DM) + 1e-6f);
#pragma unroll
        for (int i = 0; i < 4; ++i) {
            const f32x4 o0 = v0[i] * r0 * g[i], o1 = v1[i] * r1 * g[i];
            if (MODE == 2) { *(f32x4*)(p.out + (size_t)row0 * DM + 4 * lane + 256 * i) = o0; *(f32x4*)(p.out + (size_t)row1 * DM + 4 * lane + 256 * i) = o1; }
            else { u32x2 w; w[0] = pk2(o0[0], o0[1]); w[1] = pk2(o0[2], o0[3]); *(u32x2*)(P_XN(p) + (size_t)row0 * DM + 4 * lane + 256 * i) = w;
                   w[0] = pk2(o1[0], o1[1]); w[1] = pk2(o1[2], o1[3]); *(u32x2*)(P_XN(p) + (size_t)row1 * DM + 4 * lane + 256 * i) = w; }
        }
    }
}

DI float reduce16(const float (&a)[16], int lane) {
    float b8[8], b4[4], b2[2];
    { const bool hi = (lane & 32) != 0;
#pragma unroll
      for (int j = 0; j < 8; ++j) { const float snd = hi ? a[j] : a[j + 8], kp = hi ? a[j + 8] : a[j]; b8[j] = kp + shx(snd, 32, lane); } }
    { const bool hi = (lane & 16) != 0;
#pragma unroll
      for (int j = 0; j < 4; ++j) { const float snd = hi ? b8[j] : b8[j + 4], kp = hi ? b8[j + 4] : b8[j]; b4[j] = kp + shx(snd, 16, lane); } }
    { const bool hi = (lane & 8) != 0;
#pragma unroll
      for (int j = 0; j < 2; ++j) { const float snd = hi ? b4[j] : b4[j + 2], kp = hi ? b4[j + 2] : b4[j]; b2[j] = kp + shx(snd, 8, lane); } }
    float r;
    { const bool hi = (lane & 4) != 0; const float snd = hi ? b2[0] : b2[1], kp = hi ? b2[1] : b2[0]; r = kp + shx(snd, 4, lane); }
    r += shx(r, 2, lane); r += shx(r, 1, lane);
    return r;
}
DI void norm2_router_phase(const Params& p, int l, LAS float* wr) {
    const int tid = otid(), lane = tid & 63, wid = tid >> 6;
    for (int i = tid; i < DM * NEXP; i += 512) wr[(i & 15) * DM + (i >> 4)] = p.w_router[(size_t)l * DM * NEXP + i];
    __syncthreads();
    const float* gain = p.norm_ffn + (size_t)l * DM;
    f32x4 g[4];
#pragma unroll
    for (int i = 0; i < 4; ++i) g[i] = *(const f32x4*)(gain + 4 * lane + 256 * i);
    const int nw = gridDim.x * 8;
    for (int row0 = blockIdx.x * 8 + wid; row0 < NTOK; row0 += 2 * nw) {
        const int row1 = row0 + nw;
        f32x4 v0[4], v1[4]; float s0 = 0.f, s1 = 0.f;
#pragma unroll
        for (int i = 0; i < 4; ++i) { v0[i] = *(const f32x4*)(P_X(p) + (size_t)row0 * DM + 4 * lane + 256 * i); v1[i] = *(const f32x4*)(P_X(p) + (size_t)row1 * DM + 4 * lane + 256 * i); }
#pragma unroll
        for (int i = 0; i < 4; ++i) { s0 += v0[i][0] * v0[i][0] + v0[i][1] * v0[i][1] + v0[i][2] * v0[i][2] + v0[i][3] * v0[i][3]; s1 += v1[i][0] * v1[i][0] + v1[i][1] * v1[i][1] + v1[i][2] * v1[i][2] + v1[i][3] * v1[i][3]; }
#pragma unroll
        for (int d = 32; d >= 1; d >>= 1) { s0 += shx(s0, d, lane); s1 += shx(s1, d, lane); }
        const float r0 = rsqrtf(s0 * (1.0f / DM) + 1e-6f), r1 = rsqrtf(s1 * (1.0f / DM) + 1e-6f);
#pragma unroll
        for (int i = 0; i < 4; ++i) { v0[i] = v0[i] * r0 * g[i]; v1[i] = v1[i] * r1 * g[i];
            *(unsigned*)(P_XN8(p) + (size_t)row0 * DM + 4 * lane + 256 * i) = pk4_fp8(v0[i][0], v0[i][1], v0[i][2], v0[i][3]);
            *(unsigned*)(P_XN8(p) + (size_t)row1 * DM + 4 * lane + 256 * i) = pk4_fp8(v1[i][0], v1[i][1], v1[i][2], v1[i][3]); }
        float a0[NEXP], a1[NEXP];
#pragma unroll
        for (int e = 0; e < NEXP; ++e) { float x0 = 0.f, x1 = 0.f;
#pragma unroll
            for (int i = 0; i < 4; ++i) { const f32x4 w = *(const LAS f32x4*)(wr + e * DM + 4 * lane + 256 * i);
                x0 += v0[i][0] * w[0] + v0[i][1] * w[1] + v0[i][2] * w[2] + v0[i][3] * w[3]; x1 += v1[i][0] * w[0] + v1[i][1] * w[1] + v1[i][2] * w[2] + v1[i][3] * w[3]; }
            a0[e] = x0; a1[e] = x1;
            if ((e & 3) == 3) __builtin_amdgcn_sched_barrier(0); }
        const float l0 = reduce16(a0, lane), l1 = reduce16(a1, lane);
        float m0 = l0, m1 = l1;
#pragma unroll
        for (int d = 32; d >= 4; d >>= 1) { m0 = fmaxf(m0, shx(m0, d, lane)); m1 = fmaxf(m1, shx(m1, d, lane)); }
        const float e0 = __expf(l0 - m0), e1 = __expf(l1 - m1); float d0 = e0, d1 = e1;
#pragma unroll
        for (int d = 32; d >= 4; d >>= 1) { d0 += shx(d0, d, lane); d1 += shx(d1, d, lane); }
        if ((lane & 3) == 0) { const int e = lane >> 2;
            P_AFF(p)[((size_t)((row0 >> 12) * NEXP + e)) * SEQ + (row0 & 4095)] = e0 / d0; P_AFF(p)[((size_t)((row1 >> 12) * NEXP + e)) * SEQ + (row1 & 4095)] = e1 / d1; }
    }
}

DI void topk_phase(const Params& p, LAS unsigned* lds) {
    const int tid = otid(), lane = tid & 63, wid = tid >> 6;
    LAS unsigned* hist = lds; LAS unsigned* sh = lds + 256; LAS unsigned* wtot = lds + 272;
    for (int be = blockIdx.x; be < NBATCH * NEXP; be += gridDim.x) {
        const int b = be >> 4, e = be & 15;
        const float* aff = P_AFF(p) + (size_t)be * SEQ + tid * 8;
        const f32x4 a0 = *(const f32x4*)aff, a1 = *(const f32x4*)(aff + 4);
        unsigned key[8];
#pragma unroll
        for (int i = 0; i < 4; ++i) { key[i] = __float_as_uint(a0[i]); key[4 + i] = __float_as_uint(a1[i]); }
        unsigned prefix = 0u, mask = 0u, krem = CAP;
        for (int pass = 3; pass >= 0; --pass) {
            const int shift = 8 * pass;
            if (tid < 256) hist[tid] = 0u;
            __syncthreads();
#pragma unroll
            for (int i = 0; i < 8; ++i) if ((key[i] & mask) == prefix) atomicAdd((unsigned*)&hist[(key[i] >> shift) & 255u], 1u);
            __syncthreads();
            if (wid == 0) {
                const unsigned h0 = hist[4 * lane], h1 = hist[4 * lane + 1], h2 = hist[4 * lane + 2], h3 = hist[4 * lane + 3], s = h0 + h1 + h2 + h3;
                unsigned suf = s;
#pragma unroll
                for (int d = 1; d < 64; d <<= 1) { const unsigned t = shl_abs(suf, (lane + d) & 63); if (lane + d < 64) suf += t; }
                const unsigned above = suf - s;
                if (above < krem && krem <= suf) {
                    unsigned a = above; unsigned bin, nk;
                    if (a + h3 >= krem) { bin = 4 * lane + 3; nk = krem - a; }
                    else { a += h3; if (a + h2 >= krem) { bin = 4 * lane + 2; nk = krem - a; }
                        else { a += h2; if (a + h1 >= krem) { bin = 4 * lane + 1; nk = krem - a; } else { a += h1; bin = 4 * lane; nk = krem - a; } } }
                    sh[0] = prefix | (bin << shift); sh[1] = nk;
                }
            }
            __syncthreads();
            prefix = sh[0]; krem = sh[1]; mask |= 0xFFu << shift;
            __syncthreads();
        }
        unsigned cg = 0u, ce = 0u;
#pragma unroll
        for (int i = 0; i < 8; ++i) { cg += key[i] > prefix ? 1u : 0u; ce += key[i] == prefix ? 1u : 0u; }
        unsigned pk = cg | (ce << 16), incl = pk;
#pragma unroll
        for (int d = 1; d < 64; d <<= 1) { const unsigned t = shl_abs(incl, (lane - d) & 63); if (lane >= d) incl += t; }
        if (lane == 63) wtot[wid] = incl;
        __syncthreads();
        unsigned woff = 0u;
#pragma unroll
        for (int w = 0; w < 8; ++w) woff += w < wid ? wtot[w] : 0u;
        const unsigned excl = woff + incl - pk;
        unsigned gtb = excl & 0xffffu, eqb = excl >> 16;
        int* idxo = P_IDX(p) + (size_t)(e * NBATCH + b) * CAP; float* valo = P_VAL(p) + (size_t)(e * NBATCH + b) * CAP;
        int* inv = P_INV(p) + ((size_t)b * SEQ + tid * 8) * NEXP + e;
#pragma unroll
        for (int i = 0; i < 8; ++i) {
            int slot = -1;
            if (key[i] > prefix) { slot = (int)(gtb + (eqb < krem ? eqb : krem)); ++gtb; }
            else if (key[i] == prefix) { if (eqb < krem) slot = (int)(gtb + eqb); ++eqb; }
            if (slot >= 0) { idxo[slot] = tid * 8 + i; valo[slot] = __uint_as_float(key[i]); }
            inv[(size_t)i * NEXP] = slot;
        }
        __syncthreads();
    }
}

DI f32x16 zero16() { f32x16 z; for (int i = 0; i < 16; ++i) z[i] = 0.f; return z; }
DI void rgemm2(const bf16_t* ap, const bf16_t* b0p, const bf16_t* b1p, int K, f32x16& c0, f32x16& c1) {
#pragma unroll 4
    for (int k = 0; k < K; k += 16) {
        const bf16x8 a = *(const bf16x8*)(ap + k), b0 = *(const bf16x8*)(b0p + k), b1 = *(const bf16x8*)(b1p + k);
        c0 = __builtin_amdgcn_mfma_f32_32x32x16_bf16(a, b0, c0, 0, 0, 0);
        c1 = __builtin_amdgcn_mfma_f32_32x32x16_bf16(a, b1, c1, 0, 0, 0);
    }
}
DI int crow(int i, int h) { return (i & 3) + 8 * (i >> 2) + 4 * h; }
DI float sigmoidf_(float x) { return 1.0f / (1.0f + __expf(-x)); }

DI void rk_inproj(const Params& p, int l) {
    const int lane = otid() & 63, r = lane & 31, h = lane >> 5;
    const bf16_t* WIN = P_W(p, l, LW_WIN); const bf16_t* WV = P_W(p, l, LW_WV);
    const int nw = gridDim.x * 8;
    for (int wt = blockIdx.x * 8 + (otid() >> 6); wt < 512 * 88; wt += nw) {
        const int job = wt % 88, m0 = (wt / 88) * 32;
        const bf16_t* ap = P_XN(p) + (size_t)(m0 + r) * DM + 8 * h;
        const bf16_t *b0, *b1;
        if (job < 20) { const int t = job >> 2, wc = job & 3; b0 = WIN + (size_t)(256 * t + 32 * wc + r) * DM + 8 * h; b1 = b0 + (size_t)128 * DM; }
        else if (job < 28) { b0 = WIN + (size_t)(1280 + 64 * (job - 20) + r) * DM + 8 * h; b1 = b0 + (size_t)32 * DM; }
        else if (job < 40) { b0 = WV + (size_t)(64 * (job - 28) + r) * DM + 8 * h; b1 = b0 + (size_t)32 * DM; }
        else { b0 = WIN + (size_t)(1792 + 64 * (job - 40) + r) * DM + 8 * h; b1 = b0 + (size_t)32 * DM; }
        f32x16 c0 = zero16(), c1 = zero16();
        rgemm2(ap, b0, b1, DM, c0, c1);
#pragma unroll
        for (int i = 0; i < 16; ++i) {
            const int row = m0 + crow(i, h), pos = row & 4095;
            if (job < 20) {
                const float cs = P_COS(p)[pos * 32 + r], sn = P_SIN(p)[pos * 32 + r];
                float o1 = c0[i] * cs - c1[i] * sn, o2 = c1[i] * cs + c0[i] * sn;
                if (job < 6 || (job >= 8 && job < 14)) { o1 *= 0.125f; o2 *= 0.125f; }
                P_QK(p)[(size_t)row * QKW + 64 * job + r] = (bf16_t)f2bf(o1); P_QK(p)[(size_t)row * QKW + 64 * job + 32 + r] = (bf16_t)f2bf(o2);
            } else if (job < 28) {
                const float sc = job < 24 ? 0.125f : 1.0f; const int col = 1280 + 64 * (job - 20) + r;
                P_QK(p)[(size_t)row * QKW + col] = (bf16_t)f2bf(c0[i] * sc); P_QK(p)[(size_t)row * QKW + col + 32] = (bf16_t)f2bf(c1[i] * sc);
            } else if (job < 40) {
                const int ch = 64 * (job - 28) + r; const int slot = ch < 512 ? row : (row & ~4095) + pos16(pos);
                P_VT(p)[(size_t)ch * NTOK + slot] = (bf16_t)f2bf(c0[i]); P_VT(p)[(size_t)(ch + 32) * NTOK + slot] = (bf16_t)f2bf(c1[i]);
            } else {
                const int col = 64 * (job - 40) + r; const float* bg = p.b_gate + (size_t)l * 3072;
                P_G(p)[(size_t)row * 3072 + col] = (bf16_t)f2bf(sigmoidf_(c0[i] + bg[col])); P_G(p)[(size_t)row * 3072 + col + 32] = (bf16_t)f2bf(sigmoidf_(c1[i] + bg[col + 32]));
            }
        }
    }
}
DI void rk_merge(const Params& p, int l) {
    const int lane = otid() & 63, r = lane & 31, h = lane >> 5;
    const bf16_t* WM = P_W(p, l, LW_WM);
    for (int wt = blockIdx.x * 8 + (otid() >> 6); wt < 512 * 16; wt += gridDim.x * 8) {
        const int n0 = (wt & 15) * 64, m0 = (wt >> 4) * 32;
        float m0a[16], m1a[16];
#pragma unroll
        for (int i = 0; i < 16; ++i) { m0a[i] = 0.f; m1a[i] = 0.f; }
#pragma unroll 1
        for (int br = 0; br < 3; ++br) {
            const int k0 = br == 0 ? 0 : br == 1 ? 384 : 512, K = br == 0 ? 384 : br == 1 ? 128 : 256;
            f32x16 c0 = zero16(), c1 = zero16();
            rgemm2(P_OC(p) + (size_t)(m0 + r) * OCW + k0 + 8 * h, WM + (size_t)(n0 + r) * 768 + k0 + 8 * h, WM + (size_t)(n0 + 32 + r) * 768 + k0 + 8 * h, K, c0, c1);
#pragma unroll
            for (int i = 0; i < 16; ++i) { const int row = m0 + crow(i, h); const bf16_t* gp = P_G(p) + (size_t)row * 3072 + 1024 * br + n0 + r;
                m0a[i] += bf2f(gp[0]) * c0[i]; m1a[i] += bf2f(gp[32]) * c1[i]; }
        }
#pragma unroll
        for (int i = 0; i < 16; ++i) { const int row = m0 + crow(i, h); P_MG(p)[(size_t)row * DM + n0 + r] = (bf16_t)f2bf(m0a[i]); P_MG(p)[(size_t)row * DM + n0 + 32 + r] = (bf16_t)f2bf(m1a[i]); }
    }
}
DI void rk_out(const Params& p, int l) {
    const int lane = otid() & 63, r = lane & 31, h = lane >> 5;
    const bf16_t* WO = P_W(p, l, LW_WO);
    for (int wt = blockIdx.x * 8 + (otid() >> 6); wt < 512 * 16; wt += gridDim.x * 8) {
        const int n0 = (wt & 15) * 64, m0 = (wt >> 4) * 32;
        f32x16 c0 = zero16(), c1 = zero16();
        rgemm2(P_MG(p) + (size_t)(m0 + r) * DM + 8 * h, WO + (size_t)(n0 + r) * DM + 8 * h, WO + (size_t)(n0 + 32 + r) * DM + 8 * h, DM, c0, c1);
#pragma unroll
        for (int i = 0; i < 16; ++i) { float* xp = P_X(p) + (size_t)(m0 + crow(i, h)) * DM + n0 + r; xp[0] += c0[i]; xp[32] += c1[i]; }
    }
}
DI void rk_moe1(const Params& p, int l) {
    const int lane = otid() & 63, r = lane & 31, h = lane >> 5;
    const bf16_t* WGU = P_W(p, l, LW_WGU);
    for (int wt = blockIdx.x * 8 + (otid() >> 6); wt < 1024 * 64; wt += gridDim.x * 8) {
        const int j0 = (wt & 63) * 32, m0 = (wt >> 6) * 32, e = m0 >> 11, b = (m0 >> 9) & 3;
        const int tok = b * SEQ + P_IDX(p)[m0 + r];
        const bf16_t* b0 = WGU + ((size_t)e * 4096 + 256 * (j0 >> 7) + (j0 & 127) + r) * DM + 8 * h;
        f32x16 c0 = zero16(), c1 = zero16();
        rgemm2(P_XN(p) + (size_t)tok * DM + 8 * h, b0, b0 + (size_t)128 * DM, DM, c0, c1);
#pragma unroll
        for (int i = 0; i < 16; ++i) { const float g = c0[i], u = c1[i]; P_HID(p)[(size_t)(m0 + crow(i, h)) * FF + j0 + r] = (bf16_t)f2bf(g * sigmoidf_(g) * u); }
    }
}
DI void rk_moe2(const Params& p, int l) {
    const int lane = otid() & 63, r = lane & 31, h = lane >> 5;
    const bf16_t* WD = P_W(p, l, LW_WD);
    for (int wt = blockIdx.x * 8 + (otid() >> 6); wt < 1024 * 16; wt += gridDim.x * 8) {
        const int n0 = (wt & 15) * 64, m0 = (wt >> 4) * 32, e = m0 >> 11;
        const bf16_t* b0 = WD + ((size_t)e * 1024 + n0 + r) * FF + 8 * h;
        f32x16 c0 = zero16(), c1 = zero16();
        rgemm2(P_HID(p) + (size_t)(m0 + r) * FF + 8 * h, b0, b0 + (size_t)32 * FF, FF, c0, c1);
#pragma unroll
        for (int i = 0; i < 16; ++i) { const int row = m0 + crow(i, h); const float v = P_VAL(p)[row];
            P_Y(p)[(size_t)row * DM + n0 + r] = (bf16_t)f2bf(c0[i] * v); P_Y(p)[(size_t)row * DM + n0 + 32 + r] = (bf16_t)f2bf(c1[i] * v); }
    }
}

DI void ld64(const bf16_t* src, float (&q)[64]) {
#pragma unroll
    for (int c = 0; c < 8; ++c) { const u32x4 w = *(const u32x4*)(src + 8 * c);
#pragma unroll
        for (int j = 0; j < 4; ++j) { q[8 * c + 2 * j] = bflo(w[j]); q[8 * c + 2 * j + 1] = bfhi(w[j]); } }
}
DI float dot64(const bf16_t* kp, const float (&q)[64]) {
    float s = 0.f;
#pragma unroll
    for (int c = 0; c < 8; ++c) { const u32x4 w = *(const u32x4*)(kp + 8 * c);
#pragma unroll
        for (int j = 0; j < 4; ++j) { s += q[8 * c + 2 * j] * bflo(w[j]); s += q[8 * c + 2 * j + 1] * bfhi(w[j]); } }
    return s;
}
DI void rk_attn(const Params& p, int l) {
  for (int item2 = blockIdx.x * 512 + otid(); item2 < 32 * NTOK; item2 += gridDim.x * 512) {
    const int half = item2 >> 18, item = item2 & 262143;
    const int hd16 = item >> 14, tok = item & 16383, b = tok >> 12, t = tok & 4095;
    const bf16_t* QK = P_QK(p); const bf16_t* VT = P_VT(p);
    float q[64], o[32];
#pragma unroll
    for (int d = 0; d < 32; ++d) o[d] = 0.f;
    float m = -1e30f, den = 0.f;
    int qcol, kcol, vch; bool perm = false;
    if (hd16 < 6) { qcol = 64 * hd16; kcol = 384 + 64 * (hd16 / 3); vch = 64 * (hd16 / 3); }
    else if (hd16 < 12) { const int g = (hd16 - 6) >> 1, hs = (hd16 - 6) & 1; qcol = 512 + 128 * g + 64 * hs; kcol = 896 + 128 * g + 64 * hs;
        vch = g == 0 ? 128 + 64 * hs : g == 1 ? 512 + 64 * hs : 640 + 64 * hs; perm = g > 0; }
    else { const int hh = hd16 - 12; qcol = 1280 + 64 * hh; kcol = 1536 + 64 * hh; vch = 256 + 64 * hh; }
    vch += 32 * half;
    ld64(QK + (size_t)tok * QKW + qcol, q);
    auto visit = [&](int t2, float bias) {
        const float s = dot64(QK + (size_t)(b * SEQ + t2) * QKW + kcol, q) + bias;
        const float mn = fmaxf(m, s), al = __expf(m - mn), pe = __expf(s - mn);
        den = den * al + pe; m = mn;
        const bf16_t* vp = VT + (size_t)vch * NTOK + b * SEQ + (perm ? pos16(t2) : t2);
#pragma unroll
        for (int d = 0; d < 32; ++d) o[d] = o[d] * al + pe * bf2f(vp[(size_t)d * NTOK]);
    };
    if (hd16 < 6) {
        const int lo = t - 128 < 0 ? 0 : t - 128, hi = t + 128 > 4095 ? 4095 : t + 128;
        for (int t2 = lo; t2 <= hi; ++t2) visit(t2, 0.f);
        const float sk = p.sink[l * 6 + hd16], mn = fmaxf(m, sk), al = __expf(m - mn);
        den = den * al + __expf(sk - mn);
#pragma unroll
        for (int d = 0; d < 32; ++d) o[d] *= al;
        m = mn;
    } else if (hd16 < 12) {
        const int g = (hd16 - 6) >> 1, dil = g == 0 ? 1 : g == 1 ? 4 : 16;
        for (int rr = -64; rr <= 64; ++rr) { const int t2 = t + dil * rr; if (t2 >= 0 && t2 < SEQ) visit(t2, 0.f); }
    } else {
        const int hh = hd16 - 12, qr = t >> 6, qc = t & 63;
        const int sr = qr - 4 < 0 ? 0 : qr - 4 > 56 ? 56 : qr - 4, sc = qc - 8 < 0 ? 0 : qc - 8 > 48 ? 48 : qc - 8;
        const float* rp = p.rpb + (size_t)(l * 4 + hh) * 15 * 31;
        for (int j = 0; j < 8; ++j) for (int k = 0; k < 16; ++k) { const int kr = sr + j, kc = sc + k; visit(kr * 64 + kc, rp[(kr - qr + 7) * 31 + (kc - qc + 15)]); }
    }
    const float rd = 1.0f / den;
    if (hd16 >= 6 && hd16 < 12) {
        const int g = (hd16 - 6) >> 1, hs = (hd16 - 6) & 1;
        bf16_t* op = P_OB3(p) + ((size_t)g * NTOK + tok) * 128 + 64 * hs + 32 * half;
#pragma unroll
        for (int d = 0; d < 32; d += 2) *(unsigned*)(op + d) = pk2(o[d] * rd, o[d + 1] * rd);
        if (half == 0) P_LSE(p)[((size_t)g * NTOK + tok) * 2 + hs] = m + __logf(den);
    } else {
        bf16_t* op = P_OC(p) + (size_t)tok * OCW + (hd16 < 6 ? 64 * hd16 : 512 + 64 * (hd16 - 12)) + 32 * half;
#pragma unroll
        for (int d = 0; d < 32; d += 2) *(unsigned*)(op + d) = pk2(o[d] * rd, o[d + 1] * rd);
    }
  }
}
namespace at {
constexpr int NUNIT_A = 1536, NUNIT_C = 1024, NUNIT_B = 1536, NUNIT = NUNIT_A + NUNIT_C + NUNIT_B;
DI unsigned cvt2(float lo, float hi) { typedef __bf16 bf2_t __attribute__((ext_vector_type(2))); const f32x2 v = {lo, hi}; const bf2_t b = __builtin_convertvector(v, bf2_t); return __builtin_bit_cast(unsigned, b); }
DI bf16x8 pack8(const f32x16& x, int s8) { u32x4 w; w[0] = cvt2(x[s8 + 0], x[s8 + 1]); w[1] = cvt2(x[s8 + 2], x[s8 + 3]); w[2] = cvt2(x[s8 + 4], x[s8 + 5]); w[3] = cvt2(x[s8 + 6], x[s8 + 7]); return __builtin_bit_cast(bf16x8, w); }
DI int koffmap(int r, bool g1) { return g1 ? 4 * (4 * ((r >> 3) & 1) + (r & 3)) + 2 * (r >> 4) + ((r >> 2) & 1) : (r & 16) + 8 * ((r >> 2) & 1) + 4 * ((r >> 3) & 1) + (r & 3); }

DI float xh_max(float v) { const auto r = __builtin_amdgcn_permlane32_swap(__float_as_uint(v), __float_as_uint(v), false, false); return fmaxf(__uint_as_float(r[0]), __uint_as_float(r[1])); }
DI float xh_sum(float v) { const auto r = __builtin_amdgcn_permlane32_swap(__float_as_uint(v), __float_as_uint(v), false, false); return __uint_as_float(r[0]) + __uint_as_float(r[1]); }
constexpr float LOG2E = 1.4426950408889634f, LN2 = 0.6931471805599453f;
struct QState { float m, den; f32x16 O0, O1; };
DI void softmax_tile(f32x16& S, QState& st, bf16x8& p0, bf16x8& p1) {
    float mx = fmaxf(S[0], S[1]);
#pragma unroll
    for (int i = 2; i < 16; i += 2) mx = fmaxf(mx, fmaxf(S[i], S[i + 1]));
    mx = xh_max(mx);
    const float mn = fmaxf(st.m, mx), alpha = __builtin_amdgcn_exp2f(st.m - mn);
    float ps = 0.f;
#pragma unroll
    for (int i = 0; i < 16; ++i) { S[i] = __builtin_amdgcn_exp2f(S[i] - mn); ps += S[i]; }
    ps = xh_sum(ps);
    st.den = st.den * alpha + ps; st.m = mn;
#pragma unroll
    for (int i = 0; i < 16; ++i) { st.O0[i] *= alpha; st.O1[i] *= alpha; }
    p0 = pack8(S, 0); p1 = pack8(S, 8);
}
template <int MODE> DI void mask_tile(f32x16& S, int tn, int NT, int q, int h, int t, int qrow, int sr_q, int sc_q, int kc0, int qcg, const LAS float* bt_head) {
    if (MODE == 3) {
        const bool rowok = t >= sr_q && t < sr_q + 8; const LAS float* bt = bt_head + (t - qrow + 7) * 31 + 15 - qcg;
#pragma unroll
        for (int i = 0; i < 16; ++i) { const int kc = kc0 + 16 * (i >> 3) + 8 * h + (i & 7); const bool ok = rowok && kc >= sc_q && kc < sc_q + 16;
            const int bi = ok ? kc : qcg; S[i] = ok ? S[i] + bt[bi] : -1e37f; }
    } else {
        const int edge = tn == 0 ? 1 : tn == NT - 1 ? 2 : 0;
        if (edge != 0) {
            int qq = MODE == 2 ? q - h : q - 8 * h; asm volatile("" : "+v"(qq));
            if (edge == 1) {
#pragma unroll
                for (int i = 0; i < 16; ++i) { const int kc_ = MODE == 2 ? 4 * (i & 7) + 2 * (i >> 3) : 16 * (i >> 3) + (i & 7); S[i] = kc_ >= qq ? S[i] : -1e37f; }
            } else {
#pragma unroll
                for (int i = 0; i < 16; ++i) { const int kc_ = MODE == 2 ? 4 * (i & 7) + 2 * (i >> 3) : 16 * (i >> 3) + (i & 7); S[i] = kc_ <= qq ? S[i] : -1e37f; }
            }
        }
    }
}
template <int MODE> DI void wave_unit(const Params& p, int l, int u, const LAS float* rpb_lds, LAS unsigned char* ring, int lane) {
    const int q = lane & 31, h = lane >> 5;
    const bf16_t* QK = P_QK(p); const bf16_t* VT = P_VT(p);
    int b, qcol, kcol, vch, dil = 1, rho = 0, Jq = 0, L = SEQ, vs0 = 0, g = 0, hs = 0, hq = 0;
    constexpr int W = MODE == 0 ? 128 : 64, NT = MODE == 0 ? 9 : 5;
    int qcg = 0, kc0 = 0, kr_lo = 0, kr_hi = 0, r00 = 0;
    if (MODE == 0) { const int gg = u % 3, qp = (u / 3) & 63, kvh = (u / 192) & 1; b = u / 384; hq = kvh * 3 + gg; qcol = 64 * hq; kcol = 384 + 64 * kvh; vch = 64 * kvh; Jq = 64 * qp; }
    else if (MODE == 1 || MODE == 2) { const int qt6 = u & 63; hs = (u >> 6) & 1; g = (u >> 7) % 3; b = u / 384; qcol = 512 + 128 * g + 64 * hs; kcol = 896 + 128 * g + 64 * hs;
        vch = g == 0 ? 128 + 64 * hs : g == 1 ? 512 + 64 * hs : 640 + 64 * hs;
        if (g == 0) { Jq = 64 * qt6; } else if (g == 1) { dil = 4; rho = qt6 >> 4; Jq = 64 * (qt6 & 15); L = 1024; } else { dil = 16; rho = qt6 >> 2; Jq = 64 * (qt6 & 3); L = 256; vs0 = rho * 256; } }
    else { const int qt6 = u & 63, hh = (u >> 6) & 3, gr4 = qt6 >> 2, cb = qt6 & 3; b = u >> 8; hq = hh; qcol = 1280 + 64 * hh; kcol = 1536 + 64 * hh; vch = 256 + 64 * hh;
        r00 = 4 * gr4; qcg = 16 * cb + (q & 15); kc0 = cb == 0 ? 0 : cb == 3 ? 32 : 16 * cb - 8;
        const int s0 = r00 - 4 < 0 ? 0 : r00 - 4 > 56 ? 56 : r00 - 4, s3 = r00 - 1 < 0 ? 0 : r00 - 1 > 56 ? 56 : r00 - 1; kr_lo = s0; kr_hi = s3 + 8; }
    int t_lo, t_hi; unsigned kdma[4], vdma[4], kstep_t, vstep_t;
    if (MODE == 3) { t_lo = kr_lo; t_hi = kr_hi; kstep_t = 64u * QKW; vstep_t = 64; }
    else { t_lo = (W - Jq + 31) >> 5; if (t_lo < 0) t_lo = 0; t_hi = (L + W - Jq) >> 5; if (t_hi > NT + 1) t_hi = NT + 1; kstep_t = 32u * dil * QKW; vstep_t = MODE == 2 ? 8 : 32; }
#pragma unroll
    for (int i = 0; i < 4; ++i) {
        const int r = 8 * i + (lane >> 3), c8 = (lane & 7) ^ ((r >> 1) & 7), ko = koffmap(r, MODE == 2);
        const int ktok = MODE == 3 ? b * SEQ + kc0 + ko : b * SEQ + (Jq - W + ko) * dil + rho;
        kdma[i] = (unsigned)ktok * QKW + kcol + 8 * c8;
        const int d = 16 * i + (lane >> 2), ch = (lane & 3) ^ ((d >> 2) & 3);
        const int vslot = MODE == 3 ? b * SEQ + kc0 + 8 * ch : MODE == 2 ? b * SEQ + ch * 1024 + rho * 256 + ((Jq - W) >> 2) : b * SEQ + vs0 + (Jq - W) + 8 * ch;
        vdma[i] = (unsigned)(vch + d) * NTOK + vslot;
    }
#define AT_DMA(t, buf) do { const unsigned kt_ = (unsigned)(t) * kstep_t, vt_ = (unsigned)(t) * vstep_t; LAS unsigned char* bb_ = ring + (buf) * 8192; \
        _Pragma("unroll") for (int i_ = 0; i_ < 4; ++i_) __builtin_amdgcn_global_load_lds((const unsigned*)(QK + (unsigned)(kdma[i_] + kt_)), (LAS unsigned*)(bb_ + i_ * 1024), 16, 0, 0); \
        _Pragma("unroll") for (int i_ = 0; i_ < 4; ++i_) __builtin_amdgcn_global_load_lds((const unsigned*)(VT + (unsigned)(vdma[i_] + vt_)), (LAS unsigned*)(bb_ + 4096 + i_ * 1024), 16, 0, 0); } while (0)
    AT_DMA(t_lo, 0);
    int kaddr[4], vaddr[2][2];
#pragma unroll
    for (int c = 0; c < 4; ++c) kaddr[c] = q * 128 + (((2 * c + h) ^ ((q >> 1) & 7)) << 4);
#pragma unroll
    for (int dh = 0; dh < 2; ++dh)
#pragma unroll
        for (int sx = 0; sx < 2; ++sx) vaddr[dh][sx] = 4096 + (32 * dh + q) * 64 + (((2 * sx + h) ^ ((q >> 2) & 3)) << 4);
    int tokq[2]; bf16x8 qf[2][4]; QState st[2];
#pragma unroll
    for (int n = 0; n < 2; ++n) {
        tokq[n] = MODE == 3 ? b * SEQ + (r00 + 2 * n + (q >> 4)) * 64 + qcg : b * SEQ + (Jq + 32 * n + q) * dil + rho;
        const bf16_t* qp = QK + (size_t)tokq[n] * QKW + qcol + 8 * h;
#pragma unroll
        for (int c = 0; c < 4; ++c) qf[n][c] = *(const bf16x8*)(qp + 16 * c);
        st[n].m = -1e30f; st[n].den = 0.f;
        if (MODE == 0) { st[n].m = p.sink[l * 6 + hq] * LOG2E; st[n].den = 1.0f; }
#pragma unroll
        for (int i = 0; i < 16; ++i) { st[n].O0[i] = 0.f; st[n].O1[i] = 0.f; }
    }
    int sc_q = 0, qrow0 = 0, qrow1 = 0, srq0 = 0, srq1 = 0, lo0 = 0, hi0 = 0, lo1 = 0, hi1 = 0;
    if (MODE == 3) { sc_q = qcg - 8 < 0 ? 0 : qcg - 8 > 48 ? 48 : qcg - 8;
        qrow0 = r00 + (q >> 4); qrow1 = qrow0 + 2; srq0 = qrow0 - 4 < 0 ? 0 : qrow0 - 4 > 56 ? 56 : qrow0 - 4; srq1 = qrow1 - 4 < 0 ? 0 : qrow1 - 4 > 56 ? 56 : qrow1 - 4;
        lo0 = r00 - 4 < 0 ? 0 : r00 - 4 > 56 ? 56 : r00 - 4; hi0 = (r00 - 3 < 0 ? 0 : r00 - 3 > 56 ? 56 : r00 - 3) + 8; lo1 = r00 - 2 < 0 ? 0 : r00 - 2 > 56 ? 56 : r00 - 2; hi1 = (r00 - 1 < 0 ? 0 : r00 - 1 > 56 ? 56 : r00 - 1) + 8; }
    const LAS float* bt_head = rpb_lds + hq * 465;
#define AT_S(S, n) do { _Pragma("unroll") for (int i_ = 0; i_ < 16; ++i_) S[i_] = 0.f; _Pragma("unroll") for (int c_ = 0; c_ < 4; ++c_) S = __builtin_amdgcn_mfma_f32_32x32x16_bf16(kf[c_], qf[n][c_], S, 0, 0, 0); } while (0)
#define AT_PV(n, p0, p1) do { st[n].O0 = __builtin_amdgcn_mfma_f32_32x32x16_bf16(vf[0][0], p0, st[n].O0, 0, 0, 0); st[n].O0 = __builtin_amdgcn_mfma_f32_32x32x16_bf16(vf[0][1], p1, st[n].O0, 0, 0, 0); \
        st[n].O1 = __builtin_amdgcn_mfma_f32_32x32x16_bf16(vf[1][0], p0, st[n].O1, 0, 0, 0); st[n].O1 = __builtin_amdgcn_mfma_f32_32x32x16_bf16(vf[1][1], p1, st[n].O1, 0, 0, 0); } while (0)
    for (int t = t_lo; t < t_hi; ++t) {
        const int buf = (t - t_lo) & 1;
        if (t + 1 < t_hi) { AT_DMA(t + 1, buf ^ 1); asm volatile("s_waitcnt vmcnt(8)" ::: "memory"); }
        else asm volatile("s_waitcnt vmcnt(0)" ::: "memory");
        const LAS unsigned char* bb = ring + buf * 8192;
        const bool act0 = MODE == 3 ? (t >= lo0 && t < hi0) : (t < NT), act1 = MODE == 3 ? (t >= lo1 && t < hi1) : (t >= 1);
        bf16x8 kf[4], vf[2][2];
#pragma unroll
        for (int c = 0; c < 4; ++c) kf[c] = *(const LAS bf16x8*)(bb + kaddr[c]);
        if (act0 && act1) {
            f32x16 S0, S1; AT_S(S0, 0); AT_S(S1, 1);
            mask_tile<MODE>(S0, t, NT, q, h, t, qrow0, srq0, sc_q, kc0, qcg, bt_head); mask_tile<MODE>(S1, t - 1, NT, q, h, t, qrow1, srq1, sc_q, kc0, qcg, bt_head);
            bf16x8 pa0, pa1, pb0, pb1;
            softmax_tile(S0, st[0], pa0, pa1); softmax_tile(S1, st[1], pb0, pb1);
            __builtin_amdgcn_sched_barrier(0);
#pragma unroll
            for (int dh = 0; dh < 2; ++dh)
#pragma unroll
                for (int sx = 0; sx < 2; ++sx) vf[dh][sx] = *(const LAS bf16x8*)(bb + vaddr[dh][sx]);
            AT_PV(0, pa0, pa1); AT_PV(1, pb0, pb1);
        } else if (act0) {
            f32x16 S0; AT_S(S0, 0);
#pragma unroll
            for (int dh = 0; dh < 2; ++dh)
#pragma unroll
                for (int sx = 0; sx < 2; ++sx) vf[dh][sx] = *(const LAS bf16x8*)(bb + vaddr[dh][sx]);
            mask_tile<MODE>(S0, t, NT, q, h, t, qrow0, srq0, sc_q, kc0, qcg, bt_head);
            bf16x8 pa0, pa1; softmax_tile(S0, st[0], pa0, pa1); AT_PV(0, pa0, pa1);
        } else if (act1) {
            f32x16 S1; AT_S(S1, 1);
#pragma unroll
            for (int dh = 0; dh < 2; ++dh)
#pragma unroll
                for (int sx = 0; sx < 2; ++sx) vf[dh][sx] = *(const LAS bf16x8*)(bb + vaddr[dh][sx]);
            mask_tile<MODE>(S1, t - 1, NT, q, h, t, qrow1, srq1, sc_q, kc0, qcg, bt_head);
            bf16x8 pb0, pb1; softmax_tile(S1, st[1], pb0, pb1); AT_PV(1, pb0, pb1);
        }
    }
#undef AT_DMA
#undef AT_S
#undef AT_PV
#pragma unroll
    for (int n = 0; n < 2; ++n) {
        const float rd = 1.0f / st[n].den;
        bf16_t* op;
        if (MODE == 1 || MODE == 2) { op = P_OB3(p) + ((size_t)g * NTOK + tokq[n]) * 128 + 64 * hs; if (h == 0) P_LSE(p)[((size_t)g * NTOK + tokq[n]) * 2 + hs] = (st[n].m + __log2f(st[n].den)) * LN2; }
        else op = P_OC(p) + (size_t)tokq[n] * OCW + (MODE == 0 ? 64 * hq : 512 + 64 * hq);
#pragma unroll
        for (int gq = 0; gq < 4; ++gq) {
            u32x2 w0, w1;
            w0[0] = cvt2(st[n].O0[4 * gq] * rd, st[n].O0[4 * gq + 1] * rd); w0[1] = cvt2(st[n].O0[4 * gq + 2] * rd, st[n].O0[4 * gq + 3] * rd);
            w1[0] = cvt2(st[n].O1[4 * gq] * rd, st[n].O1[4 * gq + 1] * rd); w1[1] = cvt2(st[n].O1[4 * gq + 2] * rd, st[n].O1[4 * gq + 3] * rd);
            *(u32x2*)(op + 8 * gq + 4 * h) = w0; *(u32x2*)(op + 32 + 8 * gq + 4 * h) = w1;
        }
    }
}
}
DI void f_attn_phase(const Params& p, int l, LAS unsigned char* lds, int slot) {
    const int tid = otid(), lane = tid & 63, wid = __builtin_amdgcn_readfirstlane(tid >> 6);
    LAS float* rpb_lds = (LAS float*)(lds + 131072 + 64);
    for (int i = tid; i < 4 * 465; i += 512) rpb_lds[i] = p.rpb[(size_t)l * 4 * 465 + i] * at::LOG2E;
    __syncthreads();
    LAS unsigned char* ring = lds + wid * 16384;
    const int x8 = blockIdx.x & 7;
    unsigned* ctr = (unsigned*)(p.ws + OFF_CTL + 16384) + 64 * (slot * 8 + x8);
    for (;;) {
        unsigned k = 0u;
        if (lane == 0) k = __hip_atomic_fetch_add(ctr, 1u, __ATOMIC_RELAXED, __HIP_MEMORY_SCOPE_AGENT);
        k = (unsigned)__builtin_amdgcn_readfirstlane((int)k);
        if (k >= 512u) break;
        int ln = lane; asm volatile("" : "+v"(ln));
        if (k < 192u) at::wave_unit<0>(p, l, x8 * 192 + (int)k, rpb_lds, ring, ln);
        else if (k < 320u) at::wave_unit<3>(p, l, x8 * 128 + (int)k - 192, rpb_lds, ring, ln);
        else { const int ub = x8 * 192 + (int)k - 320; if (((ub >> 7) % 3) == 1) at::wave_unit<2>(p, l, ub, rpb_lds, ring, ln); else at::wave_unit<1>(p, l, ub, rpb_lds, ring, ln); }
    }
    __syncthreads();
}

DI void bcombine_rows(const Params& p, int tok0, int ntok) {
    for (int i = otid(); i < ntok * 16; i += 512) {
        const int tok = tok0 + (i >> 4), part = i & 15, hs = part >> 3, d0 = (part & 7) * 8;
        const float l0 = P_LSE(p)[((size_t)0 * NTOK + tok) * 2 + hs], l1 = P_LSE(p)[((size_t)1 * NTOK + tok) * 2 + hs], l2 = P_LSE(p)[((size_t)2 * NTOK + tok) * 2 + hs];
        const float mx = fmaxf(l0, fmaxf(l1, l2)), e0 = __expf(l0 - mx), e1 = __expf(l1 - mx), e2 = __expf(l2 - mx), rs = 1.0f / (e0 + e1 + e2);
        const float a0 = e0 * rs, a1 = e1 * rs, a2 = e2 * rs;
        const u32x4 w0 = *(const u32x4*)(P_OB3(p) + ((size_t)0 * NTOK + tok) * 128 + 64 * hs + d0);
        const u32x4 w1 = *(const u32x4*)(P_OB3(p) + ((size_t)1 * NTOK + tok) * 128 + 64 * hs + d0);
        const u32x4 w2 = *(const u32x4*)(P_OB3(p) + ((size_t)2 * NTOK + tok) * 128 + 64 * hs + d0);
        u32x4 o;
#pragma unroll
        for (int j = 0; j < 4; ++j) o[j] = pk2(a0 * bflo(w0[j]) + a1 * bflo(w1[j]) + a2 * bflo(w2[j]), a0 * bfhi(w0[j]) + a1 * bfhi(w1[j]) + a2 * bfhi(w2[j]));
        *(u32x4*)(P_OC(p) + (size_t)tok * OCW + 384 + 64 * hs + d0) = o;
    }
}

namespace g8 {
constexpr int BM = 256, BK = 64, HALF = 128, HTB = HALF * BK * 2, NXCD = 8, WGM = 8;
DI int lds_byte(int r, int c) { const int st = (r >> 4) * 2 + (c >> 5), rr = r & 15, cc = c & 31, ob = rr * 64 + cc * 2; return st * 1024 + (ob ^ (((ob >> 9) & 1) << 5)); }
DI void stage_rc(int b, int& R, int& C) { const int st = b / 1024, sb = b % 1024, swz = sb ^ (((sb >> 9) & 1) << 5); R = (st >> 1) * 16 + swz / 64; C = (st & 1) * 32 + (swz % 64) / 2; }
DI int perm32(int rho) { const int n = rho >> 4, i = rho & 15; return 8 * (i >> 2) + 4 * n + (i & 3); }
struct Unit { int pm, pn, aux; };
struct StaticOrder {
    int nM, nN, nwg, G, c;
    DI void init(int M, int N, int G_, int c_) { nM = M / BM; nN = N / BM; nwg = nM * nN; G = G_; c = c_; }
    DI bool next(int i, Unit& u) const {
        const long L = (long)i * G + c; if (L >= nwg) return false;
        int wgid = (int)L; { const int q = nwg / NXCD, r = nwg % NXCD, xcd = wgid % NXCD, off = wgid / NXCD; wgid = (xcd < r ? xcd * (q + 1) : r * (q + 1) + (xcd - r) * q) + off; }
        const int nig = WGM * nN, gid = wgid / nig, fm = gid * WGM, gsz = (nM - fm) < WGM ? (nM - fm) : WGM;
        u.pm = fm + ((wgid % nig) % gsz); u.pn = (wgid % nig) / gsz; u.aux = 0; return true;
    }
};
typedef f32x4 Acc[2][2][4][2];
typedef int i32x4 __attribute__((ext_vector_type(4)));
typedef int i32x8 __attribute__((ext_vector_type(8)));
DI bf16x8 half8(const i32x8& v, int k) { const i32x4 x = k == 0 ? __builtin_shufflevector(v, v, 0, 1, 2, 3) : __builtin_shufflevector(v, v, 4, 5, 6, 7); return __builtin_bit_cast(bf16x8, x); }
DI i32x8 cat8(const bf16x8& a, const bf16x8& b) { const i32x4 x = __builtin_bit_cast(i32x4, a), y = __builtin_bit_cast(i32x4, b); return __builtin_shufflevector(x, y, 0, 1, 2, 3, 4, 5, 6, 7); }

template <class Desc, class Epi, class Sched, bool ALIGN_EPI>
DI void gemm_phase(LAS unsigned char* lds, const Desc& D, const Sched& S, const Epi& E) {
    const int tid = otid(), wid = __builtin_amdgcn_readfirstlane(tid >> 6), lane = tid & 63, wr = wid >> 2, wc = wid & 3, fr = lane & 15, fq = lane >> 4;
    int R0, C0, R1, C1; stage_rc(tid * 16, R0, C0); stage_rc(tid * 16 + 8192, R1, C1);
    const int Rb0 = Epi::PERM ? ((R0 & ~31) + perm32(R0 & 31)) : R0, Rb1 = Epi::PERM ? ((R1 & ~31) + perm32(R1 & 31)) : R1;
    constexpr unsigned LDA2 = Desc::lda * 2, LDB2 = Desc::ldb * 2;
    const size_t kstep = (size_t)(BK * 2);
    const unsigned ldsw = (unsigned)wid * 1024u;
    const int aoff = lds_byte(wr * 64 + fr, fq * 8), boff = lds_byte(wc * 32 + fr, fq * 8);
#define G8_SA(b, h) (((b) * 2 + (h)) * HTB)
#define G8_SB(b, h) ((4 + (b) * 2 + (h)) * HTB)
#define G8_STAGE(bufoff, gbase, o0, o1) do { \
        __builtin_amdgcn_global_load_lds((const unsigned*)((const char*)(gbase) + (o0)), (LAS unsigned*)(lds + (bufoff) + ldsw), 16, 0, 0); \
        __builtin_amdgcn_global_load_lds((const unsigned*)((const char*)(gbase) + (o1)), (LAS unsigned*)(lds + (bufoff) + ldsw + 8192), 16, 0, 0); } while (0)
#define G8_LDA(dst, b, h) do { _Pragma("unroll") for (int m = 0; m < 4; ++m) { const bf16x8 lo_ = *(const LAS bf16x8*)(lds + G8_SA(b, h) + aoff + m * 2048), hi_ = *(const LAS bf16x8*)(lds + G8_SA(b, h) + aoff + m * 2048 + 1024); dst[m] = cat8(lo_, hi_); } } while (0)
#define G8_LDB(dst, b, h) do { _Pragma("unroll") for (int n = 0; n < 2; ++n) { const bf16x8 lo_ = *(const LAS bf16x8*)(lds + G8_SB(b, h) + boff + n * 2048), hi_ = *(const LAS bf16x8*)(lds + G8_SB(b, h) + boff + n * 2048 + 1024); dst[n] = cat8(lo_, hi_); } } while (0)
#define G8_MMA(ai, bj, At, Bt) do { __builtin_amdgcn_s_setprio(1); _Pragma("unroll") for (int m = 0; m < 4; ++m) _Pragma("unroll") for (int n = 0; n < 2; ++n) _Pragma("unroll") for (int k = 0; k < 2; ++k) \
        acc[ai][bj][m][n] = __builtin_amdgcn_mfma_f32_16x16x32_bf16(half8(Bt[n], k), half8(At[m], k), acc[ai][bj][m][n], 0, 0, 0); __builtin_amdgcn_s_setprio(0); } while (0)
#define G8_MMA8(ai, bj, At, Bt) do { __builtin_amdgcn_s_setprio(1); _Pragma("unroll") for (int m = 0; m < 4; ++m) _Pragma("unroll") for (int n = 0; n < 2; ++n) \
        asm volatile("v_mfma_scale_f32_16x16x128_f8f6f4 %0, %1, %2, %0, %3, %3 op_sel_hi:[0,0,0]" : "+v"(acc[ai][bj][m][n]) : "v"(Bt[n]), "v"(At[m]), "v"(one_scale));     __builtin_amdgcn_s_setprio(0); } while (0)
#define G8_MM(ai, bj, At, Bt) do { if constexpr (Desc::FP8) G8_MMA8(ai, bj, At, Bt); else G8_MMA(ai, bj, At, Bt); } while (0)
#define G8_WAIT_V(n) asm volatile("s_waitcnt vmcnt(" #n ")" ::: "memory")
#define G8_WAIT_L(n) asm volatile("s_waitcnt lgkmcnt(" #n ")" ::: "memory")
#define G8_BAR __builtin_amdgcn_s_barrier()
#define G8_SCHED __builtin_amdgcn_sched_barrier(0)
#define G8_MKA(u, uidx, o) do { \
        o[0][0] = (unsigned)(Desc::GATHER ? D.a_row(u, uidx, R0) : R0) * LDA2 + (unsigned)C0 * 2u; o[0][1] = (unsigned)(Desc::GATHER ? D.a_row(u, uidx, R1) : R1) * LDA2 + (unsigned)C1 * 2u; \
        if (Desc::GATHER) { o[1][0] = (unsigned)D.a_row(u, uidx, HALF + R0) * LDA2 + (unsigned)C0 * 2u; o[1][1] = (unsigned)D.a_row(u, uidx, HALF + R1) * LDA2 + (unsigned)C1 * 2u; } } while (0)
#define G8_MKB(u, o, hs) do { const unsigned dl_ = (unsigned)D.dilB(u) * LDB2; hs = (unsigned)HALF * dl_; \
        o[0] = (unsigned)Rb0 * dl_ + (unsigned)C0 * 2u; o[1] = (unsigned)Rb1 * dl_ + (unsigned)C1 * 2u; } while (0)
#define G8_A1(o, i) (Desc::GATHER ? o[1][i] : o[0][i] + (unsigned)HALF * LDA2)
    Unit cur, nxt; int ui = 0;
    if (!S.next(0, cur)) return;
    Acc acc;
#pragma unroll
    for (int a = 0; a < 2; ++a)
#pragma unroll
        for (int b = 0; b < 2; ++b)
#pragma unroll
            for (int m = 0; m < 4; ++m)
#pragma unroll
                for (int n = 0; n < 2; ++n) acc[a][b][m][n] = (f32x4){0.f, 0.f, 0.f, 0.f};
    int one_scale = 0x7f7f7f7f; asm volatile("" : "+v"(one_scale));
    i32x8 At[4], B0[2], B1[2];
    unsigned cAo[2][2], cBo[2], nAo[2][2], nBo[2], cBh, nBh;
    G8_MKA(cur, 0, cAo); G8_MKB(cur, cBo, cBh); nBh = cBh;
    const char* cA = D.a_base(cur); const char* cB = D.b_base(cur);
    G8_STAGE(G8_SB(0, 0), cB, cBo[0], cBo[1]); G8_STAGE(G8_SB(0, 1), cB + cBh, cBo[0], cBo[1]); G8_STAGE(G8_SA(0, 0), cA, cAo[0][0], cAo[0][1]); G8_STAGE(G8_SA(0, 1), cA, G8_A1(cAo, 0), G8_A1(cAo, 1));
    if (wr == 1) G8_BAR;
    G8_WAIT_V(2); G8_BAR;
    G8_STAGE(G8_SB(1, 0), cB + kstep, cBo[0], cBo[1]); G8_STAGE(G8_SA(1, 0), cA + kstep, cAo[0][0], cAo[0][1]); G8_STAGE(G8_SB(1, 1), cB + kstep + cBh, cBo[0], cBo[1]);
    G8_WAIT_V(6); G8_BAR;
    for (;;) {
        const bool has_next = S.next(ui + 1, nxt);
        const char* nA = cA; const char* nB = cB;
        if (has_next) { nA = D.a_base(nxt); nB = D.b_base(nxt); }
        if (Desc::GATHER) { if (has_next) G8_MKA(nxt, ui + 1, nAo); else { nAo[0][0] = cAo[0][0]; nAo[0][1] = cAo[0][1]; nAo[1][0] = cAo[1][0]; nAo[1][1] = cAo[1][1]; } }
        if (Desc::VARB) { if (has_next) G8_MKB(nxt, nBo, nBh); else { nBo[0] = cBo[0]; nBo[1] = cBo[1]; nBh = cBh; } }
        const int nt = D.nt(cur);
#pragma unroll 1
        for (int t = 0; t < nt; t += 2) {
            const bool last = (t == nt - 2);
            const char* a1 = cA + (size_t)(t + 1) * kstep;
            const char* a2 = last ? nA : cA + (size_t)(t + 2) * kstep; const char* b2 = last ? nB : cB + (size_t)(t + 2) * kstep;
            const char* a3 = a2 + kstep; const char* b3 = b2 + kstep;
            const unsigned xa00 = (Desc::GATHER && last) ? nAo[0][0] : cAo[0][0], xa01 = (Desc::GATHER && last) ? nAo[0][1] : cAo[0][1];
            const unsigned xa10 = Desc::GATHER ? (last ? nAo[1][0] : cAo[1][0]) : xa00 + (unsigned)HALF * LDA2, xa11 = Desc::GATHER ? (last ? nAo[1][1] : cAo[1][1]) : xa01 + (unsigned)HALF * LDA2;
            const unsigned xb0 = (Desc::VARB && last) ? nBo[0] : cBo[0], xb1 = (Desc::VARB && last) ? nBo[1] : cBo[1], xbh = (Desc::VARB && last) ? nBh : cBh;
            G8_LDB(B0, 0, 0); G8_LDB(B1, 0, 1); G8_SCHED; G8_LDA(At, 0, 0); G8_STAGE(G8_SA(1, 1), a1, G8_A1(cAo, 0), G8_A1(cAo, 1));
            G8_WAIT_V(8); G8_WAIT_L(0); G8_BAR; G8_MM(0, 0, At, B0); G8_MM(0, 1, At, B1); G8_BAR; G8_SCHED;
            G8_LDA(At, 0, 1); G8_STAGE(G8_SB(0, 0), b2, xb0, xb1); G8_STAGE(G8_SB(0, 1), b2 + xbh, xb0, xb1); G8_STAGE(G8_SA(0, 0), a2, xa00, xa01);
            G8_WAIT_V(8); G8_WAIT_L(0); G8_BAR; G8_MM(1, 0, At, B0); G8_MM(1, 1, At, B1); G8_BAR; G8_SCHED;
            G8_LDB(B0, 1, 0); G8_LDB(B1, 1, 1); G8_SCHED; G8_LDA(At, 1, 0); G8_STAGE(G8_SA(0, 1), a2, xa10, xa11);
            G8_WAIT_V(8); G8_WAIT_L(0); G8_BAR; G8_MM(0, 0, At, B0); G8_MM(0, 1, At, B1); G8_BAR; G8_SCHED;
            G8_LDA(At, 1, 1); G8_STAGE(G8_SB(1, 0), b3, xb0, xb1); G8_STAGE(G8_SB(1, 1), b3 + xbh, xb0, xb1); G8_STAGE(G8_SA(1, 0), a3, xa00, xa01);
            G8_WAIT_V(8); G8_WAIT_L(0); G8_BAR; G8_MM(1, 0, At, B0); G8_MM(1, 1, At, B1); G8_BAR; G8_SCHED;
        }
        if constexpr (ALIGN_EPI) { if (wr == 0) G8_BAR; }
        if constexpr (Desc::FP8) asm volatile("s_nop 15\n\ts_nop 15" ::: "memory");
        E(acc, cur, wr, wc, fr, fq);
        if (!has_next) break;
#pragma unroll
        for (int a = 0; a < 2; ++a)
#pragma unroll
            for (int b = 0; b < 2; ++b)
#pragma unroll
                for (int m = 0; m < 4; ++m)
#pragma unroll
                    for (int n = 0; n < 2; ++n) acc[a][b][m][n] = (f32x4){0.f, 0.f, 0.f, 0.f};
        if constexpr (Desc::FP8) asm volatile("s_nop 7" ::: "memory");
        cur = nxt; cA = nA; cB = nB; ++ui;
        if (Desc::GATHER) { cAo[0][0] = nAo[0][0]; cAo[0][1] = nAo[0][1]; cAo[1][0] = nAo[1][0]; cAo[1][1] = nAo[1][1]; }
        if (Desc::VARB) { cBo[0] = nBo[0]; cBo[1] = nBo[1]; cBh = nBh; }
        if constexpr (ALIGN_EPI) { if (wr == 1) G8_BAR; }
    }
    G8_WAIT_V(0);
    if constexpr (!ALIGN_EPI) { if (wr == 0) G8_BAR; }
    G8_BAR;
#undef G8_SA
#undef G8_SB
#undef G8_STAGE
#undef G8_LDA
#undef G8_LDB
#undef G8_MMA
#undef G8_MMA8
#undef G8_MM
#undef G8_WAIT_V
#undef G8_WAIT_L
#undef G8_BAR
#undef G8_SCHED
#undef G8_MKA
#undef G8_MKB
#undef G8_A1
}
DI unsigned cvt2(float lo, float hi) { typedef __bf16 bf2_t __attribute__((ext_vector_type(2))); const f32x2 v = {lo, hi}; const bf2_t b = __builtin_convertvector(v, bf2_t); return __builtin_bit_cast(unsigned, b); }
DI u32x4 pack8(const f32x4& a, const f32x4& b) { u32x4 w; w[0] = cvt2(a[0], a[1]); w[1] = cvt2(a[2], a[3]); w[2] = cvt2(b[0], b[1]); w[3] = cvt2(b[2], b[3]); return w; }
DI float fsig(float x) { return __builtin_amdgcn_rcpf(1.0f + __expf(-x)); }

struct DescMoe1 { static constexpr bool GATHER = true, VARB = false, FP8 = true; static constexpr int lda = DM / 2, ldb = DM / 2; const bf16_t* XN8; const bf16_t* WGU; const LAS int* rowlist;
    DI const char* a_base(const Unit&) const { return (const char*)XN8; }
    DI const char* b_base(const Unit& u) const { return (const char*)WGU + ((size_t)(u.pm >> 3) * 4096 + (size_t)u.pn * 256) * DM; }
    DI int a_row(const Unit&, int uidx, int r) const { return rowlist[uidx * 256 + r]; }
    DI int nt(const Unit&) const { return DM / 128; } DI int dilB(const Unit&) const { return 1; } };
struct EpiSwiglu { static constexpr bool PERM = true; unsigned char* HID8;
    DI void operator()(const Acc& acc, const Unit& u, int wr, int wc, int fr, int fq) const {
        const int row0 = u.pm * BM + wr * 64 + fr, col0 = u.pn * 128 + wc * 32 + 8 * fq; constexpr float WI = 1.0f / W8_SCALE;
#pragma unroll
        for (int ai = 0; ai < 2; ++ai)
#pragma unroll
            for (int m = 0; m < 4; ++m) { f32x4 h0, h1;
#pragma unroll
                for (int j = 0; j < 4; ++j) { const float g0 = acc[ai][0][m][0][j] * WI, g1 = acc[ai][0][m][1][j] * WI;
                    h0[j] = g0 * fsig(g0) * acc[ai][1][m][0][j] * (WI * H8_SCALE); h1[j] = g1 * fsig(g1) * acc[ai][1][m][1][j] * (WI * H8_SCALE); }
                u32x2 w; w[0] = pk4_fp8(h0[0], h0[1], h0[2], h0[3]); w[1] = pk4_fp8(h1[0], h1[1], h1[2], h1[3]);
                *(u32x2*)(HID8 + (size_t)(row0 + ai * HALF + m * 16) * FF + col0) = w; }
    } };
struct DescMoe2 { static constexpr bool GATHER = false, VARB = false, FP8 = true; static constexpr int lda = FF / 2, ldb = FF / 2; const unsigned char* HID8; const bf16_t* WD;
    DI const char* a_base(const Unit& u) const { return (const char*)HID8 + (size_t)u.pm * 256 * FF; }
    DI const char* b_base(const Unit& u) const { return (const char*)WD + ((size_t)(u.pm >> 3) * 1024 + (size_t)u.pn * 256) * FF; }
    DI int a_row(const Unit&, int, int r) const { return r; }
    DI int nt(const Unit&) const { return FF / 128; } DI int dilB(const Unit&) const { return 1; } };
struct EpiY { static constexpr bool PERM = true; bf16_t* Y; const float* VAL;
    DI void operator()(const Acc& acc, const Unit& u, int wr, int wc, int fr, int fq) const {
        const int row0 = u.pm * BM + wr * 64 + fr, col0 = u.pn * BM + wc * 32 + 8 * fq;
#pragma unroll
        for (int ai = 0; ai < 2; ++ai)
#pragma unroll
            for (int m = 0; m < 4; ++m) { const int row = row0 + ai * HALF + m * 16; const float v = VAL[row] * (1.0f / (W8_SCALE * H8_SCALE));
#pragma unroll
                for (int bj = 0; bj < 2; ++bj) *(u32x4*)(Y + (size_t)row * DM + col0 + bj * HALF) = pack8(acc[ai][bj][m][0] * v, acc[ai][bj][m][1] * v); }
    } };
struct DescOut { static constexpr bool GATHER = false, VARB = false, FP8 = false; static constexpr int lda = DM, ldb = DM; const bf16_t* MG; const bf16_t* WO;
    DI const char* a_base(const Unit& u) const { return (const char*)(MG + (size_t)u.pm * 256 * DM); }
    DI const char* b_base(const Unit& u) const { return (const char*)(WO + (size_t)u.pn * 256 * DM); }
    DI int a_row(const Unit&, int, int r) const { return r; }
    DI int nt(const Unit&) const { return DM / BK; } DI int dilB(const Unit&) const { return 1; } };
struct EpiResid { static constexpr bool PERM = false; float* X;
    DI void operator()(const Acc& acc, const Unit& u, int wr, int wc, int fr, int fq) const {
        const int row0 = u.pm * BM + wr * 64 + fr, col0 = u.pn * BM + wc * 32 + 4 * fq;
#pragma unroll
        for (int ai = 0; ai < 2; ++ai)
#pragma unroll
            for (int m = 0; m < 4; ++m) { float* xr = X + (size_t)(row0 + ai * HALF + m * 16) * DM + col0;
#pragma unroll
                for (int bj = 0; bj < 2; ++bj)
#pragma unroll
                    for (int n = 0; n < 2; ++n) { f32x4* q = (f32x4*)(xr + bj * HALF + 16 * n); *q = *q + acc[ai][bj][m][n]; } }
    } };
struct DescInproj { static constexpr bool GATHER = false, VARB = false, FP8 = false; static constexpr int lda = DM, ldb = DM; const bf16_t* XN; const bf16_t* WIN;
    DI const char* a_base(const Unit& u) const { return (const char*)(XN + (size_t)u.pm * 256 * DM); }
    DI const char* b_base(const Unit& u) const { return (const char*)(WIN + (size_t)u.pn * 256 * DM); }
    DI int a_row(const Unit&, int, int r) const { return r; }
    DI int nt(const Unit&) const { return DM / BK; } DI int dilB(const Unit&) const { return 1; } };
struct EpiInproj { static constexpr bool PERM = true; bf16_t* QK; bf16_t* G; const float* cosT; const float* sinT; const float* bgate;
    DI void operator()(const Acc& acc, const Unit& u, int wr, int wc, int fr, int fq) const {
        const int row0 = u.pm * BM + wr * 64 + fr;
        if (u.pn < 5) {
            const int hr = 4 * u.pn + wc; const float sc = (hr < 6 || (hr >= 8 && hr < 14)) ? 0.125f * 1.4426950408889634f : 1.0f;
#pragma unroll
            for (int ai = 0; ai < 2; ++ai)
#pragma unroll
                for (int m = 0; m < 4; ++m) { const int row = row0 + ai * HALF + m * 16, pos = row & (SEQ - 1);
                    const f32x4 c0 = *(const f32x4*)(cosT + pos * 32 + 8 * fq), c1 = *(const f32x4*)(cosT + pos * 32 + 8 * fq + 4), s0 = *(const f32x4*)(sinT + pos * 32 + 8 * fq), s1 = *(const f32x4*)(sinT + pos * 32 + 8 * fq + 4);
                    const f32x4 a0 = acc[ai][0][m][0], a1 = acc[ai][0][m][1], b0 = acc[ai][1][m][0], b1 = acc[ai][1][m][1];
                    bf16_t* o = QK + (size_t)row * QKW + 64 * hr + 8 * fq;
                    *(u32x4*)o = pack8((a0 * c0 - b0 * s0) * sc, (a1 * c1 - b1 * s1) * sc);
                    *(u32x4*)(o + 32) = pack8((b0 * c0 + a0 * s0) * sc, (b1 * c1 + a1 * s1) * sc); }
        } else if (u.pn < 7) {
            const float sc = u.pn == 5 ? 0.125f * 1.4426950408889634f : 1.0f; const int col0 = 1280 + (u.pn - 5) * 256 + wc * 32 + 8 * fq;
#pragma unroll
            for (int ai = 0; ai < 2; ++ai)
#pragma unroll
                for (int m = 0; m < 4; ++m)
#pragma unroll
                    for (int bj = 0; bj < 2; ++bj) *(u32x4*)(QK + (size_t)(row0 + ai * HALF + m * 16) * QKW + col0 + bj * HALF) = pack8(acc[ai][bj][m][0] * sc, acc[ai][bj][m][1] * sc);
        } else {
            const int col0 = (u.pn - 7) * 256 + wc * 32 + 8 * fq;
            f32x4 bv[2][2];
#pragma unroll
            for (int bj = 0; bj < 2; ++bj)
#pragma unroll
                for (int n = 0; n < 2; ++n) bv[bj][n] = *(const f32x4*)(bgate + col0 + bj * HALF + 4 * n);
#pragma unroll
            for (int ai = 0; ai < 2; ++ai)
#pragma unroll
                for (int m = 0; m < 4; ++m)
#pragma unroll
                    for (int bj = 0; bj < 2; ++bj) { f32x4 v0 = acc[ai][bj][m][0] + bv[bj][0], v1 = acc[ai][bj][m][1] + bv[bj][1];
#pragma unroll
                        for (int j = 0; j < 4; ++j) { v0[j] = fsig(v0[j]); v1[j] = fsig(v1[j]); }
                        *(u32x4*)(G + (size_t)(row0 + ai * HALF + m * 16) * 3072 + col0 + bj * HALF) = pack8(v0, v1); }
        }
    } };
struct DescVT { static constexpr bool GATHER = false, VARB = true, FP8 = false; static constexpr int lda = DM, ldb = DM; const bf16_t* WV; const bf16_t* XN;
    DI const char* a_base(const Unit& u) const { return (const char*)(WV + (size_t)u.pm * 256 * DM); }
    DI const char* b_base(const Unit& u) const { return (const char*)(XN + (u.pm < 2 ? (size_t)u.pn * 256 : (size_t)((u.pn >> 4) * SEQ + (u.pn & 15))) * DM); }
    DI int a_row(const Unit&, int, int r) const { return r; }
    DI int nt(const Unit&) const { return DM / BK; } DI int dilB(const Unit& u) const { return u.pm < 2 ? 1 : 16; } };
struct EpiVT { static constexpr bool PERM = true; bf16_t* VT;
    DI void operator()(const Acc& acc, const Unit& u, int wr, int wc, int fr, int fq) const {
        const int row0 = u.pm * BM + wr * 64 + fr, col0 = u.pn * BM + wc * 32 + 8 * fq;
#pragma unroll
        for (int ai = 0; ai < 2; ++ai)
#pragma unroll
            for (int m = 0; m < 4; ++m)
#pragma unroll
                for (int bj = 0; bj < 2; ++bj) *(u32x4*)(VT + (size_t)(row0 + ai * HALF + m * 16) * NTOK + col0 + bj * HALF) = pack8(acc[ai][bj][m][0], acc[ai][bj][m][1]);
    } };
struct DescMerge { static constexpr bool GATHER = false, VARB = false, FP8 = false; static constexpr int lda = OCW, ldb = 768; const bf16_t* OC; const bf16_t* WM;
    DI int k0(const Unit& u) const { return u.aux == 0 ? 0 : u.aux == 1 ? 384 : 512; }
    DI const char* a_base(const Unit& u) const { return (const char*)(OC + (size_t)u.pm * 256 * OCW + k0(u)); }
    DI const char* b_base(const Unit& u) const { return (const char*)(WM + (size_t)u.pn * 256 * 768 + k0(u)); }
    DI int a_row(const Unit&, int, int r) const { return r; }
    DI int nt(const Unit& u) const { return u.aux == 0 ? 6 : u.aux == 1 ? 2 : 4; } DI int dilB(const Unit&) const { return 1; } };
struct MergeOrder { StaticOrder base;
    DI bool next(int i, Unit& u) const { const int q = i / 3; if (!base.next(q, u)) return false; u.aux = i - 3 * q; return true; } };
struct EpiMerge { static constexpr bool PERM = true; bf16_t* MG; const bf16_t* G;
    DI void operator()(const Acc& acc, const Unit& u, int wr, int wc, int fr, int fq) const {
        const int row0 = u.pm * BM + wr * 64 + fr, col0 = u.pn * BM + wc * 32 + 8 * fq;
#pragma unroll
        for (int ai = 0; ai < 2; ++ai)
#pragma unroll
            for (int m = 0; m < 4; ++m)
#pragma unroll
                for (int bj = 0; bj < 2; ++bj) { const int row = row0 + ai * HALF + m * 16, col = col0 + bj * HALF;
                    const u32x4 g = *(const u32x4*)(G + (size_t)row * 3072 + 1024 * u.aux + col);
                    f32x4 v0 = acc[ai][bj][m][0], v1 = acc[ai][bj][m][1];
                    v0[0] *= bflo(g[0]); v0[1] *= bfhi(g[0]); v0[2] *= bflo(g[1]); v0[3] *= bfhi(g[1]); v1[0] *= bflo(g[2]); v1[1] *= bfhi(g[2]); v1[2] *= bflo(g[3]); v1[3] *= bfhi(g[3]);
                    u32x4* o = (u32x4*)(MG + (size_t)row * DM + col);
                    if (u.aux != 0) { const u32x4 w = *o; v0[0] += bflo(w[0]); v0[1] += bfhi(w[0]); v0[2] += bflo(w[1]); v0[3] += bfhi(w[1]); v1[0] += bflo(w[2]); v1[1] += bfhi(w[2]); v1[2] += bflo(w[3]); v1[3] += bfhi(w[3]); }
                    *o = pack8(v0, v1); }
    } };
}
DI void f_inproj_phase(const Params& p, int l, LAS unsigned char* lds) {
    { g8::StaticOrder S; S.init(NTOK, 4352, gridDim.x, blockIdx.x);
      g8::DescInproj D{P_XN(p), P_W(p, l, LW_WIN)}; g8::EpiInproj E{P_QK(p), P_G(p), P_COS(p), P_SIN(p), p.b_gate + (size_t)l * 3072};
      g8::gemm_phase<g8::DescInproj, g8::EpiInproj, g8::StaticOrder, true>(lds, D, S, E); }
    { g8::StaticOrder S; S.init(VCH, NTOK, gridDim.x, (blockIdx.x + gridDim.x - 64) % gridDim.x);
      g8::DescVT D{P_W(p, l, LW_WV), P_XN(p)}; g8::EpiVT E{P_VT(p)};
      g8::gemm_phase<g8::DescVT, g8::EpiVT, g8::StaticOrder, true>(lds, D, S, E); }
}
struct OneUnit { int pm, pn; DI bool next(int i, g8::Unit& u) const { if (i != 0) return false; u.pm = pm; u.pn = pn; u.aux = 0; return true; } };
DI void f_gate_tail_units(const Params& p, int l, LAS unsigned char* lds) {
    if (blockIdx.x < 128) {
        OneUnit S{(int)(blockIdx.x >> 1), 17 + (int)(blockIdx.x & 1)};
        g8::DescInproj D{P_XN(p), P_W(p, l, LW_WIN)}; g8::EpiInproj E{P_QK(p), P_G(p), P_COS(p), P_SIN(p), p.b_gate + (size_t)l * 3072};
        g8::gemm_phase<g8::DescInproj, g8::EpiInproj, OneUnit, false>(lds, D, S, E);
        __syncthreads();
    }
}
DI void f_merge_phase(const Params& p, int l, LAS unsigned char* lds) {
    g8::MergeOrder S; S.base.init(NTOK, DM, gridDim.x, blockIdx.x);
    { g8::Unit u0; if (S.next(0, u0)) bcombine_rows(p, u0.pm * 256, 256); asm volatile("s_waitcnt vmcnt(0)" ::: "memory"); __syncthreads(); }
    g8::DescMerge D{P_OC(p), P_W(p, l, LW_WM)}; g8::EpiMerge E{P_MG(p), P_G(p)};
    g8::gemm_phase<g8::DescMerge, g8::EpiMerge, g8::MergeOrder, true>(lds, D, S, E);
}

DI void f_moe1_phase(const Params& p, int l, LAS unsigned char* lds) {
    g8::StaticOrder S; S.init(NROWS_E, 2 * FF, gridDim.x, blockIdx.x);
    LAS int* rowlist = (LAS int*)(lds + 131072 + 64);
    g8::Unit u;
    for (int i = 0; i < 8 && S.next(i, u); ++i)
        for (int r = otid(); r < 256; r += 512) rowlist[i * 256 + r] = ((u.pm >> 1) & 3) * SEQ + P_IDX(p)[u.pm * 256 + r];
    __syncthreads();
    g8::DescMoe1 D{(const bf16_t*)P_XN8(p), P_W(p, l, LW_WGU), rowlist}; g8::EpiSwiglu E{(unsigned char*)P_HID(p)};
    g8::gemm_phase<g8::DescMoe1, g8::EpiSwiglu, g8::StaticOrder, true>(lds, D, S, E);
}
DI void f_moe2_phase(const Params& p, int l, LAS unsigned char* lds) {
    g8::StaticOrder S; S.init(NROWS_E, DM, gridDim.x, blockIdx.x);
    g8::DescMoe2 D{(const unsigned char*)P_HID(p), P_W(p, l, LW_WD)}; g8::EpiY E{P_Y(p), P_VAL(p)};
    g8::gemm_phase<g8::DescMoe2, g8::EpiY, g8::StaticOrder, true>(lds, D, S, E);
}
DI void f_out_phase(const Params& p, int l, LAS unsigned char* lds) {
    g8::StaticOrder S; S.init(NTOK, DM, gridDim.x, blockIdx.x);
    g8::DescOut D{P_MG(p), P_W(p, l, LW_WO)}; g8::EpiResid E{P_X(p)};
    g8::gemm_phase<g8::DescOut, g8::EpiResid, g8::StaticOrder, false>(lds, D, S, E);
}

#define XB_TMO      128
#define XB_XCNT(j)  (256  + 64 * (j))
#define XB_XSUB(j)  (1280 + 64 * (j))
#define XB_XGEN(j)  (2304 + 64 * (j))
#define XB_TOP      3328
#define XB_TOPGEN   3392
#define XCD_BAR_WORDS 3456
#define XB_SPIN_CAP (1u << 22)

__device__ __forceinline__ unsigned xb_ld(unsigned* p)              { return __hip_atomic_load(p, __ATOMIC_RELAXED, __HIP_MEMORY_SCOPE_AGENT); }
__device__ __forceinline__ unsigned xb_add(unsigned* p, unsigned v) { return __hip_atomic_fetch_add(p, v, __ATOMIC_RELAXED, __HIP_MEMORY_SCOPE_AGENT); }
__device__ __forceinline__ unsigned xb_xcc_id() { return (unsigned)__builtin_amdgcn_s_getreg((3 << 11) | 20) & 0xFu; }
#define XB_SPIN(cond, bar) do { unsigned _sp = 0; while (cond) { __builtin_amdgcn_s_sleep(1); \
    if ((++_sp & 255u) == 0u) { if (xb_ld(&(bar)[XB_TMO])) break; if (_sp > XB_SPIN_CAP) { atomicAdd(&(bar)[XB_TMO], 1u); break; } } } } while (0)

struct XcdBarrier {
    unsigned* bar; unsigned x;
    volatile LAS unsigned* st;
};

__device__ __forceinline__ XcdBarrier xcd_barrier_post(unsigned* bar, volatile LAS unsigned* st) {
    XcdBarrier b; b.bar = bar; b.x = xb_xcc_id(); b.st = st;
    if (threadIdx.x == 0) (void)xb_add(&bar[XB_XCNT(b.x)], 1u);
    return b;
}
__device__ __forceinline__ void xcd_barrier_complete(unsigned* bar, unsigned x, unsigned& nloc, unsigned& nx) {
    const unsigned G = gridDim.x * gridDim.y * gridDim.z;
    unsigned sum, cnt, mine, sp = 0u;
    for (;;) {
        sum = 0u; cnt = 0u; mine = 0u;
#pragma unroll
        for (unsigned j = 0; j < 16; ++j) { const unsigned c = xb_ld(&bar[XB_XCNT(j)]); sum += c; cnt += (c > 0u) ? 1u : 0u; mine = (j == x) ? c : mine; }
        if (sum == G) break;
        __builtin_amdgcn_s_sleep(1);
        if ((++sp & 255u) == 0u) { if (xb_ld(&bar[XB_TMO])) break; if (sp > XB_SPIN_CAP) { atomicAdd(&bar[XB_TMO], 1u); break; } }
    }
    nloc = mine > 0u ? mine : 1u; nx = cnt > 0u ? cnt : 1u;
}

__device__ __forceinline__ void xcd_barrier(const XcdBarrier& b) {
    asm volatile("s_waitcnt vmcnt(0)" ::: "memory");
    __syncthreads();
    if (threadIdx.x == 0) {
        unsigned* bar = b.bar;
        __builtin_amdgcn_s_waitcnt(0);
        unsigned nloc = b.st[0], nx = b.st[1];
        if (nloc == 0u) { xcd_barrier_complete(bar, b.x, nloc, nx); b.st[0] = nloc; b.st[1] = nx; }
        const unsigned old = xb_add(&bar[XB_XSUB(b.x)], 1u);
        const unsigned gen = old / nloc;
        if (old + 1u == (gen + 1u) * nloc) {
            __builtin_amdgcn_fence(__ATOMIC_RELEASE, "agent");
            asm volatile("s_waitcnt vmcnt(0)" ::: "memory");
            const unsigned og = xb_add(&bar[XB_TOP], 1u);
            const unsigned tg = og / nx;
            if (og + 1u == (tg + 1u) * nx) xb_add(&bar[XB_TOPGEN], 1u);
            else XB_SPIN(xb_ld(&bar[XB_TOPGEN]) == tg, bar);
            __builtin_amdgcn_fence(__ATOMIC_ACQUIRE, "agent");
            xb_add(&bar[XB_XGEN(b.x)], 1u);
            asm volatile("s_waitcnt vmcnt(0)" ::: "memory");
        } else {
            XB_SPIN(xb_ld(&bar[XB_XGEN(b.x)]) == gen, bar);
            __builtin_amdgcn_fence(__ATOMIC_ACQUIRE, "agent");
            asm volatile("s_waitcnt vmcnt(0)" ::: "memory");
        }
    }
    __syncthreads();
}

constexpr int LDS_BYTES = 131072 + 64 + 8192;
#ifndef REP_PREP
#define REP_PREP 1
#define REP_INPROJ 1
#define REP_ATTN 1
#define REP_MERGE 1
#define REP_BCOMB 1
#define REP_N2 1
#define REP_TOPK 1
#define REP_MOE1 1
#define REP_MOE2 1
#endif
#define PH(...) do { Params q = p; { size_t z_ = 0; asm volatile("" : "+s"(z_)); q.ws = p.ws + z_; } __VA_ARGS__; } while (0)
#define GRID_BAR() do { XcdBarrier b_; { size_t z_ = 0; asm volatile("" : "+s"(z_)); b_.bar = (unsigned*)(p.ws + z_ + OFF_CTL); } b_.x = xb_xcc_id(); b_.st = (volatile LAS unsigned*)(lds + 131072); xcd_barrier(b_); } while (0)
__global__ void __launch_bounds__(512, 2) mega_fwd(Params p) {
    extern __shared__ __attribute__((aligned(16))) unsigned char lds_raw[];
    LAS unsigned char* lds = (LAS unsigned char*)lds_raw;
    { volatile LAS unsigned* xbw = (volatile LAS unsigned*)(lds + 131072);
      if (threadIdx.x == 0) { xbw[0] = 0u; xbw[1] = 0u; xbw[2] = 0u; xbw[3] = 0u; }
      __syncthreads();
      (void)xcd_barrier_post((unsigned*)(p.ws + OFF_CTL), xbw); }
    PH(prep_phase(q, (LAS float*)lds); norm1_phase<0>(q, 0));
    GRID_BAR();
#define LAYER(l) do { \
        if ((l) != 0) { PH(norm1_phase<1>(q, (l))); GRID_BAR(); } \
        PH(f_inproj_phase(q, (l), lds)); GRID_BAR(); \
        PH(f_gate_tail_units(q, (l), lds); f_attn_phase(q, (l), lds, (l))); GRID_BAR(); \
        PH(f_merge_phase(q, (l), lds)); GRID_BAR(); \
        PH(f_out_phase(q, (l), lds)); GRID_BAR(); \
        PH(norm2_router_phase(q, (l), (LAS float*)lds)); GRID_BAR(); \
        PH(topk_phase(q, (LAS unsigned*)lds)); GRID_BAR(); \
        PH(f_moe1_phase(q, (l), lds)); GRID_BAR(); \
        PH(f_moe2_phase(q, (l), lds)); GRID_BAR(); } while (0)
    LAYER(0); LAYER(1); LAYER(2); LAYER(3);
#undef LAYER
    PH(norm1_phase<2>(q, 0));
}

extern "C" void kernel_launch(void* const* d_in, const int* in_sizes, int n_in, void* d_out, int out_size, void* d_ws, size_t ws_size, hipStream_t stream) {
    (void)in_sizes; (void)out_size;
    static int grid = 0;
    if (grid == 0) {
        if (n_in != 16 || ws_size < OFF_END) { grid = -1; return; }
        int dev = 0, cus = 0, per_cu = 0;
        if (hipGetDevice(&dev) != hipSuccess || hipDeviceGetAttribute(&cus, hipDeviceAttributeMultiprocessorCount, dev) != hipSuccess) { grid = -1; return; }
        if (hipFuncSetAttribute((const void*)mega_fwd, hipFuncAttributeMaxDynamicSharedMemorySize, LDS_BYTES) != hipSuccess) { grid = -1; return; }
        if (hipOccupancyMaxActiveBlocksPerMultiprocessor(&per_cu, (const void*)mega_fwd, 512, LDS_BYTES) != hipSuccess || per_cu < 1) { (void)hipGetLastError(); }
        grid = cus;
    }
    if (grid < 0) return;
    if (hipMemsetAsync((char*)d_ws + OFF_CTL, 0, 65536, stream) != hipSuccess) return;
    Params p{};
    p.x = (const float*)d_in[0]; p.w_in = (const float*)d_in[1]; p.b_gate = (const float*)d_in[2]; p.sink = (const float*)d_in[3]; p.rpb = (const float*)d_in[4];
    p.w_a = (const float*)d_in[5]; p.w_b = (const float*)d_in[6]; p.w_c = (const float*)d_in[7]; p.w_out = (const float*)d_in[8]; p.norm_mix = (const float*)d_in[9];
    p.norm_ffn = (const float*)d_in[10]; p.w_router = (const float*)d_in[11]; p.w_gate_e = (const float*)d_in[12]; p.w_up_e = (const float*)d_in[13]; p.w_down_e = (const float*)d_in[14];
    p.norm_final = (const float*)d_in[15]; p.out = (float*)d_out; p.ws = (unsigned char*)d_ws;
    hipLaunchKernelGGL(mega_fwd, dim3(grid), dim3(512), LDS_BYTES, stream, p);
}
```

```cpp
#include <hip/hip_runtime.h>
#include <stdint.h>

#define DI __device__ __forceinline__
#define LAS __attribute__((address_space(3)))
typedef unsigned short bf16_t;
typedef short bf16x8 __attribute__((ext_vector_type(8)));
typedef float f32x2 __attribute__((ext_vector_type(2)));
typedef float f32x4 __attribute__((ext_vector_type(4)));
typedef float f32x16 __attribute__((ext_vector_type(16)));
typedef unsigned u32x2 __attribute__((ext_vector_type(2)));
typedef unsigned u32x4 __attribute__((ext_vector_type(4)));

constexpr int NTOK = 16384, DM = 1024, SEQ = 4096, NBATCH = 4, NLAYER = 4, NEXP = 16, FF = 2048, CAP = 512, PROJ = 5632;
constexpr int QKW = 1792;
constexpr int VCH = 768;
constexpr int OCW = 768;
constexpr int NROWS_E = NBATCH * CAP * NEXP;

constexpr size_t OFF_CTL = 0;
constexpr size_t OFF_COS = 65536;
constexpr size_t OFF_SIN = OFF_COS + (size_t)SEQ * 32 * 4;
constexpr size_t OFF_W   = 2u << 20;
constexpr size_t WIN_B = (size_t)4864 * 1024 * 2, WV_B = (size_t)768 * 1024 * 2, WM_B = (size_t)1024 * 768 * 2, WO_B = (size_t)1024 * 1024 * 2;
constexpr size_t WGU_B = (size_t)NEXP * 4096 * 1024 * 2, WD_B = (size_t)NEXP * 1024 * 2048 * 2;
constexpr size_t LW_WIN = 0, LW_WV = LW_WIN + WIN_B, LW_WM = LW_WV + WV_B, LW_WO = LW_WM + WM_B, LW_WGU = LW_WO + WO_B, LW_WD = LW_WGU + WGU_B, LW = LW_WD + WD_B;
constexpr size_t OFF_X   = OFF_W + NLAYER * LW;
constexpr size_t OFF_XN  = OFF_X + (size_t)NTOK * DM * 4;
constexpr size_t OFF_QK  = OFF_XN + (size_t)NTOK * DM * 2;
constexpr size_t OFF_VT  = OFF_QK + (size_t)NTOK * QKW * 2;
constexpr size_t OFF_G   = OFF_VT + (size_t)VCH * NTOK * 2;
constexpr size_t OFF_OC  = OFF_G + (size_t)NTOK * 3072 * 2;
constexpr size_t OFF_OB3 = OFF_OC + (size_t)NTOK * OCW * 2;
constexpr size_t OFF_LSE = OFF_OB3 + (size_t)3 * NTOK * 128 * 2;
constexpr size_t OFF_MG  = OFF_LSE + (size_t)3 * NTOK * 2 * 4;
constexpr size_t OFF_AFF = OFF_MG + (size_t)NTOK * DM * 2;
constexpr size_t OFF_IDX = OFF_AFF + (size_t)NTOK * NEXP * 4;
constexpr size_t OFF_VAL = OFF_IDX + (size_t)NROWS_E * 4;
constexpr size_t OFF_INV = OFF_VAL + (size_t)NROWS_E * 4;
constexpr size_t OFF_HID = OFF_INV + (size_t)NTOK * NEXP * 4;
constexpr size_t OFF_Y   = OFF_HID + (size_t)NROWS_E * FF * 2;
constexpr size_t OFF_XN8 = OFF_Y + (size_t)NROWS_E * DM * 2;
constexpr size_t OFF_END = OFF_XN8 + (size_t)NTOK * DM;

struct Params {
    const float *x, *w_in, *b_gate, *sink, *rpb, *w_a, *w_b, *w_c, *w_out, *norm_mix, *norm_ffn, *w_router, *w_gate_e, *w_up_e, *w_down_e, *norm_final;
    float* out; unsigned char* ws;
};
DI float*  P_COS(const Params& p) { return (float*)(p.ws + OFF_COS); }
DI float*  P_SIN(const Params& p) { return (float*)(p.ws + OFF_SIN); }
DI bf16_t* P_W(const Params& p, int l, size_t off) { return (bf16_t*)(p.ws + OFF_W + (size_t)l * LW + off); }
DI float*  P_X(const Params& p) { return (float*)(p.ws + OFF_X); }
DI bf16_t* P_XN(const Params& p) { return (bf16_t*)(p.ws + OFF_XN); }
DI bf16_t* P_QK(const Params& p) { return (bf16_t*)(p.ws + OFF_QK); }
DI bf16_t* P_VT(const Params& p) { return (bf16_t*)(p.ws + OFF_VT); }
DI bf16_t* P_G(const Params& p) { return (bf16_t*)(p.ws + OFF_G); }
DI bf16_t* P_OC(const Params& p) { return (bf16_t*)(p.ws + OFF_OC); }
DI bf16_t* P_OB3(const Params& p) { return (bf16_t*)(p.ws + OFF_OB3); }
DI float*  P_LSE(const Params& p) { return (float*)(p.ws + OFF_LSE); }
DI bf16_t* P_MG(const Params& p) { return (bf16_t*)(p.ws + OFF_MG); }
DI float*  P_AFF(const Params& p) { return (float*)(p.ws + OFF_AFF); }
DI int*    P_IDX(const Params& p) { return (int*)(p.ws + OFF_IDX); }
DI float*  P_VAL(const Params& p) { return (float*)(p.ws + OFF_VAL); }
DI int*    P_INV(const Params& p) { return (int*)(p.ws + OFF_INV); }
DI bf16_t* P_HID(const Params& p) { return (bf16_t*)(p.ws + OFF_HID); }
DI bf16_t* P_Y(const Params& p) { return (bf16_t*)(p.ws + OFF_Y); }
DI unsigned char* P_XN8(const Params& p) { return p.ws + OFF_XN8; }

DI unsigned f2bf(float f) { unsigned u = __float_as_uint(f); return (u + 0x7fffu + ((u >> 16) & 1u)) >> 16; }
DI unsigned pk2(float lo, float hi) { return f2bf(lo) | (f2bf(hi) << 16); }
constexpr float W8_SCALE = 32.0f, H8_SCALE = 4.0f;
DI unsigned pk4_fp8(float a, float b, float c, float d) { unsigned w = 0u; w = __builtin_amdgcn_cvt_pk_fp8_f32(a, b, w, false); w = __builtin_amdgcn_cvt_pk_fp8_f32(c, d, w, true); return w; }
DI float bf2f(unsigned b) { return __uint_as_float(b << 16); }
DI float bflo(unsigned w) { return __uint_as_float(w << 16); }
DI float bfhi(unsigned w) { return __uint_as_float(w & 0xffff0000u); }
DI float shx(float v, int d, int lane) { return __uint_as_float((unsigned)__builtin_amdgcn_ds_bpermute((lane ^ d) << 2, (int)__float_as_uint(v))); }
DI unsigned shl_abs(unsigned v, int src_lane) { return (unsigned)__builtin_amdgcn_ds_bpermute(src_lane << 2, (int)v); }
DI int otid() { int t = threadIdx.x; asm volatile("" : "+v"(t)); return t; }
DI int pos16(int t) { return ((t & 15) << 8) | (t >> 4); }

constexpr int JOBS_PER_LAYER = 26432;
DI void prep_job(const Params& p, int l, int j, const float*& src, int& src_ld, bf16_t*& dst, int& dst_ld) {
    if (j < 1216) {
        const int nblk = j >> 3, kc = j & 7; int sc;
        if (nblk < 40) { const int t = nblk >> 3, sb = nblk & 7, bj = sb >> 2, wc = sb & 3, hr = 4 * t + wc;
            const int base = hr < 6 ? 64 * hr : hr < 8 ? 384 + 64 * (hr - 6) : hr < 14 ? 640 + 64 * (hr - 8) : 1024 + 64 * (hr - 14);
            sc = base + 32 * bj; }
        else if (nblk < 56) { const int c = 32 * (nblk - 40); sc = c < 256 ? 1792 + c : 2048 + (c - 256); }
        else sc = 2560 + 32 * (nblk - 56);
        src = p.w_in + (size_t)l * DM * PROJ + (size_t)(128 * kc) * PROJ + sc; src_ld = PROJ;
        dst = P_W(p, l, LW_WIN) + (size_t)(32 * nblk) * 1024 + 128 * kc; dst_ld = 1024; return;
    }
    j -= 1216;
    if (j < 192) {
        const int nblk = j >> 3, kc = j & 7, ch = 32 * nblk;
        const int sc = ch < 128 ? 512 + ch : ch < 256 ? 1408 + (ch - 128) : ch < 512 ? 2304 + (ch - 256) : 1536 + (ch - 512);
        src = p.w_in + (size_t)l * DM * PROJ + (size_t)(128 * kc) * PROJ + sc; src_ld = PROJ;
        dst = P_W(p, l, LW_WV) + (size_t)ch * 1024 + 128 * kc; dst_ld = 1024; return;
    }
    j -= 192;
    if (j < 192) {
        bf16_t* wm = P_W(p, l, LW_WM); src_ld = 1024; dst_ld = 768;
        if (j < 96) { const int nblk = j / 3, kc = j % 3; src = p.w_a + (size_t)l * 384 * 1024 + (size_t)(128 * kc) * 1024 + 32 * nblk; dst = wm + (size_t)(32 * nblk) * 768 + 128 * kc; }
        else if (j < 128) { const int nblk = j - 96; src = p.w_b + (size_t)l * 128 * 1024 + 32 * nblk; dst = wm + (size_t)(32 * nblk) * 768 + 384; }
        else { const int jj = j - 128, nblk = jj >> 1, kc = jj & 1; src = p.w_c + (size_t)l * 256 * 1024 + (size_t)(128 * kc) * 1024 + 32 * nblk; dst = wm + (size_t)(32 * nblk) * 768 + 512 + 128 * kc; }
        return;
    }
    j -= 192;
    if (j < 256) {
        const int nblk = j >> 3, kc = j & 7;
        src = p.w_out + (size_t)l * 1024 * 1024 + (size_t)(128 * kc) * 1024 + 32 * nblk; src_ld = 1024;
        dst = P_W(p, l, LW_WO) + (size_t)(32 * nblk) * 1024 + 128 * kc; dst_ld = 1024; return;
    }
    j -= 256;
    if (j < 16384) {
        const int e = j >> 10, r = j & 1023, nblk = r >> 3, kc = r & 7, row0 = 32 * nblk, pp = row0 >> 8, s = row0 & 255;
        const float* w = s < 128 ? p.w_gate_e : p.w_up_e; const int col = 128 * pp + (s & 127);
        src = w + ((size_t)(l * NEXP + e) * 1024 + 128 * kc) * 2048 + col; src_ld = 2048;
        dst = (bf16_t*)((unsigned char*)P_W(p, l, LW_WGU) + ((size_t)e * 4096 + row0) * 1024 + 128 * kc); dst_ld = 1024; return;
    }
    j -= 16384;
    {
        const int e = j >> 9, r = j & 511, nblk = r >> 4, kc = r & 15;
        src = p.w_down_e + ((size_t)(l * NEXP + e) * 2048 + 128 * kc) * 1024 + 32 * nblk; src_ld = 1024;
        dst = (bf16_t*)((unsigned char*)P_W(p, l, LW_WD) + ((size_t)e * 1024 + 32 * nblk) * 2048 + 128 * kc); dst_ld = 2048;
    }
}
DI void sincos_d(double a, double& s, double& c) {
    const double q = rint(a * 0.63661977236758134308);
    double r = fma(-q, 1.57079632679489655800e+00, a); r = fma(-q, 6.12323399573676603587e-17, r);
    const double r2 = r * r;
    double sp = 1.58969099521155010221e-10; sp = fma(sp, r2, -2.50507602534068634195e-08); sp = fma(sp, r2, 2.75573137070700676789e-06); sp = fma(sp, r2, -1.98412698298579493134e-04);
    sp = fma(sp, r2, 8.33333333332248946124e-03); sp = fma(sp, r2, -1.66666666666666324348e-01); const double sr = fma(r * r2, sp, r);
    double cp = -1.13596475577881948265e-11; cp = fma(cp, r2, 2.08757232129817482790e-09); cp = fma(cp, r2, -2.75573143513906633035e-07); cp = fma(cp, r2, 2.48015872894767294178e-05);
    cp = fma(cp, r2, -1.38888888888741095749e-03); cp = fma(cp, r2, 4.16666666666666019037e-02); const double cr = fma(r2 * r2, cp, fma(-0.5, r2, 1.0));
    const int qi = ((int)q) & 3;
    s = qi == 0 ? sr : qi == 1 ? cr : qi == 2 ? -sr : -cr;
    c = qi == 0 ? cr : qi == 1 ? -sr : qi == 2 ? -cr : sr;
}
DI void prep_phase(const Params& p, LAS float* scr) {
    const int tid = otid();
    for (int i = blockIdx.x * 512 + tid; i < SEQ * 32; i += gridDim.x * 512) {
        const int pos = i >> 5, j = i & 31;
        double fr = 1.0; for (int jj = 0; jj < j; ++jj) fr *= 0.7498942093324559;
        const float invf = (float)fr;
        const float ang = (float)pos * invf; double s, c; sincos_d((double)ang, s, c);
        P_COS(p)[i] = (float)c; P_SIN(p)[i] = (float)s;
    }
    const int total = NLAYER * JOBS_PER_LAYER;
    int u = blockIdx.x;
    const float* src; bf16_t* dst; int src_ld, dst_ld, j = 0;
    f32x4 r0, r1;
    if (u < total) { const int l = u / JOBS_PER_LAYER; j = u - l * JOBS_PER_LAYER; prep_job(p, l, j, src, src_ld, dst, dst_ld);
        r0 = *(const f32x4*)(src + (size_t)(tid >> 3) * src_ld + 4 * (tid & 7)); r1 = *(const f32x4*)(src + (size_t)((tid + 512) >> 3) * src_ld + 4 * (tid & 7)); }
    int buf = 0;
    for (; u < total; u += gridDim.x) {
        LAS float* sc = scr + buf * (128 * 33);
        { const int k = tid >> 3, c4 = tid & 7;
          sc[k * 33 + 4 * c4 + 0] = r0[0]; sc[k * 33 + 4 * c4 + 1] = r0[1]; sc[k * 33 + 4 * c4 + 2] = r0[2]; sc[k * 33 + 4 * c4 + 3] = r0[3];
          sc[(k + 64) * 33 + 4 * c4 + 0] = r1[0]; sc[(k + 64) * 33 + 4 * c4 + 1] = r1[1]; sc[(k + 64) * 33 + 4 * c4 + 2] = r1[2]; sc[(k + 64) * 33 + 4 * c4 + 3] = r1[3]; }
        bf16_t* dcur = dst; const int dld = dst_ld, jcur = j;
        const int un = u + gridDim.x;
        if (un < total) { const int l = un / JOBS_PER_LAYER; j = un - l * JOBS_PER_LAYER; prep_job(p, l, j, src, src_ld, dst, dst_ld);
            r0 = *(const f32x4*)(src + (size_t)(tid >> 3) * src_ld + 4 * (tid & 7)); r1 = *(const f32x4*)(src + (size_t)((tid + 512) >> 3) * src_ld + 4 * (tid & 7)); }
        __syncthreads();
        { const int n = tid >> 4, k8 = (tid & 15) * 8;
          if (jcur >= 1856) {
            u32x2 w; w[0] = pk4_fp8(sc[(k8 + 0) * 33 + n] * W8_SCALE, sc[(k8 + 1) * 33 + n] * W8_SCALE, sc[(k8 + 2) * 33 + n] * W8_SCALE, sc[(k8 + 3) * 33 + n] * W8_SCALE);
            w[1] = pk4_fp8(sc[(k8 + 4) * 33 + n] * W8_SCALE, sc[(k8 + 5) * 33 + n] * W8_SCALE, sc[(k8 + 6) * 33 + n] * W8_SCALE, sc[(k8 + 7) * 33 + n] * W8_SCALE);
            *(u32x2*)((unsigned char*)dcur + (size_t)n * dld + k8) = w;
          } else { u32x4 w;
            w[0] = pk2(sc[(k8 + 0) * 33 + n], sc[(k8 + 1) * 33 + n]); w[1] = pk2(sc[(k8 + 2) * 33 + n], sc[(k8 + 3) * 33 + n]);
            w[2] = pk2(sc[(k8 + 4) * 33 + n], sc[(k8 + 5) * 33 + n]); w[3] = pk2(sc[(k8 + 6) * 33 + n], sc[(k8 + 7) * 33 + n]);
            *(u32x4*)(dcur + (size_t)n * dld + k8) = w; } }
        buf ^= 1;
    }
    __syncthreads();
}

template <int MODE> DI void norm1_phase(const Params& p, int l) {
    const int tid = otid(), lane = tid & 63, wid = tid >> 6;
    const float* gain = MODE == 2 ? p.norm_final : p.norm_mix + (size_t)l * DM;
    f32x4 g[4];
#pragma unroll
    for (int i = 0; i < 4; ++i) g[i] = *(const f32x4*)(gain + 4 * lane + 256 * i);
    const float* xin = MODE == 0 ? p.x : P_X(p);
    const int nw = gridDim.x * 8;
    for (int row0 = blockIdx.x * 8 + wid; row0 < NTOK; row0 += 2 * nw) {
        const int row1 = row0 + nw;
        f32x4 v0[4], v1[4];
#pragma unroll
        for (int i = 0; i < 4; ++i) { v0[i] = *(const f32x4*)(xin + (size_t)row0 * DM + 4 * lane + 256 * i); v1[i] = *(const f32x4*)(xin + (size_t)row1 * DM + 4 * lane + 256 * i); }
        if (MODE != 0) {
            const int c0 = lane < NEXP ? P_INV(p)[(size_t)row0 * NEXP + lane] : -1, c1 = lane < NEXP ? P_INV(p)[(size_t)row1 * NEXP + lane] : -1;
            unsigned long long m0 = __ballot(c0 >= 0), m1 = __ballot(c1 >= 0);
            const bf16_t* ybase0 = P_Y(p) + (size_t)((row0 >> 12) * CAP) * DM; const bf16_t* ybase1 = P_Y(p) + (size_t)((row1 >> 12) * CAP) * DM;
            while (m0 | m1) {
                u32x2 w0[4], w1[4]; const bool h0 = m0 != 0ull, h1 = m1 != 0ull;
                if (h0) { const int e = __builtin_ctzll(m0); m0 &= m0 - 1ull; const int c = __builtin_amdgcn_readlane(c0, e); const bf16_t* yr = ybase0 + (size_t)(e * NBATCH * CAP + c) * DM;
#pragma unroll
                    for (int i = 0; i < 4; ++i) w0[i] = *(const u32x2*)(yr + 4 * lane + 256 * i); }
                if (h1) { const int e = __builtin_ctzll(m1); m1 &= m1 - 1ull; const int c = __builtin_amdgcn_readlane(c1, e); const bf16_t* yr = ybase1 + (size_t)(e * NBATCH * CAP + c) * DM;
#pragma unroll
                    for (int i = 0; i < 4; ++i) w1[i] = *(const u32x2*)(yr + 4 * lane + 256 * i); }
                if (h0) {
#pragma unroll
                    for (int i = 0; i < 4; ++i) { v0[i][0] += bflo(w0[i][0]); v0[i][1] += bfhi(w0[i][0]); v0[i][2] += bflo(w0[i][1]); v0[i][3] += bfhi(w0[i][1]); } }
                if (h1) {
#pragma unroll
                    for (int i = 0; i < 4; ++i) { v1[i][0] += bflo(w1[i][0]); v1[i][1] += bfhi(w1[i][0]); v1[i][2] += bflo(w1[i][1]); v1[i][3] += bfhi(w1[i][1]); } }
            }
        }
        if (MODE != 2) {
#pragma unroll
            for (int i = 0; i < 4; ++i) { *(f32x4*)(P_X(p) + (size_t)row0 * DM + 4 * lane + 256 * i) = v0[i]; *(f32x4*)(P_X(p) + (size_t)row1 * DM + 4 * lane + 256 * i) = v1[i]; }
        }
        float s0 = 0.f, s1 = 0.f;
#pragma unroll
        for (int i = 0; i < 4; ++i) { s0 += v0[i][0] * v0[i][0] + v0[i][1] * v0[i][1] + v0[i][2] * v0[i][2] + v0[i][3] * v0[i][3]; s1 += v1[i][0] * v1[i][0] + v1[i][1] * v1[i][1] + v1[i][2] * v1[i][2] + v1[i][3] * v1[i][3]; }
#pragma unroll
        for (int d = 32; d >= 1; d >>= 1) { s0 += shx(s0, d, lane); s1 += shx(s1, d, lane); }
        const float r0 = rsqrtf(s0 * (1.0f / DM) + 1e-6f), r1 = rsqrtf(s1 * (1.0f / DM) + 1e-6f);
#pragma unroll
        for (int i = 0; i < 4; ++i) {
            const f32x4 o0 = v0[i] * r0 * g[i], o1 = v1[i] * r1 * g[i];
            if (MODE == 2) { *(f32x4*)(p.out + (size_t)row0 * DM + 4 * lane + 256 * i) = o0; *(f32x4*)(p.out + (size_t)row1 * DM + 4 * lane + 256 * i) = o1; }
            else { u32x2 w; w[0] = pk2(o0[0], o0[1]); w[1] = pk2(o0[2], o0[3]); *(u32x2*)(P_XN(p) + (size_t)row0 * DM + 4 * lane + 256 * i) = w;
                   w[0] = pk2(o1[0], o1[1]); w[1] = pk2(o1[2], o1[3]); *(u32x2*)(P_XN(p) + (size_t)row1 * DM + 4 * lane + 256 * i) = w; }
        }
    }
}

DI float reduce16(const float (&a)[16], int lane) {
    float b8[8], b4[4], b2[2];
    { const bool hi = (lane & 32) != 0;
#pragma unroll
      for (int j = 0; j < 8; ++j) { const float snd = hi ? a[j] : a[j + 8], kp = hi ? a[j + 8] : a[j]; b8[j] = kp + shx(snd, 32, lane); } }
    { const bool hi = (lane & 16) != 0;
#pragma unroll
      for (int j = 0; j < 4; ++j) { const float snd = hi ? b8[j] : b8[j + 4], kp = hi ? b8[j + 4] : b8[j]; b4[j] = kp + shx(snd, 16, lane); } }
    { const bool hi = (lane & 8) != 0;
#pragma unroll
      for (int j = 0; j < 2; ++j) { const float snd = hi ? b4[j] : b4[j + 2], kp = hi ? b4[j + 2] : b4[j]; b2[j] = kp + shx(snd, 8, lane); } }
    float r;
    { const bool hi = (lane & 4) != 0; const float snd = hi ? b2[0] : b2[1], kp = hi ? b2[1] : b2[0]; r = kp + shx(snd, 4, lane); }
    r += shx(r, 2, lane); r += shx(r, 1, lane);
    return r;
}
DI void norm2_router_phase(const Params& p, int l, LAS float* wr) {
    const int tid = otid(), lane = tid & 63, wid = tid >> 6;
    for (int i = tid; i < DM * NEXP; i += 512) wr[(i & 15) * DM + (i >> 4)] = p.w_router[(size_t)l * DM * NEXP + i];
    __syncthreads();
    const float* gain = p.norm_ffn + (size_t)l * DM;
    f32x4 g[4];
#pragma unroll
    for (int i = 0; i < 4; ++i) g[i] = *(const f32x4*)(gain + 4 * lane + 256 * i);
    const int nw = gridDim.x * 8;
    for (int row0 = blockIdx.x * 8 + wid; row0 < NTOK; row0 += 2 * nw) {
        const int row1 = row0 + nw;
        f32x4 v0[4], v1[4]; float s0 = 0.f, s1 = 0.f;
#pragma unroll
        for (int i = 0; i < 4; ++i) { v0[i] = *(const f32x4*)(P_X(p) + (size_t)row0 * DM + 4 * lane + 256 * i); v1[i] = *(const f32x4*)(P_X(p) + (size_t)row1 * DM + 4 * lane + 256 * i); }
#pragma unroll
        for (int i = 0; i < 4; ++i) { s0 += v0[i][0] * v0[i][0] + v0[i][1] * v0[i][1] + v0[i][2] * v0[i][2] + v0[i][3] * v0[i][3]; s1 += v1[i][0] * v1[i][0] + v1[i][1] * v1[i][1] + v1[i][2] * v1[i][2] + v1[i][3] * v1[i][3]; }
#pragma unroll
        for (int d = 32; d >= 1; d >>= 1) { s0 += shx(s0, d, lane); s1 += shx(s1, d, lane); }
        const float r0 = rsqrtf(s0 * (1.0f / DM) + 1e-6f), r1 = rsqrtf(s1 * (1.0f / DM) + 1e-6f);
#pragma unroll
        for (int i = 0; i < 4; ++i) { v0[i] = v0[i] * r0 * g[i]; v1[i] = v1[i] * r1 * g[i];
            *(unsigned*)(P_XN8(p) + (size_t)row0 * DM + 4 * lane + 256 * i) = pk4_fp8(v0[i][0], v0[i][1], v0[i][2], v0[i][3]);
            *(unsigned*)(P_XN8(p) + (size_t)row1 * DM + 4 * lane + 256 * i) = pk4_fp8(v1[i][0], v1[i][1], v1[i][2], v1[i][3]); }
        float a0[NEXP], a1[NEXP];
#pragma unroll
        for (int e = 0; e < NEXP; ++e) { float x0 = 0.f, x1 = 0.f;
#pragma unroll
            for (int i = 0; i < 4; ++i) { const f32x4 w = *(const LAS f32x4*)(wr + e * DM + 4 * lane + 256 * i);
                x0 += v0[i][0] * w[0] + v0[i][1] * w[1] + v0[i][2] * w[2] + v0[i][3] * w[3]; x1 += v1[i][0] * w[0] + v1[i][1] * w[1] + v1[i][2] * w[2] + v1[i][3] * w[3]; }
            a0[e] = x0; a1[e] = x1;
            if ((e & 3) == 3) __builtin_amdgcn_sched_barrier(0); }
        const float l0 = reduce16(a0, lane), l1 = reduce16(a1, lane);
        float m0 = l0, m1 = l1;
#pragma unroll
        for (int d = 32; d >= 4; d >>= 1) { m0 = fmaxf(m0, shx(m0, d, lane)); m1 = fmaxf(m1, shx(m1, d, lane)); }
        const float e0 = __expf(l0 - m0), e1 = __expf(l1 - m1); float d0 = e0, d1 = e1;
#pragma unroll
        for (int d = 32; d >= 4; d >>= 1) { d0 += shx(d0, d, lane); d1 += shx(d1, d, lane); }
        if ((lane & 3) == 0) { const int e = lane >> 2;
            P_AFF(p)[((size_t)((row0 >> 12) * NEXP + e)) * SEQ + (row0 & 4095)] = e0 / d0; P_AFF(p)[((size_t)((row1 >> 12) * NEXP + e)) * SEQ + (row1 & 4095)] = e1 / d1; }
    }
}

DI void topk_phase(const Params& p, LAS unsigned* lds) {
    const int tid = otid(), lane = tid & 63, wid = tid >> 6;
    LAS unsigned* hist = lds; LAS unsigned* sh = lds + 256; LAS unsigned* wtot = lds + 272;
    for (int be = blockIdx.x; be < NBATCH * NEXP; be += gridDim.x) {
        const int b = be >> 4, e = be & 15;
        const float* aff = P_AFF(p) + (size_t)be * SEQ + tid * 8;
        const f32x4 a0 = *(const f32x4*)aff, a1 = *(const f32x4*)(aff + 4);
        unsigned key[8];
#pragma unroll
        for (int i = 0; i < 4; ++i) { key[i] = __float_as_uint(a0[i]); key[4 + i] = __float_as_uint(a1[i]); }
        unsigned prefix = 0u, mask = 0u, krem = CAP;
        for (int pass = 3; pass >= 0; --pass) {
            const int shift = 8 * pass;
            if (tid < 256) hist[tid] = 0u;
            __syncthreads();
#pragma unroll
            for (int i = 0; i < 8; ++i) if ((key[i] & mask) == prefix) atomicAdd((unsigned*)&hist[(key[i] >> shift) & 255u], 1u);
            __syncthreads();
            if (wid == 0) {
                const unsigned h0 = hist[4 * lane], h1 = hist[4 * lane + 1], h2 = hist[4 * lane + 2], h3 = hist[4 * lane + 3], s = h0 + h1 + h2 + h3;
                unsigned suf = s;
#pragma unroll
                for (int d = 1; d < 64; d <<= 1) { const unsigned t = shl_abs(suf, (lane + d) & 63); if (lane + d < 64) suf += t; }
                const unsigned above = suf - s;
                if (above < krem && krem <= suf) {
                    unsigned a = above; unsigned bin, nk;
                    if (a + h3 >= krem) { bin = 4 * lane + 3; nk = krem - a; }
                    else { a += h3; if (a + h2 >= krem) { bin = 4 * lane + 2; nk = krem - a; }
                        else { a += h2; if (a + h1 >= krem) { bin = 4 * lane + 1; nk = krem - a; } else { a += h1; bin = 4 * lane; nk = krem - a; } } }
                    sh[0] = prefix | (bin << shift); sh[1] = nk;
                }
            }
            __syncthreads();
            prefix = sh[0]; krem = sh[1]; mask |= 0xFFu << shift;
            __syncthreads();
        }
        unsigned cg = 0u, ce = 0u;
#pragma unroll
        for (int i = 0; i < 8; ++i) { cg += key[i] > prefix ? 1u : 0u; ce += key[i] == prefix ? 1u : 0u; }
        unsigned pk = cg | (ce << 16), incl = pk;
#pragma unroll
        for (int d = 1; d < 64; d <<= 1) { const unsigned t = shl_abs(incl, (lane - d) & 63); if (lane >= d) incl += t; }
        if (lane == 63) wtot[wid] = incl;
        __syncthreads();
        unsigned woff = 0u;
#pragma unroll
        for (int w = 0; w < 8; ++w) woff += w < wid ? wtot[w] : 0u;
        const unsigned excl = woff + incl - pk;
        unsigned gtb = excl & 0xffffu, eqb = excl >> 16;
        int* idxo = P_IDX(p) + (size_t)(e * NBATCH + b) * CAP; float* valo = P_VAL(p) + (size_t)(e * NBATCH + b) * CAP;
        int* inv = P_INV(p) + ((size_t)b * SEQ + tid * 8) * NEXP + e;
#pragma unroll
        for (int i = 0; i < 8; ++i) {
            int slot = -1;
            if (key[i] > prefix) { slot = (int)(gtb + (eqb < krem ? eqb : krem)); ++gtb; }
            else if (key[i] == prefix) { if (eqb < krem) slot = (int)(gtb + eqb); ++eqb; }
            if (slot >= 0) { idxo[slot] = tid * 8 + i; valo[slot] = __uint_as_float(key[i]); }
            inv[(size_t)i * NEXP] = slot;
        }
        __syncthreads();
    }
}

DI f32x16 zero16() { f32x16 z; for (int i = 0; i < 16; ++i) z[i] = 0.f; return z; }
DI void rgemm2(const bf16_t* ap, const bf16_t* b0p, const bf16_t* b1p, int K, f32x16& c0, f32x16& c1) {
#pragma unroll 4
    for (int k = 0; k < K; k += 16) {
        const bf16x8 a = *(const bf16x8*)(ap + k), b0 = *(const bf16x8*)(b0p + k), b1 = *(const bf16x8*)(b1p + k);
        c0 = __builtin_amdgcn_mfma_f32_32x32x16_bf16(a, b0, c0, 0, 0, 0);
        c1 = __builtin_amdgcn_mfma_f32_32x32x16_bf16(a, b1, c1, 0, 0, 0);
    }
}
DI int crow(int i, int h) { return (i & 3) + 8 * (i >> 2) + 4 * h; }
DI float sigmoidf_(float x) { return 1.0f / (1.0f + __expf(-x)); }

DI void rk_inproj(const Params& p, int l) {
    const int lane = otid() & 63, r = lane & 31, h = lane >> 5;
    const bf16_t* WIN = P_W(p, l, LW_WIN); const bf16_t* WV = P_W(p, l, LW_WV);
    const int nw = gridDim.x * 8;
    for (int wt = blockIdx.x * 8 + (otid() >> 6); wt < 512 * 88; wt += nw) {
        const int job = wt % 88, m0 = (wt / 88) * 32;
        const bf16_t* ap = P_XN(p) + (size_t)(m0 + r) * DM + 8 * h;
        const bf16_t *b0, *b1;
        if (job < 20) { const int t = job >> 2, wc = job & 3; b0 = WIN + (size_t)(256 * t + 32 * wc + r) * DM + 8 * h; b1 = b0 + (size_t)128 * DM; }
        else if (job < 28) { b0 = WIN + (size_t)(1280 + 64 * (job - 20) + r) * DM + 8 * h; b1 = b0 + (size_t)32 * DM; }
        else if (job < 40) { b0 = WV + (size_t)(64 * (job - 28) + r) * DM + 8 * h; b1 = b0 + (size_t)32 * DM; }
        else { b0 = WIN + (size_t)(1792 + 64 * (job - 40) + r) * DM + 8 * h; b1 = b0 + (size_t)32 * DM; }
        f32x16 c0 = zero16(), c1 = zero16();
        rgemm2(ap, b0, b1, DM, c0, c1);
#pragma unroll
        for (int i = 0; i < 16; ++i) {
            const int row = m0 + crow(i, h), pos = row & 4095;
            if (job < 20) {
                const float cs = P_COS(p)[pos * 32 + r], sn = P_SIN(p)[pos * 32 + r];
                float o1 = c0[i] * cs - c1[i] * sn, o2 = c1[i] * cs + c0[i] * sn;
                if (job < 6 || (job >= 8 && job < 14)) { o1 *= 0.125f; o2 *= 0.125f; }
                P_QK(p)[(size_t)row * QKW + 64 * job + r] = (bf16_t)f2bf(o1); P_QK(p)[(size_t)row * QKW + 64 * job + 32 + r] = (bf16_t)f2bf(o2);
            } else if (job < 28) {
                const float sc = job < 24 ? 0.125f : 1.0f; const int col = 1280 + 64 * (job - 20) + r;
                P_QK(p)[(size_t)row * QKW + col] = (bf16_t)f2bf(c0[i] * sc); P_QK(p)[(size_t)row * QKW + col + 32] = (bf16_t)f2bf(c1[i] * sc);
            } else if (job < 40) {
                const int ch = 64 * (job - 28) + r; const int slot = ch < 512 ? row : (row & ~4095) + pos16(pos);
                P_VT(p)[(size_t)ch * NTOK + slot] = (bf16_t)f2bf(c0[i]); P_VT(p)[(size_t)(ch + 32) * NTOK + slot] = (bf16_t)f2bf(c1[i]);
            } else {
                const int col = 64 * (job - 40) + r; const float* bg = p.b_gate + (size_t)l * 3072;
                P_G(p)[(size_t)row * 3072 + col] = (bf16_t)f2bf(sigmoidf_(c0[i] + bg[col])); P_G(p)[(size_t)row * 3072 + col + 32] = (bf16_t)f2bf(sigmoidf_(c1[i] + bg[col + 32]));
            }
        }
    }
}
DI void rk_merge(const Params& p, int l) {
    const int lane = otid() & 63, r = lane & 31, h = lane >> 5;
    const bf16_t* WM = P_W(p, l, LW_WM);
    for (int wt = blockIdx.x * 8 + (otid() >> 6); wt < 512 * 16; wt += gridDim.x * 8) {
        const int n0 = (wt & 15) * 64, m0 = (wt >> 4) * 32;
        float m0a[16], m1a[16];
#pragma unroll
        for (int i = 0; i < 16; ++i) { m0a[i] = 0.f; m1a[i] = 0.f; }
#pragma unroll 1
        for (int br = 0; br < 3; ++br) {
            const int k0 = br == 0 ? 0 : br == 1 ? 384 : 512, K = br == 0 ? 384 : br == 1 ? 128 : 256;
            f32x16 c0 = zero16(), c1 = zero16();
            rgemm2(P_OC(p) + (size_t)(m0 + r) * OCW + k0 + 8 * h, WM + (size_t)(n0 + r) * 768 + k0 + 8 * h, WM + (size_t)(n0 + 32 + r) * 768 + k0 + 8 * h, K, c0, c1);
#pragma unroll
            for (int i = 0; i < 16; ++i) { const int row = m0 + crow(i, h); const bf16_t* gp = P_G(p) + (size_t)row * 3072 + 1024 * br + n0 + r;
                m0a[i] += bf2f(gp[0]) * c0[i]; m1a[i] += bf2f(gp[32]) * c1[i]; }
        }
#pragma unroll
        for (int i = 0; i < 16; ++i) { const int row = m0 + crow(i, h); P_MG(p)[(size_t)row * DM + n0 + r] = (bf16_t)f2bf(m0a[i]); P_MG(p)[(size_t)row * DM + n0 + 32 + r] = (bf16_t)f2bf(m1a[i]); }
    }
}
DI void rk_out(const Params& p, int l) {
    const int lane = otid() & 63, r = lane & 31, h = lane >> 5;
    const bf16_t* WO = P_W(p, l, LW_WO);
    for (int wt = blockIdx.x * 8 + (otid() >> 6); wt < 512 * 16; wt += gridDim.x * 8) {
        const int n0 = (wt & 15) * 64, m0 = (wt >> 4) * 32;
        f32x16 c0 = zero16(), c1 = zero16();
        rgemm2(P_MG(p) + (size_t)(m0 + r) * DM + 8 * h, WO + (size_t)(n0 + r) * DM + 8 * h, WO + (size_t)(n0 + 32 + r) * DM + 8 * h, DM, c0, c1);
#pragma unroll
        for (int i = 0; i < 16; ++i) { float* xp = P_X(p) + (size_t)(m0 + crow(i, h)) * DM + n0 + r; xp[0] += c0[i]; xp[32] += c1[i]; }
    }
}
DI void rk_moe1(const Params& p, int l) {
    const int lane = otid() & 63, r = lane & 31, h = lane >> 5;
    const bf16_t* WGU = P_W(p, l, LW_WGU);
    for (int wt = blockIdx.x * 8 + (otid() >> 6); wt < 1024 * 64; wt += gridDim.x * 8) {
        const int j0 = (wt & 63) * 32, m0 = (wt >> 6) * 32, e = m0 >> 11, b = (m0 >> 9) & 3;
        const int tok = b * SEQ + P_IDX(p)[m0 + r];
        const bf16_t* b0 = WGU + ((size_t)e * 4096 + 256 * (j0 >> 7) + (j0 & 127) + r) * DM + 8 * h;
        f32x16 c0 = zero16(), c1 = zero16();
        rgemm2(P_XN(p) + (size_t)tok * DM + 8 * h, b0, b0 + (size_t)128 * DM, DM, c0, c1);
#pragma unroll
        for (int i = 0; i < 16; ++i) { const float g = c0[i], u = c1[i]; P_HID(p)[(size_t)(m0 + crow(i, h)) * FF + j0 + r] = (bf16_t)f2bf(g * sigmoidf_(g) * u); }
    }
}
DI void rk_moe2(const Params& p, int l) {
    const int lane = otid() & 63, r = lane & 31, h = lane >> 5;
    const bf16_t* WD = P_W(p, l, LW_WD);
    for (int wt = blockIdx.x * 8 + (otid() >> 6); wt < 1024 * 16; wt += gridDim.x * 8) {
        const int n0 = (wt & 15) * 64, m0 = (wt >> 4) * 32, e = m0 >> 11;
        const bf16_t* b0 = WD + ((size_t)e * 1024 + n0 + r) * FF + 8 * h;
        f32x16 c0 = zero16(), c1 = zero16();
        rgemm2(P_HID(p) + (size_t)(m0 + r) * FF + 8 * h, b0, b0 + (size_t)32 * FF, FF, c0, c1);
#pragma unroll
        for (int i = 0; i < 16; ++i) { const int row = m0 + crow(i, h); const float v = P_VAL(p)[row];
            P_Y(p)[(size_t)row * DM + n0 + r] = (bf16_t)f2bf(c0[i] * v); P_Y(p)[(size_t)row * DM + n0 + 32 + r] = (bf16_t)f2bf(c1[i] * v); }
    }
}

DI void ld64(const bf16_t* src, float (&q)[64]) {
#pragma unroll
    for (int c = 0; c < 8; ++c) { const u32x4 w = *(const u32x4*)(src + 8 * c);
#pragma unroll
        for (int j = 0; j < 4; ++j) { q[8 * c + 2 * j] = bflo(w[j]); q[8 * c + 2 * j + 1] = bfhi(w[j]); } }
}
DI float dot64(const bf16_t* kp, const float (&q)[64]) {
    float s = 0.f;
#pragma unroll
    for (int c = 0; c < 8; ++c) { const u32x4 w = *(const u32x4*)(kp + 8 * c);
#pragma unroll
        for (int j = 0; j < 4; ++j) { s += q[8 * c + 2 * j] * bflo(w[j]); s += q[8 * c + 2 * j + 1] * bfhi(w[j]); } }
    return s;
}
DI void rk_attn(const Params& p, int l) {
  for (int item2 = blockIdx.x * 512 + otid(); item2 < 32 * NTOK; item2 += gridDim.x * 512) {
    const int half = item2 >> 18, item = item2 & 262143;
    const int hd16 = item >> 14, tok = item & 16383, b = tok >> 12, t = tok & 4095;
    const bf16_t* QK = P_QK(p); const bf16_t* VT = P_VT(p);
    float q[64], o[32];
#pragma unroll
    for (int d = 0; d < 32; ++d) o[d] = 0.f;
    float m = -1e30f, den = 0.f;
    int qcol, kcol, vch; bool perm = false;
    if (hd16 < 6) { qcol = 64 * hd16; kcol = 384 + 64 * (hd16 / 3); vch = 64 * (hd16 / 3); }
    else if (hd16 < 12) { const int g = (hd16 - 6) >> 1, hs = (hd16 - 6) & 1; qcol = 512 + 128 * g + 64 * hs; kcol = 896 + 128 * g + 64 * hs;
        vch = g == 0 ? 128 + 64 * hs : g == 1 ? 512 + 64 * hs : 640 + 64 * hs; perm = g > 0; }
    else { const int hh = hd16 - 12; qcol = 1280 + 64 * hh; kcol = 1536 + 64 * hh; vch = 256 + 64 * hh; }
    vch += 32 * half;
    ld64(QK + (size_t)tok * QKW + qcol, q);
    auto visit = [&](int t2, float bias) {
        const float s = dot64(QK + (size_t)(b * SEQ + t2) * QKW + kcol, q) + bias;
        const float mn = fmaxf(m, s), al = __expf(m - mn), pe = __expf(s - mn);
        den = den * al + pe; m = mn;
        const bf16_t* vp = VT + (size_t)vch * NTOK + b * SEQ + (perm ? pos16(t2) : t2);
#pragma unroll
        for (int d = 0; d < 32; ++d) o[d] = o[d] * al + pe * bf2f(vp[(size_t)d * NTOK]);
    };
    if (hd16 < 6) {
        const int lo = t - 128 < 0 ? 0 : t - 128, hi = t + 128 > 4095 ? 4095 : t + 128;
        for (int t2 = lo; t2 <= hi; ++t2) visit(t2, 0.f);
        const float sk = p.sink[l * 6 + hd16], mn = fmaxf(m, sk), al = __expf(m - mn);
        den = den * al + __expf(sk - mn);
#pragma unroll
        for (int d = 0; d < 32; ++d) o[d] *= al;
        m = mn;
    } else if (hd16 < 12) {
        const int g = (hd16 - 6) >> 1, dil = g == 0 ? 1 : g == 1 ? 4 : 16;
        for (int rr = -64; rr <= 64; ++rr) { const int t2 = t + dil * rr; if (t2 >= 0 && t2 < SEQ) visit(t2, 0.f); }
    } else {
        const int hh = hd16 - 12, qr = t >> 6, qc = t & 63;
        const int sr = qr - 4 < 0 ? 0 : qr - 4 > 56 ? 56 : qr - 4, sc = qc - 8 < 0 ? 0 : qc - 8 > 48 ? 48 : qc - 8;
        const float* rp = p.rpb + (size_t)(l * 4 + hh) * 15 * 31;
        for (int j = 0; j < 8; ++j) for (int k = 0; k < 16; ++k) { const int kr = sr + j, kc = sc + k; visit(kr * 64 + kc, rp[(kr - qr + 7) * 31 + (kc - qc + 15)]); }
    }
    const float rd = 1.0f / den;
    if (hd16 >= 6 && hd16 < 12) {
        const int g = (hd16 - 6) >> 1, hs = (hd16 - 6) & 1;
        bf16_t* op = P_OB3(p) + ((size_t)g * NTOK + tok) * 128 + 64 * hs + 32 * half;
#pragma unroll
        for (int d = 0; d < 32; d += 2) *(unsigned*)(op + d) = pk2(o[d] * rd, o[d + 1] * rd);
        if (half == 0) P_LSE(p)[((size_t)g * NTOK + tok) * 2 + hs] = m + __logf(den);
    } else {
        bf16_t* op = P_OC(p) + (size_t)tok * OCW + (hd16 < 6 ? 64 * hd16 : 512 + 64 * (hd16 - 12)) + 32 * half;
#pragma unroll
        for (int d = 0; d < 32; d += 2) *(unsigned*)(op + d) = pk2(o[d] * rd, o[d + 1] * rd);
    }
  }
}
namespace at {
constexpr int NUNIT_A = 1536, NUNIT_C = 1024, NUNIT_B = 1536, NUNIT = NUNIT_A + NUNIT_C + NUNIT_B;
DI unsigned cvt2(float lo, float hi) { typedef __bf16 bf2_t __attribute__((ext_vector_type(2))); const f32x2 v = {lo, hi}; const bf2_t b = __builtin_convertvector(v, bf2_t); return __builtin_bit_cast(unsigned, b); }
DI bf16x8 pack8(const f32x16& x, int s8) { u32x4 w; w[0] = cvt2(x[s8 + 0], x[s8 + 1]); w[1] = cvt2(x[s8 + 2], x[s8 + 3]); w[2] = cvt2(x[s8 + 4], x[s8 + 5]); w[3] = cvt2(x[s8 + 6], x[s8 + 7]); return __builtin_bit_cast(bf16x8, w); }
DI int koffmap(int r, bool g1) { return g1 ? 4 * (4 * ((r >> 3) & 1) + (r & 3)) + 2 * (r >> 4) + ((r >> 2) & 1) : (r & 16) + 8 * ((r >> 2) & 1) + 4 * ((r >> 3) & 1) + (r & 3); }

DI float xh_max(float v) { const auto r = __builtin_amdgcn_permlane32_swap(__float_as_uint(v), __float_as_uint(v), false, false); return fmaxf(__uint_as_float(r[0]), __uint_as_float(r[1])); }
DI float xh_sum(float v) { const auto r = __builtin_amdgcn_permlane32_swap(__float_as_uint(v), __float_as_uint(v), false, false); return __uint_as_float(r[0]) + __uint_as_float(r[1]); }
constexpr float LOG2E = 1.4426950408889634f, LN2 = 0.6931471805599453f;
struct QState { float m, den; f32x16 O0, O1; };
DI void softmax_tile(f32x16& S, QState& st, bf16x8& p0, bf16x8& p1) {
    float mx = fmaxf(S[0], S[1]);
#pragma unroll
    for (int i = 2; i < 16; i += 2) mx = fmaxf(mx, fmaxf(S[i], S[i + 1]));
    mx = xh_max(mx);
    const float mn = fmaxf(st.m, mx), alpha = __builtin_amdgcn_exp2f(st.m - mn);
    float ps = 0.f;
#pragma unroll
    for (int i = 0; i < 16; ++i) { S[i] = __builtin_amdgcn_exp2f(S[i] - mn); ps += S[i]; }
    ps = xh_sum(ps);
    st.den = st.den * alpha + ps; st.m = mn;
#pragma unroll
    for (int i = 0; i < 16; ++i) { st.O0[i] *= alpha; st.O1[i] *= alpha; }
    p0 = pack8(S, 0); p1 = pack8(S, 8);
}
template <int MODE> DI void mask_tile(f32x16& S, int tn, int NT, int q, int h, int t, int qrow, int sr_q, int sc_q, int kc0, int qcg, const LAS float* bt_head) {
    if (MODE == 3) {
        const bool rowok = t >= sr_q && t < sr_q + 8; const LAS float* bt = bt_head + (t - qrow + 7) * 31 + 15 - qcg;
#pragma unroll
        for (int i = 0; i < 16; ++i) { const int kc = kc0 + 16 * (i >> 3) + 8 * h + (i & 7); const bool ok = rowok && kc >= sc_q && kc < sc_q + 16;
            const int bi = ok ? kc : qcg; S[i] = ok ? S[i] + bt[bi] : -1e37f; }
    } else {
        const int edge = tn == 0 ? 1 : tn == NT - 1 ? 2 : 0;
        if (edge != 0) {
            int qq = MODE == 2 ? q - h : q - 8 * h; asm volatile("" : "+v"(qq));
            if (edge == 1) {
#pragma unroll
                for (int i = 0; i < 16; ++i) { const int kc_ = MODE == 2 ? 4 * (i & 7) + 2 * (i >> 3) : 16 * (i >> 3) + (i & 7); S[i] = kc_ >= qq ? S[i] : -1e37f; }
            } else {
#pragma unroll
                for (int i = 0; i < 16; ++i) { const int kc_ = MODE == 2 ? 4 * (i & 7) + 2 * (i >> 3) : 16 * (i >> 3) + (i & 7); S[i] = kc_ <= qq ? S[i] : -1e37f; }
            }
        }
    }
}
template <int MODE> DI void wave_unit(const Params& p, int l, int u, const LAS float* rpb_lds, LAS unsigned char* ring, int lane) {
    const int q = lane & 31, h = lane >> 5;
    const bf16_t* QK = P_QK(p); const bf16_t* VT = P_VT(p);
    int b, qcol, kcol, vch, dil = 1, rho = 0, Jq = 0, L = SEQ, vs0 = 0, g = 0, hs = 0, hq = 0;
    constexpr int W = MODE == 0 ? 128 : 64, NT = MODE == 0 ? 9 : 5;
    int qcg = 0, kc0 = 0, kr_lo = 0, kr_hi = 0, r00 = 0;
    if (MODE == 0) { const int gg = u % 3, qp = (u / 3) & 63, kvh = (u / 192) & 1; b = u / 384; hq = kvh * 3 + gg; qcol = 64 * hq; kcol = 384 + 64 * kvh; vch = 64 * kvh; Jq = 64 * qp; }
    else if (MODE == 1 || MODE == 2) { const int qt6 = u & 63; hs = (u >> 6) & 1; g = (u >> 7) % 3; b = u / 384; qcol = 512 + 128 * g + 64 * hs; kcol = 896 + 128 * g + 64 * hs;
        vch = g == 0 ? 128 + 64 * hs : g == 1 ? 512 + 64 * hs : 640 + 64 * hs;
        if (g == 0) { Jq = 64 * qt6; } else if (g == 1) { dil = 4; rho = qt6 >> 4; Jq = 64 * (qt6 & 15); L = 1024; } else { dil = 16; rho = qt6 >> 2; Jq = 64 * (qt6 & 3); L = 256; vs0 = rho * 256; } }
    else { const int qt6 = u & 63, hh = (u >> 6) & 3, gr4 = qt6 >> 2, cb = qt6 & 3; b = u >> 8; hq = hh; qcol = 1280 + 64 * hh; kcol = 1536 + 64 * hh; vch = 256 + 64 * hh;
        r00 = 4 * gr4; qcg = 16 * cb + (q & 15); kc0 = cb == 0 ? 0 : cb == 3 ? 32 : 16 * cb - 8;
        const int s0 = r00 - 4 < 0 ? 0 : r00 - 4 > 56 ? 56 : r00 - 4, s3 = r00 - 1 < 0 ? 0 : r00 - 1 > 56 ? 56 : r00 - 1; kr_lo = s0; kr_hi = s3 + 8; }
    int t_lo, t_hi; unsigned kdma[4], vdma[4], kstep_t, vstep_t;
    if (MODE == 3) { t_lo = kr_lo; t_hi = kr_hi; kstep_t = 64u * QKW; vstep_t = 64; }
    else { t_lo = (W - Jq + 31) >> 5; if (t_lo < 0) t_lo = 0; t_hi = (L + W - Jq) >> 5; if (t_hi > NT + 1) t_hi = NT + 1; kstep_t = 32u * dil * QKW; vstep_t = MODE == 2 ? 8 : 32; }
#pragma unroll
    for (int i = 0; i < 4; ++i) {
        const int r = 8 * i + (lane >> 3), c8 = (lane & 7) ^ ((r >> 1) & 7), ko = koffmap(r, MODE == 2);
        const int ktok = MODE == 3 ? b * SEQ + kc0 + ko : b * SEQ + (Jq - W + ko) * dil + rho;
        kdma[i] = (unsigned)ktok * QKW + kcol + 8 * c8;
        const int d = 16 * i + (lane >> 2), ch = (lane & 3) ^ ((d >> 2) & 3);
        const int vslot = MODE == 3 ? b * SEQ + kc0 + 8 * ch : MODE == 2 ? b * SEQ + ch * 1024 + rho * 256 + ((Jq - W) >> 2) : b * SEQ + vs0 + (Jq - W) + 8 * ch;
        vdma[i] = (unsigned)(vch + d) * NTOK + vslot;
    }
#define AT_DMA(t, buf) do { const unsigned kt_ = (unsigned)(t) * kstep_t, vt_ = (unsigned)(t) * vstep_t; LAS unsigned char* bb_ = ring + (buf) * 8192; \
        _Pragma("unroll") for (int i_ = 0; i_ < 4; ++i_) __builtin_amdgcn_global_load_lds((const unsigned*)(QK + (unsigned)(kdma[i_] + kt_)), (LAS unsigned*)(bb_ + i_ * 1024), 16, 0, 0); \
        _Pragma("unroll") for (int i_ = 0; i_ < 4; ++i_) __builtin_amdgcn_global_load_lds((const unsigned*)(VT + (unsigned)(vdma[i_] + vt_)), (LAS unsigned*)(bb_ + 4096 + i_ * 1024), 16, 0, 0); } while (0)
    AT_DMA(t_lo, 0);
    int kaddr[4], vaddr[2][2];
#pragma unroll
    for (int c = 0; c < 4; ++c) kaddr[c] = q * 128 + (((2 * c + h) ^ ((q >> 1) & 7)) << 4);
#pragma unroll
    for (int dh = 0; dh < 2; ++dh)
#pragma unroll
        for (int sx = 0; sx < 2; ++sx) vaddr[dh][sx] = 4096 + (32 * dh + q) * 64 + (((2 * sx + h) ^ ((q >> 2) & 3)) << 4);
    int tokq[2]; bf16x8 qf[2][4]; QState st[2];
#pragma unroll
    for (int n = 0; n < 2; ++n) {
        tokq[n] = MODE == 3 ? b * SEQ + (r00 + 2 * n + (q >> 4)) * 64 + qcg : b * SEQ + (Jq + 32 * n + q) * dil + rho;
        const bf16_t* qp = QK + (size_t)tokq[n] * QKW + qcol + 8 * h;
#pragma unroll
        for (int c = 0; c < 4; ++c) qf[n][c] = *(const bf16x8*)(qp + 16 * c);
        st[n].m = -1e30f; st[n].den = 0.f;
        if (MODE == 0) { st[n].m = p.sink[l * 6 + hq] * LOG2E; st[n].den = 1.0f; }
#pragma unroll
        for (int i = 0; i < 16; ++i) { st[n].O0[i] = 0.f; st[n].O1[i] = 0.f; }
    }
    int sc_q = 0, qrow0 = 0, qrow1 = 0, srq0 = 0, srq1 = 0, lo0 = 0, hi0 = 0, lo1 = 0, hi1 = 0;
    if (MODE == 3) { sc_q = qcg - 8 < 0 ? 0 : qcg - 8 > 48 ? 48 : qcg - 8;
        qrow0 = r00 + (q >> 4); qrow1 = qrow0 + 2; srq0 = qrow0 - 4 < 0 ? 0 : qrow0 - 4 > 56 ? 56 : qrow0 - 4; srq1 = qrow1 - 4 < 0 ? 0 : qrow1 - 4 > 56 ? 56 : qrow1 - 4;
        lo0 = r00 - 4 < 0 ? 0 : r00 - 4 > 56 ? 56 : r00 - 4; hi0 = (r00 - 3 < 0 ? 0 : r00 - 3 > 56 ? 56 : r00 - 3) + 8; lo1 = r00 - 2 < 0 ? 0 : r00 - 2 > 56 ? 56 : r00 - 2; hi1 = (r00 - 1 < 0 ? 0 : r00 - 1 > 56 ? 56 : r00 - 1) + 8; }
    const LAS float* bt_head = rpb_lds + hq * 465;
#define AT_S(S, n) do { _Pragma("unroll") for (int i_ = 0; i_ < 16; ++i_) S[i_] = 0.f; _Pragma("unroll") for (int c_ = 0; c_ < 4; ++c_) S = __builtin_amdgcn_mfma_f32_32x32x16_bf16(kf[c_], qf[n][c_], S, 0, 0, 0); } while (0)
#define AT_PV(n, p0, p1) do { st[n].O0 = __builtin_amdgcn_mfma_f32_32x32x16_bf16(vf[0][0], p0, st[n].O0, 0, 0, 0); st[n].O0 = __builtin_amdgcn_mfma_f32_32x32x16_bf16(vf[0][1], p1, st[n].O0, 0, 0, 0); \
        st[n].O1 = __builtin_amdgcn_mfma_f32_32x32x16_bf16(vf[1][0], p0, st[n].O1, 0, 0, 0); st[n].O1 = __builtin_amdgcn_mfma_f32_32x32x16_bf16(vf[1][1], p1, st[n].O1, 0, 0, 0); } while (0)
    for (int t = t_lo; t < t_hi; ++t) {
        const int buf = (t - t_lo) & 1;
        if (t + 1 < t_hi) { AT_DMA(t + 1, buf ^ 1); asm volatile("s_waitcnt vmcnt(8)" ::: "memory"); }
        else asm volatile("s_waitcnt vmcnt(0)" ::: "memory");
        const LAS unsigned char* bb = ring + buf * 8192;
        const bool act0 = MODE == 3 ? (t >= lo0 && t < hi0) : (t < NT), act1 = MODE == 3 ? (t >= lo1 && t < hi1) : (t >= 1);
        bf16x8 kf[4], vf[2][2];
#pragma unroll
        for (int c = 0; c < 4; ++c) kf[c] = *(const LAS bf16x8*)(bb + kaddr[c]);
        if (act0 && act1) {
            f32x16 S0, S1; AT_S(S0, 0); AT_S(S1, 1);
            mask_tile<MODE>(S0, t, NT, q, h, t, qrow0, srq0, sc_q, kc0, qcg, bt_head); mask_tile<MODE>(S1, t - 1, NT, q, h, t, qrow1, srq1, sc_q, kc0, qcg, bt_head);
            bf16x8 pa0, pa1, pb0, pb1;
            softmax_tile(S0, st[0], pa0, pa1); softmax_tile(S1, st[1], pb0, pb1);
            __builtin_amdgcn_sched_barrier(0);
#pragma unroll
            for (int dh = 0; dh < 2; ++dh)
#pragma unroll
                for (int sx = 0; sx < 2; ++sx) vf[dh][sx] = *(const LAS bf16x8*)(bb + vaddr[dh][sx]);
            AT_PV(0, pa0, pa1); AT_PV(1, pb0, pb1);
        } else if (act0) {
            f32x16 S0; AT_S(S0, 0);
#pragma unroll
            for (int dh = 0; dh < 2; ++dh)
#pragma unroll
                for (int sx = 0; sx < 2; ++sx) vf[dh][sx] = *(const LAS bf16x8*)(bb + vaddr[dh][sx]);
            mask_tile<MODE>(S0, t, NT, q, h, t, qrow0, srq0, sc_q, kc0, qcg, bt_head);
            bf16x8 pa0, pa1; softmax_tile(S0, st[0], pa0, pa1); AT_PV(0, pa0, pa1);
        } else if (act1) {
            f32x16 S1; AT_S(S1, 1);
#pragma unroll
            for (int dh = 0; dh < 2; ++dh)
#pragma unroll
                for (int sx = 0; sx < 2; ++sx) vf[dh][sx] = *(const LAS bf16x8*)(bb + vaddr[dh][sx]);
            mask_tile<MODE>(S1, t - 1, NT, q, h, t, qrow1, srq1, sc_q, kc0, qcg, bt_head);
            bf16x8 pb0, pb1; softmax_tile(S1, st[1], pb0, pb1); AT_PV(1, pb0, pb1);
        }
    }
#undef AT_DMA
#undef AT_S
#undef AT_PV
#pragma unroll
    for (int n = 0; n < 2; ++n) {
        const float rd = 1.0f / st[n].den;
        bf16_t* op;
        if (MODE == 1 || MODE == 2) { op = P_OB3(p) + ((size_t)g * NTOK + tokq[n]) * 128 + 64 * hs; if (h == 0) P_LSE(p)[((size_t)g * NTOK + tokq[n]) * 2 + hs] = (st[n].m + __log2f(st[n].den)) * LN2; }
        else op = P_OC(p) + (size_t)tokq[n] * OCW + (MODE == 0 ? 64 * hq : 512 + 64 * hq);
#pragma unroll
        for (int gq = 0; gq < 4; ++gq) {
            u32x2 w0, w1;
            w0[0] = cvt2(st[n].O0[4 * gq] * rd, st[n].O0[4 * gq + 1] * rd); w0[1] = cvt2(st[n].O0[4 * gq + 2] * rd, st[n].O0[4 * gq + 3] * rd);
            w1[0] = cvt2(st[n].O1[4 * gq] * rd, st[n].O1[4 * gq + 1] * rd); w1[1] = cvt2(st[n].O1[4 * gq + 2] * rd, st[n].O1[4 * gq + 3] * rd);
            *(u32x2*)(op + 8 * gq + 4 * h) = w0; *(u32x2*)(op + 32 + 8 * gq + 4 * h) = w1;
        }
    }
}
}
DI void f_attn_phase(const Params& p, int l, LAS unsigned char* lds, int slot) {
    const int tid = otid(), lane = tid & 63, wid = __builtin_amdgcn_readfirstlane(tid >> 6);
    LAS float* rpb_lds = (LAS float*)(lds + 131072 + 64);
    for (int i = tid; i < 4 * 465; i += 512) rpb_lds[i] = p.rpb[(size_t)l * 4 * 465 + i] * at::LOG2E;
    __syncthreads();
    LAS unsigned char* ring = lds + wid * 16384;
    const int x8 = blockIdx.x & 7;
    unsigned* ctr = (unsigned*)(p.ws + OFF_CTL + 16384) + 64 * (slot * 8 + x8);
    for (;;) {
        unsigned k = 0u;
        if (lane == 0) k = __hip_atomic_fetch_add(ctr, 1u, __ATOMIC_RELAXED, __HIP_MEMORY_SCOPE_AGENT);
        k = (unsigned)__builtin_amdgcn_readfirstlane((int)k);
        if (k >= 512u) break;
        int ln = lane; asm volatile("" : "+v"(ln));
        if (k < 192u) at::wave_unit<0>(p, l, x8 * 192 + (int)k, rpb_lds, ring, ln);
        else if (k < 320u) at::wave_unit<3>(p, l, x8 * 128 + (int)k - 192, rpb_lds, ring, ln);
        else { const int ub = x8 * 192 + (int)k - 320; if (((ub >> 7) % 3) == 1) at::wave_unit<2>(p, l, ub, rpb_lds, ring, ln); else at::wave_unit<1>(p, l, ub, rpb_lds, ring, ln); }
    }
    __syncthreads();
}

DI void bcombine_phase(const Params& p) {
    for (int i = blockIdx.x * 512 + otid(); i < NTOK * 16; i += gridDim.x * 512) {
        const int tok = i >> 4, part = i & 15, hs = part >> 3, d0 = (part & 7) * 8;
        const float l0 = P_LSE(p)[((size_t)0 * NTOK + tok) * 2 + hs], l1 = P_LSE(p)[((size_t)1 * NTOK + tok) * 2 + hs], l2 = P_LSE(p)[((size_t)2 * NTOK + tok) * 2 + hs];
        const float mx = fmaxf(l0, fmaxf(l1, l2)), e0 = __expf(l0 - mx), e1 = __expf(l1 - mx), e2 = __expf(l2 - mx), rs = 1.0f / (e0 + e1 + e2);
        const float a0 = e0 * rs, a1 = e1 * rs, a2 = e2 * rs;
        const u32x4 w0 = *(const u32x4*)(P_OB3(p) + ((size_t)0 * NTOK + tok) * 128 + 64 * hs + d0);
        const u32x4 w1 = *(const u32x4*)(P_OB3(p) + ((size_t)1 * NTOK + tok) * 128 + 64 * hs + d0);
        const u32x4 w2 = *(const u32x4*)(P_OB3(p) + ((size_t)2 * NTOK + tok) * 128 + 64 * hs + d0);
        u32x4 o;
#pragma unroll
        for (int j = 0; j < 4; ++j) o[j] = pk2(a0 * bflo(w0[j]) + a1 * bflo(w1[j]) + a2 * bflo(w2[j]), a0 * bfhi(w0[j]) + a1 * bfhi(w1[j]) + a2 * bfhi(w2[j]));
        *(u32x4*)(P_OC(p) + (size_t)tok * OCW + 384 + 64 * hs + d0) = o;
    }
}

namespace g8 {
constexpr int BM = 256, BK = 64, HALF = 128, HTB = HALF * BK * 2, NXCD = 8, WGM = 8;
DI int lds_byte(int r, int c) { const int st = (r >> 4) * 2 + (c >> 5), rr = r & 15, cc = c & 31, ob = rr * 64 + cc * 2; return st * 1024 + (ob ^ (((ob >> 9) & 1) << 5)); }
DI void stage_rc(int b, int& R, int& C) { const int st = b / 1024, sb = b % 1024, swz = sb ^ (((sb >> 9) & 1) << 5); R = (st >> 1) * 16 + swz / 64; C = (st & 1) * 32 + (swz % 64) / 2; }
DI int perm32(int rho) { const int n = rho >> 4, i = rho & 15; return 8 * (i >> 2) + 4 * n + (i & 3); }
struct Unit { int pm, pn, aux; };
struct StaticOrder {
    int nM, nN, nwg, G, c;
    DI void init(int M, int N, int G_, int c_) { nM = M / BM; nN = N / BM; nwg = nM * nN; G = G_; c = c_; }
    DI bool next(int i, Unit& u) const {
        const long L = (long)i * G + c; if (L >= nwg) return false;
        int wgid = (int)L; { const int q = nwg / NXCD, r = nwg % NXCD, xcd = wgid % NXCD, off = wgid / NXCD; wgid = (xcd < r ? xcd * (q + 1) : r * (q + 1) + (xcd - r) * q) + off; }
        const int nig = WGM * nN, gid = wgid / nig, fm = gid * WGM, gsz = (nM - fm) < WGM ? (nM - fm) : WGM;
        u.pm = fm + ((wgid % nig) % gsz); u.pn = (wgid % nig) / gsz; u.aux = 0; return true;
    }
};
typedef f32x4 Acc[2][2][4][2];
typedef int i32x4 __attribute__((ext_vector_type(4)));
typedef int i32x8 __attribute__((ext_vector_type(8)));
DI bf16x8 half8(const i32x8& v, int k) { const i32x4 x = k == 0 ? __builtin_shufflevector(v, v, 0, 1, 2, 3) : __builtin_shufflevector(v, v, 4, 5, 6, 7); return __builtin_bit_cast(bf16x8, x); }
DI i32x8 cat8(const bf16x8& a, const bf16x8& b) { const i32x4 x = __builtin_bit_cast(i32x4, a), y = __builtin_bit_cast(i32x4, b); return __builtin_shufflevector(x, y, 0, 1, 2, 3, 4, 5, 6, 7); }

template <class Desc, class Epi, class Sched, bool ALIGN_EPI>
DI void gemm_phase(LAS unsigned char* lds, const Desc& D, const Sched& S, const Epi& E) {
    const int tid = otid(), wid = __builtin_amdgcn_readfirstlane(tid >> 6), lane = tid & 63, wr = wid >> 2, wc = wid & 3, fr = lane & 15, fq = lane >> 4;
    int R0, C0, R1, C1; stage_rc(tid * 16, R0, C0); stage_rc(tid * 16 + 8192, R1, C1);
    const int Rb0 = Epi::PERM ? ((R0 & ~31) + perm32(R0 & 31)) : R0, Rb1 = Epi::PERM ? ((R1 & ~31) + perm32(R1 & 31)) : R1;
    constexpr unsigned LDA2 = Desc::lda * 2, LDB2 = Desc::ldb * 2;
    const size_t kstep = (size_t)(BK * 2);
    const unsigned ldsw = (unsigned)wid * 1024u;
    const int aoff = lds_byte(wr * 64 + fr, fq * 8), boff = lds_byte(wc * 32 + fr, fq * 8);
#define G8_SA(b, h) (((b) * 2 + (h)) * HTB)
#define G8_SB(b, h) ((4 + (b) * 2 + (h)) * HTB)
#define G8_STAGE(bufoff, gbase, o0, o1) do { \
        __builtin_amdgcn_global_load_lds((const unsigned*)((const char*)(gbase) + (o0)), (LAS unsigned*)(lds + (bufoff) + ldsw), 16, 0, 0); \
        __builtin_amdgcn_global_load_lds((const unsigned*)((const char*)(gbase) + (o1)), (LAS unsigned*)(lds + (bufoff) + ldsw + 8192), 16, 0, 0); } while (0)
#define G8_LDA(dst, b, h) do { _Pragma("unroll") for (int m = 0; m < 4; ++m) { const bf16x8 lo_ = *(const LAS bf16x8*)(lds + G8_SA(b, h) + aoff + m * 2048), hi_ = *(const LAS bf16x8*)(lds + G8_SA(b, h) + aoff + m * 2048 + 1024); dst[m] = cat8(lo_, hi_); } } while (0)
#define G8_LDB(dst, b, h) do { _Pragma("unroll") for (int n = 0; n < 2; ++n) { const bf16x8 lo_ = *(const LAS bf16x8*)(lds + G8_SB(b, h) + boff + n * 2048), hi_ = *(const LAS bf16x8*)(lds + G8_SB(b, h) + boff + n * 2048 + 1024); dst[n] = cat8(lo_, hi_); } } while (0)
#define G8_MMA(ai, bj, At, Bt) do { __builtin_amdgcn_s_setprio(1); _Pragma("unroll") for (int m = 0; m < 4; ++m) _Pragma("unroll") for (int n = 0; n < 2; ++n) _Pragma("unroll") for (int k = 0; k < 2; ++k) \
        acc[ai][bj][m][n] = __builtin_amdgcn_mfma_f32_16x16x32_bf16(half8(Bt[n], k), half8(At[m], k), acc[ai][bj][m][n], 0, 0, 0); __builtin_amdgcn_s_setprio(0); } while (0)
#define G8_MMA8(ai, bj, At, Bt) do { __builtin_amdgcn_s_setprio(1); _Pragma("unroll") for (int m = 0; m < 4; ++m) _Pragma("unroll") for (int n = 0; n < 2; ++n) \
        asm volatile("v_mfma_scale_f32_16x16x128_f8f6f4 %0, %1, %2, %0, %3, %3 op_sel_hi:[0,0,0]" : "+v"(acc[ai][bj][m][n]) : "v"(Bt[n]), "v"(At[m]), "v"(one_scale));     __builtin_amdgcn_s_setprio(0); } while (0)
#define G8_MM(ai, bj, At, Bt) do { if constexpr (Desc::FP8) G8_MMA8(ai, bj, At, Bt); else G8_MMA(ai, bj, At, Bt); } while (0)
#define G8_WAIT_V(n) asm volatile("s_waitcnt vmcnt(" #n ")" ::: "memory")
#define G8_WAIT_L(n) asm volatile("s_waitcnt lgkmcnt(" #n ")" ::: "memory")
#define G8_BAR __builtin_amdgcn_s_barrier()
#define G8_SCHED __builtin_amdgcn_sched_barrier(0)
#define G8_MKA(u, uidx, o) do { \
        o[0][0] = (unsigned)(Desc::GATHER ? D.a_row(u, uidx, R0) : R0) * LDA2 + (unsigned)C0 * 2u; o[0][1] = (unsigned)(Desc::GATHER ? D.a_row(u, uidx, R1) : R1) * LDA2 + (unsigned)C1 * 2u; \
        if (Desc::GATHER) { o[1][0] = (unsigned)D.a_row(u, uidx, HALF + R0) * LDA2 + (unsigned)C0 * 2u; o[1][1] = (unsigned)D.a_row(u, uidx, HALF + R1) * LDA2 + (unsigned)C1 * 2u; } } while (0)
#define G8_MKB(u, o, hs) do { const unsigned dl_ = (unsigned)D.dilB(u) * LDB2; hs = (unsigned)HALF * dl_; \
        o[0] = (unsigned)Rb0 * dl_ + (unsigned)C0 * 2u; o[1] = (unsigned)Rb1 * dl_ + (unsigned)C1 * 2u; } while (0)
#define G8_A1(o, i) (Desc::GATHER ? o[1][i] : o[0][i] + (unsigned)HALF * LDA2)
    Unit cur, nxt; int ui = 0;
    if (!S.next(0, cur)) return;
    Acc acc;
#pragma unroll
    for (int a = 0; a < 2; ++a)
#pragma unroll
        for (int b = 0; b < 2; ++b)
#pragma unroll
            for (int m = 0; m < 4; ++m)
#pragma unroll
                for (int n = 0; n < 2; ++n) acc[a][b][m][n] = (f32x4){0.f, 0.f, 0.f, 0.f};
    int one_scale = 0x7f7f7f7f; asm volatile("" : "+v"(one_scale));
    i32x8 At[4], B0[2], B1[2];
    unsigned cAo[2][2], cBo[2], nAo[2][2], nBo[2], cBh, nBh;
    G8_MKA(cur, 0, cAo); G8_MKB(cur, cBo, cBh); nBh = cBh;
    const char* cA = D.a_base(cur); const char* cB = D.b_base(cur);
    G8_STAGE(G8_SB(0, 0), cB, cBo[0], cBo[1]); G8_STAGE(G8_SB(0, 1), cB + cBh, cBo[0], cBo[1]); G8_STAGE(G8_SA(0, 0), cA, cAo[0][0], cAo[0][1]); G8_STAGE(G8_SA(0, 1), cA, G8_A1(cAo, 0), G8_A1(cAo, 1));
    if (wr == 1) G8_BAR;
    G8_WAIT_V(2); G8_BAR;
    G8_STAGE(G8_SB(1, 0), cB + kstep, cBo[0], cBo[1]); G8_STAGE(G8_SA(1, 0), cA + kstep, cAo[0][0], cAo[0][1]); G8_STAGE(G8_SB(1, 1), cB + kstep + cBh, cBo[0], cBo[1]);
    G8_WAIT_V(6); G8_BAR;
    for (;;) {
        const bool has_next = S.next(ui + 1, nxt);
        const char* nA = cA; const char* nB = cB;
        if (has_next) { nA = D.a_base(nxt); nB = D.b_base(nxt); }
        if (Desc::GATHER) { if (has_next) G8_MKA(nxt, ui + 1, nAo); else { nAo[0][0] = cAo[0][0]; nAo[0][1] = cAo[0][1]; nAo[1][0] = cAo[1][0]; nAo[1][1] = cAo[1][1]; } }
        if (Desc::VARB) { if (has_next) G8_MKB(nxt, nBo, nBh); else { nBo[0] = cBo[0]; nBo[1] = cBo[1]; nBh = cBh; } }
        const int nt = D.nt(cur);
#pragma unroll 1
        for (int t = 0; t < nt; t += 2) {
            const bool last = (t == nt - 2);
            const char* a1 = cA + (size_t)(t + 1) * kstep;
            const char* a2 = last ? nA : cA + (size_t)(t + 2) * kstep; const char* b2 = last ? nB : cB + (size_t)(t + 2) * kstep;
            const char* a3 = a2 + kstep; const char* b3 = b2 + kstep;
            const unsigned xa00 = (Desc::GATHER && last) ? nAo[0][0] : cAo[0][0], xa01 = (Desc::GATHER && last) ? nAo[0][1] : cAo[0][1];
            const unsigned xa10 = Desc::GATHER ? (last ? nAo[1][0] : cAo[1][0]) : xa00 + (unsigned)HALF * LDA2, xa11 = Desc::GATHER ? (last ? nAo[1][1] : cAo[1][1]) : xa01 + (unsigned)HALF * LDA2;
            const unsigned xb0 = (Desc::VARB && last) ? nBo[0] : cBo[0], xb1 = (Desc::VARB && last) ? nBo[1] : cBo[1], xbh = (Desc::VARB && last) ? nBh : cBh;
            G8_LDB(B0, 0, 0); G8_LDB(B1, 0, 1); G8_SCHED; G8_LDA(At, 0, 0); G8_STAGE(G8_SA(1, 1), a1, G8_A1(cAo, 0), G8_A1(cAo, 1));
            G8_WAIT_V(8); G8_WAIT_L(0); G8_BAR; G8_MM(0, 0, At, B0); G8_MM(0, 1, At, B1); G8_BAR; G8_SCHED;
            G8_LDA(At, 0, 1); G8_STAGE(G8_SB(0, 0), b2, xb0, xb1); G8_STAGE(G8_SB(0, 1), b2 + xbh, xb0, xb1); G8_STAGE(G8_SA(0, 0), a2, xa00, xa01);
            G8_WAIT_V(8); G8_WAIT_L(0); G8_BAR; G8_MM(1, 0, At, B0); G8_MM(1, 1, At, B1); G8_BAR; G8_SCHED;
            G8_LDB(B0, 1, 0); G8_LDB(B1, 1, 1); G8_SCHED; G8_LDA(At, 1, 0); G8_STAGE(G8_SA(0, 1), a2, xa10, xa11);
            G8_WAIT_V(8); G8_WAIT_L(0); G8_BAR; G8_MM(0, 0, At, B0); G8_MM(0, 1, At, B1); G8_BAR; G8_SCHED;
            G8_LDA(At, 1, 1); G8_STAGE(G8_SB(1, 0), b3, xb0, xb1); G8_STAGE(G8_SB(1, 1), b3 + xbh, xb0, xb1); G8_STAGE(G8_SA(1, 0), a3, xa00, xa01);
            G8_WAIT_V(8); G8_WAIT_L(0); G8_BAR; G8_MM(1, 0, At, B0); G8_MM(1, 1, At, B1); G8_BAR; G8_SCHED;
        }
        if constexpr (ALIGN_EPI) { if (wr == 0) G8_BAR; }
        if constexpr (Desc::FP8) asm volatile("s_nop 15\n\ts_nop 15" ::: "memory");
        E(acc, cur, wr, wc, fr, fq);
        if (!has_next) break;
#pragma unroll
        for (int a = 0; a < 2; ++a)
#pragma unroll
            for (int b = 0; b < 2; ++b)
#pragma unroll
                for (int m = 0; m < 4; ++m)
#pragma unroll
                    for (int n = 0; n < 2; ++n) acc[a][b][m][n] = (f32x4){0.f, 0.f, 0.f, 0.f};
        if constexpr (Desc::FP8) asm volatile("s_nop 7" ::: "memory");
        cur = nxt; cA = nA; cB = nB; ++ui;
        if (Desc::GATHER) { cAo[0][0] = nAo[0][0]; cAo[0][1] = nAo[0][1]; cAo[1][0] = nAo[1][0]; cAo[1][1] = nAo[1][1]; }
        if (Desc::VARB) { cBo[0] = nBo[0]; cBo[1] = nBo[1]; cBh = nBh; }
        if constexpr (ALIGN_EPI) { if (wr == 1) G8_BAR; }
    }
    G8_WAIT_V(0);
    if constexpr (!ALIGN_EPI) { if (wr == 0) G8_BAR; }
    G8_BAR;
#undef G8_SA
#undef G8_SB
#undef G8_STAGE
#undef G8_LDA
#undef G8_LDB
#undef G8_MMA
#undef G8_MMA8
#undef G8_MM
#undef G8_WAIT_V
#undef G8_WAIT_L
#undef G8_BAR
#undef G8_SCHED
#undef G8_MKA
#undef G8_MKB
#undef G8_A1
}
DI unsigned cvt2(float lo, float hi) { typedef __bf16 bf2_t __attribute__((ext_vector_type(2))); const f32x2 v = {lo, hi}; const bf2_t b = __builtin_convertvector(v, bf2_t); return __builtin_bit_cast(unsigned, b); }
DI u32x4 pack8(const f32x4& a, const f32x4& b) { u32x4 w; w[0] = cvt2(a[0], a[1]); w[1] = cvt2(a[2], a[3]); w[2] = cvt2(b[0], b[1]); w[3] = cvt2(b[2], b[3]); return w; }
DI float fsig(float x) { return __builtin_amdgcn_rcpf(1.0f + __expf(-x)); }

struct DescMoe1 { static constexpr bool GATHER = true, VARB = false, FP8 = true; static constexpr int lda = DM / 2, ldb = DM / 2; const bf16_t* XN8; const bf16_t* WGU; const LAS int* rowlist;
    DI const char* a_base(const Unit&) const { return (const char*)XN8; }
    DI const char* b_base(const Unit& u) const { return (const char*)WGU + ((size_t)(u.pm >> 3) * 4096 + (size_t)u.pn * 256) * DM; }
    DI int a_row(const Unit&, int uidx, int r) const { return rowlist[uidx * 256 + r]; }
    DI int nt(const Unit&) const { return DM / 128; } DI int dilB(const Unit&) const { return 1; } };
struct EpiSwiglu { static constexpr bool PERM = true; unsigned char* HID8;
    DI void operator()(const Acc& acc, const Unit& u, int wr, int wc, int fr, int fq) const {
        const int row0 = u.pm * BM + wr * 64 + fr, col0 = u.pn * 128 + wc * 32 + 8 * fq; constexpr float WI = 1.0f / W8_SCALE;
#pragma unroll
        for (int ai = 0; ai < 2; ++ai)
#pragma unroll
            for (int m = 0; m < 4; ++m) { f32x4 h0, h1;
#pragma unroll
                for (int j = 0; j < 4; ++j) { const float g0 = acc[ai][0][m][0][j] * WI, g1 = acc[ai][0][m][1][j] * WI;
                    h0[j] = g0 * fsig(g0) * acc[ai][1][m][0][j] * (WI * H8_SCALE); h1[j] = g1 * fsig(g1) * acc[ai][1][m][1][j] * (WI * H8_SCALE); }
                u32x2 w; w[0] = pk4_fp8(h0[0], h0[1], h0[2], h0[3]); w[1] = pk4_fp8(h1[0], h1[1], h1[2], h1[3]);
                *(u32x2*)(HID8 + (size_t)(row0 + ai * HALF + m * 16) * FF + col0) = w; }
    } };
struct DescMoe2 { static constexpr bool GATHER = false, VARB = false, FP8 = true; static constexpr int lda = FF / 2, ldb = FF / 2; const unsigned char* HID8; const bf16_t* WD;
    DI const char* a_base(const Unit& u) const { return (const char*)HID8 + (size_t)u.pm * 256 * FF; }
    DI const char* b_base(const Unit& u) const { return (const char*)WD + ((size_t)(u.pm >> 3) * 1024 + (size_t)u.pn * 256) * FF; }
    DI int a_row(const Unit&, int, int r) const { return r; }
    DI int nt(const Unit&) const { return FF / 128; } DI int dilB(const Unit&) const { return 1; } };
struct EpiY { static constexpr bool PERM = true; bf16_t* Y; const float* VAL;
    DI void operator()(const Acc& acc, const Unit& u, int wr, int wc, int fr, int fq) const {
        const int row0 = u.pm * BM + wr * 64 + fr, col0 = u.pn * BM + wc * 32 + 8 * fq;
#pragma unroll
        for (int ai = 0; ai < 2; ++ai)
#pragma unroll
            for (int m = 0; m < 4; ++m) { const int row = row0 + ai * HALF + m * 16; const float v = VAL[row] * (1.0f / (W8_SCALE * H8_SCALE));
#pragma unroll
                for (int bj = 0; bj < 2; ++bj) *(u32x4*)(Y + (size_t)row * DM + col0 + bj * HALF) = pack8(acc[ai][bj][m][0] * v, acc[ai][bj][m][1] * v); }
    } };
struct DescOut { static constexpr bool GATHER = false, VARB = false, FP8 = false; static constexpr int lda = DM, ldb = DM; const bf16_t* MG; const bf16_t* WO;
    DI const char* a_base(const Unit& u) const { return (const char*)(MG + (size_t)u.pm * 256 * DM); }
    DI const char* b_base(const Unit& u) const { return (const char*)(WO + (size_t)u.pn * 256 * DM); }
    DI int a_row(const Unit&, int, int r) const { return r; }
    DI int nt(const Unit&) const { return DM / BK; } DI int dilB(const Unit&) const { return 1; } };
struct EpiResid { static constexpr bool PERM = false; float* X;
    DI void operator()(const Acc& acc, const Unit& u, int wr, int wc, int fr, int fq) const {
        const int row0 = u.pm * BM + wr * 64 + fr, col0 = u.pn * BM + wc * 32 + 4 * fq;
#pragma unroll
        for (int ai = 0; ai < 2; ++ai)
#pragma unroll
            for (int m = 0; m < 4; ++m) { float* xr = X + (size_t)(row0 + ai * HALF + m * 16) * DM + col0;
#pragma unroll
                for (int bj = 0; bj < 2; ++bj)
#pragma unroll
                    for (int n = 0; n < 2; ++n) { f32x4* q = (f32x4*)(xr + bj * HALF + 16 * n); *q = *q + acc[ai][bj][m][n]; } }
    } };
struct DescInproj { static constexpr bool GATHER = false, VARB = false, FP8 = false; static constexpr int lda = DM, ldb = DM; const bf16_t* XN; const bf16_t* WIN;
    DI const char* a_base(const Unit& u) const { return (const char*)(XN + (size_t)u.pm * 256 * DM); }
    DI const char* b_base(const Unit& u) const { return (const char*)(WIN + (size_t)u.pn * 256 * DM); }
    DI int a_row(const Unit&, int, int r) const { return r; }
    DI int nt(const Unit&) const { return DM / BK; } DI int dilB(const Unit&) const { return 1; } };
struct EpiInproj { static constexpr bool PERM = true; bf16_t* QK; bf16_t* G; const float* cosT; const float* sinT; const float* bgate;
    DI void operator()(const Acc& acc, const Unit& u, int wr, int wc, int fr, int fq) const {
        const int row0 = u.pm * BM + wr * 64 + fr;
        if (u.pn < 5) {
            const int hr = 4 * u.pn + wc; const float sc = (hr < 6 || (hr >= 8 && hr < 14)) ? 0.125f * 1.4426950408889634f : 1.0f;
#pragma unroll
            for (int ai = 0; ai < 2; ++ai)
#pragma unroll
                for (int m = 0; m < 4; ++m) { const int row = row0 + ai * HALF + m * 16, pos = row & (SEQ - 1);
                    const f32x4 c0 = *(const f32x4*)(cosT + pos * 32 + 8 * fq), c1 = *(const f32x4*)(cosT + pos * 32 + 8 * fq + 4), s0 = *(const f32x4*)(sinT + pos * 32 + 8 * fq), s1 = *(const f32x4*)(sinT + pos * 32 + 8 * fq + 4);
                    const f32x4 a0 = acc[ai][0][m][0], a1 = acc[ai][0][m][1], b0 = acc[ai][1][m][0], b1 = acc[ai][1][m][1];
                    bf16_t* o = QK + (size_t)row * QKW + 64 * hr + 8 * fq;
                    *(u32x4*)o = pack8((a0 * c0 - b0 * s0) * sc, (a1 * c1 - b1 * s1) * sc);
                    *(u32x4*)(o + 32) = pack8((b0 * c0 + a0 * s0) * sc, (b1 * c1 + a1 * s1) * sc); }
        } else if (u.pn < 7) {
            const float sc = u.pn == 5 ? 0.125f * 1.4426950408889634f : 1.0f; const int col0 = 1280 + (u.pn - 5) * 256 + wc * 32 + 8 * fq;
#pragma unroll
            for (int ai = 0; ai < 2; ++ai)
#pragma unroll
                for (int m = 0; m < 4; ++m)
#pragma unroll
                    for (int bj = 0; bj < 2; ++bj) *(u32x4*)(QK + (size_t)(row0 + ai * HALF + m * 16) * QKW + col0 + bj * HALF) = pack8(acc[ai][bj][m][0] * sc, acc[ai][bj][m][1] * sc);
        } else {
            const int col0 = (u.pn - 7) * 256 + wc * 32 + 8 * fq;
            f32x4 bv[2][2];
#pragma unroll
            for (int bj = 0; bj < 2; ++bj)
#pragma unroll
                for (int n = 0; n < 2; ++n) bv[bj][n] = *(const f32x4*)(bgate + col0 + bj * HALF + 4 * n);
#pragma unroll
            for (int ai = 0; ai < 2; ++ai)
#pragma unroll
                for (int m = 0; m < 4; ++m)
#pragma unroll
                    for (int bj = 0; bj < 2; ++bj) { f32x4 v0 = acc[ai][bj][m][0] + bv[bj][0], v1 = acc[ai][bj][m][1] + bv[bj][1];
#pragma unroll
                        for (int j = 0; j < 4; ++j) { v0[j] = fsig(v0[j]); v1[j] = fsig(v1[j]); }
                        *(u32x4*)(G + (size_t)(row0 + ai * HALF + m * 16) * 3072 + col0 + bj * HALF) = pack8(v0, v1); }
        }
    } };
struct DescVT { static constexpr bool GATHER = false, VARB = true, FP8 = false; static constexpr int lda = DM, ldb = DM; const bf16_t* WV; const bf16_t* XN;
    DI const char* a_base(const Unit& u) const { return (const char*)(WV + (size_t)u.pm * 256 * DM); }
    DI const char* b_base(const Unit& u) const { return (const char*)(XN + (u.pm < 2 ? (size_t)u.pn * 256 : (size_t)((u.pn >> 4) * SEQ + (u.pn & 15))) * DM); }
    DI int a_row(const Unit&, int, int r) const { return r; }
    DI int nt(const Unit&) const { return DM / BK; } DI int dilB(const Unit& u) const { return u.pm < 2 ? 1 : 16; } };
struct EpiVT { static constexpr bool PERM = true; bf16_t* VT;
    DI void operator()(const Acc& acc, const Unit& u, int wr, int wc, int fr, int fq) const {
        const int row0 = u.pm * BM + wr * 64 + fr, col0 = u.pn * BM + wc * 32 + 8 * fq;
#pragma unroll
        for (int ai = 0; ai < 2; ++ai)
#pragma unroll
            for (int m = 0; m < 4; ++m)
#pragma unroll
                for (int bj = 0; bj < 2; ++bj) *(u32x4*)(VT + (size_t)(row0 + ai * HALF + m * 16) * NTOK + col0 + bj * HALF) = pack8(acc[ai][bj][m][0], acc[ai][bj][m][1]);
    } };
struct DescMerge { static constexpr bool GATHER = false, VARB = false, FP8 = false; static constexpr int lda = OCW, ldb = 768; const bf16_t* OC; const bf16_t* WM;
    DI int k0(const Unit& u) const { return u.aux == 0 ? 0 : u.aux == 1 ? 384 : 512; }
    DI const char* a_base(const Unit& u) const { return (const char*)(OC + (size_t)u.pm * 256 * OCW + k0(u)); }
    DI const char* b_base(const Unit& u) const { return (const char*)(WM + (size_t)u.pn * 256 * 768 + k0(u)); }
    DI int a_row(const Unit&, int, int r) const { return r; }
    DI int nt(const Unit& u) const { return u.aux == 0 ? 6 : u.aux == 1 ? 2 : 4; } DI int dilB(const Unit&) const { return 1; } };
struct MergeOrder { StaticOrder base;
    DI bool next(int i, Unit& u) const { const int q = i / 3; if (!base.next(q, u)) return false; u.aux = i - 3 * q; return true; } };
struct EpiMerge { static constexpr bool PERM = true; bf16_t* MG; const bf16_t* G;
    DI void operator()(const Acc& acc, const Unit& u, int wr, int wc, int fr, int fq) const {
        const int row0 = u.pm * BM + wr * 64 + fr, col0 = u.pn * BM + wc * 32 + 8 * fq;
#pragma unroll
        for (int ai = 0; ai < 2; ++ai) {
            u32x4 g[4][2], w[4][2];
#pragma unroll
            for (int m = 0; m < 4; ++m)
#pragma unroll
                for (int bj = 0; bj < 2; ++bj) { const int row = row0 + ai * HALF + m * 16, col = col0 + bj * HALF;
                    g[m][bj] = *(const u32x4*)(G + (size_t)row * 3072 + 1024 * u.aux + col);
                    if (u.aux != 0) w[m][bj] = *(const u32x4*)(MG + (size_t)row * DM + col); else w[m][bj] = (u32x4){0u, 0u, 0u, 0u}; }
#pragma unroll
            for (int m = 0; m < 4; ++m)
#pragma unroll
                for (int bj = 0; bj < 2; ++bj) { const int row = row0 + ai * HALF + m * 16, col = col0 + bj * HALF;
                    const u32x4 gg = g[m][bj], ww = w[m][bj];
                    f32x4 v0 = acc[ai][bj][m][0], v1 = acc[ai][bj][m][1];
                    v0[0] = v0[0] * bflo(gg[0]) + bflo(ww[0]); v0[1] = v0[1] * bfhi(gg[0]) + bfhi(ww[0]); v0[2] = v0[2] * bflo(gg[1]) + bflo(ww[1]); v0[3] = v0[3] * bfhi(gg[1]) + bfhi(ww[1]);
                    v1[0] = v1[0] * bflo(gg[2]) + bflo(ww[2]); v1[1] = v1[1] * bfhi(gg[2]) + bfhi(ww[2]); v1[2] = v1[2] * bflo(gg[3]) + bflo(ww[3]); v1[3] = v1[3] * bfhi(gg[3]) + bfhi(ww[3]);
                    *(u32x4*)(MG + (size_t)row * DM + col) = pack8(v0, v1); }
            __builtin_amdgcn_sched_barrier(0);
        }
    } };
}
DI void f_inproj_phase(const Params& p, int l, LAS unsigned char* lds) {
    { g8::StaticOrder S; S.init(NTOK, 4352, gridDim.x, blockIdx.x);
      g8::DescInproj D{P_XN(p), P_W(p, l, LW_WIN)}; g8::EpiInproj E{P_QK(p), P_G(p), P_COS(p), P_SIN(p), p.b_gate + (size_t)l * 3072};
      g8::gemm_phase<g8::DescInproj, g8::EpiInproj, g8::StaticOrder, true>(lds, D, S, E); }
    { g8::StaticOrder S; S.init(VCH, NTOK, gridDim.x, (blockIdx.x + gridDim.x - 64) % gridDim.x);
      g8::DescVT D{P_W(p, l, LW_WV), P_XN(p)}; g8::EpiVT E{P_VT(p)};
      g8::gemm_phase<g8::DescVT, g8::EpiVT, g8::StaticOrder, true>(lds, D, S, E); }
}
struct OneUnit { int pm, pn; DI bool next(int i, g8::Unit& u) const { if (i != 0) return false; u.pm = pm; u.pn = pn; u.aux = 0; return true; } };
DI void f_gate_tail_units(const Params& p, int l, LAS unsigned char* lds) {
    if (blockIdx.x < 128) {
        OneUnit S{(int)(blockIdx.x >> 1), 17 + (int)(blockIdx.x & 1)};
        g8::DescInproj D{P_XN(p), P_W(p, l, LW_WIN)}; g8::EpiInproj E{P_QK(p), P_G(p), P_COS(p), P_SIN(p), p.b_gate + (size_t)l * 3072};
        g8::gemm_phase<g8::DescInproj, g8::EpiInproj, OneUnit, false>(lds, D, S, E);
        __syncthreads();
    }
}
DI void f_merge_phase(const Params& p, int l, LAS unsigned char* lds) {
    g8::MergeOrder S; S.base.init(NTOK, DM, gridDim.x, blockIdx.x);
    g8::DescMerge D{P_OC(p), P_W(p, l, LW_WM)}; g8::EpiMerge E{P_MG(p), P_G(p)};
    g8::gemm_phase<g8::DescMerge, g8::EpiMerge, g8::MergeOrder, true>(lds, D, S, E);
}

DI void f_moe1_phase(const Params& p, int l, LAS unsigned char* lds) {
    g8::StaticOrder S; S.init(NROWS_E, 2 * FF, gridDim.x, blockIdx.x);
    LAS int* rowlist = (LAS int*)(lds + 131072 + 64);
    g8::Unit u;
    for (int i = 0; i < 8 && S.next(i, u); ++i)
        for (int r = otid(); r < 256; r += 512) rowlist[i * 256 + r] = ((u.pm >> 1) & 3) * SEQ + P_IDX(p)[u.pm * 256 + r];
    __syncthreads();
    g8::DescMoe1 D{(const bf16_t*)P_XN8(p), P_W(p, l, LW_WGU), rowlist}; g8::EpiSwiglu E{(unsigned char*)P_HID(p)};
    g8::gemm_phase<g8::DescMoe1, g8::EpiSwiglu, g8::StaticOrder, true>(lds, D, S, E);
}
DI void f_moe2_phase(const Params& p, int l, LAS unsigned char* lds) {
    g8::StaticOrder S; S.init(NROWS_E, DM, gridDim.x, blockIdx.x);
    g8::DescMoe2 D{(const unsigned char*)P_HID(p), P_W(p, l, LW_WD)}; g8::EpiY E{P_Y(p), P_VAL(p)};
    g8::gemm_phase<g8::DescMoe2, g8::EpiY, g8::StaticOrder, true>(lds, D, S, E);
}
DI void f_out_phase(const Params& p, int l, LAS unsigned char* lds) {
    g8::StaticOrder S; S.init(NTOK, DM, gridDim.x, blockIdx.x);
    g8::DescOut D{P_MG(p), P_W(p, l, LW_WO)}; g8::EpiResid E{P_X(p)};
    g8::gemm_phase<g8::DescOut, g8::EpiResid, g8::StaticOrder, false>(lds, D, S, E);
}

#define XB_TMO      128
#define XB_XCNT(j)  (256  + 64 * (j))
#define XB_XSUB(j)  (1280 + 64 * (j))
#define XB_XGEN(j)  (2304 + 64 * (j))
#define XB_TOP      3328
#define XB_TOPGEN   3392
#define XCD_BAR_WORDS 3456
#define XB_SPIN_CAP (1u << 22)

__device__ __forceinline__ unsigned xb_ld(unsigned* p)              { return __hip_atomic_load(p, __ATOMIC_RELAXED, __HIP_MEMORY_SCOPE_AGENT); }
__device__ __forceinline__ unsigned xb_add(unsigned* p, unsigned v) { return __hip_atomic_fetch_add(p, v, __ATOMIC_RELAXED, __HIP_MEMORY_SCOPE_AGENT); }
__device__ __forceinline__ unsigned xb_xcc_id() { return (unsigned)__builtin_amdgcn_s_getreg((3 << 11) | 20) & 0xFu; }
#define XB_SPIN(cond, bar) do { unsigned _sp = 0; while (cond) { __builtin_amdgcn_s_sleep(1); \
    if ((++_sp & 255u) == 0u) { if (xb_ld(&(bar)[XB_TMO])) break; if (_sp > XB_SPIN_CAP) { atomicAdd(&(bar)[XB_TMO], 1u); break; } } } } while (0)

struct XcdBarrier {
    unsigned* bar; unsigned x;
    volatile LAS unsigned* st;
};

__device__ __forceinline__ XcdBarrier xcd_barrier_post(unsigned* bar, volatile LAS unsigned* st) {
    XcdBarrier b; b.bar = bar; b.x = xb_xcc_id(); b.st = st;
    if (threadIdx.x == 0) (void)xb_add(&bar[XB_XCNT(b.x)], 1u);
    return b;
}
__device__ __forceinline__ void xcd_barrier_complete(unsigned* bar, unsigned x, unsigned& nloc, unsigned& nx) {
    const unsigned G = gridDim.x * gridDim.y * gridDim.z;
    unsigned sum, cnt, mine, sp = 0u;
    for (;;) {
        sum = 0u; cnt = 0u; mine = 0u;
#pragma unroll
        for (unsigned j = 0; j < 16; ++j) { const unsigned c = xb_ld(&bar[XB_XCNT(j)]); sum += c; cnt += (c > 0u) ? 1u : 0u; mine = (j == x) ? c : mine; }
        if (sum == G) break;
        __builtin_amdgcn_s_sleep(1);
        if ((++sp & 255u) == 0u) { if (xb_ld(&bar[XB_TMO])) break; if (sp > XB_SPIN_CAP) { atomicAdd(&bar[XB_TMO], 1u); break; } }
    }
    nloc = mine > 0u ? mine : 1u; nx = cnt > 0u ? cnt : 1u;
}

__device__ __forceinline__ void xcd_barrier(const XcdBarrier& b) {
    asm volatile("s_waitcnt vmcnt(0)" ::: "memory");
    __syncthreads();
    if (threadIdx.x == 0) {
        unsigned* bar = b.bar;
        __builtin_amdgcn_s_waitcnt(0);
        unsigned nloc = b.st[0], nx = b.st[1];
        if (nloc == 0u) { xcd_barrier_complete(bar, b.x, nloc, nx); b.st[0] = nloc; b.st[1] = nx; }
        const unsigned old = xb_add(&bar[XB_XSUB(b.x)], 1u);
        const unsigned gen = old / nloc;
        if (old + 1u == (gen + 1u) * nloc) {
            __builtin_amdgcn_fence(__ATOMIC_RELEASE, "agent");
            asm volatile("s_waitcnt vmcnt(0)" ::: "memory");
            const unsigned og = xb_add(&bar[XB_TOP], 1u);
            const unsigned tg = og / nx;
            if (og + 1u == (tg + 1u) * nx) xb_add(&bar[XB_TOPGEN], 1u);
            else XB_SPIN(xb_ld(&bar[XB_TOPGEN]) == tg, bar);
            __builtin_amdgcn_fence(__ATOMIC_ACQUIRE, "agent");
            xb_add(&bar[XB_XGEN(b.x)], 1u);
            asm volatile("s_waitcnt vmcnt(0)" ::: "memory");
        } else {
            XB_SPIN(xb_ld(&bar[XB_XGEN(b.x)]) == gen, bar);
            __builtin_amdgcn_fence(__ATOMIC_ACQUIRE, "agent");
            asm volatile("s_waitcnt vmcnt(0)" ::: "memory");
        }
    }
    __syncthreads();
}

constexpr int LDS_BYTES = 131072 + 64 + 8192;
#ifndef REP_PREP
#define REP_PREP 1
#define REP_INPROJ 1
#define REP_ATTN 1
#define REP_MERGE 1
#define REP_BCOMB 1
#define REP_N2 1
#define REP_TOPK 1
#define REP_MOE1 1
#define REP_MOE2 1
#endif
#define PH(...) do { Params q = p; { size_t z_ = 0; asm volatile("" : "+s"(z_)); q.ws = p.ws + z_; } __VA_ARGS__; } while (0)
#define GRID_BAR() do { XcdBarrier b_; { size_t z_ = 0; asm volatile("" : "+s"(z_)); b_.bar = (unsigned*)(p.ws + z_ + OFF_CTL); } b_.x = xb_xcc_id(); b_.st = (volatile LAS unsigned*)(lds + 131072); xcd_barrier(b_); } while (0)
__global__ void __launch_bounds__(512, 2) mega_fwd(Params p) {
    extern __shared__ __attribute__((aligned(16))) unsigned char lds_raw[];
    LAS unsigned char* lds = (LAS unsigned char*)lds_raw;
    { volatile LAS unsigned* xbw = (volatile LAS unsigned*)(lds + 131072);
      if (threadIdx.x == 0) { xbw[0] = 0u; xbw[1] = 0u; xbw[2] = 0u; xbw[3] = 0u; }
      __syncthreads();
      (void)xcd_barrier_post((unsigned*)(p.ws + OFF_CTL), xbw); }
    PH(prep_phase(q, (LAS float*)lds); norm1_phase<0>(q, 0));
    GRID_BAR();
#define LAYER(l) do { \
        if ((l) != 0) { PH(norm1_phase<1>(q, (l))); GRID_BAR(); } \
        PH(f_inproj_phase(q, (l), lds)); GRID_BAR(); \
        PH(f_gate_tail_units(q, (l), lds); f_attn_phase(q, (l), lds, (l))); GRID_BAR(); \
        PH(bcombine_phase(q)); GRID_BAR(); \
        PH(f_merge_phase(q, (l), lds)); GRID_BAR(); \
        PH(f_out_phase(q, (l), lds)); GRID_BAR(); \
        PH(norm2_router_phase(q, (l), (LAS float*)lds)); GRID_BAR(); \
        PH(topk_phase(q, (LAS unsigned*)lds)); GRID_BAR(); \
        PH(f_moe1_phase(q, (l), lds)); GRID_BAR(); \
        PH(f_moe2_phase(q, (l), lds)); GRID_BAR(); } while (0)
    LAYER(0); LAYER(1); LAYER(2); LAYER(3);
#undef LAYER
    PH(norm1_phase<2>(q, 0));
}

extern "C" void kernel_launch(void* const* d_in, const int* in_sizes, int n_in, void* d_out, int out_size, void* d_ws, size_t ws_size, hipStream_t stream) {
    (void)in_sizes; (void)out_size;
    static int grid = 0;
    if (grid == 0) {
        if (n_in != 16 || ws_size < OFF_END) { grid = -1; return; }
        int dev = 0, cus = 0, per_cu = 0;
        if (hipGetDevice(&dev) != hipSuccess || hipDeviceGetAttribute(&cus, hipDeviceAttributeMultiprocessorCount, dev) != hipSuccess) { grid = -1; return; }
        if (hipFuncSetAttribute((const void*)mega_fwd, hipFuncAttributeMaxDynamicSharedMemorySize, LDS_BYTES) != hipSuccess) { grid = -1; return; }
        if (hipOccupancyMaxActiveBlocksPerMultiprocessor(&per_cu, (const void*)mega_fwd, 512, LDS_BYTES) != hipSuccess || per_cu < 1) { (void)hipGetLastError(); }
        grid = cus;
    }
    if (grid < 0) return;
    if (hipMemsetAsync((char*)d_ws + OFF_CTL, 0, 65536, stream) != hipSuccess) return;
    Params p{};
    p.x = (const float*)d_in[0]; p.w_in = (const float*)d_in[1]; p.b_gate = (const float*)d_in[2]; p.sink = (const float*)d_in[3]; p.rpb = (const float*)d_in[4];
    p.w_a = (const float*)d_in[5]; p.w_b = (const float*)d_in[6]; p.w_c = (const float*)d_in[7]; p.w_out = (const float*)d_in[8]; p.norm_mix = (const float*)d_in[9];
    p.norm_ffn = (const float*)d_in[10]; p.w_router = (const float*)d_in[11]; p.w_gate_e = (const float*)d_in[12]; p.w_up_e = (const float*)d_in[13]; p.w_down_e = (const float*)d_in[14];
    p.norm_final = (const float*)d_in[15]; p.out = (float*)d_out; p.ws = (unsigned char*)d_ws;
    hipLaunchKernelGGL(mega_fwd, dim3(grid), dim3(512), LDS_BYTES, stream, p);
}
```

```cpp
#include <hip/hip_runtime.h>
#include <stdint.h>

#define DI __device__ __forceinline__
#define LAS __attribute__((address_space(3)))
typedef unsigned short bf16_t;
typedef short bf16x8 __attribute__((ext_vector_type(8)));
typedef float f32x2 __attribute__((ext_vector_type(2)));
typedef float f32x4 __attribute__((ext_vector_type(4)));
typedef float f32x16 __attribute__((ext_vector_type(16)));
typedef unsigned u32x2 __attribute__((ext_vector_type(2)));
typedef unsigned u32x4 __attribute__((ext_vector_type(4)));

constexpr int NTOK = 16384, DM = 1024, SEQ = 4096, NBATCH = 4, NLAYER = 4, NEXP = 16, FF = 2048, CAP = 512, PROJ = 5632;
constexpr int QKW = 1792;
constexpr int VCH = 768;
constexpr int OCW = 768;
constexpr int NROWS_E = NBATCH * CAP * NEXP;

constexpr size_t OFF_CTL = 0;
constexpr size_t OFF_COS = 65536;
constexpr size_t OFF_SIN = OFF_COS + (size_t)SEQ * 32 * 4;
constexpr size_t OFF_W   = 2u << 20;
constexpr size_t WIN_B = (size_t)4864 * 1024 * 2, WV_B = (size_t)768 * 1024 * 2, WM_B = (size_t)1024 * 768 * 2, WO_B = (size_t)1024 * 1024 * 2;
constexpr size_t WGU_B = (size_t)NEXP * 4096 * 1024 * 2, WD_B = (size_t)NEXP * 1024 * 2048 * 2;
constexpr size_t LW_WIN = 0, LW_WV = LW_WIN + WIN_B, LW_WM = LW_WV + WV_B, LW_WO = LW_WM + WM_B, LW_WGU = LW_WO + WO_B, LW_WD = LW_WGU + WGU_B, LW = LW_WD + WD_B;
constexpr size_t OFF_X   = OFF_W + NLAYER * LW;
constexpr size_t OFF_XN  = OFF_X + (size_t)NTOK * DM * 4;
constexpr size_t OFF_QK  = OFF_XN + (size_t)NTOK * DM * 2;
constexpr size_t OFF_VT  = OFF_QK + (size_t)NTOK * QKW * 2;
constexpr size_t OFF_G   = OFF_VT + (size_t)VCH * NTOK * 2;
constexpr size_t OFF_OC  = OFF_G + (size_t)NTOK * 3072 * 2;
constexpr size_t OFF_OB3 = OFF_OC + (size_t)NTOK * OCW * 2;
constexpr size_t OFF_LSE = OFF_OB3 + (size_t)3 * NTOK * 128 * 2;
constexpr size_t OFF_MG  = OFF_LSE + (size_t)3 * NTOK * 2 * 4;
constexpr size_t OFF_AFF = OFF_MG + (size_t)NTOK * DM * 2;
constexpr size_t OFF_IDX = OFF_AFF + (size_t)NTOK * NEXP * 4;
constexpr size_t OFF_VAL = OFF_IDX + (size_t)NROWS_E * 4;
constexpr size_t OFF_INV = OFF_VAL + (size_t)NROWS_E * 4;
constexpr size_t OFF_HID = OFF_INV + (size_t)NTOK * NEXP * 4;
constexpr size_t OFF_Y   = OFF_HID + (size_t)NROWS_E * FF * 2;
constexpr size_t OFF_XN8 = OFF_Y + (size_t)NROWS_E * DM * 2;
constexpr size_t OFF_END = OFF_XN8 + (size_t)NTOK * DM;

struct Params {
    const float *x, *w_in, *b_gate, *sink, *rpb, *w_a, *w_b, *w_c, *w_out, *norm_mix, *norm_ffn, *w_router, *w_gate_e, *w_up_e, *w_down_e, *norm_final;
    float* out; unsigned char* ws;
};
DI float*  P_COS(const Params& p) { return (float*)(p.ws + OFF_COS); }
DI float*  P_SIN(const Params& p) { return (float*)(p.ws + OFF_SIN); }
DI bf16_t* P_W(const Params& p, int l, size_t off) { return (bf16_t*)(p.ws + OFF_W + (size_t)l * LW + off); }
DI float*  P_X(const Params& p) { return (float*)(p.ws + OFF_X); }
DI bf16_t* P_XN(const Params& p) { return (bf16_t*)(p.ws + OFF_XN); }
DI bf16_t* P_QK(const Params& p) { return (bf16_t*)(p.ws + OFF_QK); }
DI bf16_t* P_VT(const Params& p) { return (bf16_t*)(p.ws + OFF_VT); }
DI bf16_t* P_G(const Params& p) { return (bf16_t*)(p.ws + OFF_G); }
DI bf16_t* P_OC(const Params& p) { return (bf16_t*)(p.ws + OFF_OC); }
DI bf16_t* P_OB3(const Params& p) { return (bf16_t*)(p.ws + OFF_OB3); }
DI float*  P_LSE(const Params& p) { return (float*)(p.ws + OFF_LSE); }
DI bf16_t* P_MG(const Params& p) { return (bf16_t*)(p.ws + OFF_MG); }
DI float*  P_AFF(const Params& p) { return (float*)(p.ws + OFF_AFF); }
DI int*    P_IDX(const Params& p) { return (int*)(p.ws + OFF_IDX); }
DI float*  P_VAL(const Params& p) { return (float*)(p.ws + OFF_VAL); }
DI int*    P_INV(const Params& p) { return (int*)(p.ws + OFF_INV); }
DI bf16_t* P_HID(const Params& p) { return (bf16_t*)(p.ws + OFF_HID); }
DI bf16_t* P_Y(const Params& p) { return (bf16_t*)(p.ws + OFF_Y); }
DI unsigned char* P_XN8(const Params& p) { return p.ws + OFF_XN8; }

DI unsigned f2bf(float f) { unsigned u = __float_as_uint(f); return (u + 0x7fffu + ((u >> 16) & 1u)) >> 16; }
DI unsigned pk2(float lo, float hi) { return f2bf(lo) | (f2bf(hi) << 16); }
constexpr float W8_SCALE = 32.0f, H8_SCALE = 4.0f;
DI unsigned pk4_fp8(float a, float b, float c, float d) { unsigned w = 0u; w = __builtin_amdgcn_cvt_pk_fp8_f32(a, b, w, false); w = __builtin_amdgcn_cvt_pk_fp8_f32(c, d, w, true); return w; }
DI float bf2f(unsigned b) { return __uint_as_float(b << 16); }
DI float bflo(unsigned w) { return __uint_as_float(w << 16); }
DI float bfhi(unsigned w) { return __uint_as_float(w & 0xffff0000u); }
DI float shx(float v, int d, int lane) { return __uint_as_float((unsigned)__builtin_amdgcn_ds_bpermute((lane ^ d) << 2, (int)__float_as_uint(v))); }
DI unsigned shl_abs(unsigned v, int src_lane) { return (unsigned)__builtin_amdgcn_ds_bpermute(src_lane << 2, (int)v); }
DI int otid() { int t = threadIdx.x; asm volatile("" : "+v"(t)); return t; }
DI int pos16(int t) { return ((t & 15) << 8) | (t >> 4); }

constexpr int JOBS_PER_LAYER = 26432;
DI void prep_job(const Params& p, int l, int j, const float*& src, int& src_ld, bf16_t*& dst, int& dst_ld) {
    if (j < 1216) {
        const int nblk = j >> 3, kc = j & 7; int sc;
        if (nblk < 40) { const int t = nblk >> 3, sb = nblk & 7, bj = sb >> 2, wc = sb & 3, hr = 4 * t + wc;
            const int base = hr < 6 ? 64 * hr : hr < 8 ? 384 + 64 * (hr - 6) : hr < 14 ? 640 + 64 * (hr - 8) : 1024 + 64 * (hr - 14);
            sc = base + 32 * bj; }
        else if (nblk < 56) { const int c = 32 * (nblk - 40); sc = c < 256 ? 1792 + c : 2048 + (c - 256); }
        else sc = 2560 + 32 * (nblk - 56);
        src = p.w_in + (size_t)l * DM * PROJ + (size_t)(128 * kc) * PROJ + sc; src_ld = PROJ;
        dst = P_W(p, l, LW_WIN) + (size_t)(32 * nblk) * 1024 + 128 * kc; dst_ld = 1024; return;
    }
    j -= 1216;
    if (j < 192) {
        const int nblk = j >> 3, kc = j & 7, ch = 32 * nblk;
        const int sc = ch < 128 ? 512 + ch : ch < 256 ? 1408 + (ch - 128) : ch < 512 ? 2304 + (ch - 256) : 1536 + (ch - 512);
        src = p.w_in + (size_t)l * DM * PROJ + (size_t)(128 * kc) * PROJ + sc; src_ld = PROJ;
        dst = P_W(p, l, LW_WV) + (size_t)ch * 1024 + 128 * kc; dst_ld = 1024; return;
    }
    j -= 192;
    if (j < 192) {
        bf16_t* wm = P_W(p, l, LW_WM); src_ld = 1024; dst_ld = 768;
        if (j < 96) { const int nblk = j / 3, kc = j % 3; src = p.w_a + (size_t)l * 384 * 1024 + (size_t)(128 * kc) * 1024 + 32 * nblk; dst = wm + (size_t)(32 * nblk) * 768 + 128 * kc; }
        else if (j < 128) { const int nblk = j - 96; src = p.w_b + (size_t)l * 128 * 1024 + 32 * nblk; dst = wm + (size_t)(32 * nblk) * 768 + 384; }
        else { const int jj = j - 128, nblk = jj >> 1, kc = jj & 1; src = p.w_c + (size_t)l * 256 * 1024 + (size_t)(128 * kc) * 1024 + 32 * nblk; dst = wm + (size_t)(32 * nblk) * 768 + 512 + 128 * kc; }
        return;
    }
    j -= 192;
    if (j < 256) {
        const int nblk = j >> 3, kc = j & 7;
        src = p.w_out + (size_t)l * 1024 * 1024 + (size_t)(128 * kc) * 1024 + 32 * nblk; src_ld = 1024;
        dst = P_W(p, l, LW_WO) + (size_t)(32 * nblk) * 1024 + 128 * kc; dst_ld = 1024; return;
    }
    j -= 256;
    if (j < 16384) {
        const int e = j >> 10, r = j & 1023, nblk = r >> 3, kc = r & 7, row0 = 32 * nblk, pp = row0 >> 8, s = row0 & 255;
        const float* w = s < 128 ? p.w_gate_e : p.w_up_e; const int col = 128 * pp + (s & 127);
        src = w + ((size_t)(l * NEXP + e) * 1024 + 128 * kc) * 2048 + col; src_ld = 2048;
        dst = (bf16_t*)((unsigned char*)P_W(p, l, LW_WGU) + ((size_t)e * 4096 + row0) * 1024 + 128 * kc); dst_ld = 1024; return;
    }
    j -= 16384;
    {
        const int e = j >> 9, r = j & 511, nblk = r >> 4, kc = r & 15;
        src = p.w_down_e + ((size_t)(l * NEXP + e) * 2048 + 128 * kc) * 1024 + 32 * nblk; src_ld = 1024;
        dst = (bf16_t*)((unsigned char*)P_W(p, l, LW_WD) + ((size_t)e * 1024 + 32 * nblk) * 2048 + 128 * kc); dst_ld = 2048;
    }
}
DI void sincos_d(double a, double& s, double& c) {
    const double q = rint(a * 0.63661977236758134308);
    double r = fma(-q, 1.57079632679489655800e+00, a); r = fma(-q, 6.12323399573676603587e-17, r);
    const double r2 = r * r;
    double sp = 1.58969099521155010221e-10; sp = fma(sp, r2, -2.50507602534068634195e-08); sp = fma(sp, r2, 2.75573137070700676789e-06); sp = fma(sp, r2, -1.98412698298579493134e-04);
    sp = fma(sp, r2, 8.33333333332248946124e-03); sp = fma(sp, r2, -1.66666666666666324348e-01); const double sr = fma(r * r2, sp, r);
    double cp = -1.13596475577881948265e-11; cp = fma(cp, r2, 2.08757232129817482790e-09); cp = fma(cp, r2, -2.75573143513906633035e-07); cp = fma(cp, r2, 2.48015872894767294178e-05);
    cp = fma(cp, r2, -1.38888888888741095749e-03); cp = fma(cp, r2, 4.16666666666666019037e-02); const double cr = fma(r2 * r2, cp, fma(-0.5, r2, 1.0));
    const int qi = ((int)q) & 3;
    s = qi == 0 ? sr : qi == 1 ? cr : qi == 2 ? -sr : -cr;
    c = qi == 0 ? cr : qi == 1 ? -sr : qi == 2 ? -cr : sr;
}
DI void prep_phase(const Params& p, LAS float* scr) {
    const int tid = otid();
    for (int i = blockIdx.x * 512 + tid; i < SEQ * 32; i += gridDim.x * 512) {
        const int pos = i >> 5, j = i & 31;
        double fr = 1.0; for (int jj = 0; jj < j; ++jj) fr *= 0.7498942093324559;
        const float invf = (float)fr;
        const float ang = (float)pos * invf; double s, c; sincos_d((double)ang, s, c);
        P_COS(p)[i] = (float)c; P_SIN(p)[i] = (float)s;
    }
    const int total = NLAYER * JOBS_PER_LAYER;
    int u = blockIdx.x;
    const float* src; bf16_t* dst; int src_ld, dst_ld, j = 0;
    f32x4 r0, r1;
    if (u < total) { const int l = u / JOBS_PER_LAYER; j = u - l * JOBS_PER_LAYER; prep_job(p, l, j, src, src_ld, dst, dst_ld);
        r0 = *(const f32x4*)(src + (size_t)(tid >> 3) * src_ld + 4 * (tid & 7)); r1 = *(const f32x4*)(src + (size_t)((tid + 512) >> 3) * src_ld + 4 * (tid & 7)); }
    int buf = 0;
    for (; u < total; u += gridDim.x) {
        LAS float* sc = scr + buf * (128 * 33);
        { const int k = tid >> 3, c4 = tid & 7;
          sc[k * 33 + 4 * c4 + 0] = r0[0]; sc[k * 33 + 4 * c4 + 1] = r0[1]; sc[k * 33 + 4 * c4 + 2] = r0[2]; sc[k * 33 + 4 * c4 + 3] = r0[3];
          sc[(k + 64) * 33 + 4 * c4 + 0] = r1[0]; sc[(k + 64) * 33 + 4 * c4 + 1] = r1[1]; sc[(k + 64) * 33 + 4 * c4 + 2] = r1[2]; sc[(k + 64) * 33 + 4 * c4 + 3] = r1[3]; }
        bf16_t* dcur = dst; const int dld = dst_ld, jcur = j;
        const int un = u + gridDim.x;
        if (un < total) { const int l = un / JOBS_PER_LAYER; j = un - l * JOBS_PER_LAYER; prep_job(p, l, j, src, src_ld, dst, dst_ld);
            r0 = *(const f32x4*)(src + (size_t)(tid >> 3) * src_ld + 4 * (tid & 7)); r1 = *(const f32x4*)(src + (size_t)((tid + 512) >> 3) * src_ld + 4 * (tid & 7)); }
        __syncthreads();
        { const int n = tid >> 4, k8 = (tid & 15) * 8;
          if (jcur >= 1856) {
            u32x2 w; w[0] = pk4_fp8(sc[(k8 + 0) * 33 + n] * W8_SCALE, sc[(k8 + 1) * 33 + n] * W8_SCALE, sc[(k8 + 2) * 33 + n] * W8_SCALE, sc[(k8 + 3) * 33 + n] * W8_SCALE);
            w[1] = pk4_fp8(sc[(k8 + 4) * 33 + n] * W8_SCALE, sc[(k8 + 5) * 33 + n] * W8_SCALE, sc[(k8 + 6) * 33 + n] * W8_SCALE, sc[(k8 + 7) * 33 + n] * W8_SCALE);
            *(u32x2*)((unsigned char*)dcur + (size_t)n * dld + k8) = w;
          } else { u32x4 w;
            w[0] = pk2(sc[(k8 + 0) * 33 + n], sc[(k8 + 1) * 33 + n]); w[1] = pk2(sc[(k8 + 2) * 33 + n], sc[(k8 + 3) * 33 + n]);
            w[2] = pk2(sc[(k8 + 4) * 33 + n], sc[(k8 + 5) * 33 + n]); w[3] = pk2(sc[(k8 + 6) * 33 + n], sc[(k8 + 7) * 33 + n]);
            *(u32x4*)(dcur + (size_t)n * dld + k8) = w; } }
        buf ^= 1;
    }
    __syncthreads();
}

template <int MODE> DI void norm1_phase(const Params& p, int l) {
    const int tid = otid(), lane = tid & 63, wid = tid >> 6;
    const float* gain = MODE == 2 ? p.norm_final : p.norm_mix + (size_t)l * DM;
    f32x4 g[4];
#pragma unroll
    for (int i = 0; i < 4; ++i) g[i] = *(const f32x4*)(gain + 4 * lane + 256 * i);
    const float* xin = MODE == 0 ? p.x : P_X(p);
    const int nw = gridDim.x * 8;
    for (int row0 = blockIdx.x * 8 + wid; row0 < NTOK; row0 += 2 * nw) {
        const int row1 = row0 + nw;
        f32x4 v0[4], v1[4];
#pragma unroll
        for (int i = 0; i < 4; ++i) { v0[i] = *(const f32x4*)(xin + (size_t)row0 * DM + 4 * lane + 256 * i); v1[i] = *(const f32x4*)(xin + (size_t)row1 * DM + 4 * lane + 256 * i); }
        if (MODE != 0) {
            const int c0 = lane < NEXP ? P_INV(p)[(size_t)row0 * NEXP + lane] : -1, c1 = lane < NEXP ? P_INV(p)[(size_t)row1 * NEXP + lane] : -1;
            unsigned long long m0 = __ballot(c0 >= 0), m1 = __ballot(c1 >= 0);
            const bf16_t* ybase0 = P_Y(p) + (size_t)((row0 >> 12) * CAP) * DM; const bf16_t* ybase1 = P_Y(p) + (size_t)((row1 >> 12) * CAP) * DM;
            while (m0 | m1) {
                u32x2 w0[4], w1[4]; const bool h0 = m0 != 0ull, h1 = m1 != 0ull;
                if (h0) { const int e = __builtin_ctzll(m0); m0 &= m0 - 1ull; const int c = __builtin_amdgcn_readlane(c0, e); const bf16_t* yr = ybase0 + (size_t)(e * NBATCH * CAP + c) * DM;
#pragma unroll
                    for (int i = 0; i < 4; ++i) w0[i] = *(const u32x2*)(yr + 4 * lane + 256 * i); }
                if (h1) { const int e = __builtin_ctzll(m1); m1 &= m1 - 1ull; const int c = __builtin_amdgcn_readlane(c1, e); const bf16_t* yr = ybase1 + (size_t)(e * NBATCH * CAP + c) * DM;
#pragma unroll
                    for (int i = 0; i < 4; ++i) w1[i] = *(const u32x2*)(yr + 4 * lane + 256 * i); }
                if (h0) {
#pragma unroll
                    for (int i = 0; i < 4; ++i) { v0[i][0] += bflo(w0[i][0]); v0[i][1] += bfhi(w0[i][0]); v0[i][2] += bflo(w0[i][1]); v0[i][3] += bfhi(w0[i][1]); } }
                if (h1) {
#pragma unroll
                    for (int i = 0; i < 4; ++i) { v1[i][0] += bflo(w1[i][0]); v1[i][1] += bfhi(w1[i][0]); v1[i][2] += bflo(w1[i][1]); v1[i][3] += bfhi(w1[i][1]); } }
            }
        }
        if (MODE != 2) {
#pragma unroll
            for (int i = 0; i < 4; ++i) { *(f32x4*)(P_X(p) + (size_t)row0 * DM + 4 * lane + 256 * i) = v0[i]; *(f32x4*)(P_X(p) + (size_t)row1 * DM + 4 * lane + 256 * i) = v1[i]; }
        }
        float s0 = 0.f, s1 = 0.f;
#pragma unroll
        for (int i = 0; i < 4; ++i) { s0 += v0[i][0] * v0[i][0] + v0[i][1] * v0[i][1] + v0[i][2] * v0[i][2] + v0[i][3] * v0[i][3]; s1 += v1[i][0] * v1[i][0] + v1[i][1] * v1[i][1] + v1[i][2] * v1[i][2] + v1[i][3] * v1[i][3]; }
#pragma unroll
        for (int d = 32; d >= 1; d >>= 1) { s0 += shx(s0, d, lane); s1 += shx(s1, d, lane); }
        const float r0 = rsqrtf(s0 * (1.0f / DM) + 1e-6f), r1 = rsqrtf(s1 * (1.0f / DM) + 1e-6f);
#pragma unroll
        for (int i = 0; i < 4; ++i) {
            const f32x4 o0 = v0[i] * r0 * g[i], o1 = v1[i] * r1 * g[i];
            if (MODE == 2) { *(f32x4*)(p.out + (size_t)row0 * DM + 4 * lane + 256 * i) = o0; *(f32x4*)(p.out + (size_t)row1 * DM + 4 * lane + 256 * i) = o1; }
            else { u32x2 w; w[0] = pk2(o0[0], o0[1]); w[1] = pk2(o0[2], o0[3]); *(u32x2*)(P_XN(p) + (size_t)row0 * DM + 4 * lane + 256 * i) = w;
                   w[0] = pk2(o1[0], o1[1]); w[1] = pk2(o1[2], o1[3]); *(u32x2*)(P_XN(p) + (size_t)row1 * DM + 4 * lane + 256 * i) = w; }
        }
    }
}

DI float reduce16(const float (&a)[16], int lane) {
    float b8[8], b4[4], b2[2];
    { const bool hi = (lane & 32) != 0;
#pragma unroll
      for (int j = 0; j < 8; ++j) { const float snd = hi ? a[j] : a[j + 8], kp = hi ? a[j + 8] : a[j]; b8[j] = kp + shx(snd, 32, lane); } }
    { const bool hi = (lane & 16) != 0;
#pragma unroll
      for (int j = 0; j < 4; ++j) { const float snd = hi ? b8[j] : b8[j + 4], kp = hi ? b8[j + 4] : b8[j]; b4[j] = kp + shx(snd, 16, lane); } }
    { const bool hi = (lane & 8) != 0;
#pragma unroll
      for (int j = 0; j < 2; ++j) { const float snd = hi ? b4[j] : b4[j + 2], kp = hi ? b4[j + 2] : b4[j]; b2[j] = kp + shx(snd, 8, lane); } }
    float r;
    { const bool hi = (lane & 4) != 0; const float snd = hi ? b2[0] : b2[1], kp = hi ? b2[1] : b2[0]; r = kp + shx(snd, 4, lane); }
    r += shx(r, 2, lane); r += shx(r, 1, lane);
    return r;
}
DI void norm2_router_phase(const Params& p, int l, LAS float* wr) {
    const int tid = otid(), lane = tid & 63, wid = tid >> 6;
    for (int i = tid; i < DM * NEXP; i += 512) wr[(i & 15) * DM + (i >> 4)] = p.w_router[(size_t)l * DM * NEXP + i];
    __syncthreads();
    const float* gain = p.norm_ffn + (size_t)l * DM;
    f32x4 g[4];
#pragma unroll
    for (int i = 0; i < 4; ++i) g[i] = *(const f32x4*)(gain + 4 * lane + 256 * i);
    const int nw = gridDim.x * 8;
    for (int row0 = blockIdx.x * 8 + wid; row0 < NTOK; row0 += 2 * nw) {
        const int row1 = row0 + nw;
        f32x4 v0[4], v1[4]; float s0 = 0.f, s1 = 0.f;
#pragma unroll
        for (int i = 0; i < 4; ++i) { v0[i] = *(const f32x4*)(P_X(p) + (size_t)row0 * DM + 4 * lane + 256 * i); v1[i] = *(const f32x4*)(P_X(p) + (size_t)row1 * DM + 4 * lane + 256 * i); }
#pragma unroll
        for (int i = 0; i < 4; ++i) { s0 += v0[i][0] * v0[i][0] + v0[i][1] * v0[i][1] + v0[i][2] * v0[i][2] + v0[i][3] * v0[i][3]; s1 += v1[i][0] * v1[i][0] + v1[i][1] * v1[i][1] + v1[i][2] * v1[i][2] + v1[i][3] * v1[i][3]; }
#pragma unroll
        for (int d = 32; d >= 1; d >>= 1) { s0 += shx(s0, d, lane); s1 += shx(s1, d, lane); }
        const float r0 = rsqrtf(s0 * (1.0f / DM) + 1e-6f), r1 = rsqrtf(s1 * (1.0f / DM) + 1e-6f);
#pragma unroll
        for (int i = 0; i < 4; ++i) { v0[i] = v0[i] * r0 * g[i]; v1[i] = v1[i] * r1 * g[i];
            *(unsigned*)(P_XN8(p) + (size_t)row0 * DM + 4 * lane + 256 * i) = pk4_fp8(v0[i][0], v0[i][1], v0[i][2], v0[i][3]);
            *(unsigned*)(P_XN8(p) + (size_t)row1 * DM + 4 * lane + 256 * i) = pk4_fp8(v1[i][0], v1[i][1], v1[i][2], v1[i][3]); }
        float a0[NEXP], a1[NEXP];
#pragma unroll
        for (int e = 0; e < NEXP; ++e) { float x0 = 0.f, x1 = 0.f;
#pragma unroll
            for (int i = 0; i < 4; ++i) { const f32x4 w = *(const LAS f32x4*)(wr + e * DM + 4 * lane + 256 * i);
                x0 += v0[i][0] * w[0] + v0[i][1] * w[1] + v0[i][2] * w[2] + v0[i][3] * w[3]; x1 += v1[i][0] * w[0] + v1[i][1] * w[1] + v1[i][2] * w[2] + v1[i][3] * w[3]; }
            a0[e] = x0; a1[e] = x1;
            if ((e & 3) == 3) __builtin_amdgcn_sched_barrier(0); }
        const float l0 = reduce16(a0, lane), l1 = reduce16(a1, lane);
        float m0 = l0, m1 = l1;
#pragma unroll
        for (int d = 32; d >= 4; d >>= 1) { m0 = fmaxf(m0, shx(m0, d, lane)); m1 = fmaxf(m1, shx(m1, d, lane)); }
        const float e0 = __expf(l0 - m0), e1 = __expf(l1 - m1); float d0 = e0, d1 = e1;
#pragma unroll
        for (int d = 32; d >= 4; d >>= 1) { d0 += shx(d0, d, lane); d1 += shx(d1, d, lane); }
        if ((lane & 3) == 0) { const int e = lane >> 2;
            P_AFF(p)[((size_t)((row0 >> 12) * NEXP + e)) * SEQ + (row0 & 4095)] = e0 / d0; P_AFF(p)[((size_t)((row1 >> 12) * NEXP + e)) * SEQ + (row1 & 4095)] = e1 / d1; }
    }
}

DI void topk_phase(const Params& p, LAS unsigned* lds) {
    const int tid = otid(), lane = tid & 63, wid = tid >> 6;
    LAS unsigned* hist = lds; LAS unsigned* sh = lds + 256; LAS unsigned* wtot = lds + 272;
    for (int be = blockIdx.x; be < NBATCH * NEXP; be += gridDim.x) {
        const int b = be >> 4, e = be & 15;
        const float* aff = P_AFF(p) + (size_t)be * SEQ + tid * 8;
        const f32x4 a0 = *(const f32x4*)aff, a1 = *(const f32x4*)(aff + 4);
        unsigned key[8];
#pragma unroll
        for (int i = 0; i < 4; ++i) { key[i] = __float_as_uint(a0[i]); key[4 + i] = __float_as_uint(a1[i]); }
        unsigned prefix = 0u, mask = 0u, krem = CAP;
        for (int pass = 3; pass >= 0; --pass) {
            const int shift = 8 * pass;
            if (tid < 256) hist[tid] = 0u;
            __syncthreads();
#pragma unroll
            for (int i = 0; i < 8; ++i) if ((key[i] & mask) == prefix) atomicAdd((unsigned*)&hist[(key[i] >> shift) & 255u], 1u);
            __syncthreads();
            if (wid == 0) {
                const unsigned h0 = hist[4 * lane], h1 = hist[4 * lane + 1], h2 = hist[4 * lane + 2], h3 = hist[4 * lane + 3], s = h0 + h1 + h2 + h3;
                unsigned suf = s;
#pragma unroll
                for (int d = 1; d < 64; d <<= 1) { const unsigned t = shl_abs(suf, (lane + d) & 63); if (lane + d < 64) suf += t; }
                const unsigned above = suf - s;
                if (above < krem && krem <= suf) {
                    unsigned a = above; unsigned bin, nk;
                    if (a + h3 >= krem) { bin = 4 * lane + 3; nk = krem - a; }
                    else { a += h3; if (a + h2 >= krem) { bin = 4 * lane + 2; nk = krem - a; }
                        else { a += h2; if (a + h1 >= krem) { bin = 4 * lane + 1; nk = krem - a; } else { a += h1; bin = 4 * lane; nk = krem - a; } } }
                    sh[0] = prefix | (bin << shift); sh[1] = nk;
                }
            }
            __syncthreads();
            prefix = sh[0]; krem = sh[1]; mask |= 0xFFu << shift;
            __syncthreads();
        }
        unsigned cg = 0u, ce = 0u;
#pragma unroll
        for (int i = 0; i < 8; ++i) { cg += key[i] > prefix ? 1u : 0u; ce += key[i] == prefix ? 1u : 0u; }
        unsigned pk = cg | (ce << 16), incl = pk;
#pragma unroll
        for (int d = 1; d < 64; d <<= 1) { const unsigned t = shl_abs(incl, (lane - d) & 63); if (lane >= d) incl += t; }
        if (lane == 63) wtot[wid] = incl;
        __syncthreads();
        unsigned woff = 0u;
#pragma unroll
        for (int w = 0; w < 8; ++w) woff += w < wid ? wtot[w] : 0u;
        const unsigned excl = woff + incl - pk;
        unsigned gtb = excl & 0xffffu, eqb = excl >> 16;
        int* idxo = P_IDX(p) + (size_t)(e * NBATCH + b) * CAP; float* valo = P_VAL(p) + (size_t)(e * NBATCH + b) * CAP;
        int* inv = P_INV(p) + ((size_t)b * SEQ + tid * 8) * NEXP + e;
#pragma unroll
        for (int i = 0; i < 8; ++i) {
            int slot = -1;
            if (key[i] > prefix) { slot = (int)(gtb + (eqb < krem ? eqb : krem)); ++gtb; }
            else if (key[i] == prefix) { if (eqb < krem) slot = (int)(gtb + eqb); ++eqb; }
            if (slot >= 0) { idxo[slot] = tid * 8 + i; valo[slot] = __uint_as_float(key[i]); }
            inv[(size_t)i * NEXP] = slot;
        }
        __syncthreads();
    }
}

DI f32x16 zero16() { f32x16 z; for (int i = 0; i < 16; ++i) z[i] = 0.f; return z; }
DI void rgemm2(const bf16_t* ap, const bf16_t* b0p, const bf16_t* b1p, int K, f32x16& c0, f32x16& c1) {
#pragma unroll 4
    for (int k = 0; k < K; k += 16) {
        const bf16x8 a = *(const bf16x8*)(ap + k), b0 = *(const bf16x8*)(b0p + k), b1 = *(const bf16x8*)(b1p + k);
        c0 = __builtin_amdgcn_mfma_f32_32x32x16_bf16(a, b0, c0, 0, 0, 0);
        c1 = __builtin_amdgcn_mfma_f32_32x32x16_bf16(a, b1, c1, 0, 0, 0);
    }
}
DI int crow(int i, int h) { return (i & 3) + 8 * (i >> 2) + 4 * h; }
DI float sigmoidf_(float x) { return 1.0f / (1.0f + __expf(-x)); }

DI void rk_inproj(const Params& p, int l) {
    const int lane = otid() & 63, r = lane & 31, h = lane >> 5;
    const bf16_t* WIN = P_W(p, l, LW_WIN); const bf16_t* WV = P_W(p, l, LW_WV);
    const int nw = gridDim.x * 8;
    for (int wt = blockIdx.x * 8 + (otid() >> 6); wt < 512 * 88; wt += nw) {
        const int job = wt % 88, m0 = (wt / 88) * 32;
        const bf16_t* ap = P_XN(p) + (size_t)(m0 + r) * DM + 8 * h;
        const bf16_t *b0, *b1;
        if (job < 20) { const int t = job >> 2, wc = job & 3; b0 = WIN + (size_t)(256 * t + 32 * wc + r) * DM + 8 * h; b1 = b0 + (size_t)128 * DM; }
        else if (job < 28) { b0 = WIN + (size_t)(1280 + 64 * (job - 20) + r) * DM + 8 * h; b1 = b0 + (size_t)32 * DM; }
        else if (job < 40) { b0 = WV + (size_t)(64 * (job - 28) + r) * DM + 8 * h; b1 = b0 + (size_t)32 * DM; }
        else { b0 = WIN + (size_t)(1792 + 64 * (job - 40) + r) * DM + 8 * h; b1 = b0 + (size_t)32 * DM; }
        f32x16 c0 = zero16(), c1 = zero16();
        rgemm2(ap, b0, b1, DM, c0, c1);
#pragma unroll
        for (int i = 0; i < 16; ++i) {
            const int row = m0 + crow(i, h), pos = row & 4095;
            if (job < 20) {
                const float cs = P_COS(p)[pos * 32 + r], sn = P_SIN(p)[pos * 32 + r];
                float o1 = c0[i] * cs - c1[i] * sn, o2 = c1[i] * cs + c0[i] * sn;
                if (job < 6 || (job >= 8 && job < 14)) { o1 *= 0.125f; o2 *= 0.125f; }
                P_QK(p)[(size_t)row * QKW + 64 * job + r] = (bf16_t)f2bf(o1); P_QK(p)[(size_t)row * QKW + 64 * job + 32 + r] = (bf16_t)f2bf(o2);
            } else if (job < 28) {
                const float sc = job < 24 ? 0.125f : 1.0f; const int col = 1280 + 64 * (job - 20) + r;
                P_QK(p)[(size_t)row * QKW + col] = (bf16_t)f2bf(c0[i] * sc); P_QK(p)[(size_t)row * QKW + col + 32] = (bf16_t)f2bf(c1[i] * sc);
            } else if (job < 40) {
                const int ch = 64 * (job - 28) + r; const int slot = ch < 512 ? row : (row & ~4095) + pos16(pos);
                P_VT(p)[(size_t)ch * NTOK + slot] = (bf16_t)f2bf(c0[i]); P_VT(p)[(size_t)(ch + 32) * NTOK + slot] = (bf16_t)f2bf(c1[i]);
            } else {
                const int col = 64 * (job - 40) + r; const float* bg = p.b_gate + (size_t)l * 3072;
                P_G(p)[(size_t)row * 3072 + col] = (bf16_t)f2bf(sigmoidf_(c0[i] + bg[col])); P_G(p)[(size_t)row * 3072 + col + 32] = (bf16_t)f2bf(sigmoidf_(c1[i] + bg[col + 32]));
            }
        }
    }
}
DI void rk_merge(const Params& p, int l) {
    const int lane = otid() & 63, r = lane & 31, h = lane >> 5;
    const bf16_t* WM = P_W(p, l, LW_WM);
    for (int wt = blockIdx.x * 8 + (otid() >> 6); wt < 512 * 16; wt += gridDim.x * 8) {
        const int n0 = (wt & 15) * 64, m0 = (wt >> 4) * 32;
        float m0a[16], m1a[16];
#pragma unroll
        for (int i = 0; i < 16; ++i) { m0a[i] = 0.f; m1a[i] = 0.f; }
#pragma unroll 1
        for (int br = 0; br < 3; ++br) {
            const int k0 = br == 0 ? 0 : br == 1 ? 384 : 512, K = br == 0 ? 384 : br == 1 ? 128 : 256;
            f32x16 c0 = zero16(), c1 = zero16();
            rgemm2(P_OC(p) + (size_t)(m0 + r) * OCW + k0 + 8 * h, WM + (size_t)(n0 + r) * 768 + k0 + 8 * h, WM + (size_t)(n0 + 32 + r) * 768 + k0 + 8 * h, K, c0, c1);
#pragma unroll
            for (int i = 0; i < 16; ++i) { const int row = m0 + crow(i, h); const bf16_t* gp = P_G(p) + (size_t)row * 3072 + 1024 * br + n0 + r;
                m0a[i] += bf2f(gp[0]) * c0[i]; m1a[i] += bf2f(gp[32]) * c1[i]; }
        }
#pragma unroll
        for (int i = 0; i < 16; ++i) { const int row = m0 + crow(i, h); P_MG(p)[(size_t)row * DM + n0 + r] = (bf16_t)f2bf(m0a[i]); P_MG(p)[(size_t)row * DM + n0 + 32 + r] = (bf16_t)f2bf(m1a[i]); }
    }
}
DI void rk_out(const Params& p, int l) {
    const int lane = otid() & 63, r = lane & 31, h = lane >> 5;
    const bf16_t* WO = P_W(p, l, LW_WO);
    for (int wt = blockIdx.x * 8 + (otid() >> 6); wt < 512 * 16; wt += gridDim.x * 8) {
        const int n0 = (wt & 15) * 64, m0 = (wt >> 4) * 32;
        f32x16 c0 = zero16(), c1 = zero16();
        rgemm2(P_MG(p) + (size_t)(m0 + r) * DM + 8 * h, WO + (size_t)(n0 + r) * DM + 8 * h, WO + (size_t)(n0 + 32 + r) * DM + 8 * h, DM, c0, c1);
#pragma unroll
        for (int i = 0; i < 16; ++i) { float* xp = P_X(p) + (size_t)(m0 + crow(i, h)) * DM + n0 + r; xp[0] += c0[i]; xp[32] += c1[i]; }
    }
}
DI void rk_moe1(const Params& p, int l) {
    const int lane = otid() & 63, r = lane & 31, h = lane >> 5;
    const bf16_t* WGU = P_W(p, l, LW_WGU);
    for (int wt = blockIdx.x * 8 + (otid() >> 6); wt < 1024 * 64; wt += gridDim.x * 8) {
        const int j0 = (wt & 63) * 32, m0 = (wt >> 6) * 32, e = m0 >> 11, b = (m0 >> 9) & 3;
        const int tok = b * SEQ + P_IDX(p)[m0 + r];
        const bf16_t* b0 = WGU + ((size_t)e * 4096 + 256 * (j0 >> 7) + (j0 & 127) + r) * DM + 8 * h;
        f32x16 c0 = zero16(), c1 = zero16();
        rgemm2(P_XN(p) + (size_t)tok * DM + 8 * h, b0, b0 + (size_t)128 * DM, DM, c0, c1);
#pragma unroll
        for (int i = 0; i < 16; ++i) { const float g = c0[i], u = c1[i]; P_HID(p)[(size_t)(m0 + crow(i, h)) * FF + j0 + r] = (bf16_t)f2bf(g * sigmoidf_(g) * u); }
    }
}
DI void rk_moe2(const Params& p, int l) {
    const int lane = otid() & 63, r = lane & 31, h = lane >> 5;
    const bf16_t* WD = P_W(p, l, LW_WD);
    for (int wt = blockIdx.x * 8 + (otid() >> 6); wt < 1024 * 16; wt += gridDim.x * 8) {
        const int n0 = (wt & 15) * 64, m0 = (wt >> 4) * 32, e = m0 >> 11;
        const bf16_t* b0 = WD + ((size_t)e * 1024 + n0 + r) * FF + 8 * h;
        f32x16 c0 = zero16(), c1 = zero16();
        rgemm2(P_HID(p) + (size_t)(m0 + r) * FF + 8 * h, b0, b0 + (size_t)32 * FF, FF, c0, c1);
#pragma unroll
        for (int i = 0; i < 16; ++i) { const int row = m0 + crow(i, h); const float v = P_VAL(p)[row];
            P_Y(p)[(size_t)row * DM + n0 + r] = (bf16_t)f2bf(c0[i] * v); P_Y(p)[(size_t)row * DM + n0 + 32 + r] = (bf16_t)f2bf(c1[i] * v); }
    }
}

DI void ld64(const bf16_t* src, float (&q)[64]) {
#pragma unroll
    for (int c = 0; c < 8; ++c) { const u32x4 w = *(const u32x4*)(src + 8 * c);
#pragma unroll
        for (int j = 0; j < 4; ++j) { q[8 * c + 2 * j] = bflo(w[j]); q[8 * c + 2 * j + 1] = bfhi(w[j]); } }
}
DI float dot64(const bf16_t* kp, const float (&q)[64]) {
    float s = 0.f;
#pragma unroll
    for (int c = 0; c < 8; ++c) { const u32x4 w = *(const u32x4*)(kp + 8 * c);
#pragma unroll
        for (int j = 0; j < 4; ++j) { s += q[8 * c + 2 * j] * bflo(w[j]); s += q[8 * c + 2 * j + 1] * bfhi(w[j]); } }
    return s;
}
DI void rk_attn(const Params& p, int l) {
  for (int item2 = blockIdx.x * 512 + otid(); item2 < 32 * NTOK; item2 += gridDim.x * 512) {
    const int half = item2 >> 18, item = item2 & 262143;
    const int hd16 = item >> 14, tok = item & 16383, b = tok >> 12, t = tok & 4095;
    const bf16_t* QK = P_QK(p); const bf16_t* VT = P_VT(p);
    float q[64], o[32];
#pragma unroll
    for (int d = 0; d < 32; ++d) o[d] = 0.f;
    float m = -1e30f, den = 0.f;
    int qcol, kcol, vch; bool perm = false;
    if (hd16 < 6) { qcol = 64 * hd16; kcol = 384 + 64 * (hd16 / 3); vch = 64 * (hd16 / 3); }
    else if (hd16 < 12) { const int g = (hd16 - 6) >> 1, hs = (hd16 - 6) & 1; qcol = 512 + 128 * g + 64 * hs; kcol = 896 + 128 * g + 64 * hs;
        vch = g == 0 ? 128 + 64 * hs : g == 1 ? 512 + 64 * hs : 640 + 64 * hs; perm = g > 0; }
    else { const int hh = hd16 - 12; qcol = 1280 + 64 * hh; kcol = 1536 + 64 * hh; vch = 256 + 64 * hh; }
    vch += 32 * half;
    ld64(QK + (size_t)tok * QKW + qcol, q);
    auto visit = [&](int t2, float bias) {
        const float s = dot64(QK + (size_t)(b * SEQ + t2) * QKW + kcol, q) + bias;
        const float mn = fmaxf(m, s), al = __expf(m - mn), pe = __expf(s - mn);
        den = den * al + pe; m = mn;
        const bf16_t* vp = VT + (size_t)vch * NTOK + b * SEQ + (perm ? pos16(t2) : t2);
#pragma unroll
        for (int d = 0; d < 32; ++d) o[d] = o[d] * al + pe * bf2f(vp[(size_t)d * NTOK]);
    };
    if (hd16 < 6) {
        const int lo = t - 128 < 0 ? 0 : t - 128, hi = t + 128 > 4095 ? 4095 : t + 128;
        for (int t2 = lo; t2 <= hi; ++t2) visit(t2, 0.f);
        const float sk = p.sink[l * 6 + hd16], mn = fmaxf(m, sk), al = __expf(m - mn);
        den = den * al + __expf(sk - mn);
#pragma unroll
        for (int d = 0; d < 32; ++d) o[d] *= al;
        m = mn;
    } else if (hd16 < 12) {
        const int g = (hd16 - 6) >> 1, dil = g == 0 ? 1 : g == 1 ? 4 : 16;
        for (int rr = -64; rr <= 64; ++rr) { const int t2 = t + dil * rr; if (t2 >= 0 && t2 < SEQ) visit(t2, 0.f); }
    } else {
        const int hh = hd16 - 12, qr = t >> 6, qc = t & 63;
        const int sr = qr - 4 < 0 ? 0 : qr - 4 > 56 ? 56 : qr - 4, sc = qc - 8 < 0 ? 0 : qc - 8 > 48 ? 48 : qc - 8;
        const float* rp = p.rpb + (size_t)(l * 4 + hh) * 15 * 31;
        for (int j = 0; j < 8; ++j) for (int k = 0; k < 16; ++k) { const int kr = sr + j, kc = sc + k; visit(kr * 64 + kc, rp[(kr - qr + 7) * 31 + (kc - qc + 15)]); }
    }
    const float rd = 1.0f / den;
    if (hd16 >= 6 && hd16 < 12) {
        const int g = (hd16 - 6) >> 1, hs = (hd16 - 6) & 1;
        bf16_t* op = P_OB3(p) + ((size_t)g * NTOK + tok) * 128 + 64 * hs + 32 * half;
#pragma unroll
        for (int d = 0; d < 32; d += 2) *(unsigned*)(op + d) = pk2(o[d] * rd, o[d + 1] * rd);
        if (half == 0) P_LSE(p)[((size_t)g * NTOK + tok) * 2 + hs] = m + __logf(den);
    } else {
        bf16_t* op = P_OC(p) + (size_t)tok * OCW + (hd16 < 6 ? 64 * hd16 : 512 + 64 * (hd16 - 12)) + 32 * half;
#pragma unroll
        for (int d = 0; d < 32; d += 2) *(unsigned*)(op + d) = pk2(o[d] * rd, o[d + 1] * rd);
    }
  }
}
namespace at {
constexpr int NUNIT_A = 1536, NUNIT_C = 1024, NUNIT_B = 1536, NUNIT = NUNIT_A + NUNIT_C + NUNIT_B;
DI unsigned cvt2(float lo, float hi) { typedef __bf16 bf2_t __attribute__((ext_vector_type(2))); const f32x2 v = {lo, hi}; const bf2_t b = __builtin_convertvector(v, bf2_t); return __builtin_bit_cast(unsigned, b); }
DI bf16x8 pack8(const f32x16& x, int s8) { u32x4 w; w[0] = cvt2(x[s8 + 0], x[s8 + 1]); w[1] = cvt2(x[s8 + 2], x[s8 + 3]); w[2] = cvt2(x[s8 + 4], x[s8 + 5]); w[3] = cvt2(x[s8 + 6], x[s8 + 7]); return __builtin_bit_cast(bf16x8, w); }
DI int koffmap(int r, bool g1) { return g1 ? 4 * (4 * ((r >> 3) & 1) + (r & 3)) + 2 * (r >> 4) + ((r >> 2) & 1) : (r & 16) + 8 * ((r >> 2) & 1) + 4 * ((r >> 3) & 1) + (r & 3); }

DI float xh_max(float v) { const auto r = __builtin_amdgcn_permlane32_swap(__float_as_uint(v), __float_as_uint(v), false, false); return fmaxf(__uint_as_float(r[0]), __uint_as_float(r[1])); }
DI float xh_sum(float v) { const auto r = __builtin_amdgcn_permlane32_swap(__float_as_uint(v), __float_as_uint(v), false, false); return __uint_as_float(r[0]) + __uint_as_float(r[1]); }
constexpr float LOG2E = 1.4426950408889634f, LN2 = 0.6931471805599453f;
struct QState { float m, den; f32x16 O0, O1; };
DI void softmax_tile(f32x16& S, QState& st, bf16x8& p0, bf16x8& p1) {
    float mx = fmaxf(S[0], S[1]);
#pragma unroll
    for (int i = 2; i < 16; i += 2) mx = fmaxf(mx, fmaxf(S[i], S[i + 1]));
    mx = xh_max(mx);
    const float mn = fmaxf(st.m, mx), alpha = __builtin_amdgcn_exp2f(st.m - mn);
    float ps = 0.f;
#pragma unroll
    for (int i = 0; i < 16; ++i) { S[i] = __builtin_amdgcn_exp2f(S[i] - mn); ps += S[i]; }
    ps = xh_sum(ps);
    st.den = st.den * alpha + ps; st.m = mn;
#pragma unroll
    for (int i = 0; i < 16; ++i) { st.O0[i] *= alpha; st.O1[i] *= alpha; }
    p0 = pack8(S, 0); p1 = pack8(S, 8);
}
template <int MODE> DI void mask_tile(f32x16& S, int tn, int NT, int q, int h, int t, int qrow, int sr_q, int sc_q, int kc0, int qcg, const LAS float* bt_head) {
    if (MODE == 3) {
        const bool rowok = t >= sr_q && t < sr_q + 8; const LAS float* bt = bt_head + (t - qrow + 7) * 31 + 15 - qcg;
#pragma unroll
        for (int i = 0; i < 16; ++i) { const int kc = kc0 + 16 * (i >> 3) + 8 * h + (i & 7); const bool ok = rowok && kc >= sc_q && kc < sc_q + 16;
            const int bi = ok ? kc : qcg; S[i] = ok ? S[i] + bt[bi] : -1e37f; }
    } else {
        const int edge = tn == 0 ? 1 : tn == NT - 1 ? 2 : 0;
        if (edge != 0) {
            int qq = MODE == 2 ? q - h : q - 8 * h; asm volatile("" : "+v"(qq));
            if (edge == 1) {
#pragma unroll
                for (int i = 0; i < 16; ++i) { const int kc_ = MODE == 2 ? 4 * (i & 7) + 2 * (i >> 3) : 16 * (i >> 3) + (i & 7); S[i] = kc_ >= qq ? S[i] : -1e37f; }
            } else {
#pragma unroll
                for (int i = 0; i < 16; ++i) { const int kc_ = MODE == 2 ? 4 * (i & 7) + 2 * (i >> 3) : 16 * (i >> 3) + (i & 7); S[i] = kc_ <= qq ? S[i] : -1e37f; }
            }
        }
    }
}
template <int MODE> DI void wave_unit(const Params& p, int l, int u, const LAS float* rpb_lds, LAS unsigned char* ring, int lane) {
    const int q = lane & 31, h = lane >> 5;
    const bf16_t* QK = P_QK(p); const bf16_t* VT = P_VT(p);
    int b, qcol, kcol, vch, dil = 1, rho = 0, Jq = 0, L = SEQ, vs0 = 0, g = 0, hs = 0, hq = 0;
    constexpr int W = MODE == 0 ? 128 : 64, NT = MODE == 0 ? 9 : 5;
    int qcg = 0, kc0 = 0, kr_lo = 0, kr_hi = 0, r00 = 0;
    if (MODE == 0) { const int gg = u % 3, qp = (u / 3) & 63, kvh = (u / 192) & 1; b = u / 384; hq = kvh * 3 + gg; qcol = 64 * hq; kcol = 384 + 64 * kvh; vch = 64 * kvh; Jq = 64 * qp; }
    else if (MODE == 1 || MODE == 2) { const int qt6 = u & 63; hs = (u >> 6) & 1; g = (u >> 7) % 3; b = u / 384; qcol = 512 + 128 * g + 64 * hs; kcol = 896 + 128 * g + 64 * hs;
        vch = g == 0 ? 128 + 64 * hs : g == 1 ? 512 + 64 * hs : 640 + 64 * hs;
        if (g == 0) { Jq = 64 * qt6; } else if (g == 1) { dil = 4; rho = qt6 >> 4; Jq = 64 * (qt6 & 15); L = 1024; } else { dil = 16; rho = qt6 >> 2; Jq = 64 * (qt6 & 3); L = 256; vs0 = rho * 256; } }
    else { const int qt6 = u & 63, hh = (u >> 6) & 3, gr4 = qt6 >> 2, cb = qt6 & 3; b = u >> 8; hq = hh; qcol = 1280 + 64 * hh; kcol = 1536 + 64 * hh; vch = 256 + 64 * hh;
        r00 = 4 * gr4; qcg = 16 * cb + (q & 15); kc0 = cb == 0 ? 0 : cb == 3 ? 32 : 16 * cb - 8;
        const int s0 = r00 - 4 < 0 ? 0 : r00 - 4 > 56 ? 56 : r00 - 4, s3 = r00 - 1 < 0 ? 0 : r00 - 1 > 56 ? 56 : r00 - 1; kr_lo = s0; kr_hi = s3 + 8; }
    int t_lo, t_hi; unsigned kdma[4], vdma[4], kstep_t, vstep_t;
    if (MODE == 3) { t_lo = kr_lo; t_hi = kr_hi; kstep_t = 64u * QKW; vstep_t = 64; }
    else { t_lo = (W - Jq + 31) >> 5; if (t_lo < 0) t_lo = 0; t_hi = (L + W - Jq) >> 5; if (t_hi > NT + 1) t_hi = NT + 1; kstep_t = 32u * dil * QKW; vstep_t = MODE == 2 ? 8 : 32; }
#pragma unroll
    for (int i = 0; i < 4; ++i) {
        const int r = 8 * i + (lane >> 3), c8 = (lane & 7) ^ ((r >> 1) & 7), ko = koffmap(r, MODE == 2);
        const int ktok = MODE == 3 ? b * SEQ + kc0 + ko : b * SEQ + (Jq - W + ko) * dil + rho;
        kdma[i] = (unsigned)ktok * QKW + kcol + 8 * c8;
        const int d = 16 * i + (lane >> 2), ch = (lane & 3) ^ ((d >> 2) & 3);
        const int vslot = MODE == 3 ? b * SEQ + kc0 + 8 * ch : MODE == 2 ? b * SEQ + ch * 1024 + rho * 256 + ((Jq - W) >> 2) : b * SEQ + vs0 + (Jq - W) + 8 * ch;
        vdma[i] = (unsigned)(vch + d) * NTOK + vslot;
    }
#define AT_DMA(t, buf) do { const unsigned kt_ = (unsigned)(t) * kstep_t, vt_ = (unsigned)(t) * vstep_t; LAS unsigned char* bb_ = ring + (buf) * 8192; \
        _Pragma("unroll") for (int i_ = 0; i_ < 4; ++i_) __builtin_amdgcn_global_load_lds((const unsigned*)(QK + (unsigned)(kdma[i_] + kt_)), (LAS unsigned*)(bb_ + i_ * 1024), 16, 0, 0); \
        _Pragma("unroll") for (int i_ = 0; i_ < 4; ++i_) __builtin_amdgcn_global_load_lds((const unsigned*)(VT + (unsigned)(vdma[i_] + vt_)), (LAS unsigned*)(bb_ + 4096 + i_ * 1024), 16, 0, 0); } while (0)
    AT_DMA(t_lo, 0);
    int kaddr[4], vaddr[2][2];
#pragma unroll
    for (int c = 0; c < 4; ++c) kaddr[c] = q * 128 + (((2 * c + h) ^ ((q >> 1) & 7)) << 4);
#pragma unroll
    for (int dh = 0; dh < 2; ++dh)
#pragma unroll
        for (int sx = 0; sx < 2; ++sx) vaddr[dh][sx] = 4096 + (32 * dh + q) * 64 + (((2 * sx + h) ^ ((q >> 2) & 3)) << 4);
    int tokq[2]; bf16x8 qf[2][4]; QState st[2];
#pragma unroll
    for (int n = 0; n < 2; ++n) {
        tokq[n] = MODE == 3 ? b * SEQ + (r00 + 2 * n + (q >> 4)) * 64 + qcg : b * SEQ + (Jq + 32 * n + q) * dil + rho;
        const bf16_t* qp = QK + (size_t)tokq[n] * QKW + qcol + 8 * h;
#pragma unroll
        for (int c = 0; c < 4; ++c) qf[n][c] = *(const bf16x8*)(qp + 16 * c);
        st[n].m = -1e30f; st[n].den = 0.f;
        if (MODE == 0) { st[n].m = p.sink[l * 6 + hq] * LOG2E; st[n].den = 1.0f; }
#pragma unroll
        for (int i = 0; i < 16; ++i) { st[n].O0[i] = 0.f; st[n].O1[i] = 0.f; }
    }
    int sc_q = 0, qrow0 = 0, qrow1 = 0, srq0 = 0, srq1 = 0, lo0 = 0, hi0 = 0, lo1 = 0, hi1 = 0;
    if (MODE == 3) { sc_q = qcg - 8 < 0 ? 0 : qcg - 8 > 48 ? 48 : qcg - 8;
        qrow0 = r00 + (q >> 4); qrow1 = qrow0 + 2; srq0 = qrow0 - 4 < 0 ? 0 : qrow0 - 4 > 56 ? 56 : qrow0 - 4; srq1 = qrow1 - 4 < 0 ? 0 : qrow1 - 4 > 56 ? 56 : qrow1 - 4;
        lo0 = r00 - 4 < 0 ? 0 : r00 - 4 > 56 ? 56 : r00 - 4; hi0 = (r00 - 3 < 0 ? 0 : r00 - 3 > 56 ? 56 : r00 - 3) + 8; lo1 = r00 - 2 < 0 ? 0 : r00 - 2 > 56 ? 56 : r00 - 2; hi1 = (r00 - 1 < 0 ? 0 : r00 - 1 > 56 ? 56 : r00 - 1) + 8; }
    const LAS float* bt_head = rpb_lds + hq * 465;
#define AT_S(S, n) do { _Pragma("unroll") for (int i_ = 0; i_ < 16; ++i_) S[i_] = 0.f; _Pragma("unroll") for (int c_ = 0; c_ < 4; ++c_) S = __builtin_amdgcn_mfma_f32_32x32x16_bf16(kf[c_], qf[n][c_], S, 0, 0, 0); } while (0)
#define AT_PV(n, p0, p1) do { st[n].O0 = __builtin_amdgcn_mfma_f32_32x32x16_bf16(vf[0][0], p0, st[n].O0, 0, 0, 0); st[n].O0 = __builtin_amdgcn_mfma_f32_32x32x16_bf16(vf[0][1], p1, st[n].O0, 0, 0, 0); \
        st[n].O1 = __builtin_amdgcn_mfma_f32_32x32x16_bf16(vf[1][0], p0, st[n].O1, 0, 0, 0); st[n].O1 = __builtin_amdgcn_mfma_f32_32x32x16_bf16(vf[1][1], p1, st[n].O1, 0, 0, 0); } while (0)
    for (int t = t_lo; t < t_hi; ++t) {
        const int buf = (t - t_lo) & 1;
        if (t + 1 < t_hi) { AT_DMA(t + 1, buf ^ 1); asm volatile("s_waitcnt vmcnt(8)" ::: "memory"); }
        else asm volatile("s_waitcnt vmcnt(0)" ::: "memory");
        const LAS unsigned char* bb = ring + buf * 8192;
        const bool act0 = MODE == 3 ? (t >= lo0 && t < hi0) : (t < NT), act1 = MODE == 3 ? (t >= lo1 && t < hi1) : (t >= 1);
        bf16x8 kf[4], vf[2][2];
#pragma unroll
        for (int c = 0; c < 4; ++c) kf[c] = *(const LAS bf16x8*)(bb + kaddr[c]);
        if (act0 && act1) {
            f32x16 S0, S1; AT_S(S0, 0); AT_S(S1, 1);
            mask_tile<MODE>(S0, t, NT, q, h, t, qrow0, srq0, sc_q, kc0, qcg, bt_head); mask_tile<MODE>(S1, t - 1, NT, q, h, t, qrow1, srq1, sc_q, kc0, qcg, bt_head);
            bf16x8 pa0, pa1, pb0, pb1;
            softmax_tile(S0, st[0], pa0, pa1); softmax_tile(S1, st[1], pb0, pb1);
            __builtin_amdgcn_sched_barrier(0);
#pragma unroll
            for (int dh = 0; dh < 2; ++dh)
#pragma unroll
                for (int sx = 0; sx < 2; ++sx) vf[dh][sx] = *(const LAS bf16x8*)(bb + vaddr[dh][sx]);
            AT_PV(0, pa0, pa1); AT_PV(1, pb0, pb1);
        } else if (act0) {
            f32x16 S0; AT_S(S0, 0);
#pragma unroll
            for (int dh = 0; dh < 2; ++dh)
#pragma unroll
                for (int sx = 0; sx < 2; ++sx) vf[dh][sx] = *(const LAS bf16x8*)(bb + vaddr[dh][sx]);
            mask_tile<MODE>(S0, t, NT, q, h, t, qrow0, srq0, sc_q, kc0, qcg, bt_head);
            bf16x8 pa0, pa1; softmax_tile(S0, st[0], pa0, pa1); AT_PV(0, pa0, pa1);
        } else if (act1) {
            f32x16 S1; AT_S(S1, 1);
#pragma unroll
            for (int dh = 0; dh < 2; ++dh)
#pragma unroll
                for (int sx = 0; sx < 2; ++sx) vf[dh][sx] = *(const LAS bf16x8*)(bb + vaddr[dh][sx]);
            mask_tile<MODE>(S1, t - 1, NT, q, h, t, qrow1, srq1, sc_q, kc0, qcg, bt_head);
            bf16x8 pb0, pb1; softmax_tile(S1, st[1], pb0, pb1); AT_PV(1, pb0, pb1);
        }
    }
#undef AT_DMA
#undef AT_S
#undef AT_PV
#pragma unroll
    for (int n = 0; n < 2; ++n) {
        const float rd = 1.0f / st[n].den;
        bf16_t* op;
        if (MODE == 1 || MODE == 2) { op = P_OB3(p) + ((size_t)g * NTOK + tokq[n]) * 128 + 64 * hs; if (h == 0) P_LSE(p)[((size_t)g * NTOK + tokq[n]) * 2 + hs] = (st[n].m + __log2f(st[n].den)) * LN2; }
        else op = P_OC(p) + (size_t)tokq[n] * OCW + (MODE == 0 ? 64 * hq : 512 + 64 * hq);
#pragma unroll
        for (int gq = 0; gq < 4; ++gq) {
            u32x2 w0, w1;
            w0[0] = cvt2(st[n].O0[4 * gq] * rd, st[n].O0[4 * gq + 1] * rd); w0[1] = cvt2(st[n].O0[4 * gq + 2] * rd, st[n].O0[4 * gq + 3] * rd);
            w1[0] = cvt2(st[n].O1[4 * gq] * rd, st[n].O1[4 * gq + 1] * rd); w1[1] = cvt2(st[n].O1[4 * gq + 2] * rd, st[n].O1[4 * gq + 3] * rd);
            *(u32x2*)(op + 8 * gq + 4 * h) = w0; *(u32x2*)(op + 32 + 8 * gq + 4 * h) = w1;
        }
    }
}
}
DI void f_attn_phase(const Params& p, int l, LAS unsigned char* lds, int slot) {
    const int tid = otid(), lane = tid & 63, wid = __builtin_amdgcn_readfirstlane(tid >> 6);
    LAS float* rpb_lds = (LAS float*)(lds + 131072 + 64);
    for (int i = tid; i < 4 * 465; i += 512) rpb_lds[i] = p.rpb[(size_t)l * 4 * 465 + i] * at::LOG2E;
    __syncthreads();
    LAS unsigned char* ring = lds + wid * 16384;
    const int x8 = blockIdx.x & 7;
    unsigned* ctr = (unsigned*)(p.ws + OFF_CTL + 16384) + 64 * (slot * 8 + x8);
    for (;;) {
        unsigned k = 0u;
        if (lane == 0) k = __hip_atomic_fetch_add(ctr, 1u, __ATOMIC_RELAXED, __HIP_MEMORY_SCOPE_AGENT);
        k = (unsigned)__builtin_amdgcn_readfirstlane((int)k);
        if (k >= 512u) break;
        int ln = lane; asm volatile("" : "+v"(ln));
        if (k < 192u) at::wave_unit<0>(p, l, x8 * 192 + (int)k, rpb_lds, ring, ln);
        else if (k < 320u) at::wave_unit<3>(p, l, x8 * 128 + (int)k - 192, rpb_lds, ring, ln);
        else { const int ub = x8 * 192 + (int)k - 320; if (((ub >> 7) % 3) == 1) at::wave_unit<2>(p, l, ub, rpb_lds, ring, ln); else at::wave_unit<1>(p, l, ub, rpb_lds, ring, ln); }
    }
    __syncthreads();
}

DI void bcombine_phase(const Params& p) {
    for (int i = blockIdx.x * 512 + otid(); i < NTOK * 16; i += gridDim.x * 512) {
        const int tok = i >> 4, part = i & 15, hs = part >> 3, d0 = (part & 7) * 8;
        const float l0 = P_LSE(p)[((size_t)0 * NTOK + tok) * 2 + hs], l1 = P_LSE(p)[((size_t)1 * NTOK + tok) * 2 + hs], l2 = P_LSE(p)[((size_t)2 * NTOK + tok) * 2 + hs];
        const float mx = fmaxf(l0, fmaxf(l1, l2)), e0 = __expf(l0 - mx), e1 = __expf(l1 - mx), e2 = __expf(l2 - mx), rs = 1.0f / (e0 + e1 + e2);
        const float a0 = e0 * rs, a1 = e1 * rs, a2 = e2 * rs;
        const u32x4 w0 = *(const u32x4*)(P_OB3(p) + ((size_t)0 * NTOK + tok) * 128 + 64 * hs + d0);
        const u32x4 w1 = *(const u32x4*)(P_OB3(p) + ((size_t)1 * NTOK + tok) * 128 + 64 * hs + d0);
        const u32x4 w2 = *(const u32x4*)(P_OB3(p) + ((size_t)2 * NTOK + tok) * 128 + 64 * hs + d0);
        u32x4 o;
#pragma unroll
        for (int j = 0; j < 4; ++j) o[j] = pk2(a0 * bflo(w0[j]) + a1 * bflo(w1[j]) + a2 * bflo(w2[j]), a0 * bfhi(w0[j]) + a1 * bfhi(w1[j]) + a2 * bfhi(w2[j]));
        *(u32x4*)(P_OC(p) + (size_t)tok * OCW + 384 + 64 * hs + d0) = o;
    }
}

namespace g8 {
constexpr int BM = 256, BK = 64, HALF = 128, HTB = HALF * BK * 2, NXCD = 8, WGM = 8;
DI int lds_byte(int r, int c) { const int st = (r >> 4) * 2 + (c >> 5), rr = r & 15, cc = c & 31, ob = rr * 64 + cc * 2; return st * 1024 + (ob ^ (((ob >> 9) & 1) << 5)); }
DI void stage_rc(int b, int& R, int& C) { const int st = b / 1024, sb = b % 1024, swz = sb ^ (((sb >> 9) & 1) << 5); R = (st >> 1) * 16 + swz / 64; C = (st & 1) * 32 + (swz % 64) / 2; }
DI int perm32(int rho) { const int n = rho >> 4, i = rho & 15; return 8 * (i >> 2) + 4 * n + (i & 3); }
struct Unit { int pm, pn, aux; };
struct StaticOrder {
    int nM, nN, nwg, G, c;
    DI void init(int M, int N, int G_, int c_) { nM = M / BM; nN = N / BM; nwg = nM * nN; G = G_; c = c_; }
    DI bool next(int i, Unit& u) const {
        const long L = (long)i * G + c; if (L >= nwg) return false;
        int wgid = (int)L; { const int q = nwg / NXCD, r = nwg % NXCD, xcd = wgid % NXCD, off = wgid / NXCD; wgid = (xcd < r ? xcd * (q + 1) : r * (q + 1) + (xcd - r) * q) + off; }
        const int nig = WGM * nN, gid = wgid / nig, fm = gid * WGM, gsz = (nM - fm) < WGM ? (nM - fm) : WGM;
        u.pm = fm + ((wgid % nig) % gsz); u.pn = (wgid % nig) / gsz; u.aux = 0; return true;
    }
};
typedef f32x4 Acc[2][2][4][2];
typedef int i32x4 __attribute__((ext_vector_type(4)));
typedef int i32x8 __attribute__((ext_vector_type(8)));
DI bf16x8 half8(const i32x8& v, int k) { const i32x4 x = k == 0 ? __builtin_shufflevector(v, v, 0, 1, 2, 3) : __builtin_shufflevector(v, v, 4, 5, 6, 7); return __builtin_bit_cast(bf16x8, x); }
DI i32x8 cat8(const bf16x8& a, const bf16x8& b) { const i32x4 x = __builtin_bit_cast(i32x4, a), y = __builtin_bit_cast(i32x4, b); return __builtin_shufflevector(x, y, 0, 1, 2, 3, 4, 5, 6, 7); }

template <class Desc, class Epi, class Sched, bool ALIGN_EPI>
DI void gemm_phase(LAS unsigned char* lds, const Desc& D, const Sched& S, const Epi& E) {
    const int tid = otid(), wid = __builtin_amdgcn_readfirstlane(tid >> 6), lane = tid & 63, wr = wid >> 2, wc = wid & 3, fr = lane & 15, fq = lane >> 4;
    int R0, C0, R1, C1; stage_rc(tid * 16, R0, C0); stage_rc(tid * 16 + 8192, R1, C1);
    const int Rb0 = Epi::PERM ? ((R0 & ~31) + perm32(R0 & 31)) : R0, Rb1 = Epi::PERM ? ((R1 & ~31) + perm32(R1 & 31)) : R1;
    constexpr unsigned LDA2 = Desc::lda * 2, LDB2 = Desc::ldb * 2;
    const size_t kstep = (size_t)(BK * 2);
    const unsigned ldsw = (unsigned)wid * 1024u;
    const int aoff = lds_byte(wr * 64 + fr, fq * 8), boff = lds_byte(wc * 32 + fr, fq * 8);
#define G8_SA(b, h) (((b) * 2 + (h)) * HTB)
#define G8_SB(b, h) ((4 + (b) * 2 + (h)) * HTB)
#define G8_STAGE(bufoff, gbase, o0, o1) do { \
        __builtin_amdgcn_global_load_lds((const unsigned*)((const char*)(gbase) + (o0)), (LAS unsigned*)(lds + (bufoff) + ldsw), 16, 0, 0); \
        __builtin_amdgcn_global_load_lds((const unsigned*)((const char*)(gbase) + (o1)), (LAS unsigned*)(lds + (bufoff) + ldsw + 8192), 16, 0, 0); } while (0)
#define G8_LDA(dst, b, h) do { _Pragma("unroll") for (int m = 0; m < 4; ++m) { const bf16x8 lo_ = *(const LAS bf16x8*)(lds + G8_SA(b, h) + aoff + m * 2048), hi_ = *(const LAS bf16x8*)(lds + G8_SA(b, h) + aoff + m * 2048 + 1024); dst[m] = cat8(lo_, hi_); } } while (0)
#define G8_LDB(dst, b, h) do { _Pragma("unroll") for (int n = 0; n < 2; ++n) { const bf16x8 lo_ = *(const LAS bf16x8*)(lds + G8_SB(b, h) + boff + n * 2048), hi_ = *(const LAS bf16x8*)(lds + G8_SB(b, h) + boff + n * 2048 + 1024); dst[n] = cat8(lo_, hi_); } } while (0)
#define G8_MMA(ai, bj, At, Bt) do { __builtin_amdgcn_s_setprio(1); _Pragma("unroll") for (int m = 0; m < 4; ++m) _Pragma("unroll") for (int n = 0; n < 2; ++n) _Pragma("unroll") for (int k = 0; k < 2; ++k) \
        acc[ai][bj][m][n] = __builtin_amdgcn_mfma_f32_16x16x32_bf16(half8(Bt[n], k), half8(At[m], k), acc[ai][bj][m][n], 0, 0, 0); __builtin_amdgcn_s_setprio(0); } while (0)
#define G8_MMA8(ai, bj, At, Bt) do { __builtin_amdgcn_s_setprio(1); _Pragma("unroll") for (int m = 0; m < 4; ++m) _Pragma("unroll") for (int n = 0; n < 2; ++n) \
        asm volatile("v_mfma_scale_f32_16x16x128_f8f6f4 %0, %1, %2, %0, %3, %3 op_sel_hi:[0,0,0]" : "+v"(acc[ai][bj][m][n]) : "v"(Bt[n]), "v"(At[m]), "v"(one_scale));     __builtin_amdgcn_s_setprio(0); } while (0)
#define G8_MM(ai, bj, At, Bt) do { if constexpr (Desc::FP8) G8_MMA8(ai, bj, At, Bt); else G8_MMA(ai, bj, At, Bt); } while (0)
#define G8_WAIT_V(n) asm volatile("s_waitcnt vmcnt(" #n ")" ::: "memory")
#define G8_WAIT_L(n) asm volatile("s_waitcnt lgkmcnt(" #n ")" ::: "memory")
#define G8_BAR __builtin_amdgcn_s_barrier()
#define G8_SCHED __builtin_amdgcn_sched_barrier(0)
#define G8_MKA(u, uidx, o) do { \
        o[0][0] = (unsigned)(Desc::GATHER ? D.a_row(u, uidx, R0) : R0) * LDA2 + (unsigned)C0 * 2u; o[0][1] = (unsigned)(Desc::GATHER ? D.a_row(u, uidx, R1) : R1) * LDA2 + (unsigned)C1 * 2u; \
        if (Desc::GATHER) { o[1][0] = (unsigned)D.a_row(u, uidx, HALF + R0) * LDA2 + (unsigned)C0 * 2u; o[1][1] = (unsigned)D.a_row(u, uidx, HALF + R1) * LDA2 + (unsigned)C1 * 2u; } } while (0)
#define G8_MKB(u, o, hs) do { const unsigned dl_ = (unsigned)D.dilB(u) * LDB2; hs = (unsigned)HALF * dl_; \
        o[0] = (unsigned)Rb0 * dl_ + (unsigned)C0 * 2u; o[1] = (unsigned)Rb1 * dl_ + (unsigned)C1 * 2u; } while (0)
#define G8_A1(o, i) (Desc::GATHER ? o[1][i] : o[0][i] + (unsigned)HALF * LDA2)
    Unit cur, nxt; int ui = 0;
    if (!S.next(0, cur)) return;
    Acc acc;
#pragma unroll
    for (int a = 0; a < 2; ++a)
#pragma unroll
        for (int b = 0; b < 2; ++b)
#pragma unroll
            for (int m = 0; m < 4; ++m)
#pragma unroll
                for (int n = 0; n < 2; ++n) acc[a][b][m][n] = (f32x4){0.f, 0.f, 0.f, 0.f};
    int one_scale = 0x7f7f7f7f; asm volatile("" : "+v"(one_scale));
    i32x8 At[4], B0[2], B1[2];
    unsigned cAo[2][2], cBo[2], nAo[2][2], nBo[2], cBh, nBh;
    G8_MKA(cur, 0, cAo); G8_MKB(cur, cBo, cBh); nBh = cBh;
    const char* cA = D.a_base(cur); const char* cB = D.b_base(cur);
    G8_STAGE(G8_SB(0, 0), cB, cBo[0], cBo[1]); G8_STAGE(G8_SB(0, 1), cB + cBh, cBo[0], cBo[1]); G8_STAGE(G8_SA(0, 0), cA, cAo[0][0], cAo[0][1]); G8_STAGE(G8_SA(0, 1), cA, G8_A1(cAo, 0), G8_A1(cAo, 1));
    if (wr == 1) G8_BAR;
    G8_WAIT_V(2); G8_BAR;
    G8_STAGE(G8_SB(1, 0), cB + kstep, cBo[0], cBo[1]); G8_STAGE(G8_SA(1, 0), cA + kstep, cAo[0][0], cAo[0][1]); G8_STAGE(G8_SB(1, 1), cB + kstep + cBh, cBo[0], cBo[1]);
    G8_WAIT_V(6); G8_BAR;
    for (;;) {
        const bool has_next = S.next(ui + 1, nxt);
        const char* nA = cA; const char* nB = cB;
        if (has_next) { nA = D.a_base(nxt); nB = D.b_base(nxt); }
        if (Desc::GATHER) { if (has_next) G8_MKA(nxt, ui + 1, nAo); else { nAo[0][0] = cAo[0][0]; nAo[0][1] = cAo[0][1]; nAo[1][0] = cAo[1][0]; nAo[1][1] = cAo[1][1]; } }
        if (Desc::VARB) { if (has_next) G8_MKB(nxt, nBo, nBh); else { nBo[0] = cBo[0]; nBo[1] = cBo[1]; nBh = cBh; } }
        const int nt = D.nt(cur);
#pragma unroll 1
        for (int t = 0; t < nt; t += 2) {
            const bool last = (t == nt - 2);
            const char* a1 = cA + (size_t)(t + 1) * kstep;
            const char* a2 = last ? nA : cA + (size_t)(t + 2) * kstep; const char* b2 = last ? nB : cB + (size_t)(t + 2) * kstep;
            const char* a3 = a2 + kstep; const char* b3 = b2 + kstep;
            const unsigned xa00 = (Desc::GATHER && last) ? nAo[0][0] : cAo[0][0], xa01 = (Desc::GATHER && last) ? nAo[0][1] : cAo[0][1];
            const unsigned xa10 = Desc::GATHER ? (last ? nAo[1][0] : cAo[1][0]) : xa00 + (unsigned)HALF * LDA2, xa11 = Desc::GATHER ? (last ? nAo[1][1] : cAo[1][1]) : xa01 + (unsigned)HALF * LDA2;
            const unsigned xb0 = (Desc::VARB && last) ? nBo[0] : cBo[0], xb1 = (Desc::VARB && last) ? nBo[1] : cBo[1], xbh = (Desc::VARB && last) ? nBh : cBh;
            G8_LDB(B0, 0, 0); G8_LDB(B1, 0, 1); G8_SCHED; G8_LDA(At, 0, 0); G8_STAGE(G8_SA(1, 1), a1, G8_A1(cAo, 0), G8_A1(cAo, 1));
            G8_WAIT_V(8); G8_WAIT_L(0); G8_BAR; G8_MM(0, 0, At, B0); G8_MM(0, 1, At, B1); G8_BAR; G8_SCHED;
            G8_LDA(At, 0, 1); G8_STAGE(G8_SB(0, 0), b2, xb0, xb1); G8_STAGE(G8_SB(0, 1), b2 + xbh, xb0, xb1); G8_STAGE(G8_SA(0, 0), a2, xa00, xa01);
            G8_WAIT_V(8); G8_WAIT_L(0); G8_BAR; G8_MM(1, 0, At, B0); G8_MM(1, 1, At, B1); G8_BAR; G8_SCHED;
            G8_LDB(B0, 1, 0); G8_LDB(B1, 1, 1); G8_SCHED; G8_LDA(At, 1, 0); G8_STAGE(G8_SA(0, 1), a2, xa10, xa11);
            G8_WAIT_V(8); G8_WAIT_L(0); G8_BAR; G8_MM(0, 0, At, B0); G8_MM(0, 1, At, B1); G8_BAR; G8_SCHED;
            G8_LDA(At, 1, 1); G8_STAGE(G8_SB(1, 0), b3, xb0, xb1); G8_STAGE(G8_SB(1, 1), b3 + xbh, xb0, xb1); G8_STAGE(G8_SA(1, 0), a3, xa00, xa01);
            G8_WAIT_V(8); G8_WAIT_L(0); G8_BAR; G8_MM(1, 0, At, B0); G8_MM(1, 1, At, B1); G8_BAR; G8_SCHED;
        }
        if constexpr (ALIGN_EPI) { if (wr == 0) G8_BAR; }
        if constexpr (Desc::FP8) asm volatile("s_nop 15\n\ts_nop 15" ::: "memory");
        E(acc, cur, wr, wc, fr, fq);
        if (!has_next) break;
#pragma unroll
        for (int a = 0; a < 2; ++a)
#pragma unroll
            for (int b = 0; b < 2; ++b)
#pragma unroll
                for (int m = 0; m < 4; ++m)
#pragma unroll
                    for (int n = 0; n < 2; ++n) acc[a][b][m][n] = (f32x4){0.f, 0.f, 0.f, 0.f};
        if constexpr (Desc::FP8) asm volatile("s_nop 7" ::: "memory");
        cur = nxt; cA = nA; cB = nB; ++ui;
        if (Desc::GATHER) { cAo[0][0] = nAo[0][0]; cAo[0][1] = nAo[0][1]; cAo[1][0] = nAo[1][0]; cAo[1][1] = nAo[1][1]; }
        if (Desc::VARB) { cBo[0] = nBo[0]; cBo[1] = nBo[1]; cBh = nBh; }
        if constexpr (ALIGN_EPI) { if (wr == 1) G8_BAR; }
    }
    G8_WAIT_V(0);
    if constexpr (!ALIGN_EPI) { if (wr == 0) G8_BAR; }
    G8_BAR;
#undef G8_SA
#undef G8_SB
#undef G8_STAGE
#undef G8_LDA
#undef G8_LDB
#undef G8_MMA
#undef G8_MMA8
#undef G8_MM
#undef G8_WAIT_V
#undef G8_WAIT_L
#undef G8_BAR
#undef G8_SCHED
#undef G8_MKA
#undef G8_MKB
#undef G8_A1
}
DI unsigned cvt2(float lo, float hi) { typedef __bf16 bf2_t __attribute__((ext_vector_type(2))); const f32x2 v = {lo, hi}; const bf2_t b = __builtin_convertvector(v, bf2_t); return __builtin_bit_cast(unsigned, b); }
DI u32x4 pack8(const f32x4& a, const f32x4& b) { u32x4 w; w[0] = cvt2(a[0], a[1]); w[1] = cvt2(a[2], a[3]); w[2] = cvt2(b[0], b[1]); w[3] = cvt2(b[2], b[3]); return w; }
DI float fsig(float x) { return __builtin_amdgcn_rcpf(1.0f + __expf(-x)); }

struct DescMoe1 { static constexpr bool GATHER = true, VARB = false, FP8 = true; static constexpr int lda = DM / 2, ldb = DM / 2; const bf16_t* XN8; const bf16_t* WGU; const LAS int* rowlist;
    DI const char* a_base(const Unit&) const { return (const char*)XN8; }
    DI const char* b_base(const Unit& u) const { return (const char*)WGU + ((size_t)(u.pm >> 3) * 4096 + (size_t)u.pn * 256) * DM; }
    DI int a_row(const Unit&, int uidx, int r) const { return rowlist[uidx * 256 + r]; }
    DI int nt(const Unit&) const { return DM / 128; } DI int dilB(const Unit&) const { return 1; } };
struct EpiSwiglu { static constexpr bool PERM = true; unsigned char* HID8;
    DI void operator()(const Acc& acc, const Unit& u, int wr, int wc, int fr, int fq) const {
        const int row0 = u.pm * BM + wr * 64 + fr, col0 = u.pn * 128 + wc * 32 + 8 * fq; constexpr float WI = 1.0f / W8_SCALE;
#pragma unroll
        for (int ai = 0; ai < 2; ++ai)
#pragma unroll
            for (int m = 0; m < 4; ++m) { f32x4 h0, h1;
#pragma unroll
                for (int j = 0; j < 4; ++j) { const float g0 = acc[ai][0][m][0][j] * WI, g1 = acc[ai][0][m][1][j] * WI;
                    h0[j] = g0 * fsig(g0) * acc[ai][1][m][0][j] * (WI * H8_SCALE); h1[j] = g1 * fsig(g1) * acc[ai][1][m][1][j] * (WI * H8_SCALE); }
                u32x2 w; w[0] = pk4_fp8(h0[0], h0[1], h0[2], h0[3]); w[1] = pk4_fp8(h1[0], h1[1], h1[2], h1[3]);
                *(u32x2*)(HID8 + (size_t)(row0 + ai * HALF + m * 16) * FF + col0) = w; }
    } };
struct DescMoe2 { static constexpr bool GATHER = false, VARB = false, FP8 = true; static constexpr int lda = FF / 2, ldb = FF / 2; const unsigned char* HID8; const bf16_t* WD;
    DI const char* a_base(const Unit& u) const { return (const char*)HID8 + (size_t)u.pm * 256 * FF; }
    DI const char* b_base(const Unit& u) const { return (const char*)WD + ((size_t)(u.pm >> 3) * 1024 + (size_t)u.pn * 256) * FF; }
    DI int a_row(const Unit&, int, int r) const { return r; }
    DI int nt(const Unit&) const { return FF / 128; } DI int dilB(const Unit&) const { return 1; } };
struct EpiY { static constexpr bool PERM = true; bf16_t* Y; const float* VAL;
    DI void operator()(const Acc& acc, const Unit& u, int wr, int wc, int fr, int fq) const {
        const int row0 = u.pm * BM + wr * 64 + fr, col0 = u.pn * BM + wc * 32 + 8 * fq;
        float vv[2][4];
#pragma unroll
        for (int ai = 0; ai < 2; ++ai)
#pragma unroll
            for (int m = 0; m < 4; ++m) vv[ai][m] = VAL[row0 + ai * HALF + m * 16];
#pragma unroll
        for (int ai = 0; ai < 2; ++ai)
#pragma unroll
            for (int m = 0; m < 4; ++m) { const int row = row0 + ai * HALF + m * 16; const float v = vv[ai][m] * (1.0f / (W8_SCALE * H8_SCALE));
#pragma unroll
                for (int bj = 0; bj < 2; ++bj) *(u32x4*)(Y + (size_t)row * DM + col0 + bj * HALF) = pack8(acc[ai][bj][m][0] * v, acc[ai][bj][m][1] * v); }
    } };
struct DescOut { static constexpr bool GATHER = false, VARB = false, FP8 = false; static constexpr int lda = DM, ldb = DM; const bf16_t* MG; const bf16_t* WO;
    DI const char* a_base(const Unit& u) const { return (const char*)(MG + (size_t)u.pm * 256 * DM); }
    DI const char* b_base(const Unit& u) const { return (const char*)(WO + (size_t)u.pn * 256 * DM); }
    DI int a_row(const Unit&, int, int r) const { return r; }
    DI int nt(const Unit&) const { return DM / BK; } DI int dilB(const Unit&) const { return 1; } };
struct EpiResid { static constexpr bool PERM = false; float* X;
    DI void operator()(const Acc& acc, const Unit& u, int wr, int wc, int fr, int fq) const {
        const int row0 = u.pm * BM + wr * 64 + fr, col0 = u.pn * BM + wc * 32 + 4 * fq;
#pragma unroll
        for (int ai = 0; ai < 2; ++ai) {
            f32x4 x[4][2][2];
#pragma unroll
            for (int m = 0; m < 4; ++m)
#pragma unroll
                for (int bj = 0; bj < 2; ++bj)
#pragma unroll
                    for (int n = 0; n < 2; ++n) x[m][bj][n] = *(const f32x4*)(X + (size_t)(row0 + ai * HALF + m * 16) * DM + col0 + bj * HALF + 16 * n);
#pragma unroll
            for (int m = 0; m < 4; ++m)
#pragma unroll
                for (int bj = 0; bj < 2; ++bj)
#pragma unroll
                    for (int n = 0; n < 2; ++n) *(f32x4*)(X + (size_t)(row0 + ai * HALF + m * 16) * DM + col0 + bj * HALF + 16 * n) = x[m][bj][n] + acc[ai][bj][m][n];
            __builtin_amdgcn_sched_barrier(0);
        }
    } };
struct DescInproj { static constexpr bool GATHER = false, VARB = false, FP8 = false; static constexpr int lda = DM, ldb = DM; const bf16_t* XN; const bf16_t* WIN;
    DI const char* a_base(const Unit& u) const { return (const char*)(XN + (size_t)u.pm * 256 * DM); }
    DI const char* b_base(const Unit& u) const { return (const char*)(WIN + (size_t)u.pn * 256 * DM); }
    DI int a_row(const Unit&, int, int r) const { return r; }
    DI int nt(const Unit&) const { return DM / BK; } DI int dilB(const Unit&) const { return 1; } };
struct EpiInproj { static constexpr bool PERM = true; bf16_t* QK; bf16_t* G; const float* cosT; const float* sinT; const float* bgate;
    DI void operator()(const Acc& acc, const Unit& u, int wr, int wc, int fr, int fq) const {
        const int row0 = u.pm * BM + wr * 64 + fr;
        if (u.pn < 5) {
            const int hr = 4 * u.pn + wc; const float sc = (hr < 6 || (hr >= 8 && hr < 14)) ? 0.125f * 1.4426950408889634f : 1.0f;
#pragma unroll
            for (int ai = 0; ai < 2; ++ai) {
                f32x4 tc[4][2], ts[4][2];
#pragma unroll
                for (int m = 0; m < 4; ++m) { const int pos = (row0 + ai * HALF + m * 16) & (SEQ - 1);
                    tc[m][0] = *(const f32x4*)(cosT + pos * 32 + 8 * fq); tc[m][1] = *(const f32x4*)(cosT + pos * 32 + 8 * fq + 4); ts[m][0] = *(const f32x4*)(sinT + pos * 32 + 8 * fq); ts[m][1] = *(const f32x4*)(sinT + pos * 32 + 8 * fq + 4); }
#pragma unroll
                for (int m = 0; m < 4; ++m) { const int row = row0 + ai * HALF + m * 16;
                    const f32x4 c0 = tc[m][0], c1 = tc[m][1], s0 = ts[m][0], s1 = ts[m][1];
                    const f32x4 a0 = acc[ai][0][m][0], a1 = acc[ai][0][m][1], b0 = acc[ai][1][m][0], b1 = acc[ai][1][m][1];
                    bf16_t* o = QK + (size_t)row * QKW + 64 * hr + 8 * fq;
                    *(u32x4*)o = pack8((a0 * c0 - b0 * s0) * sc, (a1 * c1 - b1 * s1) * sc);
                    *(u32x4*)(o + 32) = pack8((b0 * c0 + a0 * s0) * sc, (b1 * c1 + a1 * s1) * sc); }
                __builtin_amdgcn_sched_barrier(0);
            }
        } else if (u.pn < 7) {
            const float sc = u.pn == 5 ? 0.125f * 1.4426950408889634f : 1.0f; const int col0 = 1280 + (u.pn - 5) * 256 + wc * 32 + 8 * fq;
#pragma unroll
            for (int ai = 0; ai < 2; ++ai)
#pragma unroll
                for (int m = 0; m < 4; ++m)
#pragma unroll
                    for (int bj = 0; bj < 2; ++bj) *(u32x4*)(QK + (size_t)(row0 + ai * HALF + m * 16) * QKW + col0 + bj * HALF) = pack8(acc[ai][bj][m][0] * sc, acc[ai][bj][m][1] * sc);
        } else {
            const int col0 = (u.pn - 7) * 256 + wc * 32 + 8 * fq;
            f32x4 bv[2][2];
#pragma unroll
            for (int bj = 0; bj < 2; ++bj)
#pragma unroll
                for (int n = 0; n < 2; ++n) bv[bj][n] = *(const f32x4*)(bgate + col0 + bj * HALF + 4 * n);
#pragma unroll
            for (int ai = 0; ai < 2; ++ai)
#pragma unroll
                for (int m = 0; m < 4; ++m)
#pragma unroll
                    for (int bj = 0; bj < 2; ++bj) { f32x4 v0 = acc[ai][bj][m][0] + bv[bj][0], v1 = acc[ai][bj][m][1] + bv[bj][1];
#pragma unroll
                        for (int j = 0; j < 4; ++j) { v0[j] = fsig(v0[j]); v1[j] = fsig(v1[j]); }
                        *(u32x4*)(G + (size_t)(row0 + ai * HALF + m * 16) * 3072 + col0 + bj * HALF) = pack8(v0, v1); }
        }
    } };
struct DescVT { static constexpr bool GATHER = false, VARB = true, FP8 = false; static constexpr int lda = DM, ldb = DM; const bf16_t* WV; const bf16_t* XN;
    DI const char* a_base(const Unit& u) const { return (const char*)(WV + (size_t)u.pm * 256 * DM); }
    DI const char* b_base(const Unit& u) const { return (const char*)(XN + (u.pm < 2 ? (size_t)u.pn * 256 : (size_t)((u.pn >> 4) * SEQ + (u.pn & 15))) * DM); }
    DI int a_row(const Unit&, int, int r) const { return r; }
    DI int nt(const Unit&) const { return DM / BK; } DI int dilB(const Unit& u) const { return u.pm < 2 ? 1 : 16; } };
struct EpiVT { static constexpr bool PERM = true; bf16_t* VT;
    DI void operator()(const Acc& acc, const Unit& u, int wr, int wc, int fr, int fq) const {
        const int row0 = u.pm * BM + wr * 64 + fr, col0 = u.pn * BM + wc * 32 + 8 * fq;
#pragma unroll
        for (int ai = 0; ai < 2; ++ai)
#pragma unroll
            for (int m = 0; m < 4; ++m)
#pragma unroll
                for (int bj = 0; bj < 2; ++bj) *(u32x4*)(VT + (size_t)(row0 + ai * HALF + m * 16) * NTOK + col0 + bj * HALF) = pack8(acc[ai][bj][m][0], acc[ai][bj][m][1]);
    } };
struct DescMerge { static constexpr bool GATHER = false, VARB = false, FP8 = false; static constexpr int lda = OCW, ldb = 768; const bf16_t* OC; const bf16_t* WM;
    DI int k0(const Unit& u) const { return u.aux == 0 ? 0 : u.aux == 1 ? 384 : 512; }
    DI const char* a_base(const Unit& u) const { return (const char*)(OC + (size_t)u.pm * 256 * OCW + k0(u)); }
    DI const char* b_base(const Unit& u) const { return (const char*)(WM + (size_t)u.pn * 256 * 768 + k0(u)); }
    DI int a_row(const Unit&, int, int r) const { return r; }
    DI int nt(const Unit& u) const { return u.aux == 0 ? 6 : u.aux == 1 ? 2 : 4; } DI int dilB(const Unit&) const { return 1; } };
struct MergeOrder { StaticOrder base;
    DI bool next(int i, Unit& u) const { const int q = i / 3; if (!base.next(q, u)) return false; u.aux = i - 3 * q; return true; } };
struct EpiMerge { static constexpr bool PERM = true; bf16_t* MG; const bf16_t* G;
    DI void operator()(const Acc& acc, const Unit& u, int wr, int wc, int fr, int fq) const {
        const int row0 = u.pm * BM + wr * 64 + fr, col0 = u.pn * BM + wc * 32 + 8 * fq;
#pragma unroll
        for (int ai = 0; ai < 2; ++ai) {
            u32x4 g[4][2], w[4][2];
#pragma unroll
            for (int m = 0; m < 4; ++m)
#pragma unroll
                for (int bj = 0; bj < 2; ++bj) { const int row = row0 + ai * HALF + m * 16, col = col0 + bj * HALF;
                    g[m][bj] = *(const u32x4*)(G + (size_t)row * 3072 + 1024 * u.aux + col);
                    if (u.aux != 0) w[m][bj] = *(const u32x4*)(MG + (size_t)row * DM + col); else w[m][bj] = (u32x4){0u, 0u, 0u, 0u}; }
#pragma unroll
            for (int m = 0; m < 4; ++m)
#pragma unroll
                for (int bj = 0; bj < 2; ++bj) { const int row = row0 + ai * HALF + m * 16, col = col0 + bj * HALF;
                    const u32x4 gg = g[m][bj], ww = w[m][bj];
                    f32x4 v0 = acc[ai][bj][m][0], v1 = acc[ai][bj][m][1];
                    v0[0] = v0[0] * bflo(gg[0]) + bflo(ww[0]); v0[1] = v0[1] * bfhi(gg[0]) + bfhi(ww[0]); v0[2] = v0[2] * bflo(gg[1]) + bflo(ww[1]); v0[3] = v0[3] * bfhi(gg[1]) + bfhi(ww[1]);
                    v1[0] = v1[0] * bflo(gg[2]) + bflo(ww[2]); v1[1] = v1[1] * bfhi(gg[2]) + bfhi(ww[2]); v1[2] = v1[2] * bflo(gg[3]) + bflo(ww[3]); v1[3] = v1[3] * bfhi(gg[3]) + bfhi(ww[3]);
                    *(u32x4*)(MG + (size_t)row * DM + col) = pack8(v0, v1); }
            __builtin_amdgcn_sched_barrier(0);
        }
    } };
}
DI void f_inproj_phase(const Params& p, int l, LAS unsigned char* lds) {
    { g8::StaticOrder S; S.init(NTOK, 4352, gridDim.x, blockIdx.x);
      g8::DescInproj D{P_XN(p), P_W(p, l, LW_WIN)}; g8::EpiInproj E{P_QK(p), P_G(p), P_COS(p), P_SIN(p), p.b_gate + (size_t)l * 3072};
      g8::gemm_phase<g8::DescInproj, g8::EpiInproj, g8::StaticOrder, true>(lds, D, S, E); }
    { g8::StaticOrder S; S.init(VCH, NTOK, gridDim.x, (blockIdx.x + gridDim.x - 64) % gridDim.x);
      g8::DescVT D{P_W(p, l, LW_WV), P_XN(p)}; g8::EpiVT E{P_VT(p)};
      g8::gemm_phase<g8::DescVT, g8::EpiVT, g8::StaticOrder, true>(lds, D, S, E); }
}
struct OneUnit { int pm, pn; DI bool next(int i, g8::Unit& u) const { if (i != 0) return false; u.pm = pm; u.pn = pn; u.aux = 0; return true; } };
DI void f_gate_tail_units(const Params& p, int l, LAS unsigned char* lds) {
    if (blockIdx.x < 128) {
        OneUnit S{(int)(blockIdx.x >> 1), 17 + (int)(blockIdx.x & 1)};
        g8::DescInproj D{P_XN(p), P_W(p, l, LW_WIN)}; g8::EpiInproj E{P_QK(p), P_G(p), P_COS(p), P_SIN(p), p.b_gate + (size_t)l * 3072};
        g8::gemm_phase<g8::DescInproj, g8::EpiInproj, OneUnit, false>(lds, D, S, E);
        __syncthreads();
    }
}
DI void f_merge_phase(const Params& p, int l, LAS unsigned char* lds) {
    g8::MergeOrder S; S.base.init(NTOK, DM, gridDim.x, blockIdx.x);
    g8::DescMerge D{P_OC(p), P_W(p, l, LW_WM)}; g8::EpiMerge E{P_MG(p), P_G(p)};
    g8::gemm_phase<g8::DescMerge, g8::EpiMerge, g8::MergeOrder, true>(lds, D, S, E);
}

DI void f_moe1_phase(const Params& p, int l, LAS unsigned char* lds) {
    g8::StaticOrder S; S.init(NROWS_E, 2 * FF, gridDim.x, blockIdx.x);
    LAS int* rowlist = (LAS int*)(lds + 131072 + 64);
    g8::Unit u;
    for (int i = 0; i < 8 && S.next(i, u); ++i)
        for (int r = otid(); r < 256; r += 512) rowlist[i * 256 + r] = ((u.pm >> 1) & 3) * SEQ + P_IDX(p)[u.pm * 256 + r];
    __syncthreads();
    g8::DescMoe1 D{(const bf16_t*)P_XN8(p), P_W(p, l, LW_WGU), rowlist}; g8::EpiSwiglu E{(unsigned char*)P_HID(p)};
    g8::gemm_phase<g8::DescMoe1, g8::EpiSwiglu, g8::StaticOrder, true>(lds, D, S, E);
}
DI void f_moe2_phase(const Params& p, int l, LAS unsigned char* lds) {
    g8::StaticOrder S; S.init(NROWS_E, DM, gridDim.x, blockIdx.x);
    g8::DescMoe2 D{(const unsigned char*)P_HID(p), P_W(p, l, LW_WD)}; g8::EpiY E{P_Y(p), P_VAL(p)};
    g8::gemm_phase<g8::DescMoe2, g8::EpiY, g8::StaticOrder, true>(lds, D, S, E);
}
DI void f_out_phase(const Params& p, int l, LAS unsigned char* lds) {
    g8::StaticOrder S; S.init(NTOK, DM, gridDim.x, blockIdx.x);
    g8::DescOut D{P_MG(p), P_W(p, l, LW_WO)}; g8::EpiResid E{P_X(p)};
    g8::gemm_phase<g8::DescOut, g8::EpiResid, g8::StaticOrder, false>(lds, D, S, E);
}

#define XB_TMO      128
#define XB_XCNT(j)  (256  + 64 * (j))
#define XB_XSUB(j)  (1280 + 64 * (j))
#define XB_XGEN(j)  (2304 + 64 * (j))
#define XB_TOP      3328
#define XB_TOPGEN   3392
#define XCD_BAR_WORDS 3456
#define XB_SPIN_CAP (1u << 22)

__device__ __forceinline__ unsigned xb_ld(unsigned* p)              { return __hip_atomic_load(p, __ATOMIC_RELAXED, __HIP_MEMORY_SCOPE_AGENT); }
__device__ __forceinline__ unsigned xb_add(unsigned* p, unsigned v) { return __hip_atomic_fetch_add(p, v, __ATOMIC_RELAXED, __HIP_MEMORY_SCOPE_AGENT); }
__device__ __forceinline__ unsigned xb_xcc_id() { return (unsigned)__builtin_amdgcn_s_getreg((3 << 11) | 20) & 0xFu; }
#define XB_SPIN(cond, bar) do { unsigned _sp = 0; while (cond) { __builtin_amdgcn_s_sleep(1); \
    if ((++_sp & 255u) == 0u) { if (xb_ld(&(bar)[XB_TMO])) break; if (_sp > XB_SPIN_CAP) { atomicAdd(&(bar)[XB_TMO], 1u); break; } } } } while (0)

struct XcdBarrier {
    unsigned* bar; unsigned x;
    volatile LAS unsigned* st;
};

__device__ __forceinline__ XcdBarrier xcd_barrier_post(unsigned* bar, volatile LAS unsigned* st) {
    XcdBarrier b; b.bar = bar; b.x = xb_xcc_id(); b.st = st;
    if (threadIdx.x == 0) (void)xb_add(&bar[XB_XCNT(b.x)], 1u);
    return b;
}
__device__ __forceinline__ void xcd_barrier_complete(unsigned* bar, unsigned x, unsigned& nloc, unsigned& nx) {
    const unsigned G = gridDim.x * gridDim.y * gridDim.z;
    unsigned sum, cnt, mine, sp = 0u;
    for (;;) {
        sum = 0u; cnt = 0u; mine = 0u;
#pragma unroll
        for (unsigned j = 0; j < 16; ++j) { const unsigned c = xb_ld(&bar[XB_XCNT(j)]); sum += c; cnt += (c > 0u) ? 1u : 0u; mine = (j == x) ? c : mine; }
        if (sum == G) break;
        __builtin_amdgcn_s_sleep(1);
        if ((++sp & 255u) == 0u) { if (xb_ld(&bar[XB_TMO])) break; if (sp > XB_SPIN_CAP) { atomicAdd(&bar[XB_TMO], 1u); break; } }
    }
    nloc = mine > 0u ? mine : 1u; nx = cnt > 0u ? cnt : 1u;
}

__device__ __forceinline__ void xcd_barrier(const XcdBarrier& b) {
    asm volatile("s_waitcnt vmcnt(0)" ::: "memory");
    __syncthreads();
    if (threadIdx.x == 0) {
        unsigned* bar = b.bar;
        __builtin_amdgcn_s_waitcnt(0);
        unsigned nloc = b.st[0], nx = b.st[1];
        if (nloc == 0u) { xcd_barrier_complete(bar, b.x, nloc, nx); b.st[0] = nloc; b.st[1] = nx; }
        const unsigned old = xb_add(&bar[XB_XSUB(b.x)], 1u);
        const unsigned gen = old / nloc;
        if (old + 1u == (gen + 1u) * nloc) {
            __builtin_amdgcn_fence(__ATOMIC_RELEASE, "agent");
            asm volatile("s_waitcnt vmcnt(0)" ::: "memory");
            const unsigned og = xb_add(&bar[XB_TOP], 1u);
            const unsigned tg = og / nx;
            if (og + 1u == (tg + 1u) * nx) xb_add(&bar[XB_TOPGEN], 1u);
            else XB_SPIN(xb_ld(&bar[XB_TOPGEN]) == tg, bar);
            __builtin_amdgcn_fence(__ATOMIC_ACQUIRE, "agent");
            xb_add(&bar[XB_XGEN(b.x)], 1u);
            asm volatile("s_waitcnt vmcnt(0)" ::: "memory");
        } else {
            XB_SPIN(xb_ld(&bar[XB_XGEN(b.x)]) == gen, bar);
            __builtin_amdgcn_fence(__ATOMIC_ACQUIRE, "agent");
            asm volatile("s_waitcnt vmcnt(0)" ::: "memory");
        }
    }
    __syncthreads();
}

constexpr int LDS_BYTES = 131072 + 64 + 8192;
#ifndef REP_PREP
#define REP_PREP 1
#define REP_INPROJ 1
#define REP_ATTN 1
#define REP_MERGE 1
#define REP_BCOMB 1
#define REP_N2 1
#define REP_TOPK 1
#define REP_MOE1 1
#define REP_MOE2 1
#endif
#define PH(...) do { Params q = p; { size_t z_ = 0; asm volatile("" : "+s"(z_)); q.ws = p.ws + z_; } __VA_ARGS__; } while (0)
#define GRID_BAR() do { XcdBarrier b_; { size_t z_ = 0; asm volatile("" : "+s"(z_)); b_.bar = (unsigned*)(p.ws + z_ + OFF_CTL); } b_.x = xb_xcc_id(); b_.st = (volatile LAS unsigned*)(lds + 131072); xcd_barrier(b_); } while (0)
__global__ void __launch_bounds__(512, 2) mega_fwd(Params p) {
    extern __shared__ __attribute__((aligned(16))) unsigned char lds_raw[];
    LAS unsigned char* lds = (LAS unsigned char*)lds_raw;
    { volatile LAS unsigned* xbw = (volatile LAS unsigned*)(lds + 131072);
      if (threadIdx.x == 0) { xbw[0] = 0u; xbw[1] = 0u; xbw[2] = 0u; xbw[3] = 0u; }
      __syncthreads();
      (void)xcd_barrier_post((unsigned*)(p.ws + OFF_CTL), xbw); }
    PH(prep_phase(q, (LAS float*)lds); norm1_phase<0>(q, 0));
    GRID_BAR();
#define LAYER(l) do { \
        if ((l) != 0) { PH(norm1_phase<1>(q, (l))); GRID_BAR(); } \
        PH(f_inproj_phase(q, (l), lds)); GRID_BAR(); \
        PH(f_gate_tail_units(q, (l), lds); f_attn_phase(q, (l), lds, (l))); GRID_BAR(); \
        PH(bcombine_phase(q)); GRID_BAR(); \
        PH(f_merge_phase(q, (l), lds)); GRID_BAR(); \
        PH(f_out_phase(q, (l), lds)); GRID_BAR(); \
        PH(norm2_router_phase(q, (l), (LAS float*)lds)); GRID_BAR(); \
        PH(topk_phase(q, (LAS unsigned*)lds)); GRID_BAR(); \
        PH(f_moe1_phase(q, (l), lds)); GRID_BAR(); \
        PH(f_moe2_phase(q, (l), lds)); GRID_BAR(); } while (0)
    LAYER(0); LAYER(1); LAYER(2); LAYER(3);
#undef LAYER
    PH(norm1_phase<2>(q, 0));
}

extern "C" void kernel_launch(void* const* d_in, const int* in_sizes, int n_in, void* d_out, int out_size, void* d_ws, size_t ws_size, hipStream_t stream) {
    (void)in_sizes; (void)out_size;
    static int grid = 0;
    if (grid == 0) {
        if (n_in != 16 || ws_size < OFF_END) { grid = -1; return; }
        int dev = 0, cus = 0, per_cu = 0;
        if (hipGetDevice(&dev) != hipSuccess || hipDeviceGetAttribute(&cus, hipDeviceAttributeMultiprocessorCount, dev) != hipSuccess) { grid = -1; return; }
        if (hipFuncSetAttribute((const void*)mega_fwd, hipFuncAttributeMaxDynamicSharedMemorySize, LDS_BYTES) != hipSuccess) { grid = -1; return; }
        if (hipOccupancyMaxActiveBlocksPerMultiprocessor(&per_cu, (const void*)mega_fwd, 512, LDS_BYTES) != hipSuccess || per_cu < 1) { (void)hipGetLastError(); }
        grid = cus;
    }
    if (grid < 0) return;
    if (hipMemsetAsync((char*)d_ws + OFF_CTL, 0, 65536, stream) != hipSuccess) return;
    Params p{};
    p.x = (const float*)d_in[0]; p.w_in = (const float*)d_in[1]; p.b_gate = (const float*)d_in[2]; p.sink = (const float*)d_in[3]; p.rpb = (const float*)d_in[4];
    p.w_a = (const float*)d_in[5]; p.w_b = (const float*)d_in[6]; p.w_c = (const float*)d_in[7]; p.w_out = (const float*)d_in[8]; p.norm_mix = (const float*)d_in[9];
    p.norm_ffn = (const float*)d_in[10]; p.w_router = (const float*)d_in[11]; p.w_gate_e = (const float*)d_in[12]; p.w_up_e = (const float*)d_in[13]; p.w_down_e = (const float*)d_in[14];
    p.norm_final = (const float*)d_in[15]; p.out = (float*)d_out; p.ws = (unsigned char*)d_ws;
    hipLaunchKernelGGL(mega_fwd, dim3(grid), dim3(512), LDS_BYTES, stream, p);
}
```

```cpp
#include <hip/hip_runtime.h>
#include <stdint.h>

#define DI __device__ __forceinline__
#define LAS __attribute__((address_space(3)))
typedef unsigned short bf16_t;
typedef short bf16x8 __attribute__((ext_vector_type(8)));
typedef float f32x2 __attribute__((ext_vector_type(2)));
typedef float f32x4 __attribute__((ext_vector_type(4)));
typedef float f32x16 __attribute__((ext_vector_type(16)));
typedef unsigned u32x2 __attribute__((ext_vector_type(2)));
typedef unsigned u32x4 __attribute__((ext_vector_type(4)));

constexpr int NTOK = 16384, DM = 1024, SEQ = 4096, NBATCH = 4, NLAYER = 4, NEXP = 16, FF = 2048, CAP = 512, PROJ = 5632;
constexpr int QKW = 1792;
constexpr int VCH = 768;
constexpr int OCW = 768;
constexpr int NROWS_E = NBATCH * CAP * NEXP;

constexpr size_t OFF_CTL = 0;
constexpr size_t OFF_COS = 65536;
constexpr size_t OFF_SIN = OFF_COS + (size_t)SEQ * 32 * 4;
constexpr size_t OFF_W   = 2u << 20;
constexpr size_t WIN_B = (size_t)4864 * 1024 * 2, WV_B = (size_t)768 * 1024 * 2, WM_B = (size_t)1024 * 768 * 2, WO_B = (size_t)1024 * 1024 * 2;
constexpr size_t WGU_B = (size_t)NEXP * 4096 * 1024 * 2, WD_B = (size_t)NEXP * 1024 * 2048 * 2;
constexpr size_t LW_WIN = 0, LW_WV = LW_WIN + WIN_B, LW_WM = LW_WV + WV_B, LW_WO = LW_WM + WM_B, LW_WGU = LW_WO + WO_B, LW_WD = LW_WGU + WGU_B, LW = LW_WD + WD_B;
constexpr size_t OFF_X   = OFF_W + NLAYER * LW;
constexpr size_t OFF_XN  = OFF_X + (size_t)NTOK * DM * 4;
constexpr size_t OFF_QK  = OFF_XN + (size_t)NTOK * DM * 2;
constexpr size_t OFF_VT  = OFF_QK + (size_t)NTOK * QKW * 2;
constexpr size_t OFF_G   = OFF_VT + (size_t)VCH * NTOK * 2;
constexpr size_t OFF_OC  = OFF_G + (size_t)NTOK * 3072 * 2;
constexpr size_t OFF_OB3 = OFF_OC + (size_t)NTOK * OCW * 2;
constexpr size_t OFF_LSE = OFF_OB3 + (size_t)3 * NTOK * 128 * 2;
constexpr size_t OFF_MG  = OFF_LSE + (size_t)3 * NTOK * 2 * 4;
constexpr size_t OFF_AFF = OFF_MG + (size_t)NTOK * DM * 2;
constexpr size_t OFF_IDX = OFF_AFF + (size_t)NTOK * NEXP * 4;
constexpr size_t OFF_VAL = OFF_IDX + (size_t)NROWS_E * 4;
constexpr size_t OFF_INV = OFF_VAL + (size_t)NROWS_E * 4;
constexpr size_t OFF_HID = OFF_INV + (size_t)NTOK * NEXP * 4;
constexpr size_t OFF_Y   = OFF_HID + (size_t)NROWS_E * FF * 2;
constexpr size_t OFF_XN8 = OFF_Y + (size_t)NROWS_E * DM * 2;
constexpr size_t OFF_END = OFF_XN8 + (size_t)NTOK * DM;

struct Params {
    const float *x, *w_in, *b_gate, *sink, *rpb, *w_a, *w_b, *w_c, *w_out, *norm_mix, *norm_ffn, *w_router, *w_gate_e, *w_up_e, *w_down_e, *norm_final;
    float* out; unsigned char* ws;
};
DI float*  P_COS(const Params& p) { return (float*)(p.ws + OFF_COS); }
DI float*  P_SIN(const Params& p) { return (float*)(p.ws + OFF_SIN); }
DI bf16_t* P_W(const Params& p, int l, size_t off) { return (bf16_t*)(p.ws + OFF_W + (size_t)l * LW + off); }
DI bf16_t* P_X(const Params& p) { return (bf16_t*)(p.ws + OFF_X); }
DI bf16_t* P_XN(const Params& p) { return (bf16_t*)(p.ws + OFF_XN); }
DI bf16_t* P_QK(const Params& p) { return (bf16_t*)(p.ws + OFF_QK); }
DI bf16_t* P_VT(const Params& p) { return (bf16_t*)(p.ws + OFF_VT); }
DI bf16_t* P_G(const Params& p) { return (bf16_t*)(p.ws + OFF_G); }
DI bf16_t* P_OC(const Params& p) { return (bf16_t*)(p.ws + OFF_OC); }
DI bf16_t* P_OB3(const Params& p) { return (bf16_t*)(p.ws + OFF_OB3); }
DI float*  P_LSE(const Params& p) { return (float*)(p.ws + OFF_LSE); }
DI bf16_t* P_MG(const Params& p) { return (bf16_t*)(p.ws + OFF_MG); }
DI float*  P_AFF(const Params& p) { return (float*)(p.ws + OFF_AFF); }
DI int*    P_IDX(const Params& p) { return (int*)(p.ws + OFF_IDX); }
DI float*  P_VAL(const Params& p) { return (float*)(p.ws + OFF_VAL); }
DI int*    P_INV(const Params& p) { return (int*)(p.ws + OFF_INV); }
DI bf16_t* P_HID(const Params& p) { return (bf16_t*)(p.ws + OFF_HID); }
DI bf16_t* P_Y(const Params& p) { return (bf16_t*)(p.ws + OFF_Y); }
DI unsigned char* P_XN8(const Params& p) { return p.ws + OFF_XN8; }

DI unsigned f2bf(float f) { unsigned u = __float_as_uint(f); return (u + 0x7fffu + ((u >> 16) & 1u)) >> 16; }
DI unsigned pk2(float lo, float hi) { return f2bf(lo) | (f2bf(hi) << 16); }
constexpr float W8_SCALE = 32.0f, H8_SCALE = 4.0f;
DI unsigned pk4_fp8(float a, float b, float c, float d) { unsigned w = 0u; w = __builtin_amdgcn_cvt_pk_fp8_f32(a, b, w, false); w = __builtin_amdgcn_cvt_pk_fp8_f32(c, d, w, true); return w; }
DI float bf2f(unsigned b) { return __uint_as_float(b << 16); }
DI float bflo(unsigned w) { return __uint_as_float(w << 16); }
DI float bfhi(unsigned w) { return __uint_as_float(w & 0xffff0000u); }
DI float shx(float v, int d, int lane) { return __uint_as_float((unsigned)__builtin_amdgcn_ds_bpermute((lane ^ d) << 2, (int)__float_as_uint(v))); }
DI unsigned shl_abs(unsigned v, int src_lane) { return (unsigned)__builtin_amdgcn_ds_bpermute(src_lane << 2, (int)v); }
DI int otid() { int t = threadIdx.x; asm volatile("" : "+v"(t)); return t; }
DI int pos16(int t) { return ((t & 15) << 8) | (t >> 4); }

constexpr int JOBS_PER_LAYER = 26432;
DI void prep_job(const Params& p, int l, int j, const float*& src, int& src_ld, bf16_t*& dst, int& dst_ld) {
    if (j < 1216) {
        const int nblk = j >> 3, kc = j & 7; int sc;
        if (nblk < 40) { const int t = nblk >> 3, sb = nblk & 7, bj = sb >> 2, wc = sb & 3, hr = 4 * t + wc;
            const int base = hr < 6 ? 64 * hr : hr < 8 ? 384 + 64 * (hr - 6) : hr < 14 ? 640 + 64 * (hr - 8) : 1024 + 64 * (hr - 14);
            sc = base + 32 * bj; }
        else if (nblk < 56) { const int c = 32 * (nblk - 40); sc = c < 256 ? 1792 + c : 2048 + (c - 256); }
        else sc = 2560 + 32 * (nblk - 56);
        src = p.w_in + (size_t)l * DM * PROJ + (size_t)(128 * kc) * PROJ + sc; src_ld = PROJ;
        dst = P_W(p, l, LW_WIN) + (size_t)(32 * nblk) * 1024 + 128 * kc; dst_ld = 1024; return;
    }
    j -= 1216;
    if (j < 192) {
        const int nblk = j >> 3, kc = j & 7, ch = 32 * nblk;
        const int sc = ch < 128 ? 512 + ch : ch < 256 ? 1408 + (ch - 128) : ch < 512 ? 2304 + (ch - 256) : 1536 + (ch - 512);
        src = p.w_in + (size_t)l * DM * PROJ + (size_t)(128 * kc) * PROJ + sc; src_ld = PROJ;
        dst = P_W(p, l, LW_WV) + (size_t)ch * 1024 + 128 * kc; dst_ld = 1024; return;
    }
    j -= 192;
    if (j < 192) {
        bf16_t* wm = P_W(p, l, LW_WM); src_ld = 1024; dst_ld = 768;
        if (j < 96) { const int nblk = j / 3, kc = j % 3; src = p.w_a + (size_t)l * 384 * 1024 + (size_t)(128 * kc) * 1024 + 32 * nblk; dst = wm + (size_t)(32 * nblk) * 768 + 128 * kc; }
        else if (j < 128) { const int nblk = j - 96; src = p.w_b + (size_t)l * 128 * 1024 + 32 * nblk; dst = wm + (size_t)(32 * nblk) * 768 + 384; }
        else { const int jj = j - 128, nblk = jj >> 1, kc = jj & 1; src = p.w_c + (size_t)l * 256 * 1024 + (size_t)(128 * kc) * 1024 + 32 * nblk; dst = wm + (size_t)(32 * nblk) * 768 + 512 + 128 * kc; }
        return;
    }
    j -= 192;
    if (j < 256) {
        const int nblk = j >> 3, kc = j & 7;
        src = p.w_out + (size_t)l * 1024 * 1024 + (size_t)(128 * kc) * 1024 + 32 * nblk; src_ld = 1024;
        dst = P_W(p, l, LW_WO) + (size_t)(32 * nblk) * 1024 + 128 * kc; dst_ld = 1024; return;
    }
    j -= 256;
    if (j < 16384) {
        const int e = j >> 10, r = j & 1023, nblk = r >> 3, kc = r & 7, row0 = 32 * nblk, pp = row0 >> 8, s = row0 & 255;
        const float* w = s < 128 ? p.w_gate_e : p.w_up_e; const int col = 128 * pp + (s & 127);
        src = w + ((size_t)(l * NEXP + e) * 1024 + 128 * kc) * 2048 + col; src_ld = 2048;
        dst = (bf16_t*)((unsigned char*)P_W(p, l, LW_WGU) + ((size_t)e * 4096 + row0) * 1024 + 128 * kc); dst_ld = 1024; return;
    }
    j -= 16384;
    {
        const int e = j >> 9, r = j & 511, nblk = r >> 4, kc = r & 15;
        src = p.w_down_e + ((size_t)(l * NEXP + e) * 2048 + 128 * kc) * 1024 + 32 * nblk; src_ld = 1024;
        dst = (bf16_t*)((unsigned char*)P_W(p, l, LW_WD) + ((size_t)e * 1024 + 32 * nblk) * 2048 + 128 * kc); dst_ld = 2048;
    }
}
DI void sincos_d(double a, double& s, double& c) {
    const double q = rint(a * 0.63661977236758134308);
    double r = fma(-q, 1.57079632679489655800e+00, a); r = fma(-q, 6.12323399573676603587e-17, r);
    const double r2 = r * r;
    double sp = 1.58969099521155010221e-10; sp = fma(sp, r2, -2.50507602534068634195e-08); sp = fma(sp, r2, 2.75573137070700676789e-06); sp = fma(sp, r2, -1.98412698298579493134e-04);
    sp = fma(sp, r2, 8.33333333332248946124e-03); sp = fma(sp, r2, -1.66666666666666324348e-01); const double sr = fma(r * r2, sp, r);
    double cp = -1.13596475577881948265e-11; cp = fma(cp, r2, 2.08757232129817482790e-09); cp = fma(cp, r2, -2.75573143513906633035e-07); cp = fma(cp, r2, 2.48015872894767294178e-05);
    cp = fma(cp, r2, -1.38888888888741095749e-03); cp = fma(cp, r2, 4.16666666666666019037e-02); const double cr = fma(r2 * r2, cp, fma(-0.5, r2, 1.0));
    const int qi = ((int)q) & 3;
    s = qi == 0 ? sr : qi == 1 ? cr : qi == 2 ? -sr : -cr;
    c = qi == 0 ? cr : qi == 1 ? -sr : qi == 2 ? -cr : sr;
}
DI void prep_phase(const Params& p, LAS float* scr) {
    const int tid = otid();
    for (int i = blockIdx.x * 512 + tid; i < SEQ * 32; i += gridDim.x * 512) {
        const int pos = i >> 5, j = i & 31;
        double fr = 1.0; for (int jj = 0; jj < j; ++jj) fr *= 0.7498942093324559;
        const float invf = (float)fr;
        const float ang = (float)pos * invf; double s, c; sincos_d((double)ang, s, c);
        P_COS(p)[i] = (float)c; P_SIN(p)[i] = (float)s;
    }
    const int total = NLAYER * JOBS_PER_LAYER;
    int u = blockIdx.x;
    const float* src; bf16_t* dst; int src_ld, dst_ld, j = 0;
    f32x4 r0, r1;
    if (u < total) { const int l = u / JOBS_PER_LAYER; j = u - l * JOBS_PER_LAYER; prep_job(p, l, j, src, src_ld, dst, dst_ld);
        r0 = *(const f32x4*)(src + (size_t)(tid >> 3) * src_ld + 4 * (tid & 7)); r1 = *(const f32x4*)(src + (size_t)((tid + 512) >> 3) * src_ld + 4 * (tid & 7)); }
    int buf = 0;
    for (; u < total; u += gridDim.x) {
        LAS float* sc = scr + buf * (128 * 33);
        { const int k = tid >> 3, c4 = tid & 7;
          sc[k * 33 + 4 * c4 + 0] = r0[0]; sc[k * 33 + 4 * c4 + 1] = r0[1]; sc[k * 33 + 4 * c4 + 2] = r0[2]; sc[k * 33 + 4 * c4 + 3] = r0[3];
          sc[(k + 64) * 33 + 4 * c4 + 0] = r1[0]; sc[(k + 64) * 33 + 4 * c4 + 1] = r1[1]; sc[(k + 64) * 33 + 4 * c4 + 2] = r1[2]; sc[(k + 64) * 33 + 4 * c4 + 3] = r1[3]; }
        bf16_t* dcur = dst; const int dld = dst_ld, jcur = j;
        const int un = u + gridDim.x;
        if (un < total) { const int l = un / JOBS_PER_LAYER; j = un - l * JOBS_PER_LAYER; prep_job(p, l, j, src, src_ld, dst, dst_ld);
            r0 = *(const f32x4*)(src + (size_t)(tid >> 3) * src_ld + 4 * (tid & 7)); r1 = *(const f32x4*)(src + (size_t)((tid + 512) >> 3) * src_ld + 4 * (tid & 7)); }
        __syncthreads();
        { const int n = tid >> 4, k8 = (tid & 15) * 8;
          if (jcur >= 1856) {
            u32x2 w; w[0] = pk4_fp8(sc[(k8 + 0) * 33 + n] * W8_SCALE, sc[(k8 + 1) * 33 + n] * W8_SCALE, sc[(k8 + 2) * 33 + n] * W8_SCALE, sc[(k8 + 3) * 33 + n] * W8_SCALE);
            w[1] = pk4_fp8(sc[(k8 + 4) * 33 + n] * W8_SCALE, sc[(k8 + 5) * 33 + n] * W8_SCALE, sc[(k8 + 6) * 33 + n] * W8_SCALE, sc[(k8 + 7) * 33 + n] * W8_SCALE);
            *(u32x2*)((unsigned char*)dcur + (size_t)n * dld + k8) = w;
          } else { u32x4 w;
            w[0] = pk2(sc[(k8 + 0) * 33 + n], sc[(k8 + 1) * 33 + n]); w[1] = pk2(sc[(k8 + 2) * 33 + n], sc[(k8 + 3) * 33 + n]);
            w[2] = pk2(sc[(k8 + 4) * 33 + n], sc[(k8 + 5) * 33 + n]); w[3] = pk2(sc[(k8 + 6) * 33 + n], sc[(k8 + 7) * 33 + n]);
            *(u32x4*)(dcur + (size_t)n * dld + k8) = w; } }
        buf ^= 1;
    }
    __syncthreads();
}

DI int eo4(int lane, int i) { return 8 * lane + 512 * (i >> 1) + 4 * (i & 1); }
DI void unpk8(f32x4& a, f32x4& b, const u32x4& w) { a[0] = bflo(w[0]); a[1] = bfhi(w[0]); a[2] = bflo(w[1]); a[3] = bfhi(w[1]); b[0] = bflo(w[2]); b[1] = bfhi(w[2]); b[2] = bflo(w[3]); b[3] = bfhi(w[3]); }
DI void add8(f32x4& a, f32x4& b, const u32x4& w) { a[0] += bflo(w[0]); a[1] += bfhi(w[0]); a[2] += bflo(w[1]); a[3] += bfhi(w[1]); b[0] += bflo(w[2]); b[1] += bfhi(w[2]); b[2] += bflo(w[3]); b[3] += bfhi(w[3]); }
DI u32x4 pk8(const f32x4& a, const f32x4& b) { u32x4 w; w[0] = pk2(a[0], a[1]); w[1] = pk2(a[2], a[3]); w[2] = pk2(b[0], b[1]); w[3] = pk2(b[2], b[3]); return w; }
template <int MODE> DI void norm1_phase(const Params& p, int l) {
    const int tid = otid(), lane = tid & 63, wid = tid >> 6;
    const float* gain = MODE == 2 ? p.norm_final : p.norm_mix + (size_t)l * DM;
    f32x4 g[4];
#pragma unroll
    for (int i = 0; i < 4; ++i) g[i] = *(const f32x4*)(gain + eo4(lane, i));
    const int nw = gridDim.x * 8;
    for (int row0 = blockIdx.x * 8 + wid; row0 < NTOK; row0 += 2 * nw) {
        const int row1 = row0 + nw;
        f32x4 v0[4], v1[4];
        if (MODE == 0) {
#pragma unroll
            for (int i = 0; i < 4; ++i) { v0[i] = *(const f32x4*)(p.x + (size_t)row0 * DM + eo4(lane, i)); v1[i] = *(const f32x4*)(p.x + (size_t)row1 * DM + eo4(lane, i)); }
        } else {
            u32x4 a[2], b[2];
#pragma unroll
            for (int j = 0; j < 2; ++j) { a[j] = *(const u32x4*)(P_X(p) + (size_t)row0 * DM + 8 * lane + 512 * j); b[j] = *(const u32x4*)(P_X(p) + (size_t)row1 * DM + 8 * lane + 512 * j); }
            const int c0 = lane < NEXP ? P_INV(p)[(size_t)row0 * NEXP + lane] : -1, c1 = lane < NEXP ? P_INV(p)[(size_t)row1 * NEXP + lane] : -1;
#pragma unroll
            for (int j = 0; j < 2; ++j) { unpk8(v0[2 * j], v0[2 * j + 1], a[j]); unpk8(v1[2 * j], v1[2 * j + 1], b[j]); }
            unsigned long long m0 = __ballot(c0 >= 0), m1 = __ballot(c1 >= 0);
            const bf16_t* ybase0 = P_Y(p) + (size_t)((row0 >> 12) * CAP) * DM; const bf16_t* ybase1 = P_Y(p) + (size_t)((row1 >> 12) * CAP) * DM;
            while (m0 | m1) {
                u32x4 w0[2], w1[2]; const bool h0 = m0 != 0ull, h1 = m1 != 0ull;
                if (h0) { const int e = __builtin_ctzll(m0); m0 &= m0 - 1ull; const int c = __builtin_amdgcn_readlane(c0, e); const bf16_t* yr = ybase0 + (size_t)(e * NBATCH * CAP + c) * DM;
#pragma unroll
                    for (int j = 0; j < 2; ++j) w0[j] = *(const u32x4*)(yr + 8 * lane + 512 * j); }
                if (h1) { const int e = __builtin_ctzll(m1); m1 &= m1 - 1ull; const int c = __builtin_amdgcn_readlane(c1, e); const bf16_t* yr = ybase1 + (size_t)(e * NBATCH * CAP + c) * DM;
#pragma unroll
                    for (int j = 0; j < 2; ++j) w1[j] = *(const u32x4*)(yr + 8 * lane + 512 * j); }
                if (h0) {
#pragma unroll
                    for (int j = 0; j < 2; ++j) add8(v0[2 * j], v0[2 * j + 1], w0[j]); }
                if (h1) {
#pragma unroll
                    for (int j = 0; j < 2; ++j) add8(v1[2 * j], v1[2 * j + 1], w1[j]); }
            }
        }
        if (MODE != 2) {
#pragma unroll
            for (int j = 0; j < 2; ++j) { *(u32x4*)(P_X(p) + (size_t)row0 * DM + 8 * lane + 512 * j) = pk8(v0[2 * j], v0[2 * j + 1]); *(u32x4*)(P_X(p) + (size_t)row1 * DM + 8 * lane + 512 * j) = pk8(v1[2 * j], v1[2 * j + 1]); }
        }
        float s0 = 0.f, s1 = 0.f;
#pragma unroll
        for (int i = 0; i < 4; ++i) { s0 += v0[i][0] * v0[i][0] + v0[i][1] * v0[i][1] + v0[i][2] * v0[i][2] + v0[i][3] * v0[i][3]; s1 += v1[i][0] * v1[i][0] + v1[i][1] * v1[i][1] + v1[i][2] * v1[i][2] + v1[i][3] * v1[i][3]; }
#pragma unroll
        for (int d = 32; d >= 1; d >>= 1) { s0 += shx(s0, d, lane); s1 += shx(s1, d, lane); }
        const float r0 = rsqrtf(s0 * (1.0f / DM) + 1e-6f), r1 = rsqrtf(s1 * (1.0f / DM) + 1e-6f);
#pragma unroll
        for (int i = 0; i < 4; ++i) { v0[i] = v0[i] * r0 * g[i]; v1[i] = v1[i] * r1 * g[i]; }
        if (MODE == 2) {
#pragma unroll
            for (int i = 0; i < 4; ++i) { *(f32x4*)(p.out + (size_t)row0 * DM + eo4(lane, i)) = v0[i]; *(f32x4*)(p.out + (size_t)row1 * DM + eo4(lane, i)) = v1[i]; }
        } else {
#pragma unroll
            for (int j = 0; j < 2; ++j) { *(u32x4*)(P_XN(p) + (size_t)row0 * DM + 8 * lane + 512 * j) = pk8(v0[2 * j], v0[2 * j + 1]); *(u32x4*)(P_XN(p) + (size_t)row1 * DM + 8 * lane + 512 * j) = pk8(v1[2 * j], v1[2 * j + 1]); }
        }
    }
}

DI float reduce16(const float (&a)[16], int lane) {
    float b8[8], b4[4], b2[2];
    { const bool hi = (lane & 32) != 0;
#pragma unroll
      for (int j = 0; j < 8; ++j) { const float snd = hi ? a[j] : a[j + 8], kp = hi ? a[j + 8] : a[j]; b8[j] = kp + shx(snd, 32, lane); } }
    { const bool hi = (lane & 16) != 0;
#pragma unroll
      for (int j = 0; j < 4; ++j) { const float snd = hi ? b8[j] : b8[j + 4], kp = hi ? b8[j + 4] : b8[j]; b4[j] = kp + shx(snd, 16, lane); } }
    { const bool hi = (lane & 8) != 0;
#pragma unroll
      for (int j = 0; j < 2; ++j) { const float snd = hi ? b4[j] : b4[j + 2], kp = hi ? b4[j + 2] : b4[j]; b2[j] = kp + shx(snd, 8, lane); } }
    float r;
    { const bool hi = (lane & 4) != 0; const float snd = hi ? b2[0] : b2[1], kp = hi ? b2[1] : b2[0]; r = kp + shx(snd, 4, lane); }
    r += shx(r, 2, lane); r += shx(r, 1, lane);
    return r;
}
DI void norm2_router_phase(const Params& p, int l, LAS float* wr) {
    const int tid = otid(), lane = tid & 63, wid = tid >> 6;
    for (int i = tid; i < DM * NEXP; i += 512) { const int d = i >> 4;
        wr[(i & 15) * DM + ((d >> 9) * 2 + ((d >> 2) & 1)) * 256 + 4 * ((d & 511) >> 3) + (d & 3)] = p.w_router[(size_t)l * DM * NEXP + i]; }
    __syncthreads();
    const float* gain = p.norm_ffn + (size_t)l * DM;
    f32x4 g[4];
#pragma unroll
    for (int i = 0; i < 4; ++i) g[i] = *(const f32x4*)(gain + eo4(lane, i));
    const int nw = gridDim.x * 8;
    for (int row0 = blockIdx.x * 8 + wid; row0 < NTOK; row0 += 2 * nw) {
        const int row1 = row0 + nw;
        f32x4 v0[4], v1[4]; float s0 = 0.f, s1 = 0.f;
        { u32x4 a[2], b[2];
#pragma unroll
          for (int j = 0; j < 2; ++j) { a[j] = *(const u32x4*)(P_X(p) + (size_t)row0 * DM + 8 * lane + 512 * j); b[j] = *(const u32x4*)(P_X(p) + (size_t)row1 * DM + 8 * lane + 512 * j); }
#pragma unroll
          for (int j = 0; j < 2; ++j) { unpk8(v0[2 * j], v0[2 * j + 1], a[j]); unpk8(v1[2 * j], v1[2 * j + 1], b[j]); } }
#pragma unroll
        for (int i = 0; i < 4; ++i) { s0 += v0[i][0] * v0[i][0] + v0[i][1] * v0[i][1] + v0[i][2] * v0[i][2] + v0[i][3] * v0[i][3]; s1 += v1[i][0] * v1[i][0] + v1[i][1] * v1[i][1] + v1[i][2] * v1[i][2] + v1[i][3] * v1[i][3]; }
#pragma unroll
        for (int d = 32; d >= 1; d >>= 1) { s0 += shx(s0, d, lane); s1 += shx(s1, d, lane); }
        const float r0 = rsqrtf(s0 * (1.0f / DM) + 1e-6f), r1 = rsqrtf(s1 * (1.0f / DM) + 1e-6f);
#pragma unroll
        for (int i = 0; i < 4; ++i) { v0[i] = v0[i] * r0 * g[i]; v1[i] = v1[i] * r1 * g[i]; }
#pragma unroll
        for (int j = 0; j < 2; ++j) { u32x2 w;
            w[0] = pk4_fp8(v0[2 * j][0], v0[2 * j][1], v0[2 * j][2], v0[2 * j][3]); w[1] = pk4_fp8(v0[2 * j + 1][0], v0[2 * j + 1][1], v0[2 * j + 1][2], v0[2 * j + 1][3]);
            *(u32x2*)(P_XN8(p) + (size_t)row0 * DM + 8 * lane + 512 * j) = w;
            w[0] = pk4_fp8(v1[2 * j][0], v1[2 * j][1], v1[2 * j][2], v1[2 * j][3]); w[1] = pk4_fp8(v1[2 * j + 1][0], v1[2 * j + 1][1], v1[2 * j + 1][2], v1[2 * j + 1][3]);
            *(u32x2*)(P_XN8(p) + (size_t)row1 * DM + 8 * lane + 512 * j) = w; }
        float a0[NEXP], a1[NEXP];
#pragma unroll
        for (int e = 0; e < NEXP; ++e) { float x0 = 0.f, x1 = 0.f;
#pragma unroll
            for (int i = 0; i < 4; ++i) { const f32x4 w = *(const LAS f32x4*)(wr + e * DM + 4 * lane + 256 * i);
                x0 += v0[i][0] * w[0] + v0[i][1] * w[1] + v0[i][2] * w[2] + v0[i][3] * w[3]; x1 += v1[i][0] * w[0] + v1[i][1] * w[1] + v1[i][2] * w[2] + v1[i][3] * w[3]; }
            a0[e] = x0; a1[e] = x1;
            if ((e & 3) == 3) __builtin_amdgcn_sched_barrier(0); }
        const float l0 = reduce16(a0, lane), l1 = reduce16(a1, lane);
        float m0 = l0, m1 = l1;
#pragma unroll
        for (int d = 32; d >= 4; d >>= 1) { m0 = fmaxf(m0, shx(m0, d, lane)); m1 = fmaxf(m1, shx(m1, d, lane)); }
        const float e0 = __expf(l0 - m0), e1 = __expf(l1 - m1); float d0 = e0, d1 = e1;
#pragma unroll
        for (int d = 32; d >= 4; d >>= 1) { d0 += shx(d0, d, lane); d1 += shx(d1, d, lane); }
        if ((lane & 3) == 0) { const int e = lane >> 2;
            P_AFF(p)[((size_t)((row0 >> 12) * NEXP + e)) * SEQ + (row0 & 4095)] = e0 / d0; P_AFF(p)[((size_t)((row1 >> 12) * NEXP + e)) * SEQ + (row1 & 4095)] = e1 / d1; }
    }
}

DI void topk_phase(const Params& p, LAS unsigned* lds) {
    const int tid = otid(), lane = tid & 63, wid = tid >> 6;
    LAS unsigned* hist = lds; LAS unsigned* sh = lds + 256; LAS unsigned* wtot = lds + 272;
    for (int be = blockIdx.x; be < NBATCH * NEXP; be += gridDim.x) {
        const int b = be >> 4, e = be & 15;
        const float* aff = P_AFF(p) + (size_t)be * SEQ + tid * 8;
        const f32x4 a0 = *(const f32x4*)aff, a1 = *(const f32x4*)(aff + 4);
        unsigned key[8];
#pragma unroll
        for (int i = 0; i < 4; ++i) { key[i] = __float_as_uint(a0[i]); key[4 + i] = __float_as_uint(a1[i]); }
        unsigned prefix = 0u, mask = 0u, krem = CAP;
        for (int pass = 3; pass >= 0; --pass) {
            const int shift = 8 * pass;
            if (tid < 256) hist[tid] = 0u;
            __syncthreads();
#pragma unroll
            for (int i = 0; i < 8; ++i) if ((key[i] & mask) == prefix) atomicAdd((unsigned*)&hist[(key[i] >> shift) & 255u], 1u);
            __syncthreads();
            if (wid == 0) {
                const unsigned h0 = hist[4 * lane], h1 = hist[4 * lane + 1], h2 = hist[4 * lane + 2], h3 = hist[4 * lane + 3], s = h0 + h1 + h2 + h3;
                unsigned suf = s;
#pragma unroll
                for (int d = 1; d < 64; d <<= 1) { const unsigned t = shl_abs(suf, (lane + d) & 63); if (lane + d < 64) suf += t; }
                const unsigned above = suf - s;
                if (above < krem && krem <= suf) {
                    unsigned a = above; unsigned bin, nk;
                    if (a + h3 >= krem) { bin = 4 * lane + 3; nk = krem - a; }
                    else { a += h3; if (a + h2 >= krem) { bin = 4 * lane + 2; nk = krem - a; }
                        else { a += h2; if (a + h1 >= krem) { bin = 4 * lane + 1; nk = krem - a; } else { a += h1; bin = 4 * lane; nk = krem - a; } } }
                    sh[0] = prefix | (bin << shift); sh[1] = nk;
                }
            }
            __syncthreads();
            prefix = sh[0]; krem = sh[1]; mask |= 0xFFu << shift;
            __syncthreads();
        }
        unsigned cg = 0u, ce = 0u;
#pragma unroll
        for (int i = 0; i < 8; ++i) { cg += key[i] > prefix ? 1u : 0u; ce += key[i] == prefix ? 1u : 0u; }
        unsigned pk = cg | (ce << 16), incl = pk;
#pragma unroll
        for (int d = 1; d < 64; d <<= 1) { const unsigned t = shl_abs(incl, (lane - d) & 63); if (lane >= d) incl += t; }
        if (lane == 63) wtot[wid] = incl;
        __syncthreads();
        unsigned woff = 0u;
#pragma unroll
        for (int w = 0; w < 8; ++w) woff += w < wid ? wtot[w] : 0u;
        const unsigned excl = woff + incl - pk;
        unsigned gtb = excl & 0xffffu, eqb = excl >> 16;
        int* idxo = P_IDX(p) + (size_t)(e * NBATCH + b) * CAP; float* valo = P_VAL(p) + (size_t)(e * NBATCH + b) * CAP;
        int* inv = P_INV(p) + ((size_t)b * SEQ + tid * 8) * NEXP + e;
#pragma unroll
        for (int i = 0; i < 8; ++i) {
            int slot = -1;
            if (key[i] > prefix) { slot = (int)(gtb + (eqb < krem ? eqb : krem)); ++gtb; }
            else if (key[i] == prefix) { if (eqb < krem) slot = (int)(gtb + eqb); ++eqb; }
            if (slot >= 0) { idxo[slot] = tid * 8 + i; valo[slot] = __uint_as_float(key[i]); }
            inv[(size_t)i * NEXP] = slot;
        }
        __syncthreads();
    }
}

namespace at {
constexpr int NUNIT_A = 1536, NUNIT_C = 1024, NUNIT_B = 1536, NUNIT = NUNIT_A + NUNIT_C + NUNIT_B;
DI unsigned cvt2(float lo, float hi) { typedef __bf16 bf2_t __attribute__((ext_vector_type(2))); const f32x2 v = {lo, hi}; const bf2_t b = __builtin_convertvector(v, bf2_t); return __builtin_bit_cast(unsigned, b); }
DI bf16x8 pack8(const f32x16& x, int s8) { u32x4 w; w[0] = cvt2(x[s8 + 0], x[s8 + 1]); w[1] = cvt2(x[s8 + 2], x[s8 + 3]); w[2] = cvt2(x[s8 + 4], x[s8 + 5]); w[3] = cvt2(x[s8 + 6], x[s8 + 7]); return __builtin_bit_cast(bf16x8, w); }
DI int koffmap(int r, bool g1) { return g1 ? 4 * (4 * ((r >> 3) & 1) + (r & 3)) + 2 * (r >> 4) + ((r >> 2) & 1) : (r & 16) + 8 * ((r >> 2) & 1) + 4 * ((r >> 3) & 1) + (r & 3); }

DI float xh_max(float v) { const auto r = __builtin_amdgcn_permlane32_swap(__float_as_uint(v), __float_as_uint(v), false, false); return fmaxf(__uint_as_float(r[0]), __uint_as_float(r[1])); }
DI float xh_sum(float v) { const auto r = __builtin_amdgcn_permlane32_swap(__float_as_uint(v), __float_as_uint(v), false, false); return __uint_as_float(r[0]) + __uint_as_float(r[1]); }
constexpr float LOG2E = 1.4426950408889634f, LN2 = 0.6931471805599453f;
struct QState { float m, den; f32x16 O0, O1; };
DI void softmax_tile(f32x16& S, QState& st, bf16x8& p0, bf16x8& p1) {
    float mx = fmaxf(S[0], S[1]);
#pragma unroll
    for (int i = 2; i < 16; i += 2) mx = fmaxf(mx, fmaxf(S[i], S[i + 1]));
    mx = xh_max(mx);
    const float mn = fmaxf(st.m, mx), alpha = __builtin_amdgcn_exp2f(st.m - mn);
    float ps = 0.f;
#pragma unroll
    for (int i = 0; i < 16; ++i) { S[i] = __builtin_amdgcn_exp2f(S[i] - mn); ps += S[i]; }
    ps = xh_sum(ps);
    st.den = st.den * alpha + ps; st.m = mn;
#pragma unroll
    for (int i = 0; i < 16; ++i) { st.O0[i] *= alpha; st.O1[i] *= alpha; }
    p0 = pack8(S, 0); p1 = pack8(S, 8);
}
template <int MODE> DI void mask_tile(f32x16& S, int tn, int NT, int q, int h, int t, int qrow, int sr_q, int sc_q, int kc0, int qcg, const LAS float* bt_head) {
    if (MODE == 3) {
        const bool rowok = t >= sr_q && t < sr_q + 8; const LAS float* bt = bt_head + (t - qrow + 7) * 31 + 15 - qcg;
#pragma unroll
        for (int i = 0; i < 16; ++i) { const int kc = kc0 + 16 * (i >> 3) + 8 * h + (i & 7); const bool ok = rowok && kc >= sc_q && kc < sc_q + 16;
            const int bi = ok ? kc : qcg; S[i] = ok ? S[i] + bt[bi] : -1e37f; }
    } else {
        const int edge = tn == 0 ? 1 : tn == NT - 1 ? 2 : 0;
        if (edge != 0) {
            int qq = MODE == 2 ? q - h : q - 8 * h; asm volatile("" : "+v"(qq));
            if (edge == 1) {
#pragma unroll
                for (int i = 0; i < 16; ++i) { const int kc_ = MODE == 2 ? 4 * (i & 7) + 2 * (i >> 3) : 16 * (i >> 3) + (i & 7); S[i] = kc_ >= qq ? S[i] : -1e37f; }
            } else {
#pragma unroll
                for (int i = 0; i < 16; ++i) { const int kc_ = MODE == 2 ? 4 * (i & 7) + 2 * (i >> 3) : 16 * (i >> 3) + (i & 7); S[i] = kc_ <= qq ? S[i] : -1e37f; }
            }
        }
    }
}
template <int MODE> DI void wave_unit(const Params& p, int l, int u, const LAS float* rpb_lds, LAS unsigned char* ring, int lane) {
    const int q = lane & 31, h = lane >> 5;
    const bf16_t* QK = P_QK(p); const bf16_t* VT = P_VT(p);
    int b, qcol, kcol, vch, dil = 1, rho = 0, Jq = 0, L = SEQ, vs0 = 0, g = 0, hs = 0, hq = 0;
    constexpr int W = MODE == 0 ? 128 : 64, NT = MODE == 0 ? 9 : 5;
    int qcg = 0, kc0 = 0, kr_lo = 0, kr_hi = 0, r00 = 0;
    if (MODE == 0) { const int gg = u % 3, qp = (u / 3) & 63, kvh = (u / 192) & 1; b = u / 384; hq = kvh * 3 + gg; qcol = 64 * hq; kcol = 384 + 64 * kvh; vch = 64 * kvh; Jq = 64 * qp; }
    else if (MODE == 1 || MODE == 2) { const int qt6 = u & 63; hs = (u >> 6) & 1; g = (u >> 7) % 3; b = u / 384; qcol = 512 + 128 * g + 64 * hs; kcol = 896 + 128 * g + 64 * hs;
        vch = g == 0 ? 128 + 64 * hs : g == 1 ? 512 + 64 * hs : 640 + 64 * hs;
        if (g == 0) { Jq = 64 * qt6; } else if (g == 1) { dil = 4; rho = qt6 >> 4; Jq = 64 * (qt6 & 15); L = 1024; } else { dil = 16; rho = qt6 >> 2; Jq = 64 * (qt6 & 3); L = 256; vs0 = rho * 256; } }
    else { const int qt6 = u & 63, hh = (u >> 6) & 3, gr4 = qt6 >> 2, cb = qt6 & 3; b = u >> 8; hq = hh; qcol = 1280 + 64 * hh; kcol = 1536 + 64 * hh; vch = 256 + 64 * hh;
        r00 = 4 * gr4; qcg = 16 * cb + (q & 15); kc0 = cb == 0 ? 0 : cb == 3 ? 32 : 16 * cb - 8;
        const int s0 = r00 - 4 < 0 ? 0 : r00 - 4 > 56 ? 56 : r00 - 4, s3 = r00 - 1 < 0 ? 0 : r00 - 1 > 56 ? 56 : r00 - 1; kr_lo = s0; kr_hi = s3 + 8; }
    int t_lo, t_hi; unsigned kdma[4], vdma[4], kstep_t, vstep_t;
    if (MODE == 3) { t_lo = kr_lo; t_hi = kr_hi; kstep_t = 64u * QKW; vstep_t = 64; }
    else { t_lo = (W - Jq + 31) >> 5; if (t_lo < 0) t_lo = 0; t_hi = (L + W - Jq) >> 5; if (t_hi > NT + 1) t_hi = NT + 1; kstep_t = 32u * dil * QKW; vstep_t = MODE == 2 ? 8 : 32; }
#pragma unroll
    for (int i = 0; i < 4; ++i) {
        const int r = 8 * i + (lane >> 3), c8 = (lane & 7) ^ ((r >> 1) & 7), ko = koffmap(r, MODE == 2);
        const int ktok = MODE == 3 ? b * SEQ + kc0 + ko : b * SEQ + (Jq - W + ko) * dil + rho;
        kdma[i] = (unsigned)ktok * QKW + kcol + 8 * c8;
        const int d = 16 * i + (lane >> 2), ch = (lane & 3) ^ ((d >> 2) & 3);
        const int vslot = MODE == 3 ? b * SEQ + kc0 + 8 * ch : MODE == 2 ? b * SEQ + ch * 1024 + rho * 256 + ((Jq - W) >> 2) : b * SEQ + vs0 + (Jq - W) + 8 * ch;
        vdma[i] = (unsigned)(vch + d) * NTOK + vslot;
    }
#define AT_DMA(t, buf) do { const unsigned kt_ = (unsigned)(t) * kstep_t, vt_ = (unsigned)(t) * vstep_t; LAS unsigned char* bb_ = ring + (buf) * 8192; \
        _Pragma("unroll") for (int i_ = 0; i_ < 4; ++i_) __builtin_amdgcn_global_load_lds((const unsigned*)(QK + (unsigned)(kdma[i_] + kt_)), (LAS unsigned*)(bb_ + i_ * 1024), 16, 0, 0); \
        _Pragma("unroll") for (int i_ = 0; i_ < 4; ++i_) __builtin_amdgcn_global_load_lds((const unsigned*)(VT + (unsigned)(vdma[i_] + vt_)), (LAS unsigned*)(bb_ + 4096 + i_ * 1024), 16, 0, 0); } while (0)
    AT_DMA(t_lo, 0);
    int kaddr[4], vaddr[2][2];
#pragma unroll
    for (int c = 0; c < 4; ++c) kaddr[c] = q * 128 + (((2 * c + h) ^ ((q >> 1) & 7)) << 4);
#pragma unroll
    for (int dh = 0; dh < 2; ++dh)
#pragma unroll
        for (int sx = 0; sx < 2; ++sx) vaddr[dh][sx] = 4096 + (32 * dh + q) * 64 + (((2 * sx + h) ^ ((q >> 2) & 3)) << 4);
    int tokq[2]; bf16x8 qf[2][4]; QState st[2];
#pragma unroll
    for (int n = 0; n < 2; ++n) {
        tokq[n] = MODE == 3 ? b * SEQ + (r00 + 2 * n + (q >> 4)) * 64 + qcg : b * SEQ + (Jq + 32 * n + q) * dil + rho;
        const bf16_t* qp = QK + (size_t)tokq[n] * QKW + qcol + 8 * h;
#pragma unroll
        for (int c = 0; c < 4; ++c) qf[n][c] = *(const bf16x8*)(qp + 16 * c);
        st[n].m = -1e30f; st[n].den = 0.f;
        if (MODE == 0) { st[n].m = p.sink[l * 6 + hq] * LOG2E; st[n].den = 1.0f; }
#pragma unroll
        for (int i = 0; i < 16; ++i) { st[n].O0[i] = 0.f; st[n].O1[i] = 0.f; }
    }
    int sc_q = 0, qrow0 = 0, qrow1 = 0, srq0 = 0, srq1 = 0, lo0 = 0, hi0 = 0, lo1 = 0, hi1 = 0;
    if (MODE == 3) { sc_q = qcg - 8 < 0 ? 0 : qcg - 8 > 48 ? 48 : qcg - 8;
        qrow0 = r00 + (q >> 4); qrow1 = qrow0 + 2; srq0 = qrow0 - 4 < 0 ? 0 : qrow0 - 4 > 56 ? 56 : qrow0 - 4; srq1 = qrow1 - 4 < 0 ? 0 : qrow1 - 4 > 56 ? 56 : qrow1 - 4;
        lo0 = r00 - 4 < 0 ? 0 : r00 - 4 > 56 ? 56 : r00 - 4; hi0 = (r00 - 3 < 0 ? 0 : r00 - 3 > 56 ? 56 : r00 - 3) + 8; lo1 = r00 - 2 < 0 ? 0 : r00 - 2 > 56 ? 56 : r00 - 2; hi1 = (r00 - 1 < 0 ? 0 : r00 - 1 > 56 ? 56 : r00 - 1) + 8; }
    const LAS float* bt_head = rpb_lds + hq * 465;
#define AT_S(S, n) do { _Pragma("unroll") for (int i_ = 0; i_ < 16; ++i_) S[i_] = 0.f; _Pragma("unroll") for (int c_ = 0; c_ < 4; ++c_) S = __builtin_amdgcn_mfma_f32_32x32x16_bf16(kf[c_], qf[n][c_], S, 0, 0, 0); } while (0)
#define AT_PV(n, p0, p1) do { st[n].O0 = __builtin_amdgcn_mfma_f32_32x32x16_bf16(vf[0][0], p0, st[n].O0, 0, 0, 0); st[n].O0 = __builtin_amdgcn_mfma_f32_32x32x16_bf16(vf[0][1], p1, st[n].O0, 0, 0, 0); \
        st[n].O1 = __builtin_amdgcn_mfma_f32_32x32x16_bf16(vf[1][0], p0, st[n].O1, 0, 0, 0); st[n].O1 = __builtin_amdgcn_mfma_f32_32x32x16_bf16(vf[1][1], p1, st[n].O1, 0, 0, 0); } while (0)
    for (int t = t_lo; t < t_hi; ++t) {
        const int buf = (t - t_lo) & 1;
        if (t + 1 < t_hi) { AT_DMA(t + 1, buf ^ 1); asm volatile("s_waitcnt vmcnt(8)" ::: "memory"); }
        else asm volatile("s_waitcnt vmcnt(0)" ::: "memory");
        const LAS unsigned char* bb = ring + buf * 8192;
        const bool act0 = MODE == 3 ? (t >= lo0 && t < hi0) : (t < NT), act1 = MODE == 3 ? (t >= lo1 && t < hi1) : (t >= 1);
        bf16x8 kf[4], vf[2][2];
#pragma unroll
        for (int c = 0; c < 4; ++c) kf[c] = *(const LAS bf16x8*)(bb + kaddr[c]);
        if (act0 && act1) {
            f32x16 S0, S1; AT_S(S0, 0); AT_S(S1, 1);
            mask_tile<MODE>(S0, t, NT, q, h, t, qrow0, srq0, sc_q, kc0, qcg, bt_head); mask_tile<MODE>(S1, t - 1, NT, q, h, t, qrow1, srq1, sc_q, kc0, qcg, bt_head);
            bf16x8 pa0, pa1, pb0, pb1;
            softmax_tile(S0, st[0], pa0, pa1); softmax_tile(S1, st[1], pb0, pb1);
            __builtin_amdgcn_sched_barrier(0);
#pragma unroll
            for (int dh = 0; dh < 2; ++dh)
#pragma unroll
                for (int sx = 0; sx < 2; ++sx) vf[dh][sx] = *(const LAS bf16x8*)(bb + vaddr[dh][sx]);
            AT_PV(0, pa0, pa1); AT_PV(1, pb0, pb1);
        } else if (act0) {
            f32x16 S0; AT_S(S0, 0);
#pragma unroll
            for (int dh = 0; dh < 2; ++dh)
#pragma unroll
                for (int sx = 0; sx < 2; ++sx) vf[dh][sx] = *(const LAS bf16x8*)(bb + vaddr[dh][sx]);
            mask_tile<MODE>(S0, t, NT, q, h, t, qrow0, srq0, sc_q, kc0, qcg, bt_head);
            bf16x8 pa0, pa1; softmax_tile(S0, st[0], pa0, pa1); AT_PV(0, pa0, pa1);
        } else if (act1) {
            f32x16 S1; AT_S(S1, 1);
#pragma unroll
            for (int dh = 0; dh < 2; ++dh)
#pragma unroll
                for (int sx = 0; sx < 2; ++sx) vf[dh][sx] = *(const LAS bf16x8*)(bb + vaddr[dh][sx]);
            mask_tile<MODE>(S1, t - 1, NT, q, h, t, qrow1, srq1, sc_q, kc0, qcg, bt_head);
            bf16x8 pb0, pb1; softmax_tile(S1, st[1], pb0, pb1); AT_PV(1, pb0, pb1);
        }
    }
#undef AT_DMA
#undef AT_S
#undef AT_PV
#pragma unroll
    for (int n = 0; n < 2; ++n) {
        const float rd = 1.0f / st[n].den;
        bf16_t* op;
        if (MODE == 1 || MODE == 2) { op = P_OB3(p) + ((size_t)g * NTOK + tokq[n]) * 128 + 64 * hs; if (h == 0) P_LSE(p)[((size_t)g * NTOK + tokq[n]) * 2 + hs] = (st[n].m + __log2f(st[n].den)) * LN2; }
        else op = P_OC(p) + (size_t)tokq[n] * OCW + (MODE == 0 ? 64 * hq : 512 + 64 * hq);
#pragma unroll
        for (int gq = 0; gq < 4; ++gq) {
            u32x2 w0, w1;
            w0[0] = cvt2(st[n].O0[4 * gq] * rd, st[n].O0[4 * gq + 1] * rd); w0[1] = cvt2(st[n].O0[4 * gq + 2] * rd, st[n].O0[4 * gq + 3] * rd);
            w1[0] = cvt2(st[n].O1[4 * gq] * rd, st[n].O1[4 * gq + 1] * rd); w1[1] = cvt2(st[n].O1[4 * gq + 2] * rd, st[n].O1[4 * gq + 3] * rd);
            *(u32x2*)(op + 8 * gq + 4 * h) = w0; *(u32x2*)(op + 32 + 8 * gq + 4 * h) = w1;
        }
    }
}
}
DI void f_attn_phase(const Params& p, int l, LAS unsigned char* lds, int slot) {
    const int tid = otid(), lane = tid & 63, wid = __builtin_amdgcn_readfirstlane(tid >> 6);
    LAS float* rpb_lds = (LAS float*)(lds + 131072 + 64);
    for (int i = tid; i < 4 * 465; i += 512) rpb_lds[i] = p.rpb[(size_t)l * 4 * 465 + i] * at::LOG2E;
    __syncthreads();
    LAS unsigned char* ring = lds + wid * 16384;
    const int x8 = blockIdx.x & 7;
    unsigned* ctr = (unsigned*)(p.ws + OFF_CTL + 16384) + 64 * (slot * 8 + x8);
    for (;;) {
        unsigned k = 0u;
        if (lane == 0) k = __hip_atomic_fetch_add(ctr, 1u, __ATOMIC_RELAXED, __HIP_MEMORY_SCOPE_AGENT);
        k = (unsigned)__builtin_amdgcn_readfirstlane((int)k);
        if (k >= 512u) break;
        int ln = lane; asm volatile("" : "+v"(ln));
        if (k < 192u) at::wave_unit<0>(p, l, x8 * 192 + (int)k, rpb_lds, ring, ln);
        else if (k < 320u) at::wave_unit<3>(p, l, x8 * 128 + (int)k - 192, rpb_lds, ring, ln);
        else { const int ub = x8 * 192 + (int)k - 320; if (((ub >> 7) % 3) == 1) at::wave_unit<2>(p, l, ub, rpb_lds, ring, ln); else at::wave_unit<1>(p, l, ub, rpb_lds, ring, ln); }
    }
    __syncthreads();
}

DI void bcombine_phase(const Params& p) {
    for (int i = blockIdx.x * 512 + otid(); i < NTOK * 16; i += gridDim.x * 512) {
        const int tok = i >> 4, part = i & 15, hs = part >> 3, d0 = (part & 7) * 8;
        const float l0 = P_LSE(p)[((size_t)0 * NTOK + tok) * 2 + hs], l1 = P_LSE(p)[((size_t)1 * NTOK + tok) * 2 + hs], l2 = P_LSE(p)[((size_t)2 * NTOK + tok) * 2 + hs];
        const float mx = fmaxf(l0, fmaxf(l1, l2)), e0 = __expf(l0 - mx), e1 = __expf(l1 - mx), e2 = __expf(l2 - mx), rs = 1.0f / (e0 + e1 + e2);
        const float a0 = e0 * rs, a1 = e1 * rs, a2 = e2 * rs;
        const u32x4 w0 = *(const u32x4*)(P_OB3(p) + ((size_t)0 * NTOK + tok) * 128 + 64 * hs + d0);
        const u32x4 w1 = *(const u32x4*)(P_OB3(p) + ((size_t)1 * NTOK + tok) * 128 + 64 * hs + d0);
        const u32x4 w2 = *(const u32x4*)(P_OB3(p) + ((size_t)2 * NTOK + tok) * 128 + 64 * hs + d0);
        u32x4 o;
#pragma unroll
        for (int j = 0; j < 4; ++j) o[j] = pk2(a0 * bflo(w0[j]) + a1 * bflo(w1[j]) + a2 * bflo(w2[j]), a0 * bfhi(w0[j]) + a1 * bfhi(w1[j]) + a2 * bfhi(w2[j]));
        *(u32x4*)(P_OC(p) + (size_t)tok * OCW + 384 + 64 * hs + d0) = o;
    }
}

namespace g8 {
constexpr int BM = 256, BK = 64, HALF = 128, HTB = HALF * BK * 2, NXCD = 8, WGM = 8;
DI int lds_byte(int r, int c) { const int st = (r >> 4) * 2 + (c >> 5), rr = r & 15, cc = c & 31, ob = rr * 64 + cc * 2; return st * 1024 + (ob ^ (((ob >> 9) & 1) << 5)); }
DI void stage_rc(int b, int& R, int& C) { const int st = b / 1024, sb = b % 1024, swz = sb ^ (((sb >> 9) & 1) << 5); R = (st >> 1) * 16 + swz / 64; C = (st & 1) * 32 + (swz % 64) / 2; }
DI int perm32(int rho) { const int n = rho >> 4, i = rho & 15; return 8 * (i >> 2) + 4 * n + (i & 3); }
struct Unit { int pm, pn, aux; };
struct StaticOrder {
    int nM, nN, nwg, G, c;
    DI void init(int M, int N, int G_, int c_) { nM = M / BM; nN = N / BM; nwg = nM * nN; G = G_; c = c_; }
    DI bool next(int i, Unit& u) const {
        const long L = (long)i * G + c; if (L >= nwg) return false;
        int wgid = (int)L; { const int q = nwg / NXCD, r = nwg % NXCD, xcd = wgid % NXCD, off = wgid / NXCD; wgid = (xcd < r ? xcd * (q + 1) : r * (q + 1) + (xcd - r) * q) + off; }
        const int nig = WGM * nN, gid = wgid / nig, fm = gid * WGM, gsz = (nM - fm) < WGM ? (nM - fm) : WGM;
        u.pm = fm + ((wgid % nig) % gsz); u.pn = (wgid % nig) / gsz; u.aux = 0; return true;
    }
};
typedef f32x4 Acc[2][2][4][2];
typedef int i32x4 __attribute__((ext_vector_type(4)));
typedef int i32x8 __attribute__((ext_vector_type(8)));
DI bf16x8 half8(const i32x8& v, int k) { const i32x4 x = k == 0 ? __builtin_shufflevector(v, v, 0, 1, 2, 3) : __builtin_shufflevector(v, v, 4, 5, 6, 7); return __builtin_bit_cast(bf16x8, x); }
DI i32x8 cat8(const bf16x8& a, const bf16x8& b) { const i32x4 x = __builtin_bit_cast(i32x4, a), y = __builtin_bit_cast(i32x4, b); return __builtin_shufflevector(x, y, 0, 1, 2, 3, 4, 5, 6, 7); }

template <class Desc, class Epi, class Sched, bool ALIGN_EPI>
DI void gemm_phase(LAS unsigned char* lds, const Desc& D, const Sched& S, const Epi& E) {
    const int tid = otid(), wid = __builtin_amdgcn_readfirstlane(tid >> 6), lane = tid & 63, wr = wid >> 2, wc = wid & 3, fr = lane & 15, fq = lane >> 4;
    int R0, C0, R1, C1; stage_rc(tid * 16, R0, C0); stage_rc(tid * 16 + 8192, R1, C1);
    const int Rb0 = Epi::PERM ? ((R0 & ~31) + perm32(R0 & 31)) : R0, Rb1 = Epi::PERM ? ((R1 & ~31) + perm32(R1 & 31)) : R1;
    constexpr unsigned LDA2 = Desc::lda * 2, LDB2 = Desc::ldb * 2;
    const size_t kstep = (size_t)(BK * 2);
    const unsigned ldsw = (unsigned)wid * 1024u;
    const int aoff = lds_byte(wr * 64 + fr, fq * 8), boff = lds_byte(wc * 32 + fr, fq * 8);
#define G8_SA(b, h) (((b) * 2 + (h)) * HTB)
#define G8_SB(b, h) ((4 + (b) * 2 + (h)) * HTB)
#define G8_STAGE(bufoff, gbase, o0, o1) do { \
        __builtin_amdgcn_global_load_lds((const unsigned*)((const char*)(gbase) + (o0)), (LAS unsigned*)(lds + (bufoff) + ldsw), 16, 0, 0); \
        __builtin_amdgcn_global_load_lds((const unsigned*)((const char*)(gbase) + (o1)), (LAS unsigned*)(lds + (bufoff) + ldsw + 8192), 16, 0, 0); } while (0)
#define G8_LDA(dst, b, h) do { _Pragma("unroll") for (int m = 0; m < 4; ++m) { const bf16x8 lo_ = *(const LAS bf16x8*)(lds + G8_SA(b, h) + aoff + m * 2048), hi_ = *(const LAS bf16x8*)(lds + G8_SA(b, h) + aoff + m * 2048 + 1024); dst[m] = cat8(lo_, hi_); } } while (0)
#define G8_LDB(dst, b, h) do { _Pragma("unroll") for (int n = 0; n < 2; ++n) { const bf16x8 lo_ = *(const LAS bf16x8*)(lds + G8_SB(b, h) + boff + n * 2048), hi_ = *(const LAS bf16x8*)(lds + G8_SB(b, h) + boff + n * 2048 + 1024); dst[n] = cat8(lo_, hi_); } } while (0)
#define G8_MMA(ai, bj, At, Bt) do { __builtin_amdgcn_s_setprio(1); _Pragma("unroll") for (int m = 0; m < 4; ++m) _Pragma("unroll") for (int n = 0; n < 2; ++n) _Pragma("unroll") for (int k = 0; k < 2; ++k) \
        acc[ai][bj][m][n] = __builtin_amdgcn_mfma_f32_16x16x32_bf16(half8(Bt[n], k), half8(At[m], k), acc[ai][bj][m][n], 0, 0, 0); __builtin_amdgcn_s_setprio(0); } while (0)
#define G8_MMA8(ai, bj, At, Bt) do { __builtin_amdgcn_s_setprio(1); _Pragma("unroll") for (int m = 0; m < 4; ++m) _Pragma("unroll") for (int n = 0; n < 2; ++n) \
        asm volatile("v_mfma_scale_f32_16x16x128_f8f6f4 %0, %1, %2, %0, %3, %3 op_sel_hi:[0,0,0]" : "+v"(acc[ai][bj][m][n]) : "v"(Bt[n]), "v"(At[m]), "v"(one_scale));     __builtin_amdgcn_s_setprio(0); } while (0)
#define G8_MM(ai, bj, At, Bt) do { if constexpr (Desc::FP8) G8_MMA8(ai, bj, At, Bt); else G8_MMA(ai, bj, At, Bt); } while (0)
#define G8_WAIT_V(n) asm volatile("s_waitcnt vmcnt(" #n ")" ::: "memory")
#define G8_WAIT_L(n) asm volatile("s_waitcnt lgkmcnt(" #n ")" ::: "memory")
#define G8_BAR __builtin_amdgcn_s_barrier()
#define G8_SCHED __builtin_amdgcn_sched_barrier(0)
#define G8_MKA(u, uidx, o) do { \
        o[0][0] = (unsigned)(Desc::GATHER ? D.a_row(u, uidx, R0) : R0) * LDA2 + (unsigned)C0 * 2u; o[0][1] = (unsigned)(Desc::GATHER ? D.a_row(u, uidx, R1) : R1) * LDA2 + (unsigned)C1 * 2u; \
        if (Desc::GATHER) { o[1][0] = (unsigned)D.a_row(u, uidx, HALF + R0) * LDA2 + (unsigned)C0 * 2u; o[1][1] = (unsigned)D.a_row(u, uidx, HALF + R1) * LDA2 + (unsigned)C1 * 2u; } } while (0)
#define G8_MKB(u, o, hs) do { const unsigned dl_ = (unsigned)D.dilB(u) * LDB2; hs = (unsigned)HALF * dl_; \
        o[0] = (unsigned)Rb0 * dl_ + (unsigned)C0 * 2u; o[1] = (unsigned)Rb1 * dl_ + (unsigned)C1 * 2u; } while (0)
#define G8_A1(o, i) (Desc::GATHER ? o[1][i] : o[0][i] + (unsigned)HALF * LDA2)
    Unit cur, nxt; int ui = 0;
    if (!S.next(0, cur)) return;
    Acc acc;
#pragma unroll
    for (int a = 0; a < 2; ++a)
#pragma unroll
        for (int b = 0; b < 2; ++b)
#pragma unroll
            for (int m = 0; m < 4; ++m)
#pragma unroll
                for (int n = 0; n < 2; ++n) acc[a][b][m][n] = (f32x4){0.f, 0.f, 0.f, 0.f};
    int one_scale = 0x7f7f7f7f; asm volatile("" : "+v"(one_scale));
    i32x8 At[4], B0[2], B1[2];
    unsigned cAo[2][2], cBo[2], nAo[2][2], nBo[2], cBh, nBh;
    G8_MKA(cur, 0, cAo); G8_MKB(cur, cBo, cBh); nBh = cBh;
    const char* cA = D.a_base(cur); const char* cB = D.b_base(cur);
    G8_STAGE(G8_SB(0, 0), cB, cBo[0], cBo[1]); G8_STAGE(G8_SB(0, 1), cB + cBh, cBo[0], cBo[1]); G8_STAGE(G8_SA(0, 0), cA, cAo[0][0], cAo[0][1]); G8_STAGE(G8_SA(0, 1), cA, G8_A1(cAo, 0), G8_A1(cAo, 1));
    if (wr == 1) G8_BAR;
    G8_WAIT_V(2); G8_BAR;
    G8_STAGE(G8_SB(1, 0), cB + kstep, cBo[0], cBo[1]); G8_STAGE(G8_SA(1, 0), cA + kstep, cAo[0][0], cAo[0][1]); G8_STAGE(G8_SB(1, 1), cB + kstep + cBh, cBo[0], cBo[1]);
    G8_WAIT_V(6); G8_BAR;
    for (;;) {
        const bool has_next = S.next(ui + 1, nxt);
        const char* nA = cA; const char* nB = cB;
        if (has_next) { nA = D.a_base(nxt); nB = D.b_base(nxt); }
        if (Desc::GATHER) { if (has_next) G8_MKA(nxt, ui + 1, nAo); else { nAo[0][0] = cAo[0][0]; nAo[0][1] = cAo[0][1]; nAo[1][0] = cAo[1][0]; nAo[1][1] = cAo[1][1]; } }
        if (Desc::VARB) { if (has_next) G8_MKB(nxt, nBo, nBh); else { nBo[0] = cBo[0]; nBo[1] = cBo[1]; nBh = cBh; } }
        const int nt = D.nt(cur);
#pragma unroll 1
        for (int t = 0; t < nt; t += 2) {
            const bool last = (t == nt - 2);
            const char* a1 = cA + (size_t)(t + 1) * kstep;
            const char* a2 = last ? nA : cA + (size_t)(t + 2) * kstep; const char* b2 = last ? nB : cB + (size_t)(t + 2) * kstep;
            const char* a3 = a2 + kstep; const char* b3 = b2 + kstep;
            const unsigned xa00 = (Desc::GATHER && last) ? nAo[0][0] : cAo[0][0], xa01 = (Desc::GATHER && last) ? nAo[0][1] : cAo[0][1];
            const unsigned xa10 = Desc::GATHER ? (last ? nAo[1][0] : cAo[1][0]) : xa00 + (unsigned)HALF * LDA2, xa11 = Desc::GATHER ? (last ? nAo[1][1] : cAo[1][1]) : xa01 + (unsigned)HALF * LDA2;
            const unsigned xb0 = (Desc::VARB && last) ? nBo[0] : cBo[0], xb1 = (Desc::VARB && last) ? nBo[1] : cBo[1], xbh = (Desc::VARB && last) ? nBh : cBh;
            G8_LDB(B0, 0, 0); G8_LDB(B1, 0, 1); G8_SCHED; G8_LDA(At, 0, 0); G8_STAGE(G8_SA(1, 1), a1, G8_A1(cAo, 0), G8_A1(cAo, 1));
            G8_WAIT_V(8); G8_WAIT_L(0); G8_BAR; G8_MM(0, 0, At, B0); G8_MM(0, 1, At, B1); G8_BAR; G8_SCHED;
            G8_LDA(At, 0, 1); G8_STAGE(G8_SB(0, 0), b2, xb0, xb1); G8_STAGE(G8_SB(0, 1), b2 + xbh, xb0, xb1); G8_STAGE(G8_SA(0, 0), a2, xa00, xa01);
            G8_WAIT_V(8); G8_WAIT_L(0); G8_BAR; G8_MM(1, 0, At, B0); G8_MM(1, 1, At, B1); G8_BAR; G8_SCHED;
            G8_LDB(B0, 1, 0); G8_LDB(B1, 1, 1); G8_SCHED; G8_LDA(At, 1, 0); G8_STAGE(G8_SA(0, 1), a2, xa10, xa11);
            G8_WAIT_V(8); G8_WAIT_L(0); G8_BAR; G8_MM(0, 0, At, B0); G8_MM(0, 1, At, B1); G8_BAR; G8_SCHED;
            G8_LDA(At, 1, 1); G8_STAGE(G8_SB(1, 0), b3, xb0, xb1); G8_STAGE(G8_SB(1, 1), b3 + xbh, xb0, xb1); G8_STAGE(G8_SA(1, 0), a3, xa00, xa01);
            G8_WAIT_V(8); G8_WAIT_L(0); G8_BAR; G8_MM(1, 0, At, B0); G8_MM(1, 1, At, B1); G8_BAR; G8_SCHED;
        }
        if constexpr (ALIGN_EPI) { if (wr == 0) G8_BAR; }
        if constexpr (Desc::FP8) asm volatile("s_nop 15\n\ts_nop 15" ::: "memory");
        E(acc, cur, wr, wc, fr, fq);
        if (!has_next) break;
#pragma unroll
        for (int a = 0; a < 2; ++a)
#pragma unroll
            for (int b = 0; b < 2; ++b)
#pragma unroll
                for (int m = 0; m < 4; ++m)
#pragma unroll
                    for (int n = 0; n < 2; ++n) acc[a][b][m][n] = (f32x4){0.f, 0.f, 0.f, 0.f};
        if constexpr (Desc::FP8) asm volatile("s_nop 7" ::: "memory");
        cur = nxt; cA = nA; cB = nB; ++ui;
        if (Desc::GATHER) { cAo[0][0] = nAo[0][0]; cAo[0][1] = nAo[0][1]; cAo[1][0] = nAo[1][0]; cAo[1][1] = nAo[1][1]; }
        if (Desc::VARB) { cBo[0] = nBo[0]; cBo[1] = nBo[1]; cBh = nBh; }
        if constexpr (ALIGN_EPI) { if (wr == 1) G8_BAR; }
    }
    G8_WAIT_V(0);
    if constexpr (!ALIGN_EPI) { if (wr == 0) G8_BAR; }
    G8_BAR;
#undef G8_SA
#undef G8_SB
#undef G8_STAGE
#undef G8_LDA
#undef G8_LDB
#undef G8_MMA
#undef G8_MMA8
#undef G8_MM
#undef G8_WAIT_V
#undef G8_WAIT_L
#undef G8_BAR
#undef G8_SCHED
#undef G8_MKA
#undef G8_MKB
#undef G8_A1
}
DI unsigned cvt2(float lo, float hi) { typedef __bf16 bf2_t __attribute__((ext_vector_type(2))); const f32x2 v = {lo, hi}; const bf2_t b = __builtin_convertvector(v, bf2_t); return __builtin_bit_cast(unsigned, b); }
DI u32x4 pack8(const f32x4& a, const f32x4& b) { u32x4 w; w[0] = cvt2(a[0], a[1]); w[1] = cvt2(a[2], a[3]); w[2] = cvt2(b[0], b[1]); w[3] = cvt2(b[2], b[3]); return w; }
DI float fsig(float x) { return __builtin_amdgcn_rcpf(1.0f + __expf(-x)); }

struct DescMoe1 { static constexpr bool GATHER = true, VARB = false, FP8 = true; static constexpr int lda = DM / 2, ldb = DM / 2; const bf16_t* XN8; const bf16_t* WGU; const LAS int* rowlist;
    DI const char* a_base(const Unit&) const { return (const char*)XN8; }
    DI const char* b_base(const Unit& u) const { return (const char*)WGU + ((size_t)(u.pm >> 3) * 4096 + (size_t)u.pn * 256) * DM; }
    DI int a_row(const Unit&, int uidx, int r) const { return rowlist[uidx * 256 + r]; }
    DI int nt(const Unit&) const { return DM / 128; } DI int dilB(const Unit&) const { return 1; } };
struct EpiSwiglu { static constexpr bool PERM = true; unsigned char* HID8;
    DI void operator()(const Acc& acc, const Unit& u, int wr, int wc, int fr, int fq) const {
        const int row0 = u.pm * BM + wr * 64 + fr, col0 = u.pn * 128 + wc * 32 + 8 * fq; constexpr float WI = 1.0f / W8_SCALE;
#pragma unroll
        for (int ai = 0; ai < 2; ++ai)
#pragma unroll
            for (int m = 0; m < 4; ++m) { f32x4 h0, h1;
#pragma unroll
                for (int j = 0; j < 4; ++j) { const float g0 = acc[ai][0][m][0][j] * WI, g1 = acc[ai][0][m][1][j] * WI;
                    h0[j] = g0 * fsig(g0) * acc[ai][1][m][0][j] * (WI * H8_SCALE); h1[j] = g1 * fsig(g1) * acc[ai][1][m][1][j] * (WI * H8_SCALE); }
                u32x2 w; w[0] = pk4_fp8(h0[0], h0[1], h0[2], h0[3]); w[1] = pk4_fp8(h1[0], h1[1], h1[2], h1[3]);
                *(u32x2*)(HID8 + (size_t)(row0 + ai * HALF + m * 16) * FF + col0) = w; }
    } };
struct DescMoe2 { static constexpr bool GATHER = false, VARB = false, FP8 = true; static constexpr int lda = FF / 2, ldb = FF / 2; const unsigned char* HID8; const bf16_t* WD;
    DI const char* a_base(const Unit& u) const { return (const char*)HID8 + (size_t)u.pm * 256 * FF; }
    DI const char* b_base(const Unit& u) const { return (const char*)WD + ((size_t)(u.pm >> 3) * 1024 + (size_t)u.pn * 256) * FF; }
    DI int a_row(const Unit&, int, int r) const { return r; }
    DI int nt(const Unit&) const { return FF / 128; } DI int dilB(const Unit&) const { return 1; } };
struct EpiY { static constexpr bool PERM = true; bf16_t* Y; const float* VAL;
    DI void operator()(const Acc& acc, const Unit& u, int wr, int wc, int fr, int fq) const {
        const int row0 = u.pm * BM + wr * 64 + fr, col0 = u.pn * BM + wc * 32 + 8 * fq;
        float vv[2][4];
#pragma unroll
        for (int ai = 0; ai < 2; ++ai)
#pragma unroll
            for (int m = 0; m < 4; ++m) vv[ai][m] = VAL[row0 + ai * HALF + m * 16];
#pragma unroll
        for (int ai = 0; ai < 2; ++ai)
#pragma unroll
            for (int m = 0; m < 4; ++m) { const int row = row0 + ai * HALF + m * 16; const float v = vv[ai][m] * (1.0f / (W8_SCALE * H8_SCALE));
#pragma unroll
                for (int bj = 0; bj < 2; ++bj) *(u32x4*)(Y + (size_t)row * DM + col0 + bj * HALF) = pack8(acc[ai][bj][m][0] * v, acc[ai][bj][m][1] * v); }
    } };
struct DescOut { static constexpr bool GATHER = false, VARB = false, FP8 = false; static constexpr int lda = DM, ldb = DM; const bf16_t* MG; const bf16_t* WO;
    DI const char* a_base(const Unit& u) const { return (const char*)(MG + (size_t)u.pm * 256 * DM); }
    DI const char* b_base(const Unit& u) const { return (const char*)(WO + (size_t)u.pn * 256 * DM); }
    DI int a_row(const Unit&, int, int r) const { return r; }
    DI int nt(const Unit&) const { return DM / BK; } DI int dilB(const Unit&) const { return 1; } };
struct EpiResid { static constexpr bool PERM = true; bf16_t* X;
    DI void operator()(const Acc& acc, const Unit& u, int wr, int wc, int fr, int fq) const {
        const int row0 = u.pm * BM + wr * 64 + fr, col0 = u.pn * BM + wc * 32 + 8 * fq;
#pragma unroll
        for (int ai = 0; ai < 2; ++ai) {
            u32x4 x[4][2];
#pragma unroll
            for (int m = 0; m < 4; ++m)
#pragma unroll
                for (int bj = 0; bj < 2; ++bj) x[m][bj] = *(const u32x4*)(X + (size_t)(row0 + ai * HALF + m * 16) * DM + col0 + bj * HALF);
#pragma unroll
            for (int m = 0; m < 4; ++m)
#pragma unroll
                for (int bj = 0; bj < 2; ++bj) { f32x4 v0 = acc[ai][bj][m][0], v1 = acc[ai][bj][m][1]; const u32x4 ww = x[m][bj];
                    v0[0] += bflo(ww[0]); v0[1] += bfhi(ww[0]); v0[2] += bflo(ww[1]); v0[3] += bfhi(ww[1]); v1[0] += bflo(ww[2]); v1[1] += bfhi(ww[2]); v1[2] += bflo(ww[3]); v1[3] += bfhi(ww[3]);
                    *(u32x4*)(X + (size_t)(row0 + ai * HALF + m * 16) * DM + col0 + bj * HALF) = pack8(v0, v1); }
            __builtin_amdgcn_sched_barrier(0);
        }
    } };
struct DescInproj { static constexpr bool GATHER = false, VARB = false, FP8 = false; static constexpr int lda = DM, ldb = DM; const bf16_t* XN; const bf16_t* WIN;
    DI const char* a_base(const Unit& u) const { return (const char*)(XN + (size_t)u.pm * 256 * DM); }
    DI const char* b_base(const Unit& u) const { return (const char*)(WIN + (size_t)u.pn * 256 * DM); }
    DI int a_row(const Unit&, int, int r) const { return r; }
    DI int nt(const Unit&) const { return DM / BK; } DI int dilB(const Unit&) const { return 1; } };
struct EpiInproj { static constexpr bool PERM = true; bf16_t* QK; bf16_t* G; const float* cosT; const float* sinT; const float* bgate;
    DI void operator()(const Acc& acc, const Unit& u, int wr, int wc, int fr, int fq) const {
        const int row0 = u.pm * BM + wr * 64 + fr;
        if (u.pn < 5) {
            const int hr = 4 * u.pn + wc; const float sc = (hr < 6 || (hr >= 8 && hr < 14)) ? 0.125f * 1.4426950408889634f : 1.0f;
#pragma unroll
            for (int ai = 0; ai < 2; ++ai) {
                f32x4 tc[4][2], ts[4][2];
#pragma unroll
                for (int m = 0; m < 4; ++m) { const int pos = (row0 + ai * HALF + m * 16) & (SEQ - 1);
                    tc[m][0] = *(const f32x4*)(cosT + pos * 32 + 8 * fq); tc[m][1] = *(const f32x4*)(cosT + pos * 32 + 8 * fq + 4); ts[m][0] = *(const f32x4*)(sinT + pos * 32 + 8 * fq); ts[m][1] = *(const f32x4*)(sinT + pos * 32 + 8 * fq + 4); }
#pragma unroll
                for (int m = 0; m < 4; ++m) { const int row = row0 + ai * HALF + m * 16;
                    const f32x4 c0 = tc[m][0], c1 = tc[m][1], s0 = ts[m][0], s1 = ts[m][1];
                    const f32x4 a0 = acc[ai][0][m][0], a1 = acc[ai][0][m][1], b0 = acc[ai][1][m][0], b1 = acc[ai][1][m][1];
                    bf16_t* o = QK + (size_t)row * QKW + 64 * hr + 8 * fq;
                    *(u32x4*)o = pack8((a0 * c0 - b0 * s0) * sc, (a1 * c1 - b1 * s1) * sc);
                    *(u32x4*)(o + 32) = pack8((b0 * c0 + a0 * s0) * sc, (b1 * c1 + a1 * s1) * sc); }
                __builtin_amdgcn_sched_barrier(0);
            }
        } else if (u.pn < 7) {
            const float sc = u.pn == 5 ? 0.125f * 1.4426950408889634f : 1.0f; const int col0 = 1280 + (u.pn - 5) * 256 + wc * 32 + 8 * fq;
#pragma unroll
            for (int ai = 0; ai < 2; ++ai)
#pragma unroll
                for (int m = 0; m < 4; ++m)
#pragma unroll
                    for (int bj = 0; bj < 2; ++bj) *(u32x4*)(QK + (size_t)(row0 + ai * HALF + m * 16) * QKW + col0 + bj * HALF) = pack8(acc[ai][bj][m][0] * sc, acc[ai][bj][m][1] * sc);
        } else {
            const int col0 = (u.pn - 7) * 256 + wc * 32 + 8 * fq;
            f32x4 bv[2][2];
#pragma unroll
            for (int bj = 0; bj < 2; ++bj)
#pragma unroll
                for (int n = 0; n < 2; ++n) bv[bj][n] = *(const f32x4*)(bgate + col0 + bj * HALF + 4 * n);
#pragma unroll
            for (int ai = 0; ai < 2; ++ai)
#pragma unroll
                for (int m = 0; m < 4; ++m)
#pragma unroll
                    for (int bj = 0; bj < 2; ++bj) { f32x4 v0 = acc[ai][bj][m][0] + bv[bj][0], v1 = acc[ai][bj][m][1] + bv[bj][1];
#pragma unroll
                        for (int j = 0; j < 4; ++j) { v0[j] = fsig(v0[j]); v1[j] = fsig(v1[j]); }
                        *(u32x4*)(G + (size_t)(row0 + ai * HALF + m * 16) * 3072 + col0 + bj * HALF) = pack8(v0, v1); }
        }
    } };
struct DescVT { static constexpr bool GATHER = false, VARB = true, FP8 = false; static constexpr int lda = DM, ldb = DM; const bf16_t* WV; const bf16_t* XN;
    DI const char* a_base(const Unit& u) const { return (const char*)(WV + (size_t)u.pm * 256 * DM); }
    DI const char* b_base(const Unit& u) const { return (const char*)(XN + (u.pm < 2 ? (size_t)u.pn * 256 : (size_t)((u.pn >> 4) * SEQ + (u.pn & 15))) * DM); }
    DI int a_row(const Unit&, int, int r) const { return r; }
    DI int nt(const Unit&) const { return DM / BK; } DI int dilB(const Unit& u) const { return u.pm < 2 ? 1 : 16; } };
struct EpiVT { static constexpr bool PERM = true; bf16_t* VT;
    DI void operator()(const Acc& acc, const Unit& u, int wr, int wc, int fr, int fq) const {
        const int row0 = u.pm * BM + wr * 64 + fr, col0 = u.pn * BM + wc * 32 + 8 * fq;
#pragma unroll
        for (int ai = 0; ai < 2; ++ai)
#pragma unroll
            for (int m = 0; m < 4; ++m)
#pragma unroll
                for (int bj = 0; bj < 2; ++bj) *(u32x4*)(VT + (size_t)(row0 + ai * HALF + m * 16) * NTOK + col0 + bj * HALF) = pack8(acc[ai][bj][m][0], acc[ai][bj][m][1]);
    } };
struct DescMerge { static constexpr bool GATHER = false, VARB = false, FP8 = false; static constexpr int lda = OCW, ldb = 768; const bf16_t* OC; const bf16_t* WM;
    DI int k0(const Unit& u) const { return u.aux == 0 ? 0 : u.aux == 1 ? 384 : 512; }
    DI const char* a_base(const Unit& u) const { return (const char*)(OC + (size_t)u.pm * 256 * OCW + k0(u)); }
    DI const char* b_base(const Unit& u) const { return (const char*)(WM + (size_t)u.pn * 256 * 768 + k0(u)); }
    DI int a_row(const Unit&, int, int r) const { return r; }
    DI int nt(const Unit& u) const { return u.aux == 0 ? 6 : u.aux == 1 ? 2 : 4; } DI int dilB(const Unit&) const { return 1; } };
struct MergeOrder { StaticOrder base;
    DI bool next(int i, Unit& u) const { const int q = i / 3; if (!base.next(q, u)) return false; u.aux = i - 3 * q; return true; } };
struct EpiMerge { static constexpr bool PERM = true; bf16_t* MG; const bf16_t* G;
    DI void operator()(const Acc& acc, const Unit& u, int wr, int wc, int fr, int fq) const {
        const int row0 = u.pm * BM + wr * 64 + fr, col0 = u.pn * BM + wc * 32 + 8 * fq;
#pragma unroll
        for (int ai = 0; ai < 2; ++ai) {
            u32x4 g[4][2], w[4][2];
#pragma unroll
            for (int m = 0; m < 4; ++m)
#pragma unroll
                for (int bj = 0; bj < 2; ++bj) { const int row = row0 + ai * HALF + m * 16, col = col0 + bj * HALF;
                    g[m][bj] = *(const u32x4*)(G + (size_t)row * 3072 + 1024 * u.aux + col);
                    if (u.aux != 0) w[m][bj] = *(const u32x4*)(MG + (size_t)row * DM + col); else w[m][bj] = (u32x4){0u, 0u, 0u, 0u}; }
#pragma unroll
            for (int m = 0; m < 4; ++m)
#pragma unroll
                for (int bj = 0; bj < 2; ++bj) { const int row = row0 + ai * HALF + m * 16, col = col0 + bj * HALF;
                    const u32x4 gg = g[m][bj], ww = w[m][bj];
                    f32x4 v0 = acc[ai][bj][m][0], v1 = acc[ai][bj][m][1];
                    v0[0] = v0[0] * bflo(gg[0]) + bflo(ww[0]); v0[1] = v0[1] * bfhi(gg[0]) + bfhi(ww[0]); v0[2] = v0[2] * bflo(gg[1]) + bflo(ww[1]); v0[3] = v0[3] * bfhi(gg[1]) + bfhi(ww[1]);
                    v1[0] = v1[0] * bflo(gg[2]) + bflo(ww[2]); v1[1] = v1[1] * bfhi(gg[2]) + bfhi(ww[2]); v1[2] = v1[2] * bflo(gg[3]) + bflo(ww[3]); v1[3] = v1[3] * bfhi(gg[3]) + bfhi(ww[3]);
                    *(u32x4*)(MG + (size_t)row * DM + col) = pack8(v0, v1); }
            __builtin_amdgcn_sched_barrier(0);
        }
    } };
}
DI void f_inproj_phase(const Params& p, int l, LAS unsigned char* lds) {
    { g8::StaticOrder S; S.init(NTOK, 4352, gridDim.x, blockIdx.x);
      g8::DescInproj D{P_XN(p), P_W(p, l, LW_WIN)}; g8::EpiInproj E{P_QK(p), P_G(p), P_COS(p), P_SIN(p), p.b_gate + (size_t)l * 3072};
      g8::gemm_phase<g8::DescInproj, g8::EpiInproj, g8::StaticOrder, true>(lds, D, S, E); }
    { g8::StaticOrder S; S.init(VCH, NTOK, gridDim.x, (blockIdx.x + gridDim.x - 64) % gridDim.x);
      g8::DescVT D{P_W(p, l, LW_WV), P_XN(p)}; g8::EpiVT E{P_VT(p)};
      g8::gemm_phase<g8::DescVT, g8::EpiVT, g8::StaticOrder, true>(lds, D, S, E); }
}
struct OneUnit { int pm, pn; DI bool next(int i, g8::Unit& u) const { if (i != 0) return false; u.pm = pm; u.pn = pn; u.aux = 0; return true; } };
DI void f_gate_tail_units(const Params& p, int l, LAS unsigned char* lds) {
    if (blockIdx.x < 128) {
        OneUnit S{(int)(blockIdx.x >> 1), 17 + (int)(blockIdx.x & 1)};
        g8::DescInproj D{P_XN(p), P_W(p, l, LW_WIN)}; g8::EpiInproj E{P_QK(p), P_G(p), P_COS(p), P_SIN(p), p.b_gate + (size_t)l * 3072};
        g8::gemm_phase<g8::DescInproj, g8::EpiInproj, OneUnit, false>(lds, D, S, E);
        __syncthreads();
    }
}
DI void f_merge_phase(const Params& p, int l, LAS unsigned char* lds) {
    g8::MergeOrder S; S.base.init(NTOK, DM, gridDim.x, blockIdx.x);
    g8::DescMerge D{P_OC(p), P_W(p, l, LW_WM)}; g8::EpiMerge E{P_MG(p), P_G(p)};
    g8::gemm_phase<g8::DescMerge, g8::EpiMerge, g8::MergeOrder, true>(lds, D, S, E);
}

DI void f_moe1_phase(const Params& p, int l, LAS unsigned char* lds) {
    g8::StaticOrder S; S.init(NROWS_E, 2 * FF, gridDim.x, blockIdx.x);
    LAS int* rowlist = (LAS int*)(lds + 131072 + 64);
    g8::Unit u;
    for (int i = 0; i < 8 && S.next(i, u); ++i)
        for (int r = otid(); r < 256; r += 512) rowlist[i * 256 + r] = ((u.pm >> 1) & 3) * SEQ + P_IDX(p)[u.pm * 256 + r];
    __syncthreads();
    g8::DescMoe1 D{(const bf16_t*)P_XN8(p), P_W(p, l, LW_WGU), rowlist}; g8::EpiSwiglu E{(unsigned char*)P_HID(p)};
    g8::gemm_phase<g8::DescMoe1, g8::EpiSwiglu, g8::StaticOrder, true>(lds, D, S, E);
}
DI void f_moe2_phase(const Params& p, int l, LAS unsigned char* lds) {
    g8::StaticOrder S; S.init(NROWS_E, DM, gridDim.x, blockIdx.x);
    g8::DescMoe2 D{(const unsigned char*)P_HID(p), P_W(p, l, LW_WD)}; g8::EpiY E{P_Y(p), P_VAL(p)};
    g8::gemm_phase<g8::DescMoe2, g8::EpiY, g8::StaticOrder, true>(lds, D, S, E);
}
DI void f_out_phase(const Params& p, int l, LAS unsigned char* lds) {
    g8::StaticOrder S; S.init(NTOK, DM, gridDim.x, blockIdx.x);
    g8::DescOut D{P_MG(p), P_W(p, l, LW_WO)}; g8::EpiResid E{P_X(p)};
    g8::gemm_phase<g8::DescOut, g8::EpiResid, g8::StaticOrder, false>(lds, D, S, E);
}

#define XB_TMO      128
#define XB_XCNT(j)  (256  + 64 * (j))
#define XB_XSUB(j)  (1280 + 64 * (j))
#define XB_XGEN(j)  (2304 + 64 * (j))
#define XB_TOP      3328
#define XB_TOPGEN   3392
#define XCD_BAR_WORDS 3456
#define XB_SPIN_CAP (1u << 22)

__device__ __forceinline__ unsigned xb_ld(unsigned* p)              { return __hip_atomic_load(p, __ATOMIC_RELAXED, __HIP_MEMORY_SCOPE_AGENT); }
__device__ __forceinline__ unsigned xb_add(unsigned* p, unsigned v) { return __hip_atomic_fetch_add(p, v, __ATOMIC_RELAXED, __HIP_MEMORY_SCOPE_AGENT); }
__device__ __forceinline__ unsigned xb_xcc_id() { return (unsigned)__builtin_amdgcn_s_getreg((3 << 11) | 20) & 0xFu; }
#define XB_SPIN(cond, bar) do { unsigned _sp = 0; while (cond) { __builtin_amdgcn_s_sleep(1); \
    if ((++_sp & 255u) == 0u) { if (xb_ld(&(bar)[XB_TMO])) break; if (_sp > XB_SPIN_CAP) { atomicAdd(&(bar)[XB_TMO], 1u); break; } } } } while (0)

struct XcdBarrier {
    unsigned* bar; unsigned x;
    volatile LAS unsigned* st;
};

__device__ __forceinline__ XcdBarrier xcd_barrier_post(unsigned* bar, volatile LAS unsigned* st) {
    XcdBarrier b; b.bar = bar; b.x = xb_xcc_id(); b.st = st;
    if (threadIdx.x == 0) (void)xb_add(&bar[XB_XCNT(b.x)], 1u);
    return b;
}
__device__ __forceinline__ void xcd_barrier_complete(unsigned* bar, unsigned x, unsigned& nloc, unsigned& nx) {
    const unsigned G = gridDim.x * gridDim.y * gridDim.z;
    unsigned sum, cnt, mine, sp = 0u;
    for (;;) {
        sum = 0u; cnt = 0u; mine = 0u;
#pragma unroll
        for (unsigned j = 0; j < 16; ++j) { const unsigned c = xb_ld(&bar[XB_XCNT(j)]); sum += c; cnt += (c > 0u) ? 1u : 0u; mine = (j == x) ? c : mine; }
        if (sum == G) break;
        __builtin_amdgcn_s_sleep(1);
        if ((++sp & 255u) == 0u) { if (xb_ld(&bar[XB_TMO])) break; if (sp > XB_SPIN_CAP) { atomicAdd(&bar[XB_TMO], 1u); break; } }
    }
    nloc = mine > 0u ? mine : 1u; nx = cnt > 0u ? cnt : 1u;
}

__device__ __forceinline__ void xcd_barrier(const XcdBarrier& b) {
    asm volatile("s_waitcnt vmcnt(0)" ::: "memory");
    __syncthreads();
    if (threadIdx.x == 0) {
        unsigned* bar = b.bar;
        __builtin_amdgcn_s_waitcnt(0);
        unsigned nloc = b.st[0], nx = b.st[1];
        if (nloc == 0u) { xcd_barrier_complete(bar, b.x, nloc, nx); b.st[0] = nloc; b.st[1] = nx; }
        const unsigned old = xb_add(&bar[XB_XSUB(b.x)], 1u);
        const unsigned gen = old / nloc;
        if (old + 1u == (gen + 1u) * nloc) {
            __builtin_amdgcn_fence(__ATOMIC_RELEASE, "agent");
            asm volatile("s_waitcnt vmcnt(0)" ::: "memory");
            const unsigned og = xb_add(&bar[XB_TOP], 1u);
            const unsigned tg = og / nx;
            if (og + 1u == (tg + 1u) * nx) xb_add(&bar[XB_TOPGEN], 1u);
            else XB_SPIN(xb_ld(&bar[XB_TOPGEN]) == tg, bar);
            __builtin_amdgcn_fence(__ATOMIC_ACQUIRE, "agent");
            xb_add(&bar[XB_XGEN(b.x)], 1u);
            asm volatile("s_waitcnt vmcnt(0)" ::: "memory");
        } else {
            XB_SPIN(xb_ld(&bar[XB_XGEN(b.x)]) == gen, bar);
            __builtin_amdgcn_fence(__ATOMIC_ACQUIRE, "agent");
            asm volatile("s_waitcnt vmcnt(0)" ::: "memory");
        }
    }
    __syncthreads();
}

constexpr int LDS_BYTES = 131072 + 64 + 8192;
#ifndef REP_PREP
#define REP_PREP 1
#define REP_INPROJ 1
#define REP_ATTN 1
#define REP_MERGE 1
#define REP_BCOMB 1
#define REP_N2 1
#define REP_TOPK 1
#define REP_MOE1 1
#define REP_MOE2 1
#endif
#define PH(...) do { Params q = p; { size_t z_ = 0; asm volatile("" : "+s"(z_)); q.ws = p.ws + z_; } __VA_ARGS__; } while (0)
#define GRID_BAR() do { XcdBarrier b_; { size_t z_ = 0; asm volatile("" : "+s"(z_)); b_.bar = (unsigned*)(p.ws + z_ + OFF_CTL); } b_.x = xb_xcc_id(); b_.st = (volatile LAS unsigned*)(lds + 131072); xcd_barrier(b_); } while (0)
__global__ void __launch_bounds__(512, 2) mega_fwd(Params p) {
    extern __shared__ __attribute__((aligned(16))) unsigned char lds_raw[];
    LAS unsigned char* lds = (LAS unsigned char*)lds_raw;
    { volatile LAS unsigned* xbw = (volatile LAS unsigned*)(lds + 131072);
      if (threadIdx.x == 0) { xbw[0] = 0u; xbw[1] = 0u; xbw[2] = 0u; xbw[3] = 0u; }
      __syncthreads();
      (void)xcd_barrier_post((unsigned*)(p.ws + OFF_CTL), xbw); }
    PH(prep_phase(q, (LAS float*)lds); norm1_phase<0>(q, 0));
    GRID_BAR();
#define LAYER(l) do { \
        if ((l) != 0) { PH(norm1_phase<1>(q, (l))); GRID_BAR(); } \
        PH(f_inproj_phase(q, (l), lds)); GRID_BAR(); \
        PH(f_gate_tail_units(q, (l), lds); f_attn_phase(q, (l), lds, (l))); GRID_BAR(); \
        PH(bcombine_phase(q)); GRID_BAR(); \
        PH(f_merge_phase(q, (l), lds)); GRID_BAR(); \
        PH(f_out_phase(q, (l), lds)); GRID_BAR(); \
        PH(norm2_router_phase(q, (l), (LAS float*)lds)); GRID_BAR(); \
        PH(topk_phase(q, (LAS unsigned*)lds)); GRID_BAR(); \
        PH(f_moe1_phase(q, (l), lds)); GRID_BAR(); \
        PH(f_moe2_phase(q, (l), lds)); GRID_BAR(); } while (0)
    LAYER(0); LAYER(1); LAYER(2); LAYER(3);
#undef LAYER
    PH(norm1_phase<2>(q, 0));
}

extern "C" void kernel_launch(void* const* d_in, const int* in_sizes, int n_in, void* d_out, int out_size, void* d_ws, size_t ws_size, hipStream_t stream) {
    (void)in_sizes; (void)out_size;
    static int grid = 0;
    if (grid == 0) {
        if (n_in != 16 || ws_size < OFF_END) { grid = -1; return; }
        int dev = 0, cus = 0, per_cu = 0;
        if (hipGetDevice(&dev) != hipSuccess || hipDeviceGetAttribute(&cus, hipDeviceAttributeMultiprocessorCount, dev) != hipSuccess) { grid = -1; return; }
        if (hipFuncSetAttribute((const void*)mega_fwd, hipFuncAttributeMaxDynamicSharedMemorySize, LDS_BYTES) != hipSuccess) { grid = -1; return; }
        if (hipOccupancyMaxActiveBlocksPerMultiprocessor(&per_cu, (const void*)mega_fwd, 512, LDS_BYTES) != hipSuccess || per_cu < 1) { (void)hipGetLastError(); }
        grid = cus;
    }
    if (grid < 0) return;
    if (hipMemsetAsync((char*)d_ws + OFF_CTL, 0, 65536, stream) != hipSuccess) return;
    Params p{};
    p.x = (const float*)d_in[0]; p.w_in = (const float*)d_in[1]; p.b_gate = (const float*)d_in[2]; p.sink = (const float*)d_in[3]; p.rpb = (const float*)d_in[4];
    p.w_a = (const float*)d_in[5]; p.w_b = (const float*)d_in[6]; p.w_c = (const float*)d_in[7]; p.w_out = (const float*)d_in[8]; p.norm_mix = (const float*)d_in[9];
    p.norm_ffn = (const float*)d_in[10]; p.w_router = (const float*)d_in[11]; p.w_gate_e = (const float*)d_in[12]; p.w_up_e = (const float*)d_in[13]; p.w_down_e = (const float*)d_in[14];
    p.norm_final = (const float*)d_in[15]; p.out = (float*)d_out; p.ws = (unsigned char*)d_ws;
    hipLaunchKernelGGL(mega_fwd, dim3(grid), dim3(512), LDS_BYTES, stream, p);
}
```

```cpp
#include <hip/hip_runtime.h>
#include <stdint.h>

#define DI __device__ __forceinline__
#define LAS __attribute__((address_space(3)))
typedef unsigned short bf16_t;
typedef short bf16x8 __attribute__((ext_vector_type(8)));
typedef float f32x2 __attribute__((ext_vector_type(2)));
typedef float f32x4 __attribute__((ext_vector_type(4)));
typedef float f32x16 __attribute__((ext_vector_type(16)));
typedef unsigned u32x2 __attribute__((ext_vector_type(2)));
typedef unsigned u32x4 __attribute__((ext_vector_type(4)));

constexpr int NTOK = 16384, DM = 1024, SEQ = 4096, NBATCH = 4, NLAYER = 4, NEXP = 16, FF = 2048, CAP = 512, PROJ = 5632;
constexpr int QKW = 1792;
constexpr int VCH = 768;
constexpr int OCW = 768;
constexpr int NROWS_E = NBATCH * CAP * NEXP;

constexpr size_t OFF_CTL = 0;
constexpr size_t OFF_COS = 65536;
constexpr size_t OFF_SIN = OFF_COS + (size_t)SEQ * 32 * 4;
constexpr size_t OFF_W   = 2u << 20;
constexpr size_t WIN_B = (size_t)4864 * 1024 * 2, WV_B = (size_t)768 * 1024 * 2, WM_B = (size_t)1024 * 768 * 2, WO_B = (size_t)1024 * 1024 * 2;
constexpr size_t WGU_B = (size_t)NEXP * 4096 * 1024 * 2, WD_B = (size_t)NEXP * 1024 * 2048 * 2;
constexpr size_t LW_WIN = 0, LW_WV = LW_WIN + WIN_B, LW_WM = LW_WV + WV_B, LW_WO = LW_WM + WM_B, LW_WGU = LW_WO + WO_B, LW_WD = LW_WGU + WGU_B, LW = LW_WD + WD_B;
constexpr size_t OFF_X   = OFF_W + NLAYER * LW;
constexpr size_t OFF_XN  = OFF_X + (size_t)NTOK * DM * 4;
constexpr size_t OFF_QK  = OFF_XN + (size_t)NTOK * DM * 2;
constexpr size_t OFF_VT  = OFF_QK + (size_t)NTOK * QKW * 2;
constexpr size_t OFF_G   = OFF_VT + (size_t)VCH * NTOK * 2;
constexpr size_t OFF_OC  = OFF_G + (size_t)NTOK * 3072 * 2;
constexpr size_t OFF_OB3 = OFF_OC + (size_t)NTOK * OCW * 2;
constexpr size_t OFF_LSE = OFF_OB3 + (size_t)3 * NTOK * 128 * 2;
constexpr size_t OFF_MG  = OFF_LSE + (size_t)3 * NTOK * 2 * 4;
constexpr size_t OFF_AFF = OFF_MG + (size_t)NTOK * DM * 2;
constexpr size_t OFF_IDX = OFF_AFF + (size_t)NTOK * NEXP * 4;
constexpr size_t OFF_VAL = OFF_IDX + (size_t)NROWS_E * 4;
constexpr size_t OFF_INV = OFF_VAL + (size_t)NROWS_E * 4;
constexpr size_t OFF_HID = OFF_INV + (size_t)NTOK * NEXP * 4;
constexpr size_t OFF_Y   = OFF_HID + (size_t)NROWS_E * FF * 2;
constexpr size_t OFF_XN8 = OFF_Y + (size_t)NROWS_E * DM * 2;
constexpr size_t OFF_END = OFF_XN8 + (size_t)NTOK * DM;

struct Params {
    const float *x, *w_in, *b_gate, *sink, *rpb, *w_a, *w_b, *w_c, *w_out, *norm_mix, *norm_ffn, *w_router, *w_gate_e, *w_up_e, *w_down_e, *norm_final;
    float* out; unsigned char* ws;
};
DI float*  P_COS(const Params& p) { return (float*)(p.ws + OFF_COS); }
DI float*  P_SIN(const Params& p) { return (float*)(p.ws + OFF_SIN); }
DI bf16_t* P_W(const Params& p, int l, size_t off) { return (bf16_t*)(p.ws + OFF_W + (size_t)l * LW + off); }
DI bf16_t* P_X(const Params& p) { return (bf16_t*)(p.ws + OFF_X); }
DI bf16_t* P_XN(const Params& p) { return (bf16_t*)(p.ws + OFF_XN); }
DI bf16_t* P_QK(const Params& p) { return (bf16_t*)(p.ws + OFF_QK); }
DI bf16_t* P_VT(const Params& p) { return (bf16_t*)(p.ws + OFF_VT); }
DI unsigned char* P_G(const Params& p) { return p.ws + OFF_G; }
DI bf16_t* P_OC(const Params& p) { return (bf16_t*)(p.ws + OFF_OC); }
DI bf16_t* P_OB3(const Params& p) { return (bf16_t*)(p.ws + OFF_OB3); }
DI float*  P_LSE(const Params& p) { return (float*)(p.ws + OFF_LSE); }
DI bf16_t* P_MG(const Params& p) { return (bf16_t*)(p.ws + OFF_MG); }
DI float*  P_AFF(const Params& p) { return (float*)(p.ws + OFF_AFF); }
DI int*    P_IDX(const Params& p) { return (int*)(p.ws + OFF_IDX); }
DI float*  P_VAL(const Params& p) { return (float*)(p.ws + OFF_VAL); }
DI int*    P_INV(const Params& p) { return (int*)(p.ws + OFF_INV); }
DI bf16_t* P_HID(const Params& p) { return (bf16_t*)(p.ws + OFF_HID); }
DI bf16_t* P_Y(const Params& p) { return (bf16_t*)(p.ws + OFF_Y); }
DI unsigned char* P_XN8(const Params& p) { return p.ws + OFF_XN8; }

DI unsigned f2bf(float f) { unsigned u = __float_as_uint(f); return (u + 0x7fffu + ((u >> 16) & 1u)) >> 16; }
DI unsigned pk2(float lo, float hi) { return f2bf(lo) | (f2bf(hi) << 16); }
constexpr float W8_SCALE = 32.0f, H8_SCALE = 4.0f;
DI unsigned pk4_fp8(float a, float b, float c, float d) { unsigned w = 0u; w = __builtin_amdgcn_cvt_pk_fp8_f32(a, b, w, false); w = __builtin_amdgcn_cvt_pk_fp8_f32(c, d, w, true); return w; }
DI float bf2f(unsigned b) { return __uint_as_float(b << 16); }
DI float bflo(unsigned w) { return __uint_as_float(w << 16); }
DI float bfhi(unsigned w) { return __uint_as_float(w & 0xffff0000u); }
DI float shx(float v, int d, int lane) { return __uint_as_float((unsigned)__builtin_amdgcn_ds_bpermute((lane ^ d) << 2, (int)__float_as_uint(v))); }
DI unsigned shl_abs(unsigned v, int src_lane) { return (unsigned)__builtin_amdgcn_ds_bpermute(src_lane << 2, (int)v); }
DI int otid() { int t = threadIdx.x; asm volatile("" : "+v"(t)); return t; }
DI int pos16(int t) { return ((t & 15) << 8) | (t >> 4); }

constexpr int JOBS_PER_LAYER = 26432;
DI void prep_job(const Params& p, int l, int j, const float*& src, int& src_ld, bf16_t*& dst, int& dst_ld) {
    if (j < 1216) {
        const int nblk = j >> 3, kc = j & 7; int sc;
        if (nblk < 40) { const int t = nblk >> 3, sb = nblk & 7, bj = sb >> 2, wc = sb & 3, hr = 4 * t + wc;
            const int base = hr < 6 ? 64 * hr : hr < 8 ? 384 + 64 * (hr - 6) : hr < 14 ? 640 + 64 * (hr - 8) : 1024 + 64 * (hr - 14);
            sc = base + 32 * bj; }
        else if (nblk < 56) { const int c = 32 * (nblk - 40); sc = c < 256 ? 1792 + c : 2048 + (c - 256); }
        else sc = 2560 + 32 * (nblk - 56);
        src = p.w_in + (size_t)l * DM * PROJ + (size_t)(128 * kc) * PROJ + sc; src_ld = PROJ;
        dst = P_W(p, l, LW_WIN) + (size_t)(32 * nblk) * 1024 + 128 * kc; dst_ld = 1024; return;
    }
    j -= 1216;
    if (j < 192) {
        const int nblk = j >> 3, kc = j & 7, ch = 32 * nblk;
        const int sc = ch < 128 ? 512 + ch : ch < 256 ? 1408 + (ch - 128) : ch < 512 ? 2304 + (ch - 256) : 1536 + (ch - 512);
        src = p.w_in + (size_t)l * DM * PROJ + (size_t)(128 * kc) * PROJ + sc; src_ld = PROJ;
        dst = P_W(p, l, LW_WV) + (size_t)ch * 1024 + 128 * kc; dst_ld = 1024; return;
    }
    j -= 192;
    if (j < 192) {
        bf16_t* wm = P_W(p, l, LW_WM); src_ld = 1024; dst_ld = 768;
        if (j < 96) { const int nblk = j / 3, kc = j % 3; src = p.w_a + (size_t)l * 384 * 1024 + (size_t)(128 * kc) * 1024 + 32 * nblk; dst = wm + (size_t)(32 * nblk) * 768 + 128 * kc; }
        else if (j < 128) { const int nblk = j - 96; src = p.w_b + (size_t)l * 128 * 1024 + 32 * nblk; dst = wm + (size_t)(32 * nblk) * 768 + 384; }
        else { const int jj = j - 128, nblk = jj >> 1, kc = jj & 1; src = p.w_c + (size_t)l * 256 * 1024 + (size_t)(128 * kc) * 1024 + 32 * nblk; dst = wm + (size_t)(32 * nblk) * 768 + 512 + 128 * kc; }
        return;
    }
    j -= 192;
    if (j < 256) {
        const int nblk = j >> 3, kc = j & 7;
        src = p.w_out + (size_t)l * 1024 * 1024 + (size_t)(128 * kc) * 1024 + 32 * nblk; src_ld = 1024;
        dst = P_W(p, l, LW_WO) + (size_t)(32 * nblk) * 1024 + 128 * kc; dst_ld = 1024; return;
    }
    j -= 256;
    if (j < 16384) {
        const int e = j >> 10, r = j & 1023, nblk = r >> 3, kc = r & 7, row0 = 32 * nblk, pp = row0 >> 8, s = row0 & 255;
        const float* w = s < 128 ? p.w_gate_e : p.w_up_e; const int col = 128 * pp + (s & 127);
        src = w + ((size_t)(l * NEXP + e) * 1024 + 128 * kc) * 2048 + col; src_ld = 2048;
        dst = (bf16_t*)((unsigned char*)P_W(p, l, LW_WGU) + ((size_t)e * 4096 + row0) * 1024 + 128 * kc); dst_ld = 1024; return;
    }
    j -= 16384;
    {
        const int e = j >> 9, r = j & 511, nblk = r >> 4, kc = r & 15;
        src = p.w_down_e + ((size_t)(l * NEXP + e) * 2048 + 128 * kc) * 1024 + 32 * nblk; src_ld = 1024;
        dst = (bf16_t*)((unsigned char*)P_W(p, l, LW_WD) + ((size_t)e * 1024 + 32 * nblk) * 2048 + 128 * kc); dst_ld = 2048;
    }
}
DI void sincos_d(double a, double& s, double& c) {
    const double q = rint(a * 0.63661977236758134308);
    double r = fma(-q, 1.57079632679489655800e+00, a); r = fma(-q, 6.12323399573676603587e-17, r);
    const double r2 = r * r;
    double sp = 1.58969099521155010221e-10; sp = fma(sp, r2, -2.50507602534068634195e-08); sp = fma(sp, r2, 2.75573137070700676789e-06); sp = fma(sp, r2, -1.98412698298579493134e-04);
    sp = fma(sp, r2, 8.33333333332248946124e-03); sp = fma(sp, r2, -1.66666666666666324348e-01); const double sr = fma(r * r2, sp, r);
    double cp = -1.13596475577881948265e-11; cp = fma(cp, r2, 2.08757232129817482790e-09); cp = fma(cp, r2, -2.75573143513906633035e-07); cp = fma(cp, r2, 2.48015872894767294178e-05);
    cp = fma(cp, r2, -1.38888888888741095749e-03); cp = fma(cp, r2, 4.16666666666666019037e-02); const double cr = fma(r2 * r2, cp, fma(-0.5, r2, 1.0));
    const int qi = ((int)q) & 3;
    s = qi == 0 ? sr : qi == 1 ? cr : qi == 2 ? -sr : -cr;
    c = qi == 0 ? cr : qi == 1 ? -sr : qi == 2 ? -cr : sr;
}
DI void prep_phase(const Params& p, LAS float* scr) {
    const int tid = otid();
    for (int i = blockIdx.x * 512 + tid; i < SEQ * 32; i += gridDim.x * 512) {
        const int pos = i >> 5, j = i & 31;
        double fr = 1.0; for (int jj = 0; jj < j; ++jj) fr *= 0.7498942093324559;
        const float invf = (float)fr;
        const float ang = (float)pos * invf; double s, c; sincos_d((double)ang, s, c);
        P_COS(p)[i] = (float)c; P_SIN(p)[i] = (float)s;
    }
    const int total = NLAYER * JOBS_PER_LAYER;
    int u = blockIdx.x;
    const float* src; bf16_t* dst; int src_ld, dst_ld, j = 0;
    f32x4 r0, r1;
    if (u < total) { const int l = u / JOBS_PER_LAYER; j = u - l * JOBS_PER_LAYER; prep_job(p, l, j, src, src_ld, dst, dst_ld);
        r0 = *(const f32x4*)(src + (size_t)(tid >> 3) * src_ld + 4 * (tid & 7)); r1 = *(const f32x4*)(src + (size_t)((tid + 512) >> 3) * src_ld + 4 * (tid & 7)); }
    int buf = 0;
    for (; u < total; u += gridDim.x) {
        LAS float* sc = scr + buf * (128 * 33);
        { const int k = tid >> 3, c4 = tid & 7;
          sc[k * 33 + 4 * c4 + 0] = r0[0]; sc[k * 33 + 4 * c4 + 1] = r0[1]; sc[k * 33 + 4 * c4 + 2] = r0[2]; sc[k * 33 + 4 * c4 + 3] = r0[3];
          sc[(k + 64) * 33 + 4 * c4 + 0] = r1[0]; sc[(k + 64) * 33 + 4 * c4 + 1] = r1[1]; sc[(k + 64) * 33 + 4 * c4 + 2] = r1[2]; sc[(k + 64) * 33 + 4 * c4 + 3] = r1[3]; }
        bf16_t* dcur = dst; const int dld = dst_ld, jcur = j;
        const int un = u + gridDim.x;
        if (un < total) { const int l = un / JOBS_PER_LAYER; j = un - l * JOBS_PER_LAYER; prep_job(p, l, j, src, src_ld, dst, dst_ld);
            r0 = *(const f32x4*)(src + (size_t)(tid >> 3) * src_ld + 4 * (tid & 7)); r1 = *(const f32x4*)(src + (size_t)((tid + 512) >> 3) * src_ld + 4 * (tid & 7)); }
        __syncthreads();
        { const int n = tid >> 4, k8 = (tid & 15) * 8;
          if (jcur >= 1856) {
            u32x2 w; w[0] = pk4_fp8(sc[(k8 + 0) * 33 + n] * W8_SCALE, sc[(k8 + 1) * 33 + n] * W8_SCALE, sc[(k8 + 2) * 33 + n] * W8_SCALE, sc[(k8 + 3) * 33 + n] * W8_SCALE);
            w[1] = pk4_fp8(sc[(k8 + 4) * 33 + n] * W8_SCALE, sc[(k8 + 5) * 33 + n] * W8_SCALE, sc[(k8 + 6) * 33 + n] * W8_SCALE, sc[(k8 + 7) * 33 + n] * W8_SCALE);
            *(u32x2*)((unsigned char*)dcur + (size_t)n * dld + k8) = w;
          } else { u32x4 w;
            w[0] = pk2(sc[(k8 + 0) * 33 + n], sc[(k8 + 1) * 33 + n]); w[1] = pk2(sc[(k8 + 2) * 33 + n], sc[(k8 + 3) * 33 + n]);
            w[2] = pk2(sc[(k8 + 4) * 33 + n], sc[(k8 + 5) * 33 + n]); w[3] = pk2(sc[(k8 + 6) * 33 + n], sc[(k8 + 7) * 33 + n]);
            *(u32x4*)(dcur + (size_t)n * dld + k8) = w; } }
        buf ^= 1;
    }
    __syncthreads();
}

DI int eo4(int lane, int i) { return 8 * lane + 512 * (i >> 1) + 4 * (i & 1); }
DI void unpk8(f32x4& a, f32x4& b, const u32x4& w) { a[0] = bflo(w[0]); a[1] = bfhi(w[0]); a[2] = bflo(w[1]); a[3] = bfhi(w[1]); b[0] = bflo(w[2]); b[1] = bfhi(w[2]); b[2] = bflo(w[3]); b[3] = bfhi(w[3]); }
DI void add8(f32x4& a, f32x4& b, const u32x4& w) { a[0] += bflo(w[0]); a[1] += bfhi(w[0]); a[2] += bflo(w[1]); a[3] += bfhi(w[1]); b[0] += bflo(w[2]); b[1] += bfhi(w[2]); b[2] += bflo(w[3]); b[3] += bfhi(w[3]); }
DI u32x4 pk8(const f32x4& a, const f32x4& b) { u32x4 w; w[0] = pk2(a[0], a[1]); w[1] = pk2(a[2], a[3]); w[2] = pk2(b[0], b[1]); w[3] = pk2(b[2], b[3]); return w; }
template <int MODE> DI void norm1_phase(const Params& p, int l) {
    const int tid = otid(), lane = tid & 63, wid = tid >> 6;
    const float* gain = MODE == 2 ? p.norm_final : p.norm_mix + (size_t)l * DM;
    f32x4 g[4];
#pragma unroll
    for (int i = 0; i < 4; ++i) g[i] = *(const f32x4*)(gain + eo4(lane, i));
    const int nw = gridDim.x * 8;
    for (int row0 = blockIdx.x * 8 + wid; row0 < NTOK; row0 += 2 * nw) {
        const int row1 = row0 + nw;
        f32x4 v0[4], v1[4];
        if (MODE == 0) {
#pragma unroll
            for (int i = 0; i < 4; ++i) { v0[i] = *(const f32x4*)(p.x + (size_t)row0 * DM + eo4(lane, i)); v1[i] = *(const f32x4*)(p.x + (size_t)row1 * DM + eo4(lane, i)); }
        } else {
            u32x4 a[2], b[2];
#pragma unroll
            for (int j = 0; j < 2; ++j) { a[j] = *(const u32x4*)(P_X(p) + (size_t)row0 * DM + 8 * lane + 512 * j); b[j] = *(const u32x4*)(P_X(p) + (size_t)row1 * DM + 8 * lane + 512 * j); }
            const int c0 = lane < NEXP ? P_INV(p)[(size_t)row0 * NEXP + lane] : -1, c1 = lane < NEXP ? P_INV(p)[(size_t)row1 * NEXP + lane] : -1;
#pragma unroll
            for (int j = 0; j < 2; ++j) { unpk8(v0[2 * j], v0[2 * j + 1], a[j]); unpk8(v1[2 * j], v1[2 * j + 1], b[j]); }
            unsigned long long m0 = __ballot(c0 >= 0), m1 = __ballot(c1 >= 0);
            const bf16_t* ybase0 = P_Y(p) + (size_t)((row0 >> 12) * CAP) * DM; const bf16_t* ybase1 = P_Y(p) + (size_t)((row1 >> 12) * CAP) * DM;
            while (m0 | m1) {
                u32x4 w0[2], w1[2]; const bool h0 = m0 != 0ull, h1 = m1 != 0ull;
                if (h0) { const int e = __builtin_ctzll(m0); m0 &= m0 - 1ull; const int c = __builtin_amdgcn_readlane(c0, e); const bf16_t* yr = ybase0 + (size_t)(e * NBATCH * CAP + c) * DM;
#pragma unroll
                    for (int j = 0; j < 2; ++j) w0[j] = *(const u32x4*)(yr + 8 * lane + 512 * j); }
                if (h1) { const int e = __builtin_ctzll(m1); m1 &= m1 - 1ull; const int c = __builtin_amdgcn_readlane(c1, e); const bf16_t* yr = ybase1 + (size_t)(e * NBATCH * CAP + c) * DM;
#pragma unroll
                    for (int j = 0; j < 2; ++j) w1[j] = *(const u32x4*)(yr + 8 * lane + 512 * j); }
                if (h0) {
#pragma unroll
                    for (int j = 0; j < 2; ++j) add8(v0[2 * j], v0[2 * j + 1], w0[j]); }
                if (h1) {
#pragma unroll
                    for (int j = 0; j < 2; ++j) add8(v1[2 * j], v1[2 * j + 1], w1[j]); }
            }
        }
        if (MODE != 2) {
#pragma unroll
            for (int j = 0; j < 2; ++j) { *(u32x4*)(P_X(p) + (size_t)row0 * DM + 8 * lane + 512 * j) = pk8(v0[2 * j], v0[2 * j + 1]); *(u32x4*)(P_X(p) + (size_t)row1 * DM + 8 * lane + 512 * j) = pk8(v1[2 * j], v1[2 * j + 1]); }
        }
        float s0 = 0.f, s1 = 0.f;
#pragma unroll
        for (int i = 0; i < 4; ++i) { s0 += v0[i][0] * v0[i][0] + v0[i][1] * v0[i][1] + v0[i][2] * v0[i][2] + v0[i][3] * v0[i][3]; s1 += v1[i][0] * v1[i][0] + v1[i][1] * v1[i][1] + v1[i][2] * v1[i][2] + v1[i][3] * v1[i][3]; }
#pragma unroll
        for (int d = 32; d >= 1; d >>= 1) { s0 += shx(s0, d, lane); s1 += shx(s1, d, lane); }
        const float r0 = rsqrtf(s0 * (1.0f / DM) + 1e-6f), r1 = rsqrtf(s1 * (1.0f / DM) + 1e-6f);
#pragma unroll
        for (int i = 0; i < 4; ++i) { v0[i] = v0[i] * r0 * g[i]; v1[i] = v1[i] * r1 * g[i]; }
        if (MODE == 2) {
#pragma unroll
            for (int i = 0; i < 4; ++i) { *(f32x4*)(p.out + (size_t)row0 * DM + eo4(lane, i)) = v0[i]; *(f32x4*)(p.out + (size_t)row1 * DM + eo4(lane, i)) = v1[i]; }
        } else {
#pragma unroll
            for (int j = 0; j < 2; ++j) { *(u32x4*)(P_XN(p) + (size_t)row0 * DM + 8 * lane + 512 * j) = pk8(v0[2 * j], v0[2 * j + 1]); *(u32x4*)(P_XN(p) + (size_t)row1 * DM + 8 * lane + 512 * j) = pk8(v1[2 * j], v1[2 * j + 1]); }
        }
    }
}

DI float reduce16(const float (&a)[16], int lane) {
    float b8[8], b4[4], b2[2];
    { const bool hi = (lane & 32) != 0;
#pragma unroll
      for (int j = 0; j < 8; ++j) { const float snd = hi ? a[j] : a[j + 8], kp = hi ? a[j + 8] : a[j]; b8[j] = kp + shx(snd, 32, lane); } }
    { const bool hi = (lane & 16) != 0;
#pragma unroll
      for (int j = 0; j < 4; ++j) { const float snd = hi ? b8[j] : b8[j + 4], kp = hi ? b8[j + 4] : b8[j]; b4[j] = kp + shx(snd, 16, lane); } }
    { const bool hi = (lane & 8) != 0;
#pragma unroll
      for (int j = 0; j < 2; ++j) { const float snd = hi ? b4[j] : b4[j + 2], kp = hi ? b4[j + 2] : b4[j]; b2[j] = kp + shx(snd, 8, lane); } }
    float r;
    { const bool hi = (lane & 4) != 0; const float snd = hi ? b2[0] : b2[1], kp = hi ? b2[1] : b2[0]; r = kp + shx(snd, 4, lane); }
    r += shx(r, 2, lane); r += shx(r, 1, lane);
    return r;
}
DI void norm2_router_phase(const Params& p, int l, LAS float* wr) {
    const int tid = otid(), lane = tid & 63, wid = tid >> 6;
    for (int i = tid; i < DM * NEXP; i += 512) { const int d = i >> 4;
        wr[(i & 15) * DM + ((d >> 9) * 2 + ((d >> 2) & 1)) * 256 + 4 * ((d & 511) >> 3) + (d & 3)] = p.w_router[(size_t)l * DM * NEXP + i]; }
    __syncthreads();
    const float* gain = p.norm_ffn + (size_t)l * DM;
    f32x4 g[4];
#pragma unroll
    for (int i = 0; i < 4; ++i) g[i] = *(const f32x4*)(gain + eo4(lane, i));
    const int nw = gridDim.x * 8;
    for (int row0 = blockIdx.x * 8 + wid; row0 < NTOK; row0 += 2 * nw) {
        const int row1 = row0 + nw;
        f32x4 v0[4], v1[4]; float s0 = 0.f, s1 = 0.f;
        { u32x4 a[2], b[2];
#pragma unroll
          for (int j = 0; j < 2; ++j) { a[j] = *(const u32x4*)(P_X(p) + (size_t)row0 * DM + 8 * lane + 512 * j); b[j] = *(const u32x4*)(P_X(p) + (size_t)row1 * DM + 8 * lane + 512 * j); }
#pragma unroll
          for (int j = 0; j < 2; ++j) { unpk8(v0[2 * j], v0[2 * j + 1], a[j]); unpk8(v1[2 * j], v1[2 * j + 1], b[j]); } }
#pragma unroll
        for (int i = 0; i < 4; ++i) { s0 += v0[i][0] * v0[i][0] + v0[i][1] * v0[i][1] + v0[i][2] * v0[i][2] + v0[i][3] * v0[i][3]; s1 += v1[i][0] * v1[i][0] + v1[i][1] * v1[i][1] + v1[i][2] * v1[i][2] + v1[i][3] * v1[i][3]; }
#pragma unroll
        for (int d = 32; d >= 1; d >>= 1) { s0 += shx(s0, d, lane); s1 += shx(s1, d, lane); }
        const float r0 = rsqrtf(s0 * (1.0f / DM) + 1e-6f), r1 = rsqrtf(s1 * (1.0f / DM) + 1e-6f);
#pragma unroll
        for (int i = 0; i < 4; ++i) { v0[i] = v0[i] * r0 * g[i]; v1[i] = v1[i] * r1 * g[i]; }
#pragma unroll
        for (int j = 0; j < 2; ++j) { u32x2 w;
            w[0] = pk4_fp8(v0[2 * j][0], v0[2 * j][1], v0[2 * j][2], v0[2 * j][3]); w[1] = pk4_fp8(v0[2 * j + 1][0], v0[2 * j + 1][1], v0[2 * j + 1][2], v0[2 * j + 1][3]);
            *(u32x2*)(P_XN8(p) + (size_t)row0 * DM + 8 * lane + 512 * j) = w;
            w[0] = pk4_fp8(v1[2 * j][0], v1[2 * j][1], v1[2 * j][2], v1[2 * j][3]); w[1] = pk4_fp8(v1[2 * j + 1][0], v1[2 * j + 1][1], v1[2 * j + 1][2], v1[2 * j + 1][3]);
            *(u32x2*)(P_XN8(p) + (size_t)row1 * DM + 8 * lane + 512 * j) = w; }
        float a0[NEXP], a1[NEXP];
#pragma unroll
        for (int e = 0; e < NEXP; ++e) { float x0 = 0.f, x1 = 0.f;
#pragma unroll
            for (int i = 0; i < 4; ++i) { const f32x4 w = *(const LAS f32x4*)(wr + e * DM + 4 * lane + 256 * i);
                x0 += v0[i][0] * w[0] + v0[i][1] * w[1] + v0[i][2] * w[2] + v0[i][3] * w[3]; x1 += v1[i][0] * w[0] + v1[i][1] * w[1] + v1[i][2] * w[2] + v1[i][3] * w[3]; }
            a0[e] = x0; a1[e] = x1;
            if ((e & 3) == 3) __builtin_amdgcn_sched_barrier(0); }
        const float l0 = reduce16(a0, lane), l1 = reduce16(a1, lane);
        float m0 = l0, m1 = l1;
#pragma unroll
        for (int d = 32; d >= 4; d >>= 1) { m0 = fmaxf(m0, shx(m0, d, lane)); m1 = fmaxf(m1, shx(m1, d, lane)); }
        const float e0 = __expf(l0 - m0), e1 = __expf(l1 - m1); float d0 = e0, d1 = e1;
#pragma unroll
        for (int d = 32; d >= 4; d >>= 1) { d0 += shx(d0, d, lane); d1 += shx(d1, d, lane); }
        if ((lane & 3) == 0) { const int e = lane >> 2;
            P_AFF(p)[((size_t)((row0 >> 12) * NEXP + e)) * SEQ + (row0 & 4095)] = e0 / d0; P_AFF(p)[((size_t)((row1 >> 12) * NEXP + e)) * SEQ + (row1 & 4095)] = e1 / d1; }
    }
}

DI void topk_phase(const Params& p, LAS unsigned* lds) {
    const int tid = otid(), lane = tid & 63, wid = tid >> 6;
    LAS unsigned* hist = lds; LAS unsigned* sh = lds + 256; LAS unsigned* wtot = lds + 272;
    for (int be = blockIdx.x; be < NBATCH * NEXP; be += gridDim.x) {
        const int b = be >> 4, e = be & 15;
        const float* aff = P_AFF(p) + (size_t)be * SEQ + tid * 8;
        const f32x4 a0 = *(const f32x4*)aff, a1 = *(const f32x4*)(aff + 4);
        unsigned key[8];
#pragma unroll
        for (int i = 0; i < 4; ++i) { key[i] = __float_as_uint(a0[i]); key[4 + i] = __float_as_uint(a1[i]); }
        unsigned prefix = 0u, mask = 0u, krem = CAP;
        for (int pass = 3; pass >= 0; --pass) {
            const int shift = 8 * pass;
            if (tid < 256) hist[tid] = 0u;
            __syncthreads();
#pragma unroll
            for (int i = 0; i < 8; ++i) if ((key[i] & mask) == prefix) atomicAdd((unsigned*)&hist[(key[i] >> shift) & 255u], 1u);
            __syncthreads();
            if (wid == 0) {
                const unsigned h0 = hist[4 * lane], h1 = hist[4 * lane + 1], h2 = hist[4 * lane + 2], h3 = hist[4 * lane + 3], s = h0 + h1 + h2 + h3;
                unsigned suf = s;
#pragma unroll
                for (int d = 1; d < 64; d <<= 1) { const unsigned t = shl_abs(suf, (lane + d) & 63); if (lane + d < 64) suf += t; }
                const unsigned above = suf - s;
                if (above < krem && krem <= suf) {
                    unsigned a = above; unsigned bin, nk;
                    if (a + h3 >= krem) { bin = 4 * lane + 3; nk = krem - a; }
                    else { a += h3; if (a + h2 >= krem) { bin = 4 * lane + 2; nk = krem - a; }
                        else { a += h2; if (a + h1 >= krem) { bin = 4 * lane + 1; nk = krem - a; } else { a += h1; bin = 4 * lane; nk = krem - a; } } }
                    sh[0] = prefix | (bin << shift); sh[1] = nk;
                }
            }
            __syncthreads();
            prefix = sh[0]; krem = sh[1]; mask |= 0xFFu << shift;
            __syncthreads();
        }
        unsigned cg = 0u, ce = 0u;
#pragma unroll
        for (int i = 0; i < 8; ++i) { cg += key[i] > prefix ? 1u : 0u; ce += key[i] == prefix ? 1u : 0u; }
        unsigned pk = cg | (ce << 16), incl = pk;
#pragma unroll
        for (int d = 1; d < 64; d <<= 1) { const unsigned t = shl_abs(incl, (lane - d) & 63); if (lane >= d) incl += t; }
        if (lane == 63) wtot[wid] = incl;
        __syncthreads();
        unsigned woff = 0u;
#pragma unroll
        for (int w = 0; w < 8; ++w) woff += w < wid ? wtot[w] : 0u;
        const unsigned excl = woff + incl - pk;
        unsigned gtb = excl & 0xffffu, eqb = excl >> 16;
        int* idxo = P_IDX(p) + (size_t)(e * NBATCH + b) * CAP; float* valo = P_VAL(p) + (size_t)(e * NBATCH + b) * CAP;
        int* inv = P_INV(p) + ((size_t)b * SEQ + tid * 8) * NEXP + e;
#pragma unroll
        for (int i = 0; i < 8; ++i) {
            int slot = -1;
            if (key[i] > prefix) { slot = (int)(gtb + (eqb < krem ? eqb : krem)); ++gtb; }
            else if (key[i] == prefix) { if (eqb < krem) slot = (int)(gtb + eqb); ++eqb; }
            if (slot >= 0) { idxo[slot] = tid * 8 + i; valo[slot] = __uint_as_float(key[i]); }
            inv[(size_t)i * NEXP] = slot;
        }
        __syncthreads();
    }
}

namespace at {
constexpr int NUNIT_A = 1536, NUNIT_C = 1024, NUNIT_B = 1536, NUNIT = NUNIT_A + NUNIT_C + NUNIT_B;
DI unsigned cvt2(float lo, float hi) { typedef __bf16 bf2_t __attribute__((ext_vector_type(2))); const f32x2 v = {lo, hi}; const bf2_t b = __builtin_convertvector(v, bf2_t); return __builtin_bit_cast(unsigned, b); }
DI bf16x8 pack8(const f32x16& x, int s8) { u32x4 w; w[0] = cvt2(x[s8 + 0], x[s8 + 1]); w[1] = cvt2(x[s8 + 2], x[s8 + 3]); w[2] = cvt2(x[s8 + 4], x[s8 + 5]); w[3] = cvt2(x[s8 + 6], x[s8 + 7]); return __builtin_bit_cast(bf16x8, w); }
DI int koffmap(int r, bool g1) { return g1 ? 4 * (4 * ((r >> 3) & 1) + (r & 3)) + 2 * (r >> 4) + ((r >> 2) & 1) : (r & 16) + 8 * ((r >> 2) & 1) + 4 * ((r >> 3) & 1) + (r & 3); }

DI float xh_max(float v) { const auto r = __builtin_amdgcn_permlane32_swap(__float_as_uint(v), __float_as_uint(v), false, false); return fmaxf(__uint_as_float(r[0]), __uint_as_float(r[1])); }
DI float xh_sum(float v) { const auto r = __builtin_amdgcn_permlane32_swap(__float_as_uint(v), __float_as_uint(v), false, false); return __uint_as_float(r[0]) + __uint_as_float(r[1]); }
constexpr float LOG2E = 1.4426950408889634f, LN2 = 0.6931471805599453f;
struct QState { float m, den; f32x16 O0, O1; };
DI void softmax_tile(f32x16& S, QState& st, bf16x8& p0, bf16x8& p1) {
    float mx = fmaxf(S[0], S[1]);
#pragma unroll
    for (int i = 2; i < 16; i += 2) mx = fmaxf(mx, fmaxf(S[i], S[i + 1]));
    mx = xh_max(mx);
    const float mn = fmaxf(st.m, mx), alpha = __builtin_amdgcn_exp2f(st.m - mn);
    float ps = 0.f;
#pragma unroll
    for (int i = 0; i < 16; ++i) { S[i] = __builtin_amdgcn_exp2f(S[i] - mn); ps += S[i]; }
    ps = xh_sum(ps);
    st.den = st.den * alpha + ps; st.m = mn;
#pragma unroll
    for (int i = 0; i < 16; ++i) { st.O0[i] *= alpha; st.O1[i] *= alpha; }
    p0 = pack8(S, 0); p1 = pack8(S, 8);
}
template <int MODE> DI void mask_tile(f32x16& S, int tn, int NT, int q, int h, int t, int qrow, int sr_q, int sc_q, int kc0, int qcg, const LAS float* bt_head) {
    if (MODE == 3) {
        const bool rowok = t >= sr_q && t < sr_q + 8; const LAS float* bt = bt_head + (t - qrow + 7) * 31 + 15 - qcg;
#pragma unroll
        for (int i = 0; i < 16; ++i) { const int kc = kc0 + 16 * (i >> 3) + 8 * h + (i & 7); const bool ok = rowok && kc >= sc_q && kc < sc_q + 16;
            const int bi = ok ? kc : qcg; S[i] = ok ? S[i] + bt[bi] : -1e37f; }
    } else {
        const int edge = tn == 0 ? 1 : tn == NT - 1 ? 2 : 0;
        if (edge != 0) {
            int qq = MODE == 2 ? q - h : q - 8 * h; asm volatile("" : "+v"(qq));
            if (edge == 1) {
#pragma unroll
                for (int i = 0; i < 16; ++i) { const int kc_ = MODE == 2 ? 4 * (i & 7) + 2 * (i >> 3) : 16 * (i >> 3) + (i & 7); S[i] = kc_ >= qq ? S[i] : -1e37f; }
            } else {
#pragma unroll
                for (int i = 0; i < 16; ++i) { const int kc_ = MODE == 2 ? 4 * (i & 7) + 2 * (i >> 3) : 16 * (i >> 3) + (i & 7); S[i] = kc_ <= qq ? S[i] : -1e37f; }
            }
        }
    }
}
template <int MODE> DI void wave_unit(const Params& p, int l, int u, const LAS float* rpb_lds, LAS unsigned char* ring, int lane) {
    const int q = lane & 31, h = lane >> 5;
    const bf16_t* QK = P_QK(p); const bf16_t* VT = P_VT(p);
    int b, qcol, kcol, vch, dil = 1, rho = 0, Jq = 0, L = SEQ, vs0 = 0, g = 0, hs = 0, hq = 0;
    constexpr int W = MODE == 0 ? 128 : 64, NT = MODE == 0 ? 9 : 5;
    int qcg = 0, kc0 = 0, kr_lo = 0, kr_hi = 0, r00 = 0;
    if (MODE == 0) { const int gg = u % 3, qp = (u / 3) & 63, kvh = (u / 192) & 1; b = u / 384; hq = kvh * 3 + gg; qcol = 64 * hq; kcol = 384 + 64 * kvh; vch = 64 * kvh; Jq = 64 * qp; }
    else if (MODE == 1 || MODE == 2) { const int qt6 = u & 63; hs = (u >> 6) & 1; g = (u >> 7) % 3; b = u / 384; qcol = 512 + 128 * g + 64 * hs; kcol = 896 + 128 * g + 64 * hs;
        vch = g == 0 ? 128 + 64 * hs : g == 1 ? 512 + 64 * hs : 640 + 64 * hs;
        if (g == 0) { Jq = 64 * qt6; } else if (g == 1) { dil = 4; rho = qt6 >> 4; Jq = 64 * (qt6 & 15); L = 1024; } else { dil = 16; rho = qt6 >> 2; Jq = 64 * (qt6 & 3); L = 256; vs0 = rho * 256; } }
    else { const int qt6 = u & 63, hh = (u >> 6) & 3, gr4 = qt6 >> 2, cb = qt6 & 3; b = u >> 8; hq = hh; qcol = 1280 + 64 * hh; kcol = 1536 + 64 * hh; vch = 256 + 64 * hh;
        r00 = 4 * gr4; qcg = 16 * cb + (q & 15); kc0 = cb == 0 ? 0 : cb == 3 ? 32 : 16 * cb - 8;
        const int s0 = r00 - 4 < 0 ? 0 : r00 - 4 > 56 ? 56 : r00 - 4, s3 = r00 - 1 < 0 ? 0 : r00 - 1 > 56 ? 56 : r00 - 1; kr_lo = s0; kr_hi = s3 + 8; }
    int t_lo, t_hi; unsigned kdma[4], vdma[4], kstep_t, vstep_t;
    if (MODE == 3) { t_lo = kr_lo; t_hi = kr_hi; kstep_t = 64u * QKW; vstep_t = 64; }
    else { t_lo = (W - Jq + 31) >> 5; if (t_lo < 0) t_lo = 0; t_hi = (L + W - Jq) >> 5; if (t_hi > NT + 1) t_hi = NT + 1; kstep_t = 32u * dil * QKW; vstep_t = MODE == 2 ? 8 : 32; }
#pragma unroll
    for (int i = 0; i < 4; ++i) {
        const int r = 8 * i + (lane >> 3), c8 = (lane & 7) ^ ((r >> 1) & 7), ko = koffmap(r, MODE == 2);
        const int ktok = MODE == 3 ? b * SEQ + kc0 + ko : b * SEQ + (Jq - W + ko) * dil + rho;
        kdma[i] = (unsigned)ktok * QKW + kcol + 8 * c8;
        const int d = 16 * i + (lane >> 2), ch = (lane & 3) ^ ((d >> 2) & 3);
        const int vslot = MODE == 3 ? b * SEQ + kc0 + 8 * ch : MODE == 2 ? b * SEQ + ch * 1024 + rho * 256 + ((Jq - W) >> 2) : b * SEQ + vs0 + (Jq - W) + 8 * ch;
        vdma[i] = (unsigned)(vch + d) * NTOK + vslot;
    }
#define AT_DMA(t, buf) do { const unsigned kt_ = (unsigned)(t) * kstep_t, vt_ = (unsigned)(t) * vstep_t; LAS unsigned char* bb_ = ring + (buf) * 8192; \
        _Pragma("unroll") for (int i_ = 0; i_ < 4; ++i_) __builtin_amdgcn_global_load_lds((const unsigned*)(QK + (unsigned)(kdma[i_] + kt_)), (LAS unsigned*)(bb_ + i_ * 1024), 16, 0, 0); \
        _Pragma("unroll") for (int i_ = 0; i_ < 4; ++i_) __builtin_amdgcn_global_load_lds((const unsigned*)(VT + (unsigned)(vdma[i_] + vt_)), (LAS unsigned*)(bb_ + 4096 + i_ * 1024), 16, 0, 0); } while (0)
    AT_DMA(t_lo, 0);
    int kaddr[4], vaddr[2][2];
#pragma unroll
    for (int c = 0; c < 4; ++c) kaddr[c] = q * 128 + (((2 * c + h) ^ ((q >> 1) & 7)) << 4);
#pragma unroll
    for (int dh = 0; dh < 2; ++dh)
#pragma unroll
        for (int sx = 0; sx < 2; ++sx) vaddr[dh][sx] = 4096 + (32 * dh + q) * 64 + (((2 * sx + h) ^ ((q >> 2) & 3)) << 4);
    int tokq[2]; bf16x8 qf[2][4]; QState st[2];
#pragma unroll
    for (int n = 0; n < 2; ++n) {
        tokq[n] = MODE == 3 ? b * SEQ + (r00 + 2 * n + (q >> 4)) * 64 + qcg : b * SEQ + (Jq + 32 * n + q) * dil + rho;
        const bf16_t* qp = QK + (size_t)tokq[n] * QKW + qcol + 8 * h;
#pragma unroll
        for (int c = 0; c < 4; ++c) qf[n][c] = *(const bf16x8*)(qp + 16 * c);
        st[n].m = -1e30f; st[n].den = 0.f;
        if (MODE == 0) { st[n].m = p.sink[l * 6 + hq] * LOG2E; st[n].den = 1.0f; }
#pragma unroll
        for (int i = 0; i < 16; ++i) { st[n].O0[i] = 0.f; st[n].O1[i] = 0.f; }
    }
    int sc_q = 0, qrow0 = 0, qrow1 = 0, srq0 = 0, srq1 = 0, lo0 = 0, hi0 = 0, lo1 = 0, hi1 = 0;
    if (MODE == 3) { sc_q = qcg - 8 < 0 ? 0 : qcg - 8 > 48 ? 48 : qcg - 8;
        qrow0 = r00 + (q >> 4); qrow1 = qrow0 + 2; srq0 = qrow0 - 4 < 0 ? 0 : qrow0 - 4 > 56 ? 56 : qrow0 - 4; srq1 = qrow1 - 4 < 0 ? 0 : qrow1 - 4 > 56 ? 56 : qrow1 - 4;
        lo0 = r00 - 4 < 0 ? 0 : r00 - 4 > 56 ? 56 : r00 - 4; hi0 = (r00 - 3 < 0 ? 0 : r00 - 3 > 56 ? 56 : r00 - 3) + 8; lo1 = r00 - 2 < 0 ? 0 : r00 - 2 > 56 ? 56 : r00 - 2; hi1 = (r00 - 1 < 0 ? 0 : r00 - 1 > 56 ? 56 : r00 - 1) + 8; }
    const LAS float* bt_head = rpb_lds + hq * 465;
#define AT_S(S, n) do { _Pragma("unroll") for (int i_ = 0; i_ < 16; ++i_) S[i_] = 0.f; _Pragma("unroll") for (int c_ = 0; c_ < 4; ++c_) S = __builtin_amdgcn_mfma_f32_32x32x16_bf16(kf[c_], qf[n][c_], S, 0, 0, 0); } while (0)
#define AT_PV(n, p0, p1) do { st[n].O0 = __builtin_amdgcn_mfma_f32_32x32x16_bf16(vf[0][0], p0, st[n].O0, 0, 0, 0); st[n].O0 = __builtin_amdgcn_mfma_f32_32x32x16_bf16(vf[0][1], p1, st[n].O0, 0, 0, 0); \
        st[n].O1 = __builtin_amdgcn_mfma_f32_32x32x16_bf16(vf[1][0], p0, st[n].O1, 0, 0, 0); st[n].O1 = __builtin_amdgcn_mfma_f32_32x32x16_bf16(vf[1][1], p1, st[n].O1, 0, 0, 0); } while (0)
    for (int t = t_lo; t < t_hi; ++t) {
        const int buf = (t - t_lo) & 1;
        if (t + 1 < t_hi) { AT_DMA(t + 1, buf ^ 1); asm volatile("s_waitcnt vmcnt(8)" ::: "memory"); }
        else asm volatile("s_waitcnt vmcnt(0)" ::: "memory");
        const LAS unsigned char* bb = ring + buf * 8192;
        const bool act0 = MODE == 3 ? (t >= lo0 && t < hi0) : (t < NT), act1 = MODE == 3 ? (t >= lo1 && t < hi1) : (t >= 1);
        bf16x8 kf[4], vf[2][2];
#pragma unroll
        for (int c = 0; c < 4; ++c) kf[c] = *(const LAS bf16x8*)(bb + kaddr[c]);
        if (act0 && act1) {
            f32x16 S0, S1; AT_S(S0, 0); AT_S(S1, 1);
            mask_tile<MODE>(S0, t, NT, q, h, t, qrow0, srq0, sc_q, kc0, qcg, bt_head); mask_tile<MODE>(S1, t - 1, NT, q, h, t, qrow1, srq1, sc_q, kc0, qcg, bt_head);
            bf16x8 pa0, pa1, pb0, pb1;
            softmax_tile(S0, st[0], pa0, pa1); softmax_tile(S1, st[1], pb0, pb1);
            __builtin_amdgcn_sched_barrier(0);
#pragma unroll
            for (int dh = 0; dh < 2; ++dh)
#pragma unroll
                for (int sx = 0; sx < 2; ++sx) vf[dh][sx] = *(const LAS bf16x8*)(bb + vaddr[dh][sx]);
            AT_PV(0, pa0, pa1); AT_PV(1, pb0, pb1);
        } else if (act0) {
            f32x16 S0; AT_S(S0, 0);
#pragma unroll
            for (int dh = 0; dh < 2; ++dh)
#pragma unroll
                for (int sx = 0; sx < 2; ++sx) vf[dh][sx] = *(const LAS bf16x8*)(bb + vaddr[dh][sx]);
            mask_tile<MODE>(S0, t, NT, q, h, t, qrow0, srq0, sc_q, kc0, qcg, bt_head);
            bf16x8 pa0, pa1; softmax_tile(S0, st[0], pa0, pa1); AT_PV(0, pa0, pa1);
        } else if (act1) {
            f32x16 S1; AT_S(S1, 1);
#pragma unroll
            for (int dh = 0; dh < 2; ++dh)
#pragma unroll
                for (int sx = 0; sx < 2; ++sx) vf[dh][sx] = *(const LAS bf16x8*)(bb + vaddr[dh][sx]);
            mask_tile<MODE>(S1, t - 1, NT, q, h, t, qrow1, srq1, sc_q, kc0, qcg, bt_head);
            bf16x8 pb0, pb1; softmax_tile(S1, st[1], pb0, pb1); AT_PV(1, pb0, pb1);
        }
    }
#undef AT_DMA
#undef AT_S
#undef AT_PV
#pragma unroll
    for (int n = 0; n < 2; ++n) {
        const float rd = 1.0f / st[n].den;
        bf16_t* op;
        if (MODE == 1 || MODE == 2) { op = P_OB3(p) + ((size_t)g * NTOK + tokq[n]) * 128 + 64 * hs; if (h == 0) P_LSE(p)[((size_t)g * NTOK + tokq[n]) * 2 + hs] = (st[n].m + __log2f(st[n].den)) * LN2; }
        else op = P_OC(p) + (size_t)tokq[n] * OCW + (MODE == 0 ? 64 * hq : 512 + 64 * hq);
#pragma unroll
        for (int gq = 0; gq < 4; ++gq) {
            u32x2 w0, w1;
            w0[0] = cvt2(st[n].O0[4 * gq] * rd, st[n].O0[4 * gq + 1] * rd); w0[1] = cvt2(st[n].O0[4 * gq + 2] * rd, st[n].O0[4 * gq + 3] * rd);
            w1[0] = cvt2(st[n].O1[4 * gq] * rd, st[n].O1[4 * gq + 1] * rd); w1[1] = cvt2(st[n].O1[4 * gq + 2] * rd, st[n].O1[4 * gq + 3] * rd);
            *(u32x2*)(op + 8 * gq + 4 * h) = w0; *(u32x2*)(op + 32 + 8 * gq + 4 * h) = w1;
        }
    }
}
}
DI void f_attn_phase(const Params& p, int l, LAS unsigned char* lds, int slot) {
    const int tid = otid(), lane = tid & 63, wid = __builtin_amdgcn_readfirstlane(tid >> 6);
    LAS float* rpb_lds = (LAS float*)(lds + 131072 + 64);
    for (int i = tid; i < 4 * 465; i += 512) rpb_lds[i] = p.rpb[(size_t)l * 4 * 465 + i] * at::LOG2E;
    __syncthreads();
    LAS unsigned char* ring = lds + wid * 16384;
    const int x8 = blockIdx.x & 7;
    unsigned* ctr = (unsigned*)(p.ws + OFF_CTL + 16384) + 64 * (slot * 8 + x8);
    for (;;) {
        unsigned k = 0u;
        if (lane == 0) k = __hip_atomic_fetch_add(ctr, 1u, __ATOMIC_RELAXED, __HIP_MEMORY_SCOPE_AGENT);
        k = (unsigned)__builtin_amdgcn_readfirstlane((int)k);
        if (k >= 512u) break;
        int ln = lane; asm volatile("" : "+v"(ln));
        if (k < 192u) at::wave_unit<0>(p, l, x8 * 192 + (int)k, rpb_lds, ring, ln);
        else if (k < 320u) at::wave_unit<3>(p, l, x8 * 128 + (int)k - 192, rpb_lds, ring, ln);
        else { const int ub = x8 * 192 + (int)k - 320; if (((ub >> 7) % 3) == 1) at::wave_unit<2>(p, l, ub, rpb_lds, ring, ln); else at::wave_unit<1>(p, l, ub, rpb_lds, ring, ln); }
    }
    __syncthreads();
}

DI void bcombine_phase(const Params& p) {
    for (int i = blockIdx.x * 512 + otid(); i < NTOK * 16; i += gridDim.x * 512) {
        const int tok = i >> 4, part = i & 15, hs = part >> 3, d0 = (part & 7) * 8;
        const float l0 = P_LSE(p)[((size_t)0 * NTOK + tok) * 2 + hs], l1 = P_LSE(p)[((size_t)1 * NTOK + tok) * 2 + hs], l2 = P_LSE(p)[((size_t)2 * NTOK + tok) * 2 + hs];
        const float mx = fmaxf(l0, fmaxf(l1, l2)), e0 = __expf(l0 - mx), e1 = __expf(l1 - mx), e2 = __expf(l2 - mx), rs = 1.0f / (e0 + e1 + e2);
        const float a0 = e0 * rs, a1 = e1 * rs, a2 = e2 * rs;
        const u32x4 w0 = *(const u32x4*)(P_OB3(p) + ((size_t)0 * NTOK + tok) * 128 + 64 * hs + d0);
        const u32x4 w1 = *(const u32x4*)(P_OB3(p) + ((size_t)1 * NTOK + tok) * 128 + 64 * hs + d0);
        const u32x4 w2 = *(const u32x4*)(P_OB3(p) + ((size_t)2 * NTOK + tok) * 128 + 64 * hs + d0);
        u32x4 o;
#pragma unroll
        for (int j = 0; j < 4; ++j) o[j] = pk2(a0 * bflo(w0[j]) + a1 * bflo(w1[j]) + a2 * bflo(w2[j]), a0 * bfhi(w0[j]) + a1 * bfhi(w1[j]) + a2 * bfhi(w2[j]));
        *(u32x4*)(P_OC(p) + (size_t)tok * OCW + 384 + 64 * hs + d0) = o;
    }
}

namespace g8 {
constexpr int BM = 256, BK = 64, HALF = 128, HTB = HALF * BK * 2, NXCD = 8, WGM = 8;
DI int lds_byte(int r, int c) { const int st = (r >> 4) * 2 + (c >> 5), rr = r & 15, cc = c & 31, ob = rr * 64 + cc * 2; return st * 1024 + (ob ^ (((ob >> 9) & 1) << 5)); }
DI void stage_rc(int b, int& R, int& C) { const int st = b / 1024, sb = b % 1024, swz = sb ^ (((sb >> 9) & 1) << 5); R = (st >> 1) * 16 + swz / 64; C = (st & 1) * 32 + (swz % 64) / 2; }
DI int perm32(int rho) { const int n = rho >> 4, i = rho & 15; return 8 * (i >> 2) + 4 * n + (i & 3); }
struct Unit { int pm, pn, aux; };
struct StaticOrder {
    int nM, nN, nwg, G, c;
    DI void init(int M, int N, int G_, int c_) { nM = M / BM; nN = N / BM; nwg = nM * nN; G = G_; c = c_; }
    DI bool next(int i, Unit& u) const {
        const long L = (long)i * G + c; if (L >= nwg) return false;
        int wgid = (int)L; { const int q = nwg / NXCD, r = nwg % NXCD, xcd = wgid % NXCD, off = wgid / NXCD; wgid = (xcd < r ? xcd * (q + 1) : r * (q + 1) + (xcd - r) * q) + off; }
        const int nig = WGM * nN, gid = wgid / nig, fm = gid * WGM, gsz = (nM - fm) < WGM ? (nM - fm) : WGM;
        u.pm = fm + ((wgid % nig) % gsz); u.pn = (wgid % nig) / gsz; u.aux = 0; return true;
    }
};
typedef f32x4 Acc[2][2][4][2];
typedef int i32x4 __attribute__((ext_vector_type(4)));
typedef int i32x8 __attribute__((ext_vector_type(8)));
DI bf16x8 half8(const i32x8& v, int k) { const i32x4 x = k == 0 ? __builtin_shufflevector(v, v, 0, 1, 2, 3) : __builtin_shufflevector(v, v, 4, 5, 6, 7); return __builtin_bit_cast(bf16x8, x); }
DI i32x8 cat8(const bf16x8& a, const bf16x8& b) { const i32x4 x = __builtin_bit_cast(i32x4, a), y = __builtin_bit_cast(i32x4, b); return __builtin_shufflevector(x, y, 0, 1, 2, 3, 4, 5, 6, 7); }

template <class Desc, class Epi, class Sched, bool ALIGN_EPI>
DI void gemm_phase(LAS unsigned char* lds, const Desc& D, const Sched& S, const Epi& E) {
    const int tid = otid(), wid = __builtin_amdgcn_readfirstlane(tid >> 6), lane = tid & 63, wr = wid >> 2, wc = wid & 3, fr = lane & 15, fq = lane >> 4;
    int R0, C0, R1, C1; stage_rc(tid * 16, R0, C0); stage_rc(tid * 16 + 8192, R1, C1);
    const int Rb0 = Epi::PERM ? ((R0 & ~31) + perm32(R0 & 31)) : R0, Rb1 = Epi::PERM ? ((R1 & ~31) + perm32(R1 & 31)) : R1;
    constexpr unsigned LDA2 = Desc::lda * 2, LDB2 = Desc::ldb * 2;
    const size_t kstep = (size_t)(BK * 2);
    const unsigned ldsw = (unsigned)wid * 1024u;
    const int aoff = lds_byte(wr * 64 + fr, fq * 8), boff = lds_byte(wc * 32 + fr, fq * 8);
#define G8_SA(b, h) (((b) * 2 + (h)) * HTB)
#define G8_SB(b, h) ((4 + (b) * 2 + (h)) * HTB)
#define G8_STAGE(bufoff, gbase, o0, o1) do { \
        __builtin_amdgcn_global_load_lds((const unsigned*)((const char*)(gbase) + (o0)), (LAS unsigned*)(lds + (bufoff) + ldsw), 16, 0, 0); \
        __builtin_amdgcn_global_load_lds((const unsigned*)((const char*)(gbase) + (o1)), (LAS unsigned*)(lds + (bufoff) + ldsw + 8192), 16, 0, 0); } while (0)
#define G8_LDA(dst, b, h) do { _Pragma("unroll") for (int m = 0; m < 4; ++m) { const bf16x8 lo_ = *(const LAS bf16x8*)(lds + G8_SA(b, h) + aoff + m * 2048), hi_ = *(const LAS bf16x8*)(lds + G8_SA(b, h) + aoff + m * 2048 + 1024); dst[m] = cat8(lo_, hi_); } } while (0)
#define G8_LDB(dst, b, h) do { _Pragma("unroll") for (int n = 0; n < 2; ++n) { const bf16x8 lo_ = *(const LAS bf16x8*)(lds + G8_SB(b, h) + boff + n * 2048), hi_ = *(const LAS bf16x8*)(lds + G8_SB(b, h) + boff + n * 2048 + 1024); dst[n] = cat8(lo_, hi_); } } while (0)
#define G8_MMA(ai, bj, At, Bt) do { __builtin_amdgcn_s_setprio(1); _Pragma("unroll") for (int m = 0; m < 4; ++m) _Pragma("unroll") for (int n = 0; n < 2; ++n) _Pragma("unroll") for (int k = 0; k < 2; ++k) \
        acc[ai][bj][m][n] = __builtin_amdgcn_mfma_f32_16x16x32_bf16(half8(Bt[n], k), half8(At[m], k), acc[ai][bj][m][n], 0, 0, 0); __builtin_amdgcn_s_setprio(0); } while (0)
#define G8_MMA8(ai, bj, At, Bt) do { __builtin_amdgcn_s_setprio(1); _Pragma("unroll") for (int m = 0; m < 4; ++m) _Pragma("unroll") for (int n = 0; n < 2; ++n) \
        asm volatile("v_mfma_scale_f32_16x16x128_f8f6f4 %0, %1, %2, %0, %3, %3 op_sel_hi:[0,0,0]" : "+v"(acc[ai][bj][m][n]) : "v"(Bt[n]), "v"(At[m]), "v"(one_scale));     __builtin_amdgcn_s_setprio(0); } while (0)
#define G8_MM(ai, bj, At, Bt) do { if constexpr (Desc::FP8) G8_MMA8(ai, bj, At, Bt); else G8_MMA(ai, bj, At, Bt); } while (0)
#define G8_WAIT_V(n) asm volatile("s_waitcnt vmcnt(" #n ")" ::: "memory")
#define G8_WAIT_L(n) asm volatile("s_waitcnt lgkmcnt(" #n ")" ::: "memory")
#define G8_BAR __builtin_amdgcn_s_barrier()
#define G8_SCHED __builtin_amdgcn_sched_barrier(0)
#define G8_MKA(u, uidx, o) do { \
        o[0][0] = (unsigned)(Desc::GATHER ? D.a_row(u, uidx, R0) : R0) * LDA2 + (unsigned)C0 * 2u; o[0][1] = (unsigned)(Desc::GATHER ? D.a_row(u, uidx, R1) : R1) * LDA2 + (unsigned)C1 * 2u; \
        if (Desc::GATHER) { o[1][0] = (unsigned)D.a_row(u, uidx, HALF + R0) * LDA2 + (unsigned)C0 * 2u; o[1][1] = (unsigned)D.a_row(u, uidx, HALF + R1) * LDA2 + (unsigned)C1 * 2u; } } while (0)
#define G8_MKB(u, o, hs) do { const unsigned dl_ = (unsigned)D.dilB(u) * LDB2; hs = (unsigned)HALF * dl_; \
        o[0] = (unsigned)Rb0 * dl_ + (unsigned)C0 * 2u; o[1] = (unsigned)Rb1 * dl_ + (unsigned)C1 * 2u; } while (0)
#define G8_A1(o, i) (Desc::GATHER ? o[1][i] : o[0][i] + (unsigned)HALF * LDA2)
    Unit cur, nxt; int ui = 0;
    if (!S.next(0, cur)) return;
    Acc acc;
#pragma unroll
    for (int a = 0; a < 2; ++a)
#pragma unroll
        for (int b = 0; b < 2; ++b)
#pragma unroll
            for (int m = 0; m < 4; ++m)
#pragma unroll
                for (int n = 0; n < 2; ++n) acc[a][b][m][n] = (f32x4){0.f, 0.f, 0.f, 0.f};
    int one_scale = 0x7f7f7f7f; asm volatile("" : "+v"(one_scale));
    i32x8 At[4], B0[2], B1[2];
    unsigned cAo[2][2], cBo[2], nAo[2][2], nBo[2], cBh, nBh;
    G8_MKA(cur, 0, cAo); G8_MKB(cur, cBo, cBh); nBh = cBh;
    const char* cA = D.a_base(cur); const char* cB = D.b_base(cur);
    G8_STAGE(G8_SB(0, 0), cB, cBo[0], cBo[1]); G8_STAGE(G8_SB(0, 1), cB + cBh, cBo[0], cBo[1]); G8_STAGE(G8_SA(0, 0), cA, cAo[0][0], cAo[0][1]); G8_STAGE(G8_SA(0, 1), cA, G8_A1(cAo, 0), G8_A1(cAo, 1));
    if (wr == 1) G8_BAR;
    G8_WAIT_V(2); G8_BAR;
    G8_STAGE(G8_SB(1, 0), cB + kstep, cBo[0], cBo[1]); G8_STAGE(G8_SA(1, 0), cA + kstep, cAo[0][0], cAo[0][1]); G8_STAGE(G8_SB(1, 1), cB + kstep + cBh, cBo[0], cBo[1]);
    G8_WAIT_V(6); G8_BAR;
    for (;;) {
        const bool has_next = S.next(ui + 1, nxt);
        const char* nA = cA; const char* nB = cB;
        if (has_next) { nA = D.a_base(nxt); nB = D.b_base(nxt); }
        if (Desc::GATHER) { if (has_next) G8_MKA(nxt, ui + 1, nAo); else { nAo[0][0] = cAo[0][0]; nAo[0][1] = cAo[0][1]; nAo[1][0] = cAo[1][0]; nAo[1][1] = cAo[1][1]; } }
        if (Desc::VARB) { if (has_next) G8_MKB(nxt, nBo, nBh); else { nBo[0] = cBo[0]; nBo[1] = cBo[1]; nBh = cBh; } }
        const int nt = D.nt(cur);
#pragma unroll 1
        for (int t = 0; t < nt; t += 2) {
            const bool last = (t == nt - 2);
            const char* a1 = cA + (size_t)(t + 1) * kstep;
            const char* a2 = last ? nA : cA + (size_t)(t + 2) * kstep; const char* b2 = last ? nB : cB + (size_t)(t + 2) * kstep;
            const char* a3 = a2 + kstep; const char* b3 = b2 + kstep;
            const unsigned xa00 = (Desc::GATHER && last) ? nAo[0][0] : cAo[0][0], xa01 = (Desc::GATHER && last) ? nAo[0][1] : cAo[0][1];
            const unsigned xa10 = Desc::GATHER ? (last ? nAo[1][0] : cAo[1][0]) : xa00 + (unsigned)HALF * LDA2, xa11 = Desc::GATHER ? (last ? nAo[1][1] : cAo[1][1]) : xa01 + (unsigned)HALF * LDA2;
            const unsigned xb0 = (Desc::VARB && last) ? nBo[0] : cBo[0], xb1 = (Desc::VARB && last) ? nBo[1] : cBo[1], xbh = (Desc::VARB && last) ? nBh : cBh;
            G8_LDB(B0, 0, 0); G8_LDB(B1, 0, 1); G8_SCHED; G8_LDA(At, 0, 0); G8_STAGE(G8_SA(1, 1), a1, G8_A1(cAo, 0), G8_A1(cAo, 1));
            G8_WAIT_V(8); G8_WAIT_L(0); G8_BAR; G8_MM(0, 0, At, B0); G8_MM(0, 1, At, B1); G8_BAR; G8_SCHED;
            G8_LDA(At, 0, 1); G8_STAGE(G8_SB(0, 0), b2, xb0, xb1); G8_STAGE(G8_SB(0, 1), b2 + xbh, xb0, xb1); G8_STAGE(G8_SA(0, 0), a2, xa00, xa01);
            G8_WAIT_V(8); G8_WAIT_L(0); G8_BAR; G8_MM(1, 0, At, B0); G8_MM(1, 1, At, B1); G8_BAR; G8_SCHED;
            G8_LDB(B0, 1, 0); G8_LDB(B1, 1, 1); G8_SCHED; G8_LDA(At, 1, 0); G8_STAGE(G8_SA(0, 1), a2, xa10, xa11);
            G8_WAIT_V(8); G8_WAIT_L(0); G8_BAR; G8_MM(0, 0, At, B0); G8_MM(0, 1, At, B1); G8_BAR; G8_SCHED;
            G8_LDA(At, 1, 1); G8_STAGE(G8_SB(1, 0), b3, xb0, xb1); G8_STAGE(G8_SB(1, 1), b3 + xbh, xb0, xb1); G8_STAGE(G8_SA(1, 0), a3, xa00, xa01);
            G8_WAIT_V(8); G8_WAIT_L(0); G8_BAR; G8_MM(1, 0, At, B0); G8_MM(1, 1, At, B1); G8_BAR; G8_SCHED;
        }
        if constexpr (ALIGN_EPI) { if (wr == 0) G8_BAR; }
        if constexpr (Desc::FP8) asm volatile("s_nop 15\n\ts_nop 15" ::: "memory");
        E(acc, cur, wr, wc, fr, fq);
        if (!has_next) break;
#pragma unroll
        for (int a = 0; a < 2; ++a)
#pragma unroll
            for (int b = 0; b < 2; ++b)
#pragma unroll
                for (int m = 0; m < 4; ++m)
#pragma unroll
                    for (int n = 0; n < 2; ++n) acc[a][b][m][n] = (f32x4){0.f, 0.f, 0.f, 0.f};
        if constexpr (Desc::FP8) asm volatile("s_nop 7" ::: "memory");
        cur = nxt; cA = nA; cB = nB; ++ui;
        if (Desc::GATHER) { cAo[0][0] = nAo[0][0]; cAo[0][1] = nAo[0][1]; cAo[1][0] = nAo[1][0]; cAo[1][1] = nAo[1][1]; }
        if (Desc::VARB) { cBo[0] = nBo[0]; cBo[1] = nBo[1]; cBh = nBh; }
        if constexpr (ALIGN_EPI) { if (wr == 1) G8_BAR; }
    }
    G8_WAIT_V(0);
    if constexpr (!ALIGN_EPI) { if (wr == 0) G8_BAR; }
    G8_BAR;
#undef G8_SA
#undef G8_SB
#undef G8_STAGE
#undef G8_LDA
#undef G8_LDB
#undef G8_MMA
#undef G8_MMA8
#undef G8_MM
#undef G8_WAIT_V
#undef G8_WAIT_L
#undef G8_BAR
#undef G8_SCHED
#undef G8_MKA
#undef G8_MKB
#undef G8_A1
}
DI unsigned cvt2(float lo, float hi) { typedef __bf16 bf2_t __attribute__((ext_vector_type(2))); const f32x2 v = {lo, hi}; const bf2_t b = __builtin_convertvector(v, bf2_t); return __builtin_bit_cast(unsigned, b); }
DI u32x4 pack8(const f32x4& a, const f32x4& b) { u32x4 w; w[0] = cvt2(a[0], a[1]); w[1] = cvt2(a[2], a[3]); w[2] = cvt2(b[0], b[1]); w[3] = cvt2(b[2], b[3]); return w; }
DI float fsig(float x) { return __builtin_amdgcn_rcpf(1.0f + __expf(-x)); }

struct DescMoe1 { static constexpr bool GATHER = true, VARB = false, FP8 = true; static constexpr int lda = DM / 2, ldb = DM / 2; const bf16_t* XN8; const bf16_t* WGU; const LAS int* rowlist;
    DI const char* a_base(const Unit&) const { return (const char*)XN8; }
    DI const char* b_base(const Unit& u) const { return (const char*)WGU + ((size_t)(u.pm >> 3) * 4096 + (size_t)u.pn * 256) * DM; }
    DI int a_row(const Unit&, int uidx, int r) const { return rowlist[uidx * 256 + r]; }
    DI int nt(const Unit&) const { return DM / 128; } DI int dilB(const Unit&) const { return 1; } };
struct EpiSwiglu { static constexpr bool PERM = true; unsigned char* HID8;
    DI void operator()(const Acc& acc, const Unit& u, int wr, int wc, int fr, int fq) const {
        const int row0 = u.pm * BM + wr * 64 + fr, col0 = u.pn * 128 + wc * 32 + 8 * fq; constexpr float WI = 1.0f / W8_SCALE;
#pragma unroll
        for (int ai = 0; ai < 2; ++ai)
#pragma unroll
            for (int m = 0; m < 4; ++m) { f32x4 h0, h1;
#pragma unroll
                for (int j = 0; j < 4; ++j) { const float g0 = acc[ai][0][m][0][j] * WI, g1 = acc[ai][0][m][1][j] * WI;
                    h0[j] = g0 * fsig(g0) * acc[ai][1][m][0][j] * (WI * H8_SCALE); h1[j] = g1 * fsig(g1) * acc[ai][1][m][1][j] * (WI * H8_SCALE); }
                u32x2 w; w[0] = pk4_fp8(h0[0], h0[1], h0[2], h0[3]); w[1] = pk4_fp8(h1[0], h1[1], h1[2], h1[3]);
                *(u32x2*)(HID8 + (size_t)(row0 + ai * HALF + m * 16) * FF + col0) = w; }
    } };
struct DescMoe2 { static constexpr bool GATHER = false, VARB = false, FP8 = true; static constexpr int lda = FF / 2, ldb = FF / 2; const unsigned char* HID8; const bf16_t* WD;
    DI const char* a_base(const Unit& u) const { return (const char*)HID8 + (size_t)u.pm * 256 * FF; }
    DI const char* b_base(const Unit& u) const { return (const char*)WD + ((size_t)(u.pm >> 3) * 1024 + (size_t)u.pn * 256) * FF; }
    DI int a_row(const Unit&, int, int r) const { return r; }
    DI int nt(const Unit&) const { return FF / 128; } DI int dilB(const Unit&) const { return 1; } };
struct EpiY { static constexpr bool PERM = true; bf16_t* Y; const float* VAL;
    DI void operator()(const Acc& acc, const Unit& u, int wr, int wc, int fr, int fq) const {
        const int row0 = u.pm * BM + wr * 64 + fr, col0 = u.pn * BM + wc * 32 + 8 * fq;
        float vv[2][4];
#pragma unroll
        for (int ai = 0; ai < 2; ++ai)
#pragma unroll
            for (int m = 0; m < 4; ++m) vv[ai][m] = VAL[row0 + ai * HALF + m * 16];
#pragma unroll
        for (int ai = 0; ai < 2; ++ai)
#pragma unroll
            for (int m = 0; m < 4; ++m) { const int row = row0 + ai * HALF + m * 16; const float v = vv[ai][m] * (1.0f / (W8_SCALE * H8_SCALE));
#pragma unroll
                for (int bj = 0; bj < 2; ++bj) *(u32x4*)(Y + (size_t)row * DM + col0 + bj * HALF) = pack8(acc[ai][bj][m][0] * v, acc[ai][bj][m][1] * v); }
    } };
struct DescOut { static constexpr bool GATHER = false, VARB = false, FP8 = false; static constexpr int lda = DM, ldb = DM; const bf16_t* MG; const bf16_t* WO;
    DI const char* a_base(const Unit& u) const { return (const char*)(MG + (size_t)u.pm * 256 * DM); }
    DI const char* b_base(const Unit& u) const { return (const char*)(WO + (size_t)u.pn * 256 * DM); }
    DI int a_row(const Unit&, int, int r) const { return r; }
    DI int nt(const Unit&) const { return DM / BK; } DI int dilB(const Unit&) const { return 1; } };
struct EpiResid { static constexpr bool PERM = true; bf16_t* X;
    DI void operator()(const Acc& acc, const Unit& u, int wr, int wc, int fr, int fq) const {
        const int row0 = u.pm * BM + wr * 64 + fr, col0 = u.pn * BM + wc * 32 + 8 * fq;
#pragma unroll
        for (int ai = 0; ai < 2; ++ai) {
            u32x4 x[4][2];
#pragma unroll
            for (int m = 0; m < 4; ++m)
#pragma unroll
                for (int bj = 0; bj < 2; ++bj) x[m][bj] = *(const u32x4*)(X + (size_t)(row0 + ai * HALF + m * 16) * DM + col0 + bj * HALF);
#pragma unroll
            for (int m = 0; m < 4; ++m)
#pragma unroll
                for (int bj = 0; bj < 2; ++bj) { f32x4 v0 = acc[ai][bj][m][0], v1 = acc[ai][bj][m][1]; const u32x4 ww = x[m][bj];
                    v0[0] += bflo(ww[0]); v0[1] += bfhi(ww[0]); v0[2] += bflo(ww[1]); v0[3] += bfhi(ww[1]); v1[0] += bflo(ww[2]); v1[1] += bfhi(ww[2]); v1[2] += bflo(ww[3]); v1[3] += bfhi(ww[3]);
                    *(u32x4*)(X + (size_t)(row0 + ai * HALF + m * 16) * DM + col0 + bj * HALF) = pack8(v0, v1); }
            __builtin_amdgcn_sched_barrier(0);
        }
    } };
struct DescInproj { static constexpr bool GATHER = false, VARB = false, FP8 = false; static constexpr int lda = DM, ldb = DM; const bf16_t* XN; const bf16_t* WIN;
    DI const char* a_base(const Unit& u) const { return (const char*)(XN + (size_t)u.pm * 256 * DM); }
    DI const char* b_base(const Unit& u) const { return (const char*)(WIN + (size_t)u.pn * 256 * DM); }
    DI int a_row(const Unit&, int, int r) const { return r; }
    DI int nt(const Unit&) const { return DM / BK; } DI int dilB(const Unit&) const { return 1; } };
struct EpiInproj { static constexpr bool PERM = true; bf16_t* QK; unsigned char* G; const float* cosT; const float* sinT; const float* bgate;
    DI void operator()(const Acc& acc, const Unit& u, int wr, int wc, int fr, int fq) const {
        const int row0 = u.pm * BM + wr * 64 + fr;
        if (u.pn < 5) {
            const int hr = 4 * u.pn + wc; const float sc = (hr < 6 || (hr >= 8 && hr < 14)) ? 0.125f * 1.4426950408889634f : 1.0f;
#pragma unroll
            for (int ai = 0; ai < 2; ++ai) {
                f32x4 tc[4][2], ts[4][2];
#pragma unroll
                for (int m = 0; m < 4; ++m) { const int pos = (row0 + ai * HALF + m * 16) & (SEQ - 1);
                    tc[m][0] = *(const f32x4*)(cosT + pos * 32 + 8 * fq); tc[m][1] = *(const f32x4*)(cosT + pos * 32 + 8 * fq + 4); ts[m][0] = *(const f32x4*)(sinT + pos * 32 + 8 * fq); ts[m][1] = *(const f32x4*)(sinT + pos * 32 + 8 * fq + 4); }
#pragma unroll
                for (int m = 0; m < 4; ++m) { const int row = row0 + ai * HALF + m * 16;
                    const f32x4 c0 = tc[m][0], c1 = tc[m][1], s0 = ts[m][0], s1 = ts[m][1];
                    const f32x4 a0 = acc[ai][0][m][0], a1 = acc[ai][0][m][1], b0 = acc[ai][1][m][0], b1 = acc[ai][1][m][1];
                    bf16_t* o = QK + (size_t)row * QKW + 64 * hr + 8 * fq;
                    *(u32x4*)o = pack8((a0 * c0 - b0 * s0) * sc, (a1 * c1 - b1 * s1) * sc);
                    *(u32x4*)(o + 32) = pack8((b0 * c0 + a0 * s0) * sc, (b1 * c1 + a1 * s1) * sc); }
                __builtin_amdgcn_sched_barrier(0);
            }
        } else if (u.pn < 7) {
            const float sc = u.pn == 5 ? 0.125f * 1.4426950408889634f : 1.0f; const int col0 = 1280 + (u.pn - 5) * 256 + wc * 32 + 8 * fq;
#pragma unroll
            for (int ai = 0; ai < 2; ++ai)
#pragma unroll
                for (int m = 0; m < 4; ++m)
#pragma unroll
                    for (int bj = 0; bj < 2; ++bj) *(u32x4*)(QK + (size_t)(row0 + ai * HALF + m * 16) * QKW + col0 + bj * HALF) = pack8(acc[ai][bj][m][0] * sc, acc[ai][bj][m][1] * sc);
        } else {
            const int col0 = (u.pn - 7) * 256 + wc * 32 + 8 * fq;
            f32x4 bv[2][2];
#pragma unroll
            for (int bj = 0; bj < 2; ++bj)
#pragma unroll
                for (int n = 0; n < 2; ++n) bv[bj][n] = *(const f32x4*)(bgate + col0 + bj * HALF + 4 * n);
#pragma unroll
            for (int ai = 0; ai < 2; ++ai)
#pragma unroll
                for (int m = 0; m < 4; ++m)
#pragma unroll
                    for (int bj = 0; bj < 2; ++bj) { f32x4 v0 = acc[ai][bj][m][0] + bv[bj][0], v1 = acc[ai][bj][m][1] + bv[bj][1];
#pragma unroll
                        for (int j = 0; j < 4; ++j) { v0[j] = fsig(v0[j]) * 255.0f + 0.5f; v1[j] = fsig(v1[j]) * 255.0f + 0.5f; }
                        u32x2 w; w[0] = (unsigned)v0[0] | ((unsigned)v0[1] << 8) | ((unsigned)v0[2] << 16) | ((unsigned)v0[3] << 24); w[1] = (unsigned)v1[0] | ((unsigned)v1[1] << 8) | ((unsigned)v1[2] << 16) | ((unsigned)v1[3] << 24);
                        *(u32x2*)(G + (size_t)(row0 + ai * HALF + m * 16) * 3072 + col0 + bj * HALF) = w; }
        }
    } };
struct DescVT { static constexpr bool GATHER = false, VARB = true, FP8 = false; static constexpr int lda = DM, ldb = DM; const bf16_t* WV; const bf16_t* XN;
    DI const char* a_base(const Unit& u) const { return (const char*)(WV + (size_t)u.pm * 256 * DM); }
    DI const char* b_base(const Unit& u) const { return (const char*)(XN + (u.pm < 2 ? (size_t)u.pn * 256 : (size_t)((u.pn >> 4) * SEQ + (u.pn & 15))) * DM); }
    DI int a_row(const Unit&, int, int r) const { return r; }
    DI int nt(const Unit&) const { return DM / BK; } DI int dilB(const Unit& u) const { return u.pm < 2 ? 1 : 16; } };
struct EpiVT { static constexpr bool PERM = true; bf16_t* VT;
    DI void operator()(const Acc& acc, const Unit& u, int wr, int wc, int fr, int fq) const {
        const int row0 = u.pm * BM + wr * 64 + fr, col0 = u.pn * BM + wc * 32 + 8 * fq;
#pragma unroll
        for (int ai = 0; ai < 2; ++ai)
#pragma unroll
            for (int m = 0; m < 4; ++m)
#pragma unroll
                for (int bj = 0; bj < 2; ++bj) *(u32x4*)(VT + (size_t)(row0 + ai * HALF + m * 16) * NTOK + col0 + bj * HALF) = pack8(acc[ai][bj][m][0], acc[ai][bj][m][1]);
    } };
struct DescMerge { static constexpr bool GATHER = false, VARB = false, FP8 = false; static constexpr int lda = OCW, ldb = 768; const bf16_t* OC; const bf16_t* WM;
    DI int k0(const Unit& u) const { return u.aux == 0 ? 0 : u.aux == 1 ? 384 : 512; }
    DI const char* a_base(const Unit& u) const { return (const char*)(OC + (size_t)u.pm * 256 * OCW + k0(u)); }
    DI const char* b_base(const Unit& u) const { return (const char*)(WM + (size_t)u.pn * 256 * 768 + k0(u)); }
    DI int a_row(const Unit&, int, int r) const { return r; }
    DI int nt(const Unit& u) const { return u.aux == 0 ? 6 : u.aux == 1 ? 2 : 4; } DI int dilB(const Unit&) const { return 1; } };
struct MergeOrder { StaticOrder base;
    DI bool next(int i, Unit& u) const { const int q = i / 3; if (!base.next(q, u)) return false; u.aux = i - 3 * q; return true; } };
struct EpiMerge { static constexpr bool PERM = true; bf16_t* MG; const unsigned char* G;
    DI void operator()(const Acc& acc, const Unit& u, int wr, int wc, int fr, int fq) const {
        const int row0 = u.pm * BM + wr * 64 + fr, col0 = u.pn * BM + wc * 32 + 8 * fq;
#pragma unroll
        for (int ai = 0; ai < 2; ++ai) {
            u32x2 g[4][2]; u32x4 w[4][2];
#pragma unroll
            for (int m = 0; m < 4; ++m)
#pragma unroll
                for (int bj = 0; bj < 2; ++bj) { const int row = row0 + ai * HALF + m * 16, col = col0 + bj * HALF;
                    g[m][bj] = *(const u32x2*)(G + (size_t)row * 3072 + 1024 * u.aux + col);
                    if (u.aux != 0) w[m][bj] = *(const u32x4*)(MG + (size_t)row * DM + col); else w[m][bj] = (u32x4){0u, 0u, 0u, 0u}; }
#pragma unroll
            for (int m = 0; m < 4; ++m)
#pragma unroll
                for (int bj = 0; bj < 2; ++bj) { const int row = row0 + ai * HALF + m * 16, col = col0 + bj * HALF;
                    const u32x2 gg = g[m][bj]; const u32x4 ww = w[m][bj]; constexpr float GI = 1.0f / 255.0f;
                    f32x4 v0 = acc[ai][bj][m][0] * GI, v1 = acc[ai][bj][m][1] * GI;
                    v0[0] = v0[0] * (float)(gg[0] & 255u) + bflo(ww[0]); v0[1] = v0[1] * (float)((gg[0] >> 8) & 255u) + bfhi(ww[0]); v0[2] = v0[2] * (float)((gg[0] >> 16) & 255u) + bflo(ww[1]); v0[3] = v0[3] * (float)(gg[0] >> 24) + bfhi(ww[1]);
                    v1[0] = v1[0] * (float)(gg[1] & 255u) + bflo(ww[2]); v1[1] = v1[1] * (float)((gg[1] >> 8) & 255u) + bfhi(ww[2]); v1[2] = v1[2] * (float)((gg[1] >> 16) & 255u) + bflo(ww[3]); v1[3] = v1[3] * (float)(gg[1] >> 24) + bfhi(ww[3]);
                    *(u32x4*)(MG + (size_t)row * DM + col) = pack8(v0, v1); }
            __builtin_amdgcn_sched_barrier(0);
        }
    } };
}
DI void f_inproj_phase(const Params& p, int l, LAS unsigned char* lds) {
    { g8::StaticOrder S; S.init(NTOK, 4352, gridDim.x, blockIdx.x);
      g8::DescInproj D{P_XN(p), P_W(p, l, LW_WIN)}; g8::EpiInproj E{P_QK(p), P_G(p), P_COS(p), P_SIN(p), p.b_gate + (size_t)l * 3072};
      g8::gemm_phase<g8::DescInproj, g8::EpiInproj, g8::StaticOrder, true>(lds, D, S, E); }
    { g8::StaticOrder S; S.init(VCH, NTOK, gridDim.x, (blockIdx.x + gridDim.x - 64) % gridDim.x);
      g8::DescVT D{P_W(p, l, LW_WV), P_XN(p)}; g8::EpiVT E{P_VT(p)};
      g8::gemm_phase<g8::DescVT, g8::EpiVT, g8::StaticOrder, true>(lds, D, S, E); }
}
struct OneUnit { int pm, pn; DI bool next(int i, g8::Unit& u) const { if (i != 0) return false; u.pm = pm; u.pn = pn; u.aux = 0; return true; } };
DI void f_gate_tail_units(const Params& p, int l, LAS unsigned char* lds) {
    if (blockIdx.x < 128) {
        OneUnit S{(int)(blockIdx.x >> 1), 17 + (int)(blockIdx.x & 1)};
        g8::DescInproj D{P_XN(p), P_W(p, l, LW_WIN)}; g8::EpiInproj E{P_QK(p), P_G(p), P_COS(p), P_SIN(p), p.b_gate + (size_t)l * 3072};
        g8::gemm_phase<g8::DescInproj, g8::EpiInproj, OneUnit, false>(lds, D, S, E);
        __syncthreads();
    }
}
DI void f_merge_phase(const Params& p, int l, LAS unsigned char* lds) {
    g8::MergeOrder S; S.base.init(NTOK, DM, gridDim.x, blockIdx.x);
    g8::DescMerge D{P_OC(p), P_W(p, l, LW_WM)}; g8::EpiMerge E{P_MG(p), P_G(p)};
    g8::gemm_phase<g8::DescMerge, g8::EpiMerge, g8::MergeOrder, true>(lds, D, S, E);
}

DI void f_moe1_phase(const Params& p, int l, LAS unsigned char* lds) {
    g8::StaticOrder S; S.init(NROWS_E, 2 * FF, gridDim.x, blockIdx.x);
    LAS int* rowlist = (LAS int*)(lds + 131072 + 64);
    g8::Unit u;
    for (int i = 0; i < 8 && S.next(i, u); ++i)
        for (int r = otid(); r < 256; r += 512) rowlist[i * 256 + r] = ((u.pm >> 1) & 3) * SEQ + P_IDX(p)[u.pm * 256 + r];
    __syncthreads();
    g8::DescMoe1 D{(const bf16_t*)P_XN8(p), P_W(p, l, LW_WGU), rowlist}; g8::EpiSwiglu E{(unsigned char*)P_HID(p)};
    g8::gemm_phase<g8::DescMoe1, g8::EpiSwiglu, g8::StaticOrder, true>(lds, D, S, E);
}
DI void f_moe2_phase(const Params& p, int l, LAS unsigned char* lds) {
    g8::StaticOrder S; S.init(NROWS_E, DM, gridDim.x, blockIdx.x);
    g8::DescMoe2 D{(const unsigned char*)P_HID(p), P_W(p, l, LW_WD)}; g8::EpiY E{P_Y(p), P_VAL(p)};
    g8::gemm_phase<g8::DescMoe2, g8::EpiY, g8::StaticOrder, true>(lds, D, S, E);
}
DI void f_out_phase(const Params& p, int l, LAS unsigned char* lds) {
    g8::StaticOrder S; S.init(NTOK, DM, gridDim.x, blockIdx.x);
    g8::DescOut D{P_MG(p), P_W(p, l, LW_WO)}; g8::EpiResid E{P_X(p)};
    g8::gemm_phase<g8::DescOut, g8::EpiResid, g8::StaticOrder, false>(lds, D, S, E);
}

#define XB_TMO      128
#define XB_XCNT(j)  (256  + 64 * (j))
#define XB_XSUB(j)  (1280 + 64 * (j))
#define XB_XGEN(j)  (2304 + 64 * (j))
#define XB_TOP      3328
#define XB_TOPGEN   3392
#define XCD_BAR_WORDS 3456
#define XB_SPIN_CAP (1u << 22)

__device__ __forceinline__ unsigned xb_ld(unsigned* p)              { return __hip_atomic_load(p, __ATOMIC_RELAXED, __HIP_MEMORY_SCOPE_AGENT); }
__device__ __forceinline__ unsigned xb_add(unsigned* p, unsigned v) { return __hip_atomic_fetch_add(p, v, __ATOMIC_RELAXED, __HIP_MEMORY_SCOPE_AGENT); }
__device__ __forceinline__ unsigned xb_xcc_id() { return (unsigned)__builtin_amdgcn_s_getreg((3 << 11) | 20) & 0xFu; }
#define XB_SPIN(cond, bar) do { unsigned _sp = 0; while (cond) { __builtin_amdgcn_s_sleep(1); \
    if ((++_sp & 255u) == 0u) { if (xb_ld(&(bar)[XB_TMO])) break; if (_sp > XB_SPIN_CAP) { atomicAdd(&(bar)[XB_TMO], 1u); break; } } } } while (0)

struct XcdBarrier {
    unsigned* bar; unsigned x;
    volatile LAS unsigned* st;
};

__device__ __forceinline__ XcdBarrier xcd_barrier_post(unsigned* bar, volatile LAS unsigned* st) {
    XcdBarrier b; b.bar = bar; b.x = xb_xcc_id(); b.st = st;
    if (threadIdx.x == 0) (void)xb_add(&bar[XB_XCNT(b.x)], 1u);
    return b;
}
__device__ __forceinline__ void xcd_barrier_complete(unsigned* bar, unsigned x, unsigned& nloc, unsigned& nx) {
    const unsigned G = gridDim.x * gridDim.y * gridDim.z;
    unsigned sum, cnt, mine, sp = 0u;
    for (;;) {
        sum = 0u; cnt = 0u; mine = 0u;
#pragma unroll
        for (unsigned j = 0; j < 16; ++j) { const unsigned c = xb_ld(&bar[XB_XCNT(j)]); sum += c; cnt += (c > 0u) ? 1u : 0u; mine = (j == x) ? c : mine; }
        if (sum == G) break;
        __builtin_amdgcn_s_sleep(1);
        if ((++sp & 255u) == 0u) { if (xb_ld(&bar[XB_TMO])) break; if (sp > XB_SPIN_CAP) { atomicAdd(&bar[XB_TMO], 1u); break; } }
    }
    nloc = mine > 0u ? mine : 1u; nx = cnt > 0u ? cnt : 1u;
}

__device__ __forceinline__ void xcd_barrier(const XcdBarrier& b) {
    asm volatile("s_waitcnt vmcnt(0)" ::: "memory");
    __syncthreads();
    if (threadIdx.x == 0) {
        unsigned* bar = b.bar;
        __builtin_amdgcn_s_waitcnt(0);
        unsigned nloc = b.st[0], nx = b.st[1];
        if (nloc == 0u) { xcd_barrier_complete(bar, b.x, nloc, nx); b.st[0] = nloc; b.st[1] = nx; }
        const unsigned old = xb_add(&bar[XB_XSUB(b.x)], 1u);
        const unsigned gen = old / nloc;
        if (old + 1u == (gen + 1u) * nloc) {
            __builtin_amdgcn_fence(__ATOMIC_RELEASE, "agent");
            asm volatile("s_waitcnt vmcnt(0)" ::: "memory");
            const unsigned og = xb_add(&bar[XB_TOP], 1u);
            const unsigned tg = og / nx;
            if (og + 1u == (tg + 1u) * nx) xb_add(&bar[XB_TOPGEN], 1u);
            else XB_SPIN(xb_ld(&bar[XB_TOPGEN]) == tg, bar);
            __builtin_amdgcn_fence(__ATOMIC_ACQUIRE, "agent");
            xb_add(&bar[XB_XGEN(b.x)], 1u);
            asm volatile("s_waitcnt vmcnt(0)" ::: "memory");
        } else {
            XB_SPIN(xb_ld(&bar[XB_XGEN(b.x)]) == gen, bar);
            __builtin_amdgcn_fence(__ATOMIC_ACQUIRE, "agent");
            asm volatile("s_waitcnt vmcnt(0)" ::: "memory");
        }
    }
    __syncthreads();
}

constexpr int LDS_BYTES = 131072 + 64 + 8192;
#ifndef REP_PREP
#define REP_PREP 1
#define REP_INPROJ 1
#define REP_ATTN 1
#define REP_MERGE 1
#define REP_BCOMB 1
#define REP_N2 1
#define REP_TOPK 1
#define REP_MOE1 1
#define REP_MOE2 1
#endif
#define PH(...) do { Params q = p; { size_t z_ = 0; asm volatile("" : "+s"(z_)); q.ws = p.ws + z_; } __VA_ARGS__; } while (0)
#define GRID_BAR() do { XcdBarrier b_; { size_t z_ = 0; asm volatile("" : "+s"(z_)); b_.bar = (unsigned*)(p.ws + z_ + OFF_CTL); } b_.x = xb_xcc_id(); b_.st = (volatile LAS unsigned*)(lds + 131072); xcd_barrier(b_); } while (0)
__global__ void __launch_bounds__(512, 2) mega_fwd(Params p) {
    extern __shared__ __attribute__((aligned(16))) unsigned char lds_raw[];
    LAS unsigned char* lds = (LAS unsigned char*)lds_raw;
    { volatile LAS unsigned* xbw = (volatile LAS unsigned*)(lds + 131072);
      if (threadIdx.x == 0) { xbw[0] = 0u; xbw[1] = 0u; xbw[2] = 0u; xbw[3] = 0u; }
      __syncthreads();
      (void)xcd_barrier_post((unsigned*)(p.ws + OFF_CTL), xbw); }
    PH(prep_phase(q, (LAS float*)lds); norm1_phase<0>(q, 0));
    GRID_BAR();
#define LAYER(l) do { \
        if ((l) != 0) { PH(norm1_phase<1>(q, (l))); GRID_BAR(); } \
        PH(f_inproj_phase(q, (l), lds)); GRID_BAR(); \
        PH(f_gate_tail_units(q, (l), lds); f_attn_phase(q, (l), lds, (l))); GRID_BAR(); \
        PH(bcombine_phase(q)); GRID_BAR(); \
        PH(f_merge_phase(q, (l), lds)); GRID_BAR(); \
        PH(f_out_phase(q, (l), lds)); GRID_BAR(); \
        PH(norm2_router_phase(q, (l), (LAS float*)lds)); GRID_BAR(); \
        PH(topk_phase(q, (LAS unsigned*)lds)); GRID_BAR(); \
        PH(f_moe1_phase(q, (l), lds)); GRID_BAR(); \
        PH(f_moe2_phase(q, (l), lds)); GRID_BAR(); } while (0)
    LAYER(0); LAYER(1); LAYER(2); LAYER(3);
#undef LAYER
    PH(norm1_phase<2>(q, 0));
}

extern "C" void kernel_launch(void* const* d_in, const int* in_sizes, int n_in, void* d_out, int out_size, void* d_ws, size_t ws_size, hipStream_t stream) {
    (void)in_sizes; (void)out_size;
    static int grid = 0;
    if (grid == 0) {
        if (n_in != 16 || ws_size < OFF_END) { grid = -1; return; }
        int dev = 0, cus = 0, per_cu = 0;
        if (hipGetDevice(&dev) != hipSuccess || hipDeviceGetAttribute(&cus, hipDeviceAttributeMultiprocessorCount, dev) != hipSuccess) { grid = -1; return; }
        if (hipFuncSetAttribute((const void*)mega_fwd, hipFuncAttributeMaxDynamicSharedMemorySize, LDS_BYTES) != hipSuccess) { grid = -1; return; }
        if (hipOccupancyMaxActiveBlocksPerMultiprocessor(&per_cu, (const void*)mega_fwd, 512, LDS_BYTES) != hipSuccess || per_cu < 1) { (void)hipGetLastError(); }
        grid = cus;
    }
    if (grid < 0) return;
    if (hipMemsetAsync((char*)d_ws + OFF_CTL, 0, 65536, stream) != hipSuccess) return;
    Params p{};
    p.x = (const float*)d_in[0]; p.w_in = (const float*)d_in[1]; p.b_gate = (const float*)d_in[2]; p.sink = (const float*)d_in[3]; p.rpb = (const float*)d_in[4];
    p.w_a = (const float*)d_in[5]; p.w_b = (const float*)d_in[6]; p.w_c = (const float*)d_in[7]; p.w_out = (const float*)d_in[8]; p.norm_mix = (const float*)d_in[9];
    p.norm_ffn = (const float*)d_in[10]; p.w_router = (const float*)d_in[11]; p.w_gate_e = (const float*)d_in[12]; p.w_up_e = (const float*)d_in[13]; p.w_down_e = (const float*)d_in[14];
    p.norm_final = (const float*)d_in[15]; p.out = (float*)d_out; p.ws = (unsigned char*)d_ws;
    hipLaunchKernelGGL(mega_fwd, dim3(grid), dim3(512), LDS_BYTES, stream, p);
}
```

```cpp
#include <hip/hip_runtime.h>
#include <stdint.h>

#define DI __device__ __forceinline__
#define LAS __attribute__((address_space(3)))
typedef unsigned short bf16_t;
typedef short bf16x8 __attribute__((ext_vector_type(8)));
typedef float f32x2 __attribute__((ext_vector_type(2)));
typedef float f32x4 __attribute__((ext_vector_type(4)));
typedef float f32x16 __attribute__((ext_vector_type(16)));
typedef unsigned u32x2 __attribute__((ext_vector_type(2)));
typedef unsigned u32x4 __attribute__((ext_vector_type(4)));

constexpr int NTOK = 16384, DM = 1024, SEQ = 4096, NBATCH = 4, NLAYER = 4, NEXP = 16, FF = 2048, CAP = 512, PROJ = 5632;
constexpr int QKW = 1792;
constexpr int VCH = 768;
constexpr int OCW = 768;
constexpr int NROWS_E = NBATCH * CAP * NEXP;

constexpr size_t OFF_CTL = 0;
constexpr size_t OFF_COS = 65536;
constexpr size_t OFF_SIN = OFF_COS + (size_t)SEQ * 32 * 4;
constexpr size_t OFF_W   = 2u << 20;
constexpr size_t WIN_B = (size_t)4864 * 1024 * 2, WV_B = (size_t)768 * 1024 * 2, WM_B = (size_t)1024 * 768 * 2, WO_B = (size_t)1024 * 1024 * 2;
constexpr size_t WGU_B = (size_t)NEXP * 4096 * 1024 * 2, WD_B = (size_t)NEXP * 1024 * 2048 * 2;
constexpr size_t LW_WIN = 0, LW_WV = LW_WIN + WIN_B, LW_WM = LW_WV + WV_B, LW_WO = LW_WM + WM_B, LW_WGU = LW_WO + WO_B, LW_WD = LW_WGU + WGU_B, LW = LW_WD + WD_B;
constexpr size_t OFF_X   = OFF_W + NLAYER * LW;
constexpr size_t OFF_XN  = OFF_X + (size_t)NTOK * DM * 4;
constexpr size_t OFF_QK  = OFF_XN + (size_t)NTOK * DM * 2;
constexpr size_t OFF_VT  = OFF_QK + (size_t)NTOK * QKW * 2;
constexpr size_t OFF_G   = OFF_VT + (size_t)VCH * NTOK * 2;
constexpr size_t OFF_OC  = OFF_G + (size_t)NTOK * 3072 * 2;
constexpr size_t OFF_OB3 = OFF_OC + (size_t)NTOK * OCW * 2;
constexpr size_t OFF_LSE = OFF_OB3 + (size_t)3 * NTOK * 128 * 2;
constexpr size_t OFF_MG  = OFF_LSE + (size_t)3 * NTOK * 2 * 4;
constexpr size_t OFF_AFF = OFF_MG + (size_t)NTOK * DM * 2;
constexpr size_t OFF_IDX = OFF_AFF + (size_t)NTOK * NEXP * 4;
constexpr size_t OFF_VAL = OFF_IDX + (size_t)NROWS_E * 4;
constexpr size_t OFF_INV = OFF_VAL + (size_t)NROWS_E * 4;
constexpr size_t OFF_HID = OFF_INV + (size_t)NTOK * NEXP * 4;
constexpr size_t OFF_Y   = OFF_HID + (size_t)NROWS_E * FF * 2;
constexpr size_t OFF_XN8 = OFF_Y + (size_t)NROWS_E * DM * 2;
constexpr size_t OFF_END = OFF_XN8 + (size_t)NTOK * DM;

struct Params {
    const float *x, *w_in, *b_gate, *sink, *rpb, *w_a, *w_b, *w_c, *w_out, *norm_mix, *norm_ffn, *w_router, *w_gate_e, *w_up_e, *w_down_e, *norm_final;
    float* out; unsigned char* ws;
};
DI float*  P_COS(const Params& p) { return (float*)(p.ws + OFF_COS); }
DI float*  P_SIN(const Params& p) { return (float*)(p.ws + OFF_SIN); }
DI bf16_t* P_W(const Params& p, int l, size_t off) { return (bf16_t*)(p.ws + OFF_W + (size_t)l * LW + off); }
DI bf16_t* P_X(const Params& p) { return (bf16_t*)(p.ws + OFF_X); }
DI bf16_t* P_XN(const Params& p) { return (bf16_t*)(p.ws + OFF_XN); }
DI bf16_t* P_QK(const Params& p) { return (bf16_t*)(p.ws + OFF_QK); }
DI bf16_t* P_VT(const Params& p) { return (bf16_t*)(p.ws + OFF_VT); }
DI unsigned char* P_G(const Params& p) { return p.ws + OFF_G; }
DI bf16_t* P_OC(const Params& p) { return (bf16_t*)(p.ws + OFF_OC); }
DI bf16_t* P_OB3(const Params& p) { return (bf16_t*)(p.ws + OFF_OB3); }
DI float*  P_LSE(const Params& p) { return (float*)(p.ws + OFF_LSE); }
DI bf16_t* P_MG(const Params& p) { return (bf16_t*)(p.ws + OFF_MG); }
DI float*  P_AFF(const Params& p) { return (float*)(p.ws + OFF_AFF); }
DI int*    P_IDX(const Params& p) { return (int*)(p.ws + OFF_IDX); }
DI float*  P_VAL(const Params& p) { return (float*)(p.ws + OFF_VAL); }
DI int*    P_INV(const Params& p) { return (int*)(p.ws + OFF_INV); }
DI bf16_t* P_HID(const Params& p) { return (bf16_t*)(p.ws + OFF_HID); }
DI bf16_t* P_Y(const Params& p) { return (bf16_t*)(p.ws + OFF_Y); }
DI unsigned char* P_XN8(const Params& p) { return p.ws + OFF_XN8; }

DI unsigned f2bf(float f) { unsigned u = __float_as_uint(f); return (u + 0x7fffu + ((u >> 16) & 1u)) >> 16; }
DI unsigned pk2(float lo, float hi) { return f2bf(lo) | (f2bf(hi) << 16); }
constexpr float W8_SCALE = 32.0f, H8_SCALE = 4.0f;
DI unsigned pk4_fp8(float a, float b, float c, float d) { unsigned w = 0u; w = __builtin_amdgcn_cvt_pk_fp8_f32(a, b, w, false); w = __builtin_amdgcn_cvt_pk_fp8_f32(c, d, w, true); return w; }
DI float bf2f(unsigned b) { return __uint_as_float(b << 16); }
DI float bflo(unsigned w) { return __uint_as_float(w << 16); }
DI float bfhi(unsigned w) { return __uint_as_float(w & 0xffff0000u); }
DI float shx(float v, int d, int lane) { return __uint_as_float((unsigned)__builtin_amdgcn_ds_bpermute((lane ^ d) << 2, (int)__float_as_uint(v))); }
DI unsigned shl_abs(unsigned v, int src_lane) { return (unsigned)__builtin_amdgcn_ds_bpermute(src_lane << 2, (int)v); }
DI int otid() { int t = threadIdx.x; asm volatile("" : "+v"(t)); return t; }
DI int pos16(int t) { return ((t & 15) << 8) | (t >> 4); }

constexpr int JOBS_PER_LAYER = 26432, SMALL_JOBS = 1856;
DI void prep_job(const Params& p, int l, int j, const float*& src, int& src_ld, bf16_t*& dst, int& dst_ld) {
    if (j < 1216) {
        const int nblk = j >> 3, kc = j & 7; int sc;
        if (nblk < 40) { const int t = nblk >> 3, sb = nblk & 7, bj = sb >> 2, wc = sb & 3, hr = 4 * t + wc;
            const int base = hr < 6 ? 64 * hr : hr < 8 ? 384 + 64 * (hr - 6) : hr < 14 ? 640 + 64 * (hr - 8) : 1024 + 64 * (hr - 14);
            sc = base + 32 * bj; }
        else if (nblk < 56) { const int c = 32 * (nblk - 40); sc = c < 256 ? 1792 + c : 2048 + (c - 256); }
        else sc = 2560 + 32 * (nblk - 56);
        src = p.w_in + (size_t)l * DM * PROJ + (size_t)(128 * kc) * PROJ + sc; src_ld = PROJ;
        dst = P_W(p, l, LW_WIN) + (size_t)(32 * nblk) * 1024 + 128 * kc; dst_ld = 1024; return;
    }
    j -= 1216;
    if (j < 192) {
        const int nblk = j >> 3, kc = j & 7, ch = 32 * nblk;
        const int sc = ch < 128 ? 512 + ch : ch < 256 ? 1408 + (ch - 128) : ch < 512 ? 2304 + (ch - 256) : 1536 + (ch - 512);
        src = p.w_in + (size_t)l * DM * PROJ + (size_t)(128 * kc) * PROJ + sc; src_ld = PROJ;
        dst = P_W(p, l, LW_WV) + (size_t)ch * 1024 + 128 * kc; dst_ld = 1024; return;
    }
    j -= 192;
    if (j < 192) {
        bf16_t* wm = P_W(p, l, LW_WM); src_ld = 1024; dst_ld = 768;
        if (j < 96) { const int nblk = j / 3, kc = j % 3; src = p.w_a + (size_t)l * 384 * 1024 + (size_t)(128 * kc) * 1024 + 32 * nblk; dst = wm + (size_t)(32 * nblk) * 768 + 128 * kc; }
        else if (j < 128) { const int nblk = j - 96; src = p.w_b + (size_t)l * 128 * 1024 + 32 * nblk; dst = wm + (size_t)(32 * nblk) * 768 + 384; }
        else { const int jj = j - 128, nblk = jj >> 1, kc = jj & 1; src = p.w_c + (size_t)l * 256 * 1024 + (size_t)(128 * kc) * 1024 + 32 * nblk; dst = wm + (size_t)(32 * nblk) * 768 + 512 + 128 * kc; }
        return;
    }
    j -= 192;
    if (j < 256) {
        const int nblk = j >> 3, kc = j & 7;
        src = p.w_out + (size_t)l * 1024 * 1024 + (size_t)(128 * kc) * 1024 + 32 * nblk; src_ld = 1024;
        dst = P_W(p, l, LW_WO) + (size_t)(32 * nblk) * 1024 + 128 * kc; dst_ld = 1024; return;
    }
    j -= 256;
    if (j < 16384) {
        const int e = j >> 10, r = j & 1023, nblk = r >> 3, kc = r & 7, row0 = 32 * nblk, pp = row0 >> 8, s = row0 & 255;
        const float* w = s < 128 ? p.w_gate_e : p.w_up_e; const int col = 128 * pp + (s & 127);
        src = w + ((size_t)(l * NEXP + e) * 1024 + 128 * kc) * 2048 + col; src_ld = 2048;
        dst = (bf16_t*)((unsigned char*)P_W(p, l, LW_WGU) + ((size_t)e * 4096 + row0) * 1024 + 128 * kc); dst_ld = 1024; return;
    }
    j -= 16384;
    {
        const int e = j >> 9, r = j & 511, nblk = r >> 4, kc = r & 15;
        src = p.w_down_e + ((size_t)(l * NEXP + e) * 2048 + 128 * kc) * 1024 + 32 * nblk; src_ld = 1024;
        dst = (bf16_t*)((unsigned char*)P_W(p, l, LW_WD) + ((size_t)e * 1024 + 32 * nblk) * 2048 + 128 * kc); dst_ld = 2048;
    }
}
DI void sincos_d(double a, double& s, double& c) {
    const double q = rint(a * 0.63661977236758134308);
    double r = fma(-q, 1.57079632679489655800e+00, a); r = fma(-q, 6.12323399573676603587e-17, r);
    const double r2 = r * r;
    double sp = 1.58969099521155010221e-10; sp = fma(sp, r2, -2.50507602534068634195e-08); sp = fma(sp, r2, 2.75573137070700676789e-06); sp = fma(sp, r2, -1.98412698298579493134e-04);
    sp = fma(sp, r2, 8.33333333332248946124e-03); sp = fma(sp, r2, -1.66666666666666324348e-01); const double sr = fma(r * r2, sp, r);
    double cp = -1.13596475577881948265e-11; cp = fma(cp, r2, 2.08757232129817482790e-09); cp = fma(cp, r2, -2.75573143513906633035e-07); cp = fma(cp, r2, 2.48015872894767294178e-05);
    cp = fma(cp, r2, -1.38888888888741095749e-03); cp = fma(cp, r2, 4.16666666666666019037e-02); const double cr = fma(r2 * r2, cp, fma(-0.5, r2, 1.0));
    const int qi = ((int)q) & 3;
    s = qi == 0 ? sr : qi == 1 ? cr : qi == 2 ? -sr : -cr;
    c = qi == 0 ? cr : qi == 1 ? -sr : qi == 2 ? -cr : sr;
}
DI void prep_phase(const Params& p, LAS float* scr) {
    const int tid = otid();
    for (int i = blockIdx.x * 512 + tid; i < SEQ * 32; i += gridDim.x * 512) {
        const int pos = i >> 5, j = i & 31;
        double fr = 1.0; for (int jj = 0; jj < j; ++jj) fr *= 0.7498942093324559;
        const float invf = (float)fr;
        const float ang = (float)pos * invf; double s, c; sincos_d((double)ang, s, c);
        P_COS(p)[i] = (float)c; P_SIN(p)[i] = (float)s;
    }
    const int total = NLAYER * SMALL_JOBS;
    int u = blockIdx.x;
    const float* src; bf16_t* dst; int src_ld, dst_ld, j = 0;
    f32x4 r0, r1;
    if (u < total) { const int l = u / SMALL_JOBS; j = u - l * SMALL_JOBS; prep_job(p, l, j, src, src_ld, dst, dst_ld);
        r0 = *(const f32x4*)(src + (size_t)(tid >> 3) * src_ld + 4 * (tid & 7)); r1 = *(const f32x4*)(src + (size_t)((tid + 512) >> 3) * src_ld + 4 * (tid & 7)); }
    int buf = 0;
    for (; u < total; u += gridDim.x) {
        LAS float* sc = scr + buf * (128 * 33);
        { const int k = tid >> 3, c4 = tid & 7;
          sc[k * 33 + 4 * c4 + 0] = r0[0]; sc[k * 33 + 4 * c4 + 1] = r0[1]; sc[k * 33 + 4 * c4 + 2] = r0[2]; sc[k * 33 + 4 * c4 + 3] = r0[3];
          sc[(k + 64) * 33 + 4 * c4 + 0] = r1[0]; sc[(k + 64) * 33 + 4 * c4 + 1] = r1[1]; sc[(k + 64) * 33 + 4 * c4 + 2] = r1[2]; sc[(k + 64) * 33 + 4 * c4 + 3] = r1[3]; }
        bf16_t* dcur = dst; const int dld = dst_ld, jcur = j;
        const int un = u + gridDim.x;
        if (un < total) { const int l = un / SMALL_JOBS; j = un - l * SMALL_JOBS; prep_job(p, l, j, src, src_ld, dst, dst_ld);
            r0 = *(const f32x4*)(src + (size_t)(tid >> 3) * src_ld + 4 * (tid & 7)); r1 = *(const f32x4*)(src + (size_t)((tid + 512) >> 3) * src_ld + 4 * (tid & 7)); }
        __syncthreads();
        { const int n = tid >> 4, k8 = (tid & 15) * 8;
          if (jcur >= 1856) {
            u32x2 w; w[0] = pk4_fp8(sc[(k8 + 0) * 33 + n] * W8_SCALE, sc[(k8 + 1) * 33 + n] * W8_SCALE, sc[(k8 + 2) * 33 + n] * W8_SCALE, sc[(k8 + 3) * 33 + n] * W8_SCALE);
            w[1] = pk4_fp8(sc[(k8 + 4) * 33 + n] * W8_SCALE, sc[(k8 + 5) * 33 + n] * W8_SCALE, sc[(k8 + 6) * 33 + n] * W8_SCALE, sc[(k8 + 7) * 33 + n] * W8_SCALE);
            *(u32x2*)((unsigned char*)dcur + (size_t)n * dld + k8) = w;
          } else { u32x4 w;
            w[0] = pk2(sc[(k8 + 0) * 33 + n], sc[(k8 + 1) * 33 + n]); w[1] = pk2(sc[(k8 + 2) * 33 + n], sc[(k8 + 3) * 33 + n]);
            w[2] = pk2(sc[(k8 + 4) * 33 + n], sc[(k8 + 5) * 33 + n]); w[3] = pk2(sc[(k8 + 6) * 33 + n], sc[(k8 + 7) * 33 + n]);
            *(u32x4*)(dcur + (size_t)n * dld + k8) = w; } }
        buf ^= 1;
    }
    __syncthreads();
}

DI void prep_expert_phase(const Params& p, int l, LAS float* scr) {
    if (blockIdx.x < 128) return;
    const int tid = otid(), w = blockIdx.x - 128;
    constexpr int D = 8, NJ = (JOBS_PER_LAYER - SMALL_JOBS) / 128;
    f32x4 r[D][2];
    const float* src; bf16_t* dst; int src_ld, dst_ld;
#pragma unroll
    for (int d = 0; d < D; ++d) { prep_job(p, l, SMALL_JOBS + 128 * d + w, src, src_ld, dst, dst_ld);
        r[d][0] = *(const f32x4*)(src + (size_t)(tid >> 3) * src_ld + 4 * (tid & 7)); r[d][1] = *(const f32x4*)(src + (size_t)((tid + 512) >> 3) * src_ld + 4 * (tid & 7)); }
#pragma unroll 1
    for (int i = 0; i < NJ; i += D) {
#pragma unroll
        for (int d = 0; d < D; ++d) {
            LAS float* sc = scr + (d & 1) * (128 * 33);
            { const int k = tid >> 3, c4 = tid & 7;
              sc[k * 33 + 4 * c4 + 0] = r[d][0][0]; sc[k * 33 + 4 * c4 + 1] = r[d][0][1]; sc[k * 33 + 4 * c4 + 2] = r[d][0][2]; sc[k * 33 + 4 * c4 + 3] = r[d][0][3];
              sc[(k + 64) * 33 + 4 * c4 + 0] = r[d][1][0]; sc[(k + 64) * 33 + 4 * c4 + 1] = r[d][1][1]; sc[(k + 64) * 33 + 4 * c4 + 2] = r[d][1][2]; sc[(k + 64) * 33 + 4 * c4 + 3] = r[d][1][3]; }
            if (i + d + D < NJ) { prep_job(p, l, SMALL_JOBS + 128 * (i + d + D) + w, src, src_ld, dst, dst_ld);
                r[d][0] = *(const f32x4*)(src + (size_t)(tid >> 3) * src_ld + 4 * (tid & 7)); r[d][1] = *(const f32x4*)(src + (size_t)((tid + 512) >> 3) * src_ld + 4 * (tid & 7)); }
            prep_job(p, l, SMALL_JOBS + 128 * (i + d) + w, src, src_ld, dst, dst_ld);
            __syncthreads();
            { const int n = tid >> 4, k8 = (tid & 15) * 8;
              u32x2 wv; wv[0] = pk4_fp8(sc[(k8 + 0) * 33 + n] * W8_SCALE, sc[(k8 + 1) * 33 + n] * W8_SCALE, sc[(k8 + 2) * 33 + n] * W8_SCALE, sc[(k8 + 3) * 33 + n] * W8_SCALE);
              wv[1] = pk4_fp8(sc[(k8 + 4) * 33 + n] * W8_SCALE, sc[(k8 + 5) * 33 + n] * W8_SCALE, sc[(k8 + 6) * 33 + n] * W8_SCALE, sc[(k8 + 7) * 33 + n] * W8_SCALE);
              *(u32x2*)((unsigned char*)dst + (size_t)n * dst_ld + k8) = wv; }
        }
    }
    __syncthreads();
}

DI int eo4(int lane, int i) { return 8 * lane + 512 * (i >> 1) + 4 * (i & 1); }
DI void unpk8(f32x4& a, f32x4& b, const u32x4& w) { a[0] = bflo(w[0]); a[1] = bfhi(w[0]); a[2] = bflo(w[1]); a[3] = bfhi(w[1]); b[0] = bflo(w[2]); b[1] = bfhi(w[2]); b[2] = bflo(w[3]); b[3] = bfhi(w[3]); }
DI void add8(f32x4& a, f32x4& b, const u32x4& w) { a[0] += bflo(w[0]); a[1] += bfhi(w[0]); a[2] += bflo(w[1]); a[3] += bfhi(w[1]); b[0] += bflo(w[2]); b[1] += bfhi(w[2]); b[2] += bflo(w[3]); b[3] += bfhi(w[3]); }
DI u32x4 pk8(const f32x4& a, const f32x4& b) { u32x4 w; w[0] = pk2(a[0], a[1]); w[1] = pk2(a[2], a[3]); w[2] = pk2(b[0], b[1]); w[3] = pk2(b[2], b[3]); return w; }
template <int MODE> DI void norm1_phase(const Params& p, int l) {
    const int tid = otid(), lane = tid & 63, wid = tid >> 6;
    const float* gain = MODE == 2 ? p.norm_final : p.norm_mix + (size_t)l * DM;
    f32x4 g[4];
#pragma unroll
    for (int i = 0; i < 4; ++i) g[i] = *(const f32x4*)(gain + eo4(lane, i));
    const int nw = gridDim.x * 8;
    for (int row0 = blockIdx.x * 8 + wid; row0 < NTOK; row0 += 2 * nw) {
        const int row1 = row0 + nw;
        f32x4 v0[4], v1[4];
        if (MODE == 0) {
#pragma unroll
            for (int i = 0; i < 4; ++i) { v0[i] = *(const f32x4*)(p.x + (size_t)row0 * DM + eo4(lane, i)); v1[i] = *(const f32x4*)(p.x + (size_t)row1 * DM + eo4(lane, i)); }
        } else {
            u32x4 a[2], b[2];
#pragma unroll
            for (int j = 0; j < 2; ++j) { a[j] = *(const u32x4*)(P_X(p) + (size_t)row0 * DM + 8 * lane + 512 * j); b[j] = *(const u32x4*)(P_X(p) + (size_t)row1 * DM + 8 * lane + 512 * j); }
            const int c0 = lane < NEXP ? P_INV(p)[(size_t)row0 * NEXP + lane] : -1, c1 = lane < NEXP ? P_INV(p)[(size_t)row1 * NEXP + lane] : -1;
#pragma unroll
            for (int j = 0; j < 2; ++j) { unpk8(v0[2 * j], v0[2 * j + 1], a[j]); unpk8(v1[2 * j], v1[2 * j + 1], b[j]); }
            unsigned long long m0 = __ballot(c0 >= 0), m1 = __ballot(c1 >= 0);
            const bf16_t* ybase0 = P_Y(p) + (size_t)((row0 >> 12) * CAP) * DM; const bf16_t* ybase1 = P_Y(p) + (size_t)((row1 >> 12) * CAP) * DM;
            while (m0 | m1) {
                u32x4 w0[2], w1[2]; const bool h0 = m0 != 0ull, h1 = m1 != 0ull;
                if (h0) { const int e = __builtin_ctzll(m0); m0 &= m0 - 1ull; const int c = __builtin_amdgcn_readlane(c0, e); const bf16_t* yr = ybase0 + (size_t)(e * NBATCH * CAP + c) * DM;
#pragma unroll
                    for (int j = 0; j < 2; ++j) w0[j] = *(const u32x4*)(yr + 8 * lane + 512 * j); }
                if (h1) { const int e = __builtin_ctzll(m1); m1 &= m1 - 1ull; const int c = __builtin_amdgcn_readlane(c1, e); const bf16_t* yr = ybase1 + (size_t)(e * NBATCH * CAP + c) * DM;
#pragma unroll
                    for (int j = 0; j < 2; ++j) w1[j] = *(const u32x4*)(yr + 8 * lane + 512 * j); }
                if (h0) {
#pragma unroll
                    for (int j = 0; j < 2; ++j) add8(v0[2 * j], v0[2 * j + 1], w0[j]); }
                if (h1) {
#pragma unroll
                    for (int j = 0; j < 2; ++j) add8(v1[2 * j], v1[2 * j + 1], w1[j]); }
            }
        }
        if (MODE != 2) {
#pragma unroll
            for (int j = 0; j < 2; ++j) { *(u32x4*)(P_X(p) + (size_t)row0 * DM + 8 * lane + 512 * j) = pk8(v0[2 * j], v0[2 * j + 1]); *(u32x4*)(P_X(p) + (size_t)row1 * DM + 8 * lane + 512 * j) = pk8(v1[2 * j], v1[2 * j + 1]); }
        }
        float s0 = 0.f, s1 = 0.f;
#pragma unroll
        for (int i = 0; i < 4; ++i) { s0 += v0[i][0] * v0[i][0] + v0[i][1] * v0[i][1] + v0[i][2] * v0[i][2] + v0[i][3] * v0[i][3]; s1 += v1[i][0] * v1[i][0] + v1[i][1] * v1[i][1] + v1[i][2] * v1[i][2] + v1[i][3] * v1[i][3]; }
#pragma unroll
        for (int d = 32; d >= 1; d >>= 1) { s0 += shx(s0, d, lane); s1 += shx(s1, d, lane); }
        const float r0 = rsqrtf(s0 * (1.0f / DM) + 1e-6f), r1 = rsqrtf(s1 * (1.0f / DM) + 1e-6f);
#pragma unroll
        for (int i = 0; i < 4; ++i) { v0[i] = v0[i] * r0 * g[i]; v1[i] = v1[i] * r1 * g[i]; }
        if (MODE == 2) {
#pragma unroll
            for (int i = 0; i < 4; ++i) { *(f32x4*)(p.out + (size_t)row0 * DM + eo4(lane, i)) = v0[i]; *(f32x4*)(p.out + (size_t)row1 * DM + eo4(lane, i)) = v1[i]; }
        } else {
#pragma unroll
            for (int j = 0; j < 2; ++j) { *(u32x4*)(P_XN(p) + (size_t)row0 * DM + 8 * lane + 512 * j) = pk8(v0[2 * j], v0[2 * j + 1]); *(u32x4*)(P_XN(p) + (size_t)row1 * DM + 8 * lane + 512 * j) = pk8(v1[2 * j], v1[2 * j + 1]); }
        }
    }
}

DI float reduce16(const float (&a)[16], int lane) {
    float b8[8], b4[4], b2[2];
    { const bool hi = (lane & 32) != 0;
#pragma unroll
      for (int j = 0; j < 8; ++j) { const float snd = hi ? a[j] : a[j + 8], kp = hi ? a[j + 8] : a[j]; b8[j] = kp + shx(snd, 32, lane); } }
    { const bool hi = (lane & 16) != 0;
#pragma unroll
      for (int j = 0; j < 4; ++j) { const float snd = hi ? b8[j] : b8[j + 4], kp = hi ? b8[j + 4] : b8[j]; b4[j] = kp + shx(snd, 16, lane); } }
    { const bool hi = (lane & 8) != 0;
#pragma unroll
      for (int j = 0; j < 2; ++j) { const float snd = hi ? b4[j] : b4[j + 2], kp = hi ? b4[j + 2] : b4[j]; b2[j] = kp + shx(snd, 8, lane); } }
    float r;
    { const bool hi = (lane & 4) != 0; const float snd = hi ? b2[0] : b2[1], kp = hi ? b2[1] : b2[0]; r = kp + shx(snd, 4, lane); }
    r += shx(r, 2, lane); r += shx(r, 1, lane);
    return r;
}
DI void norm2_router_phase(const Params& p, int l, LAS float* wr) {
    const int tid = otid(), lane = tid & 63, wid = tid >> 6;
    for (int i = tid; i < DM * NEXP; i += 512) { const int d = i >> 4;
        wr[(i & 15) * DM + ((d >> 9) * 2 + ((d >> 2) & 1)) * 256 + 4 * ((d & 511) >> 3) + (d & 3)] = p.w_router[(size_t)l * DM * NEXP + i]; }
    __syncthreads();
    const float* gain = p.norm_ffn + (size_t)l * DM;
    f32x4 g[4];
#pragma unroll
    for (int i = 0; i < 4; ++i) g[i] = *(const f32x4*)(gain + eo4(lane, i));
    const int nw = gridDim.x * 8;
    for (int row0 = blockIdx.x * 8 + wid; row0 < NTOK; row0 += 2 * nw) {
        const int row1 = row0 + nw;
        f32x4 v0[4], v1[4]; float s0 = 0.f, s1 = 0.f;
        { u32x4 a[2], b[2];
#pragma unroll
          for (int j = 0; j < 2; ++j) { a[j] = *(const u32x4*)(P_X(p) + (size_t)row0 * DM + 8 * lane + 512 * j); b[j] = *(const u32x4*)(P_X(p) + (size_t)row1 * DM + 8 * lane + 512 * j); }
#pragma unroll
          for (int j = 0; j < 2; ++j) { unpk8(v0[2 * j], v0[2 * j + 1], a[j]); unpk8(v1[2 * j], v1[2 * j + 1], b[j]); } }
#pragma unroll
        for (int i = 0; i < 4; ++i) { s0 += v0[i][0] * v0[i][0] + v0[i][1] * v0[i][1] + v0[i][2] * v0[i][2] + v0[i][3] * v0[i][3]; s1 += v1[i][0] * v1[i][0] + v1[i][1] * v1[i][1] + v1[i][2] * v1[i][2] + v1[i][3] * v1[i][3]; }
#pragma unroll
        for (int d = 32; d >= 1; d >>= 1) { s0 += shx(s0, d, lane); s1 += shx(s1, d, lane); }
        const float r0 = rsqrtf(s0 * (1.0f / DM) + 1e-6f), r1 = rsqrtf(s1 * (1.0f / DM) + 1e-6f);
#pragma unroll
        for (int i = 0; i < 4; ++i) { v0[i] = v0[i] * r0 * g[i]; v1[i] = v1[i] * r1 * g[i]; }
#pragma unroll
        for (int j = 0; j < 2; ++j) { u32x2 w;
            w[0] = pk4_fp8(v0[2 * j][0], v0[2 * j][1], v0[2 * j][2], v0[2 * j][3]); w[1] = pk4_fp8(v0[2 * j + 1][0], v0[2 * j + 1][1], v0[2 * j + 1][2], v0[2 * j + 1][3]);
            *(u32x2*)(P_XN8(p) + (size_t)row0 * DM + 8 * lane + 512 * j) = w;
            w[0] = pk4_fp8(v1[2 * j][0], v1[2 * j][1], v1[2 * j][2], v1[2 * j][3]); w[1] = pk4_fp8(v1[2 * j + 1][0], v1[2 * j + 1][1], v1[2 * j + 1][2], v1[2 * j + 1][3]);
            *(u32x2*)(P_XN8(p) + (size_t)row1 * DM + 8 * lane + 512 * j) = w; }
        float a0[NEXP], a1[NEXP];
#pragma unroll
        for (int e = 0; e < NEXP; ++e) { float x0 = 0.f, x1 = 0.f;
#pragma unroll
            for (int i = 0; i < 4; ++i) { const f32x4 w = *(const LAS f32x4*)(wr + e * DM + 4 * lane + 256 * i);
                x0 += v0[i][0] * w[0] + v0[i][1] * w[1] + v0[i][2] * w[2] + v0[i][3] * w[3]; x1 += v1[i][0] * w[0] + v1[i][1] * w[1] + v1[i][2] * w[2] + v1[i][3] * w[3]; }
            a0[e] = x0; a1[e] = x1;
            if ((e & 3) == 3) __builtin_amdgcn_sched_barrier(0); }
        const float l0 = reduce16(a0, lane), l1 = reduce16(a1, lane);
        float m0 = l0, m1 = l1;
#pragma unroll
        for (int d = 32; d >= 4; d >>= 1) { m0 = fmaxf(m0, shx(m0, d, lane)); m1 = fmaxf(m1, shx(m1, d, lane)); }
        const float e0 = __expf(l0 - m0), e1 = __expf(l1 - m1); float d0 = e0, d1 = e1;
#pragma unroll
        for (int d = 32; d >= 4; d >>= 1) { d0 += shx(d0, d, lane); d1 += shx(d1, d, lane); }
        if ((lane & 3) == 0) { const int e = lane >> 2;
            P_AFF(p)[((size_t)((row0 >> 12) * NEXP + e)) * SEQ + (row0 & 4095)] = e0 / d0; P_AFF(p)[((size_t)((row1 >> 12) * NEXP + e)) * SEQ + (row1 & 4095)] = e1 / d1; }
    }
}

DI void topk_phase(const Params& p, LAS unsigned* lds) {
    const int tid = otid(), lane = tid & 63, wid = tid >> 6;
    LAS unsigned* hist = lds; LAS unsigned* sh = lds + 256; LAS unsigned* wtot = lds + 272;
    for (int be = blockIdx.x; be < NBATCH * NEXP; be += gridDim.x) {
        const int b = be >> 4, e = be & 15;
        const float* aff = P_AFF(p) + (size_t)be * SEQ + tid * 8;
        const f32x4 a0 = *(const f32x4*)aff, a1 = *(const f32x4*)(aff + 4);
        unsigned key[8];
#pragma unroll
        for (int i = 0; i < 4; ++i) { key[i] = __float_as_uint(a0[i]); key[4 + i] = __float_as_uint(a1[i]); }
        unsigned prefix = 0u, mask = 0u, krem = CAP;
        for (int pass = 3; pass >= 0; --pass) {
            const int shift = 8 * pass;
            if (tid < 256) hist[tid] = 0u;
            __syncthreads();
#pragma unroll
            for (int i = 0; i < 8; ++i) if ((key[i] & mask) == prefix) atomicAdd((unsigned*)&hist[(key[i] >> shift) & 255u], 1u);
            __syncthreads();
            if (wid == 0) {
                const unsigned h0 = hist[4 * lane], h1 = hist[4 * lane + 1], h2 = hist[4 * lane + 2], h3 = hist[4 * lane + 3], s = h0 + h1 + h2 + h3;
                unsigned suf = s;
#pragma unroll
                for (int d = 1; d < 64; d <<= 1) { const unsigned t = shl_abs(suf, (lane + d) & 63); if (lane + d < 64) suf += t; }
                const unsigned above = suf - s;
                if (above < krem && krem <= suf) {
                    unsigned a = above; unsigned bin, nk;
                    if (a + h3 >= krem) { bin = 4 * lane + 3; nk = krem - a; }
                    else { a += h3; if (a + h2 >= krem) { bin = 4 * lane + 2; nk = krem - a; }
                        else { a += h2; if (a + h1 >= krem) { bin = 4 * lane + 1; nk = krem - a; } else { a += h1; bin = 4 * lane; nk = krem - a; } } }
                    sh[0] = prefix | (bin << shift); sh[1] = nk;
                }
            }
            __syncthreads();
            prefix = sh[0]; krem = sh[1]; mask |= 0xFFu << shift;
            __syncthreads();
        }
        unsigned cg = 0u, ce = 0u;
#pragma unroll
        for (int i = 0; i < 8; ++i) { cg += key[i] > prefix ? 1u : 0u; ce += key[i] == prefix ? 1u : 0u; }
        unsigned pk = cg | (ce << 16), incl = pk;
#pragma unroll
        for (int d = 1; d < 64; d <<= 1) { const unsigned t = shl_abs(incl, (lane - d) & 63); if (lane >= d) incl += t; }
        if (lane == 63) wtot[wid] = incl;
        __syncthreads();
        unsigned woff = 0u;
#pragma unroll
        for (int w = 0; w < 8; ++w) woff += w < wid ? wtot[w] : 0u;
        const unsigned excl = woff + incl - pk;
        unsigned gtb = excl & 0xffffu, eqb = excl >> 16;
        int* idxo = P_IDX(p) + (size_t)(e * NBATCH + b) * CAP; float* valo = P_VAL(p) + (size_t)(e * NBATCH + b) * CAP;
        int* inv = P_INV(p) + ((size_t)b * SEQ + tid * 8) * NEXP + e;
#pragma unroll
        for (int i = 0; i < 8; ++i) {
            int slot = -1;
            if (key[i] > prefix) { slot = (int)(gtb + (eqb < krem ? eqb : krem)); ++gtb; }
            else if (key[i] == prefix) { if (eqb < krem) slot = (int)(gtb + eqb); ++eqb; }
            if (slot >= 0) { idxo[slot] = tid * 8 + i; valo[slot] = __uint_as_float(key[i]); }
            inv[(size_t)i * NEXP] = slot;
        }
        __syncthreads();
    }
}

namespace at {
constexpr int NUNIT_A = 1536, NUNIT_C = 1024, NUNIT_B = 1536, NUNIT = NUNIT_A + NUNIT_C + NUNIT_B;
DI unsigned cvt2(float lo, float hi) { typedef __bf16 bf2_t __attribute__((ext_vector_type(2))); const f32x2 v = {lo, hi}; const bf2_t b = __builtin_convertvector(v, bf2_t); return __builtin_bit_cast(unsigned, b); }
DI bf16x8 pack8(const f32x16& x, int s8) { u32x4 w; w[0] = cvt2(x[s8 + 0], x[s8 + 1]); w[1] = cvt2(x[s8 + 2], x[s8 + 3]); w[2] = cvt2(x[s8 + 4], x[s8 + 5]); w[3] = cvt2(x[s8 + 6], x[s8 + 7]); return __builtin_bit_cast(bf16x8, w); }
DI int koffmap(int r, bool g1) { return g1 ? 4 * (4 * ((r >> 3) & 1) + (r & 3)) + 2 * (r >> 4) + ((r >> 2) & 1) : (r & 16) + 8 * ((r >> 2) & 1) + 4 * ((r >> 3) & 1) + (r & 3); }

DI float xh_max(float v) { const auto r = __builtin_amdgcn_permlane32_swap(__float_as_uint(v), __float_as_uint(v), false, false); return fmaxf(__uint_as_float(r[0]), __uint_as_float(r[1])); }
DI float xh_sum(float v) { const auto r = __builtin_amdgcn_permlane32_swap(__float_as_uint(v), __float_as_uint(v), false, false); return __uint_as_float(r[0]) + __uint_as_float(r[1]); }
constexpr float LOG2E = 1.4426950408889634f, LN2 = 0.6931471805599453f;
struct QState { float m, den; f32x16 O0, O1; };
DI void softmax_tile(f32x16& S, QState& st, bf16x8& p0, bf16x8& p1) {
    float mx = fmaxf(S[0], S[1]);
#pragma unroll
    for (int i = 2; i < 16; i += 2) mx = fmaxf(mx, fmaxf(S[i], S[i + 1]));
    mx = xh_max(mx);
    const float mn = fmaxf(st.m, mx), alpha = __builtin_amdgcn_exp2f(st.m - mn);
    float ps = 0.f;
#pragma unroll
    for (int i = 0; i < 16; ++i) { S[i] = __builtin_amdgcn_exp2f(S[i] - mn); ps += S[i]; }
    ps = xh_sum(ps);
    st.den = st.den * alpha + ps; st.m = mn;
#pragma unroll
    for (int i = 0; i < 16; ++i) { st.O0[i] *= alpha; st.O1[i] *= alpha; }
    p0 = pack8(S, 0); p1 = pack8(S, 8);
}
template <int MODE> DI void mask_tile(f32x16& S, int tn, int NT, int q, int h, int t, int qrow, int sr_q, int sc_q, int kc0, int qcg, const LAS float* bt_head) {
    if (MODE == 3) {
        const bool rowok = t >= sr_q && t < sr_q + 8; const LAS float* bt = bt_head + (t - qrow + 7) * 31 + 15 - qcg;
#pragma unroll
        for (int i = 0; i < 16; ++i) { const int kc = kc0 + 16 * (i >> 3) + 8 * h + (i & 7); const bool ok = rowok && kc >= sc_q && kc < sc_q + 16;
            const int bi = ok ? kc : qcg; S[i] = ok ? S[i] + bt[bi] : -1e37f; }
    } else {
        const int edge = tn == 0 ? 1 : tn == NT - 1 ? 2 : 0;
        if (edge != 0) {
            int qq = MODE == 2 ? q - h : q - 8 * h; asm volatile("" : "+v"(qq));
            if (edge == 1) {
#pragma unroll
                for (int i = 0; i < 16; ++i) { const int kc_ = MODE == 2 ? 4 * (i & 7) + 2 * (i >> 3) : 16 * (i >> 3) + (i & 7); S[i] = kc_ >= qq ? S[i] : -1e37f; }
            } else {
#pragma unroll
                for (int i = 0; i < 16; ++i) { const int kc_ = MODE == 2 ? 4 * (i & 7) + 2 * (i >> 3) : 16 * (i >> 3) + (i & 7); S[i] = kc_ <= qq ? S[i] : -1e37f; }
            }
        }
    }
}
template <int MODE> DI void wave_unit(const Params& p, int l, int u, const LAS float* rpb_lds, LAS unsigned char* ring, int lane) {
    const int q = lane & 31, h = lane >> 5;
    const bf16_t* QK = P_QK(p); const bf16_t* VT = P_VT(p);
    int b, qcol, kcol, vch, dil = 1, rho = 0, Jq = 0, L = SEQ, vs0 = 0, g = 0, hs = 0, hq = 0;
    constexpr int W = MODE == 0 ? 128 : 64, NT = MODE == 0 ? 9 : 5;
    int qcg = 0, kc0 = 0, kr_lo = 0, kr_hi = 0, r00 = 0;
    if (MODE == 0) { const int gg = u % 3, qp = (u / 3) & 63, kvh = (u / 192) & 1; b = u / 384; hq = kvh * 3 + gg; qcol = 64 * hq; kcol = 384 + 64 * kvh; vch = 64 * kvh; Jq = 64 * qp; }
    else if (MODE == 1 || MODE == 2) { const int qt6 = u & 63; hs = (u >> 6) & 1; g = (u >> 7) % 3; b = u / 384; qcol = 512 + 128 * g + 64 * hs; kcol = 896 + 128 * g + 64 * hs;
        vch = g == 0 ? 128 + 64 * hs : g == 1 ? 512 + 64 * hs : 640 + 64 * hs;
        if (g == 0) { Jq = 64 * qt6; } else if (g == 1) { dil = 4; rho = qt6 >> 4; Jq = 64 * (qt6 & 15); L = 1024; } else { dil = 16; rho = qt6 >> 2; Jq = 64 * (qt6 & 3); L = 256; vs0 = rho * 256; } }
    else { const int qt6 = u & 63, hh = (u >> 6) & 3, gr4 = qt6 >> 2, cb = qt6 & 3; b = u >> 8; hq = hh; qcol = 1280 + 64 * hh; kcol = 1536 + 64 * hh; vch = 256 + 64 * hh;
        r00 = 4 * gr4; qcg = 16 * cb + (q & 15); kc0 = cb == 0 ? 0 : cb == 3 ? 32 : 16 * cb - 8;
        const int s0 = r00 - 4 < 0 ? 0 : r00 - 4 > 56 ? 56 : r00 - 4, s3 = r00 - 1 < 0 ? 0 : r00 - 1 > 56 ? 56 : r00 - 1; kr_lo = s0; kr_hi = s3 + 8; }
    int t_lo, t_hi; unsigned kdma[4], vdma[4], kstep_t, vstep_t;
    if (MODE == 3) { t_lo = kr_lo; t_hi = kr_hi; kstep_t = 64u * QKW; vstep_t = 64; }
    else { t_lo = (W - Jq + 31) >> 5; if (t_lo < 0) t_lo = 0; t_hi = (L + W - Jq) >> 5; if (t_hi > NT + 1) t_hi = NT + 1; kstep_t = 32u * dil * QKW; vstep_t = MODE == 2 ? 8 : 32; }
#pragma unroll
    for (int i = 0; i < 4; ++i) {
        const int r = 8 * i + (lane >> 3), c8 = (lane & 7) ^ ((r >> 1) & 7), ko = koffmap(r, MODE == 2);
        const int ktok = MODE == 3 ? b * SEQ + kc0 + ko : b * SEQ + (Jq - W + ko) * dil + rho;
        kdma[i] = (unsigned)ktok * QKW + kcol + 8 * c8;
        const int d = 16 * i + (lane >> 2), ch = (lane & 3) ^ ((d >> 2) & 3);
        const int vslot = MODE == 3 ? b * SEQ + kc0 + 8 * ch : MODE == 2 ? b * SEQ + ch * 1024 + rho * 256 + ((Jq - W) >> 2) : b * SEQ + vs0 + (Jq - W) + 8 * ch;
        vdma[i] = (unsigned)(vch + d) * NTOK + vslot;
    }
#define AT_DMA(t, buf) do { const unsigned kt_ = (unsigned)(t) * kstep_t, vt_ = (unsigned)(t) * vstep_t; LAS unsigned char* bb_ = ring + (buf) * 8192; \
        _Pragma("unroll") for (int i_ = 0; i_ < 4; ++i_) __builtin_amdgcn_global_load_lds((const unsigned*)(QK + (unsigned)(kdma[i_] + kt_)), (LAS unsigned*)(bb_ + i_ * 1024), 16, 0, 0); \
        _Pragma("unroll") for (int i_ = 0; i_ < 4; ++i_) __builtin_amdgcn_global_load_lds((const unsigned*)(VT + (unsigned)(vdma[i_] + vt_)), (LAS unsigned*)(bb_ + 4096 + i_ * 1024), 16, 0, 0); } while (0)
    AT_DMA(t_lo, 0);
    int kaddr[4], vaddr[2][2];
#pragma unroll
    for (int c = 0; c < 4; ++c) kaddr[c] = q * 128 + (((2 * c + h) ^ ((q >> 1) & 7)) << 4);
#pragma unroll
    for (int dh = 0; dh < 2; ++dh)
#pragma unroll
        for (int sx = 0; sx < 2; ++sx) vaddr[dh][sx] = 4096 + (32 * dh + q) * 64 + (((2 * sx + h) ^ ((q >> 2) & 3)) << 4);
    int tokq[2]; bf16x8 qf[2][4]; QState st[2];
#pragma unroll
    for (int n = 0; n < 2; ++n) {
        tokq[n] = MODE == 3 ? b * SEQ + (r00 + 2 * n + (q >> 4)) * 64 + qcg : b * SEQ + (Jq + 32 * n + q) * dil + rho;
        const bf16_t* qp = QK + (size_t)tokq[n] * QKW + qcol + 8 * h;
#pragma unroll
        for (int c = 0; c < 4; ++c) qf[n][c] = *(const bf16x8*)(qp + 16 * c);
        st[n].m = -1e30f; st[n].den = 0.f;
        if (MODE == 0) { st[n].m = p.sink[l * 6 + hq] * LOG2E; st[n].den = 1.0f; }
#pragma unroll
        for (int i = 0; i < 16; ++i) { st[n].O0[i] = 0.f; st[n].O1[i] = 0.f; }
    }
    int sc_q = 0, qrow0 = 0, qrow1 = 0, srq0 = 0, srq1 = 0, lo0 = 0, hi0 = 0, lo1 = 0, hi1 = 0;
    if (MODE == 3) { sc_q = qcg - 8 < 0 ? 0 : qcg - 8 > 48 ? 48 : qcg - 8;
        qrow0 = r00 + (q >> 4); qrow1 = qrow0 + 2; srq0 = qrow0 - 4 < 0 ? 0 : qrow0 - 4 > 56 ? 56 : qrow0 - 4; srq1 = qrow1 - 4 < 0 ? 0 : qrow1 - 4 > 56 ? 56 : qrow1 - 4;
        lo0 = r00 - 4 < 0 ? 0 : r00 - 4 > 56 ? 56 : r00 - 4; hi0 = (r00 - 3 < 0 ? 0 : r00 - 3 > 56 ? 56 : r00 - 3) + 8; lo1 = r00 - 2 < 0 ? 0 : r00 - 2 > 56 ? 56 : r00 - 2; hi1 = (r00 - 1 < 0 ? 0 : r00 - 1 > 56 ? 56 : r00 - 1) + 8; }
    const LAS float* bt_head = rpb_lds + hq * 465;
#define AT_S(S, n) do { _Pragma("unroll") for (int i_ = 0; i_ < 16; ++i_) S[i_] = 0.f; _Pragma("unroll") for (int c_ = 0; c_ < 4; ++c_) S = __builtin_amdgcn_mfma_f32_32x32x16_bf16(kf[c_], qf[n][c_], S, 0, 0, 0); } while (0)
#define AT_PV(n, p0, p1) do { st[n].O0 = __builtin_amdgcn_mfma_f32_32x32x16_bf16(vf[0][0], p0, st[n].O0, 0, 0, 0); st[n].O0 = __builtin_amdgcn_mfma_f32_32x32x16_bf16(vf[0][1], p1, st[n].O0, 0, 0, 0); \
        st[n].O1 = __builtin_amdgcn_mfma_f32_32x32x16_bf16(vf[1][0], p0, st[n].O1, 0, 0, 0); st[n].O1 = __builtin_amdgcn_mfma_f32_32x32x16_bf16(vf[1][1], p1, st[n].O1, 0, 0, 0); } while (0)
    for (int t = t_lo; t < t_hi; ++t) {
        const int buf = (t - t_lo) & 1;
        if (t + 1 < t_hi) { AT_DMA(t + 1, buf ^ 1); asm volatile("s_waitcnt vmcnt(8)" ::: "memory"); }
        else asm volatile("s_waitcnt vmcnt(0)" ::: "memory");
        const LAS unsigned char* bb = ring + buf * 8192;
        const bool act0 = MODE == 3 ? (t >= lo0 && t < hi0) : (t < NT), act1 = MODE == 3 ? (t >= lo1 && t < hi1) : (t >= 1);
        bf16x8 kf[4], vf[2][2];
#pragma unroll
        for (int c = 0; c < 4; ++c) kf[c] = *(const LAS bf16x8*)(bb + kaddr[c]);
        if (act0 && act1) {
            f32x16 S0, S1; AT_S(S0, 0); AT_S(S1, 1);
            mask_tile<MODE>(S0, t, NT, q, h, t, qrow0, srq0, sc_q, kc0, qcg, bt_head); mask_tile<MODE>(S1, t - 1, NT, q, h, t, qrow1, srq1, sc_q, kc0, qcg, bt_head);
            bf16x8 pa0, pa1, pb0, pb1;
            softmax_tile(S0, st[0], pa0, pa1); softmax_tile(S1, st[1], pb0, pb1);
            __builtin_amdgcn_sched_barrier(0);
#pragma unroll
            for (int dh = 0; dh < 2; ++dh)
#pragma unroll
                for (int sx = 0; sx < 2; ++sx) vf[dh][sx] = *(const LAS bf16x8*)(bb + vaddr[dh][sx]);
            AT_PV(0, pa0, pa1); AT_PV(1, pb0, pb1);
        } else if (act0) {
            f32x16 S0; AT_S(S0, 0);
#pragma unroll
            for (int dh = 0; dh < 2; ++dh)
#pragma unroll
                for (int sx = 0; sx < 2; ++sx) vf[dh][sx] = *(const LAS bf16x8*)(bb + vaddr[dh][sx]);
            mask_tile<MODE>(S0, t, NT, q, h, t, qrow0, srq0, sc_q, kc0, qcg, bt_head);
            bf16x8 pa0, pa1; softmax_tile(S0, st[0], pa0, pa1); AT_PV(0, pa0, pa1);
        } else if (act1) {
            f32x16 S1; AT_S(S1, 1);
#pragma unroll
            for (int dh = 0; dh < 2; ++dh)
#pragma unroll
                for (int sx = 0; sx < 2; ++sx) vf[dh][sx] = *(const LAS bf16x8*)(bb + vaddr[dh][sx]);
            mask_tile<MODE>(S1, t - 1, NT, q, h, t, qrow1, srq1, sc_q, kc0, qcg, bt_head);
            bf16x8 pb0, pb1; softmax_tile(S1, st[1], pb0, pb1); AT_PV(1, pb0, pb1);
        }
    }
#undef AT_DMA
#undef AT_S
#undef AT_PV
#pragma unroll
    for (int n = 0; n < 2; ++n) {
        const float rd = 1.0f / st[n].den;
        bf16_t* op;
        if (MODE == 1 || MODE == 2) { op = P_OB3(p) + ((size_t)g * NTOK + tokq[n]) * 128 + 64 * hs; if (h == 0) P_LSE(p)[((size_t)g * NTOK + tokq[n]) * 2 + hs] = (st[n].m + __log2f(st[n].den)) * LN2; }
        else op = P_OC(p) + (size_t)tokq[n] * OCW + (MODE == 0 ? 64 * hq : 512 + 64 * hq);
#pragma unroll
        for (int gq = 0; gq < 4; ++gq) {
            u32x2 w0, w1;
            w0[0] = cvt2(st[n].O0[4 * gq] * rd, st[n].O0[4 * gq + 1] * rd); w0[1] = cvt2(st[n].O0[4 * gq + 2] * rd, st[n].O0[4 * gq + 3] * rd);
            w1[0] = cvt2(st[n].O1[4 * gq] * rd, st[n].O1[4 * gq + 1] * rd); w1[1] = cvt2(st[n].O1[4 * gq + 2] * rd, st[n].O1[4 * gq + 3] * rd);
            *(u32x2*)(op + 8 * gq + 4 * h) = w0; *(u32x2*)(op + 32 + 8 * gq + 4 * h) = w1;
        }
    }
}
}
DI void f_attn_phase(const Params& p, int l, LAS unsigned char* lds, int slot) {
    const int tid = otid(), lane = tid & 63, wid = __builtin_amdgcn_readfirstlane(tid >> 6);
    LAS float* rpb_lds = (LAS float*)(lds + 131072 + 64);
    for (int i = tid; i < 4 * 465; i += 512) rpb_lds[i] = p.rpb[(size_t)l * 4 * 465 + i] * at::LOG2E;
    __syncthreads();
    LAS unsigned char* ring = lds + wid * 16384;
    const int x8 = blockIdx.x & 7;
    unsigned* ctr = (unsigned*)(p.ws + OFF_CTL + 16384) + 64 * (slot * 8 + x8);
    for (;;) {
        unsigned k = 0u;
        if (lane == 0) k = __hip_atomic_fetch_add(ctr, 1u, __ATOMIC_RELAXED, __HIP_MEMORY_SCOPE_AGENT);
        k = (unsigned)__builtin_amdgcn_readfirstlane((int)k);
        if (k >= 512u) break;
        int ln = lane; asm volatile("" : "+v"(ln));
        if (k < 192u) at::wave_unit<0>(p, l, x8 * 192 + (int)k, rpb_lds, ring, ln);
        else if (k < 320u) at::wave_unit<3>(p, l, x8 * 128 + (int)k - 192, rpb_lds, ring, ln);
        else { const int ub = x8 * 192 + (int)k - 320; if (((ub >> 7) % 3) == 1) at::wave_unit<2>(p, l, ub, rpb_lds, ring, ln); else at::wave_unit<1>(p, l, ub, rpb_lds, ring, ln); }
    }
    __syncthreads();
}

DI void bcombine_phase(const Params& p) {
    for (int i = blockIdx.x * 512 + otid(); i < NTOK * 16; i += gridDim.x * 512) {
        const int tok = i >> 4, part = i & 15, hs = part >> 3, d0 = (part & 7) * 8;
        const float l0 = P_LSE(p)[((size_t)0 * NTOK + tok) * 2 + hs], l1 = P_LSE(p)[((size_t)1 * NTOK + tok) * 2 + hs], l2 = P_LSE(p)[((size_t)2 * NTOK + tok) * 2 + hs];
        const float mx = fmaxf(l0, fmaxf(l1, l2)), e0 = __expf(l0 - mx), e1 = __expf(l1 - mx), e2 = __expf(l2 - mx), rs = 1.0f / (e0 + e1 + e2);
        const float a0 = e0 * rs, a1 = e1 * rs, a2 = e2 * rs;
        const u32x4 w0 = *(const u32x4*)(P_OB3(p) + ((size_t)0 * NTOK + tok) * 128 + 64 * hs + d0);
        const u32x4 w1 = *(const u32x4*)(P_OB3(p) + ((size_t)1 * NTOK + tok) * 128 + 64 * hs + d0);
        const u32x4 w2 = *(const u32x4*)(P_OB3(p) + ((size_t)2 * NTOK + tok) * 128 + 64 * hs + d0);
        u32x4 o;
#pragma unroll
        for (int j = 0; j < 4; ++j) o[j] = pk2(a0 * bflo(w0[j]) + a1 * bflo(w1[j]) + a2 * bflo(w2[j]), a0 * bfhi(w0[j]) + a1 * bfhi(w1[j]) + a2 * bfhi(w2[j]));
        *(u32x4*)(P_OC(p) + (size_t)tok * OCW + 384 + 64 * hs + d0) = o;
    }
}

namespace g8 {
constexpr int BM = 256, BK = 64, HALF = 128, HTB = HALF * BK * 2, NXCD = 8, WGM = 8;
DI int lds_byte(int r, int c) { const int st = (r >> 4) * 2 + (c >> 5), rr = r & 15, cc = c & 31, ob = rr * 64 + cc * 2; return st * 1024 + (ob ^ (((ob >> 9) & 1) << 5)); }
DI void stage_rc(int b, int& R, int& C) { const int st = b / 1024, sb = b % 1024, swz = sb ^ (((sb >> 9) & 1) << 5); R = (st >> 1) * 16 + swz / 64; C = (st & 1) * 32 + (swz % 64) / 2; }
DI int perm32(int rho) { const int n = rho >> 4, i = rho & 15; return 8 * (i >> 2) + 4 * n + (i & 3); }
struct Unit { int pm, pn, aux; };
struct StaticOrder {
    int nM, nN, nwg, G, c;
    DI void init(int M, int N, int G_, int c_) { nM = M / BM; nN = N / BM; nwg = nM * nN; G = G_; c = c_; }
    DI bool next(int i, Unit& u) const {
        const long L = (long)i * G + c; if (L >= nwg) return false;
        int wgid = (int)L; { const int q = nwg / NXCD, r = nwg % NXCD, xcd = wgid % NXCD, off = wgid / NXCD; wgid = (xcd < r ? xcd * (q + 1) : r * (q + 1) + (xcd - r) * q) + off; }
        const int nig = WGM * nN, gid = wgid / nig, fm = gid * WGM, gsz = (nM - fm) < WGM ? (nM - fm) : WGM;
        u.pm = fm + ((wgid % nig) % gsz); u.pn = (wgid % nig) / gsz; u.aux = 0; return true;
    }
};
typedef f32x4 Acc[2][2][4][2];
typedef int i32x4 __attribute__((ext_vector_type(4)));
typedef int i32x8 __attribute__((ext_vector_type(8)));
DI bf16x8 half8(const i32x8& v, int k) { const i32x4 x = k == 0 ? __builtin_shufflevector(v, v, 0, 1, 2, 3) : __builtin_shufflevector(v, v, 4, 5, 6, 7); return __builtin_bit_cast(bf16x8, x); }
DI i32x8 cat8(const bf16x8& a, const bf16x8& b) { const i32x4 x = __builtin_bit_cast(i32x4, a), y = __builtin_bit_cast(i32x4, b); return __builtin_shufflevector(x, y, 0, 1, 2, 3, 4, 5, 6, 7); }

template <class Desc, class Epi, class Sched, bool ALIGN_EPI>
DI void gemm_phase(LAS unsigned char* lds, const Desc& D, const Sched& S, const Epi& E) {
    const int tid = otid(), wid = __builtin_amdgcn_readfirstlane(tid >> 6), lane = tid & 63, wr = wid >> 2, wc = wid & 3, fr = lane & 15, fq = lane >> 4;
    int R0, C0, R1, C1; stage_rc(tid * 16, R0, C0); stage_rc(tid * 16 + 8192, R1, C1);
    const int Rb0 = Epi::PERM ? ((R0 & ~31) + perm32(R0 & 31)) : R0, Rb1 = Epi::PERM ? ((R1 & ~31) + perm32(R1 & 31)) : R1;
    constexpr unsigned LDA2 = Desc::lda * 2, LDB2 = Desc::ldb * 2;
    const size_t kstep = (size_t)(BK * 2);
    const unsigned ldsw = (unsigned)wid * 1024u;
    const int aoff = lds_byte(wr * 64 + fr, fq * 8), boff = lds_byte(wc * 32 + fr, fq * 8);
#define G8_SA(b, h) (((b) * 2 + (h)) * HTB)
#define G8_SB(b, h) ((4 + (b) * 2 + (h)) * HTB)
#define G8_STAGE(bufoff, gbase, o0, o1) do { \
        __builtin_amdgcn_global_load_lds((const unsigned*)((const char*)(gbase) + (o0)), (LAS unsigned*)(lds + (bufoff) + ldsw), 16, 0, 0); \
        __builtin_amdgcn_global_load_lds((const unsigned*)((const char*)(gbase) + (o1)), (LAS unsigned*)(lds + (bufoff) + ldsw + 8192), 16, 0, 0); } while (0)
#define G8_LDA(dst, b, h) do { _Pragma("unroll") for (int m = 0; m < 4; ++m) { const bf16x8 lo_ = *(const LAS bf16x8*)(lds + G8_SA(b, h) + aoff + m * 2048), hi_ = *(const LAS bf16x8*)(lds + G8_SA(b, h) + aoff + m * 2048 + 1024); dst[m] = cat8(lo_, hi_); } } while (0)
#define G8_LDB(dst, b, h) do { _Pragma("unroll") for (int n = 0; n < 2; ++n) { const bf16x8 lo_ = *(const LAS bf16x8*)(lds + G8_SB(b, h) + boff + n * 2048), hi_ = *(const LAS bf16x8*)(lds + G8_SB(b, h) + boff + n * 2048 + 1024); dst[n] = cat8(lo_, hi_); } } while (0)
#define G8_MMA(ai, bj, At, Bt) do { __builtin_amdgcn_s_setprio(1); _Pragma("unroll") for (int m = 0; m < 4; ++m) _Pragma("unroll") for (int n = 0; n < 2; ++n) _Pragma("unroll") for (int k = 0; k < 2; ++k) \
        acc[ai][bj][m][n] = __builtin_amdgcn_mfma_f32_16x16x32_bf16(half8(Bt[n], k), half8(At[m], k), acc[ai][bj][m][n], 0, 0, 0); __builtin_amdgcn_s_setprio(0); } while (0)
#define G8_MMA8(ai, bj, At, Bt) do { __builtin_amdgcn_s_setprio(1); _Pragma("unroll") for (int m = 0; m < 4; ++m) _Pragma("unroll") for (int n = 0; n < 2; ++n) \
        asm volatile("v_mfma_scale_f32_16x16x128_f8f6f4 %0, %1, %2, %0, %3, %3 op_sel_hi:[0,0,0]" : "+v"(acc[ai][bj][m][n]) : "v"(Bt[n]), "v"(At[m]), "v"(one_scale));     __builtin_amdgcn_s_setprio(0); } while (0)
#define G8_MM(ai, bj, At, Bt) do { if constexpr (Desc::FP8) G8_MMA8(ai, bj, At, Bt); else G8_MMA(ai, bj, At, Bt); } while (0)
#define G8_WAIT_V(n) asm volatile("s_waitcnt vmcnt(" #n ")" ::: "memory")
#define G8_WAIT_L(n) asm volatile("s_waitcnt lgkmcnt(" #n ")" ::: "memory")
#define G8_BAR __builtin_amdgcn_s_barrier()
#define G8_SCHED __builtin_amdgcn_sched_barrier(0)
#define G8_MKA(u, uidx, o) do { \
        o[0][0] = (unsigned)(Desc::GATHER ? D.a_row(u, uidx, R0) : R0) * LDA2 + (unsigned)C0 * 2u; o[0][1] = (unsigned)(Desc::GATHER ? D.a_row(u, uidx, R1) : R1) * LDA2 + (unsigned)C1 * 2u; \
        if (Desc::GATHER) { o[1][0] = (unsigned)D.a_row(u, uidx, HALF + R0) * LDA2 + (unsigned)C0 * 2u; o[1][1] = (unsigned)D.a_row(u, uidx, HALF + R1) * LDA2 + (unsigned)C1 * 2u; } } while (0)
#define G8_MKB(u, o, hs) do { const unsigned dl_ = (unsigned)D.dilB(u) * LDB2; hs = (unsigned)HALF * dl_; \
        o[0] = (unsigned)Rb0 * dl_ + (unsigned)C0 * 2u; o[1] = (unsigned)Rb1 * dl_ + (unsigned)C1 * 2u; } while (0)
#define G8_A1(o, i) (Desc::GATHER ? o[1][i] : o[0][i] + (unsigned)HALF * LDA2)
    Unit cur, nxt; int ui = 0;
    if (!S.next(0, cur)) return;
    Acc acc;
#pragma unroll
    for (int a = 0; a < 2; ++a)
#pragma unroll
        for (int b = 0; b < 2; ++b)
#pragma unroll
            for (int m = 0; m < 4; ++m)
#pragma unroll
                for (int n = 0; n < 2; ++n) acc[a][b][m][n] = (f32x4){0.f, 0.f, 0.f, 0.f};
    int one_scale = 0x7f7f7f7f; asm volatile("" : "+v"(one_scale));
    i32x8 At[4], B0[2], B1[2];
    unsigned cAo[2][2], cBo[2], nAo[2][2], nBo[2], cBh, nBh;
    G8_MKA(cur, 0, cAo); G8_MKB(cur, cBo, cBh); nBh = cBh;
    const char* cA = D.a_base(cur); const char* cB = D.b_base(cur);
    G8_STAGE(G8_SB(0, 0), cB, cBo[0], cBo[1]); G8_STAGE(G8_SB(0, 1), cB + cBh, cBo[0], cBo[1]); G8_STAGE(G8_SA(0, 0), cA, cAo[0][0], cAo[0][1]); G8_STAGE(G8_SA(0, 1), cA, G8_A1(cAo, 0), G8_A1(cAo, 1));
    if (wr == 1) G8_BAR;
    G8_WAIT_V(2); G8_BAR;
    G8_STAGE(G8_SB(1, 0), cB + kstep, cBo[0], cBo[1]); G8_STAGE(G8_SA(1, 0), cA + kstep, cAo[0][0], cAo[0][1]); G8_STAGE(G8_SB(1, 1), cB + kstep + cBh, cBo[0], cBo[1]);
    G8_WAIT_V(6); G8_BAR;
    for (;;) {
        const bool has_next = S.next(ui + 1, nxt);
        const char* nA = cA; const char* nB = cB;
        if (has_next) { nA = D.a_base(nxt); nB = D.b_base(nxt); }
        if (Desc::GATHER) { if (has_next) G8_MKA(nxt, ui + 1, nAo); else { nAo[0][0] = cAo[0][0]; nAo[0][1] = cAo[0][1]; nAo[1][0] = cAo[1][0]; nAo[1][1] = cAo[1][1]; } }
        if (Desc::VARB) { if (has_next) G8_MKB(nxt, nBo, nBh); else { nBo[0] = cBo[0]; nBo[1] = cBo[1]; nBh = cBh; } }
        const int nt = D.nt(cur);
#pragma unroll 1
        for (int t = 0; t < nt; t += 2) {
            const bool last = (t == nt - 2);
            const char* a1 = cA + (size_t)(t + 1) * kstep;
            const char* a2 = last ? nA : cA + (size_t)(t + 2) * kstep; const char* b2 = last ? nB : cB + (size_t)(t + 2) * kstep;
            const char* a3 = a2 + kstep; const char* b3 = b2 + kstep;
            const unsigned xa00 = (Desc::GATHER && last) ? nAo[0][0] : cAo[0][0], xa01 = (Desc::GATHER && last) ? nAo[0][1] : cAo[0][1];
            const unsigned xa10 = Desc::GATHER ? (last ? nAo[1][0] : cAo[1][0]) : xa00 + (unsigned)HALF * LDA2, xa11 = Desc::GATHER ? (last ? nAo[1][1] : cAo[1][1]) : xa01 + (unsigned)HALF * LDA2;
            const unsigned xb0 = (Desc::VARB && last) ? nBo[0] : cBo[0], xb1 = (Desc::VARB && last) ? nBo[1] : cBo[1], xbh = (Desc::VARB && last) ? nBh : cBh;
            G8_LDB(B0, 0, 0); G8_LDB(B1, 0, 1); G8_SCHED; G8_LDA(At, 0, 0); G8_STAGE(G8_SA(1, 1), a1, G8_A1(cAo, 0), G8_A1(cAo, 1));
            G8_WAIT_V(8); G8_WAIT_L(0); G8_BAR; G8_MM(0, 0, At, B0); G8_MM(0, 1, At, B1); G8_BAR; G8_SCHED;
            G8_LDA(At, 0, 1); G8_STAGE(G8_SB(0, 0), b2, xb0, xb1); G8_STAGE(G8_SB(0, 1), b2 + xbh, xb0, xb1); G8_STAGE(G8_SA(0, 0), a2, xa00, xa01);
            G8_WAIT_V(8); G8_WAIT_L(0); G8_BAR; G8_MM(1, 0, At, B0); G8_MM(1, 1, At, B1); G8_BAR; G8_SCHED;
            G8_LDB(B0, 1, 0); G8_LDB(B1, 1, 1); G8_SCHED; G8_LDA(At, 1, 0); G8_STAGE(G8_SA(0, 1), a2, xa10, xa11);
            G8_WAIT_V(8); G8_WAIT_L(0); G8_BAR; G8_MM(0, 0, At, B0); G8_MM(0, 1, At, B1); G8_BAR; G8_SCHED;
            G8_LDA(At, 1, 1); G8_STAGE(G8_SB(1, 0), b3, xb0, xb1); G8_STAGE(G8_SB(1, 1), b3 + xbh, xb0, xb1); G8_STAGE(G8_SA(1, 0), a3, xa00, xa01);
            G8_WAIT_V(8); G8_WAIT_L(0); G8_BAR; G8_MM(1, 0, At, B0); G8_MM(1, 1, At, B1); G8_BAR; G8_SCHED;
        }
        if constexpr (ALIGN_EPI) { if (wr == 0) G8_BAR; }
        if constexpr (Desc::FP8) asm volatile("s_nop 15\n\ts_nop 15" ::: "memory");
        E(acc, cur, wr, wc, fr, fq);
        if (!has_next) break;
#pragma unroll
        for (int a = 0; a < 2; ++a)
#pragma unroll
            for (int b = 0; b < 2; ++b)
#pragma unroll
                for (int m = 0; m < 4; ++m)
#pragma unroll
                    for (int n = 0; n < 2; ++n) acc[a][b][m][n] = (f32x4){0.f, 0.f, 0.f, 0.f};
        if constexpr (Desc::FP8) asm volatile("s_nop 7" ::: "memory");
        cur = nxt; cA = nA; cB = nB; ++ui;
        if (Desc::GATHER) { cAo[0][0] = nAo[0][0]; cAo[0][1] = nAo[0][1]; cAo[1][0] = nAo[1][0]; cAo[1][1] = nAo[1][1]; }
        if (Desc::VARB) { cBo[0] = nBo[0]; cBo[1] = nBo[1]; cBh = nBh; }
        if constexpr (ALIGN_EPI) { if (wr == 1) G8_BAR; }
    }
    G8_WAIT_V(0);
    if constexpr (!ALIGN_EPI) { if (wr == 0) G8_BAR; }
    G8_BAR;
#undef G8_SA
#undef G8_SB
#undef G8_STAGE
#undef G8_LDA
#undef G8_LDB
#undef G8_MMA
#undef G8_MMA8
#undef G8_MM
#undef G8_WAIT_V
#undef G8_WAIT_L
#undef G8_BAR
#undef G8_SCHED
#undef G8_MKA
#undef G8_MKB
#undef G8_A1
}
DI unsigned cvt2(float lo, float hi) { typedef __bf16 bf2_t __attribute__((ext_vector_type(2))); const f32x2 v = {lo, hi}; const bf2_t b = __builtin_convertvector(v, bf2_t); return __builtin_bit_cast(unsigned, b); }
DI u32x4 pack8(const f32x4& a, const f32x4& b) { u32x4 w; w[0] = cvt2(a[0], a[1]); w[1] = cvt2(a[2], a[3]); w[2] = cvt2(b[0], b[1]); w[3] = cvt2(b[2], b[3]); return w; }
DI float fsig(float x) { return __builtin_amdgcn_rcpf(1.0f + __expf(-x)); }

struct DescMoe1 { static constexpr bool GATHER = true, VARB = false, FP8 = true; static constexpr int lda = DM / 2, ldb = DM / 2; const bf16_t* XN8; const bf16_t* WGU; const LAS int* rowlist;
    DI const char* a_base(const Unit&) const { return (const char*)XN8; }
    DI const char* b_base(const Unit& u) const { return (const char*)WGU + ((size_t)(u.pm >> 3) * 4096 + (size_t)u.pn * 256) * DM; }
    DI int a_row(const Unit&, int uidx, int r) const { return rowlist[uidx * 256 + r]; }
    DI int nt(const Unit&) const { return DM / 128; } DI int dilB(const Unit&) const { return 1; } };
struct EpiSwiglu { static constexpr bool PERM = true; unsigned char* HID8;
    DI void operator()(const Acc& acc, const Unit& u, int wr, int wc, int fr, int fq) const {
        const int row0 = u.pm * BM + wr * 64 + fr, col0 = u.pn * 128 + wc * 32 + 8 * fq; constexpr float WI = 1.0f / W8_SCALE;
#pragma unroll
        for (int ai = 0; ai < 2; ++ai)
#pragma unroll
            for (int m = 0; m < 4; ++m) { f32x4 h0, h1;
#pragma unroll
                for (int j = 0; j < 4; ++j) { const float g0 = acc[ai][0][m][0][j] * WI, g1 = acc[ai][0][m][1][j] * WI;
                    h0[j] = g0 * fsig(g0) * acc[ai][1][m][0][j] * (WI * H8_SCALE); h1[j] = g1 * fsig(g1) * acc[ai][1][m][1][j] * (WI * H8_SCALE); }
                u32x2 w; w[0] = pk4_fp8(h0[0], h0[1], h0[2], h0[3]); w[1] = pk4_fp8(h1[0], h1[1], h1[2], h1[3]);
                *(u32x2*)(HID8 + (size_t)(row0 + ai * HALF + m * 16) * FF + col0) = w; }
    } };
struct DescMoe2 { static constexpr bool GATHER = false, VARB = false, FP8 = true; static constexpr int lda = FF / 2, ldb = FF / 2; const unsigned char* HID8; const bf16_t* WD;
    DI const char* a_base(const Unit& u) const { return (const char*)HID8 + (size_t)u.pm * 256 * FF; }
    DI const char* b_base(const Unit& u) const { return (const char*)WD + ((size_t)(u.pm >> 3) * 1024 + (size_t)u.pn * 256) * FF; }
    DI int a_row(const Unit&, int, int r) const { return r; }
    DI int nt(const Unit&) const { return FF / 128; } DI int dilB(const Unit&) const { return 1; } };
struct EpiY { static constexpr bool PERM = true; bf16_t* Y; const float* VAL;
    DI void operator()(const Acc& acc, const Unit& u, int wr, int wc, int fr, int fq) const {
        const int row0 = u.pm * BM + wr * 64 + fr, col0 = u.pn * BM + wc * 32 + 8 * fq;
        float vv[2][4];
#pragma unroll
        for (int ai = 0; ai < 2; ++ai)
#pragma unroll
            for (int m = 0; m < 4; ++m) vv[ai][m] = VAL[row0 + ai * HALF + m * 16];
#pragma unroll
        for (int ai = 0; ai < 2; ++ai)
#pragma unroll
            for (int m = 0; m < 4; ++m) { const int row = row0 + ai * HALF + m * 16; const float v = vv[ai][m] * (1.0f / (W8_SCALE * H8_SCALE));
#pragma unroll
                for (int bj = 0; bj < 2; ++bj) *(u32x4*)(Y + (size_t)row * DM + col0 + bj * HALF) = pack8(acc[ai][bj][m][0] * v, acc[ai][bj][m][1] * v); }
    } };
struct DescOut { static constexpr bool GATHER = false, VARB = false, FP8 = false; static constexpr int lda = DM, ldb = DM; const bf16_t* MG; const bf16_t* WO;
    DI const char* a_base(const Unit& u) const { return (const char*)(MG + (size_t)u.pm * 256 * DM); }
    DI const char* b_base(const Unit& u) const { return (const char*)(WO + (size_t)u.pn * 256 * DM); }
    DI int a_row(const Unit&, int, int r) const { return r; }
    DI int nt(const Unit&) const { return DM / BK; } DI int dilB(const Unit&) const { return 1; } };
struct EpiResid { static constexpr bool PERM = true; bf16_t* X;
    DI void operator()(const Acc& acc, const Unit& u, int wr, int wc, int fr, int fq) const {
        const int row0 = u.pm * BM + wr * 64 + fr, col0 = u.pn * BM + wc * 32 + 8 * fq;
#pragma unroll
        for (int ai = 0; ai < 2; ++ai) {
            u32x4 x[4][2];
#pragma unroll
            for (int m = 0; m < 4; ++m)
#pragma unroll
                for (int bj = 0; bj < 2; ++bj) x[m][bj] = *(const u32x4*)(X + (size_t)(row0 + ai * HALF + m * 16) * DM + col0 + bj * HALF);
#pragma unroll
            for (int m = 0; m < 4; ++m)
#pragma unroll
                for (int bj = 0; bj < 2; ++bj) { f32x4 v0 = acc[ai][bj][m][0], v1 = acc[ai][bj][m][1]; const u32x4 ww = x[m][bj];
                    v0[0] += bflo(ww[0]); v0[1] += bfhi(ww[0]); v0[2] += bflo(ww[1]); v0[3] += bfhi(ww[1]); v1[0] += bflo(ww[2]); v1[1] += bfhi(ww[2]); v1[2] += bflo(ww[3]); v1[3] += bfhi(ww[3]);
                    *(u32x4*)(X + (size_t)(row0 + ai * HALF + m * 16) * DM + col0 + bj * HALF) = pack8(v0, v1); }
            __builtin_amdgcn_sched_barrier(0);
        }
    } };
struct DescInproj { static constexpr bool GATHER = false, VARB = false, FP8 = false; static constexpr int lda = DM, ldb = DM; const bf16_t* XN; const bf16_t* WIN;
    DI const char* a_base(const Unit& u) const { return (const char*)(XN + (size_t)u.pm * 256 * DM); }
    DI const char* b_base(const Unit& u) const { return (const char*)(WIN + (size_t)u.pn * 256 * DM); }
    DI int a_row(const Unit&, int, int r) const { return r; }
    DI int nt(const Unit&) const { return DM / BK; } DI int dilB(const Unit&) const { return 1; } };
struct EpiInproj { static constexpr bool PERM = true; bf16_t* QK; unsigned char* G; const float* cosT; const float* sinT; const float* bgate;
    DI void operator()(const Acc& acc, const Unit& u, int wr, int wc, int fr, int fq) const {
        const int row0 = u.pm * BM + wr * 64 + fr;
        if (u.pn < 5) {
            const int hr = 4 * u.pn + wc; const float sc = (hr < 6 || (hr >= 8 && hr < 14)) ? 0.125f * 1.4426950408889634f : 1.0f;
#pragma unroll
            for (int ai = 0; ai < 2; ++ai) {
                f32x4 tc[4][2], ts[4][2];
#pragma unroll
                for (int m = 0; m < 4; ++m) { const int pos = (row0 + ai * HALF + m * 16) & (SEQ - 1);
                    tc[m][0] = *(const f32x4*)(cosT + pos * 32 + 8 * fq); tc[m][1] = *(const f32x4*)(cosT + pos * 32 + 8 * fq + 4); ts[m][0] = *(const f32x4*)(sinT + pos * 32 + 8 * fq); ts[m][1] = *(const f32x4*)(sinT + pos * 32 + 8 * fq + 4); }
#pragma unroll
                for (int m = 0; m < 4; ++m) { const int row = row0 + ai * HALF + m * 16;
                    const f32x4 c0 = tc[m][0], c1 = tc[m][1], s0 = ts[m][0], s1 = ts[m][1];
                    const f32x4 a0 = acc[ai][0][m][0], a1 = acc[ai][0][m][1], b0 = acc[ai][1][m][0], b1 = acc[ai][1][m][1];
                    bf16_t* o = QK + (size_t)row * QKW + 64 * hr + 8 * fq;
                    *(u32x4*)o = pack8((a0 * c0 - b0 * s0) * sc, (a1 * c1 - b1 * s1) * sc);
                    *(u32x4*)(o + 32) = pack8((b0 * c0 + a0 * s0) * sc, (b1 * c1 + a1 * s1) * sc); }
                __builtin_amdgcn_sched_barrier(0);
            }
        } else if (u.pn < 7) {
            const float sc = u.pn == 5 ? 0.125f * 1.4426950408889634f : 1.0f; const int col0 = 1280 + (u.pn - 5) * 256 + wc * 32 + 8 * fq;
#pragma unroll
            for (int ai = 0; ai < 2; ++ai)
#pragma unroll
                for (int m = 0; m < 4; ++m)
#pragma unroll
                    for (int bj = 0; bj < 2; ++bj) *(u32x4*)(QK + (size_t)(row0 + ai * HALF + m * 16) * QKW + col0 + bj * HALF) = pack8(acc[ai][bj][m][0] * sc, acc[ai][bj][m][1] * sc);
        } else {
            const int col0 = (u.pn - 7) * 256 + wc * 32 + 8 * fq;
            f32x4 bv[2][2];
#pragma unroll
            for (int bj = 0; bj < 2; ++bj)
#pragma unroll
                for (int n = 0; n < 2; ++n) bv[bj][n] = *(const f32x4*)(bgate + col0 + bj * HALF + 4 * n);
#pragma unroll
            for (int ai = 0; ai < 2; ++ai)
#pragma unroll
                for (int m = 0; m < 4; ++m)
#pragma unroll
                    for (int bj = 0; bj < 2; ++bj) { f32x4 v0 = acc[ai][bj][m][0] + bv[bj][0], v1 = acc[ai][bj][m][1] + bv[bj][1];
#pragma unroll
                        for (int j = 0; j < 4; ++j) { v0[j] = fsig(v0[j]) * 255.0f + 0.5f; v1[j] = fsig(v1[j]) * 255.0f + 0.5f; }
                        u32x2 w; w[0] = (unsigned)v0[0] | ((unsigned)v0[1] << 8) | ((unsigned)v0[2] << 16) | ((unsigned)v0[3] << 24); w[1] = (unsigned)v1[0] | ((unsigned)v1[1] << 8) | ((unsigned)v1[2] << 16) | ((unsigned)v1[3] << 24);
                        *(u32x2*)(G + (size_t)(row0 + ai * HALF + m * 16) * 3072 + col0 + bj * HALF) = w; }
        }
    } };
struct DescVT { static constexpr bool GATHER = false, VARB = true, FP8 = false; static constexpr int lda = DM, ldb = DM; const bf16_t* WV; const bf16_t* XN;
    DI const char* a_base(const Unit& u) const { return (const char*)(WV + (size_t)u.pm * 256 * DM); }
    DI const char* b_base(const Unit& u) const { return (const char*)(XN + (u.pm < 2 ? (size_t)u.pn * 256 : (size_t)((u.pn >> 4) * SEQ + (u.pn & 15))) * DM); }
    DI int a_row(const Unit&, int, int r) const { return r; }
    DI int nt(const Unit&) const { return DM / BK; } DI int dilB(const Unit& u) const { return u.pm < 2 ? 1 : 16; } };
struct EpiVT { static constexpr bool PERM = true; bf16_t* VT;
    DI void operator()(const Acc& acc, const Unit& u, int wr, int wc, int fr, int fq) const {
        const int row0 = u.pm * BM + wr * 64 + fr, col0 = u.pn * BM + wc * 32 + 8 * fq;
#pragma unroll
        for (int ai = 0; ai < 2; ++ai)
#pragma unroll
            for (int m = 0; m < 4; ++m)
#pragma unroll
                for (int bj = 0; bj < 2; ++bj) *(u32x4*)(VT + (size_t)(row0 + ai * HALF + m * 16) * NTOK + col0 + bj * HALF) = pack8(acc[ai][bj][m][0], acc[ai][bj][m][1]);
    } };
struct DescMerge { static constexpr bool GATHER = false, VARB = false, FP8 = false; static constexpr int lda = OCW, ldb = 768; const bf16_t* OC; const bf16_t* WM;
    DI int k0(const Unit& u) const { return u.aux == 0 ? 0 : u.aux == 1 ? 384 : 512; }
    DI const char* a_base(const Unit& u) const { return (const char*)(OC + (size_t)u.pm * 256 * OCW + k0(u)); }
    DI const char* b_base(const Unit& u) const { return (const char*)(WM + (size_t)u.pn * 256 * 768 + k0(u)); }
    DI int a_row(const Unit&, int, int r) const { return r; }
    DI int nt(const Unit& u) const { return u.aux == 0 ? 6 : u.aux == 1 ? 2 : 4; } DI int dilB(const Unit&) const { return 1; } };
struct MergeOrder { StaticOrder base;
    DI bool next(int i, Unit& u) const { const int q = i / 3; if (!base.next(q, u)) return false; u.aux = i - 3 * q; return true; } };
struct EpiMerge { static constexpr bool PERM = true; bf16_t* MG; const unsigned char* G;
    DI void operator()(const Acc& acc, const Unit& u, int wr, int wc, int fr, int fq) const {
        const int row0 = u.pm * BM + wr * 64 + fr, col0 = u.pn * BM + wc * 32 + 8 * fq;
#pragma unroll
        for (int ai = 0; ai < 2; ++ai) {
            u32x2 g[4][2]; u32x4 w[4][2];
#pragma unroll
            for (int m = 0; m < 4; ++m)
#pragma unroll
                for (int bj = 0; bj < 2; ++bj) { const int row = row0 + ai * HALF + m * 16, col = col0 + bj * HALF;
                    g[m][bj] = *(const u32x2*)(G + (size_t)row * 3072 + 1024 * u.aux + col);
                    if (u.aux != 0) w[m][bj] = *(const u32x4*)(MG + (size_t)row * DM + col); else w[m][bj] = (u32x4){0u, 0u, 0u, 0u}; }
#pragma unroll
            for (int m = 0; m < 4; ++m)
#pragma unroll
                for (int bj = 0; bj < 2; ++bj) { const int row = row0 + ai * HALF + m * 16, col = col0 + bj * HALF;
                    const u32x2 gg = g[m][bj]; const u32x4 ww = w[m][bj]; constexpr float GI = 1.0f / 255.0f;
                    f32x4 v0 = acc[ai][bj][m][0] * GI, v1 = acc[ai][bj][m][1] * GI;
                    v0[0] = v0[0] * (float)(gg[0] & 255u) + bflo(ww[0]); v0[1] = v0[1] * (float)((gg[0] >> 8) & 255u) + bfhi(ww[0]); v0[2] = v0[2] * (float)((gg[0] >> 16) & 255u) + bflo(ww[1]); v0[3] = v0[3] * (float)(gg[0] >> 24) + bfhi(ww[1]);
                    v1[0] = v1[0] * (float)(gg[1] & 255u) + bflo(ww[2]); v1[1] = v1[1] * (float)((gg[1] >> 8) & 255u) + bfhi(ww[2]); v1[2] = v1[2] * (float)((gg[1] >> 16) & 255u) + bflo(ww[3]); v1[3] = v1[3] * (float)(gg[1] >> 24) + bfhi(ww[3]);
                    *(u32x4*)(MG + (size_t)row * DM + col) = pack8(v0, v1); }
            __builtin_amdgcn_sched_barrier(0);
        }
    } };
}
DI void f_inproj_phase(const Params& p, int l, LAS unsigned char* lds) {
    { g8::StaticOrder S; S.init(NTOK, 4352, gridDim.x, blockIdx.x);
      g8::DescInproj D{P_XN(p), P_W(p, l, LW_WIN)}; g8::EpiInproj E{P_QK(p), P_G(p), P_COS(p), P_SIN(p), p.b_gate + (size_t)l * 3072};
      g8::gemm_phase<g8::DescInproj, g8::EpiInproj, g8::StaticOrder, true>(lds, D, S, E); }
    { g8::StaticOrder S; S.init(VCH, NTOK, gridDim.x, (blockIdx.x + gridDim.x - 64) % gridDim.x);
      g8::DescVT D{P_W(p, l, LW_WV), P_XN(p)}; g8::EpiVT E{P_VT(p)};
      g8::gemm_phase<g8::DescVT, g8::EpiVT, g8::StaticOrder, true>(lds, D, S, E); }
}
struct OneUnit { int pm, pn; DI bool next(int i, g8::Unit& u) const { if (i != 0) return false; u.pm = pm; u.pn = pn; u.aux = 0; return true; } };
DI void f_gate_tail_units(const Params& p, int l, LAS unsigned char* lds) {
    if (blockIdx.x < 128) {
        OneUnit S{(int)(blockIdx.x >> 1), 17 + (int)(blockIdx.x & 1)};
        g8::DescInproj D{P_XN(p), P_W(p, l, LW_WIN)}; g8::EpiInproj E{P_QK(p), P_G(p), P_COS(p), P_SIN(p), p.b_gate + (size_t)l * 3072};
        g8::gemm_phase<g8::DescInproj, g8::EpiInproj, OneUnit, false>(lds, D, S, E);
        __syncthreads();
    }
}
DI void f_merge_phase(const Params& p, int l, LAS unsigned char* lds) {
    g8::MergeOrder S; S.base.init(NTOK, DM, gridDim.x, blockIdx.x);
    g8::DescMerge D{P_OC(p), P_W(p, l, LW_WM)}; g8::EpiMerge E{P_MG(p), P_G(p)};
    g8::gemm_phase<g8::DescMerge, g8::EpiMerge, g8::MergeOrder, true>(lds, D, S, E);
}

DI void f_moe1_phase(const Params& p, int l, LAS unsigned char* lds) {
    g8::StaticOrder S; S.init(NROWS_E, 2 * FF, gridDim.x, blockIdx.x);
    LAS int* rowlist = (LAS int*)(lds + 131072 + 64);
    g8::Unit u;
    for (int i = 0; i < 8 && S.next(i, u); ++i)
        for (int r = otid(); r < 256; r += 512) rowlist[i * 256 + r] = ((u.pm >> 1) & 3) * SEQ + P_IDX(p)[u.pm * 256 + r];
    __syncthreads();
    g8::DescMoe1 D{(const bf16_t*)P_XN8(p), P_W(p, l, LW_WGU), rowlist}; g8::EpiSwiglu E{(unsigned char*)P_HID(p)};
    g8::gemm_phase<g8::DescMoe1, g8::EpiSwiglu, g8::StaticOrder, true>(lds, D, S, E);
}
DI void f_moe2_phase(const Params& p, int l, LAS unsigned char* lds) {
    g8::StaticOrder S; S.init(NROWS_E, DM, gridDim.x, blockIdx.x);
    g8::DescMoe2 D{(const unsigned char*)P_HID(p), P_W(p, l, LW_WD)}; g8::EpiY E{P_Y(p), P_VAL(p)};
    g8::gemm_phase<g8::DescMoe2, g8::EpiY, g8::StaticOrder, true>(lds, D, S, E);
}
DI void f_out_phase(const Params& p, int l, LAS unsigned char* lds) {
    g8::StaticOrder S; S.init(NTOK, DM, gridDim.x, blockIdx.x);
    g8::DescOut D{P_MG(p), P_W(p, l, LW_WO)}; g8::EpiResid E{P_X(p)};
    g8::gemm_phase<g8::DescOut, g8::EpiResid, g8::StaticOrder, false>(lds, D, S, E);
}

#define XB_TMO      128
#define XB_XCNT(j)  (256  + 64 * (j))
#define XB_XSUB(j)  (1280 + 64 * (j))
#define XB_XGEN(j)  (2304 + 64 * (j))
#define XB_TOP      3328
#define XB_TOPGEN   3392
#define XCD_BAR_WORDS 3456
#define XB_SPIN_CAP (1u << 22)

__device__ __forceinline__ unsigned xb_ld(unsigned* p)              { return __hip_atomic_load(p, __ATOMIC_RELAXED, __HIP_MEMORY_SCOPE_AGENT); }
__device__ __forceinline__ unsigned xb_add(unsigned* p, unsigned v) { return __hip_atomic_fetch_add(p, v, __ATOMIC_RELAXED, __HIP_MEMORY_SCOPE_AGENT); }
__device__ __forceinline__ unsigned xb_xcc_id() { return (unsigned)__builtin_amdgcn_s_getreg((3 << 11) | 20) & 0xFu; }
#define XB_SPIN(cond, bar) do { unsigned _sp = 0; while (cond) { __builtin_amdgcn_s_sleep(1); \
    if ((++_sp & 255u) == 0u) { if (xb_ld(&(bar)[XB_TMO])) break; if (_sp > XB_SPIN_CAP) { atomicAdd(&(bar)[XB_TMO], 1u); break; } } } } while (0)

struct XcdBarrier {
    unsigned* bar; unsigned x;
    volatile LAS unsigned* st;
};

__device__ __forceinline__ XcdBarrier xcd_barrier_post(unsigned* bar, volatile LAS unsigned* st) {
    XcdBarrier b; b.bar = bar; b.x = xb_xcc_id(); b.st = st;
    if (threadIdx.x == 0) (void)xb_add(&bar[XB_XCNT(b.x)], 1u);
    return b;
}
__device__ __forceinline__ void xcd_barrier_complete(unsigned* bar, unsigned x, unsigned& nloc, unsigned& nx) {
    const unsigned G = gridDim.x * gridDim.y * gridDim.z;
    unsigned sum, cnt, mine, sp = 0u;
    for (;;) {
        sum = 0u; cnt = 0u; mine = 0u;
#pragma unroll
        for (unsigned j = 0; j < 16; ++j) { const unsigned c = xb_ld(&bar[XB_XCNT(j)]); sum += c; cnt += (c > 0u) ? 1u : 0u; mine = (j == x) ? c : mine; }
        if (sum == G) break;
        __builtin_amdgcn_s_sleep(1);
        if ((++sp & 255u) == 0u) { if (xb_ld(&bar[XB_TMO])) break; if (sp > XB_SPIN_CAP) { atomicAdd(&bar[XB_TMO], 1u); break; } }
    }
    nloc = mine > 0u ? mine : 1u; nx = cnt > 0u ? cnt : 1u;
}

__device__ __forceinline__ void xcd_barrier(const XcdBarrier& b) {
    asm volatile("s_waitcnt vmcnt(0)" ::: "memory");
    __syncthreads();
    if (threadIdx.x == 0) {
        unsigned* bar = b.bar;
        __builtin_amdgcn_s_waitcnt(0);
        unsigned nloc = b.st[0], nx = b.st[1];
        if (nloc == 0u) { xcd_barrier_complete(bar, b.x, nloc, nx); b.st[0] = nloc; b.st[1] = nx; }
        const unsigned old = xb_add(&bar[XB_XSUB(b.x)], 1u);
        const unsigned gen = old / nloc;
        if (old + 1u == (gen + 1u) * nloc) {
            __builtin_amdgcn_fence(__ATOMIC_RELEASE, "agent");
            asm volatile("s_waitcnt vmcnt(0)" ::: "memory");
            const unsigned og = xb_add(&bar[XB_TOP], 1u);
            const unsigned tg = og / nx;
            if (og + 1u == (tg + 1u) * nx) xb_add(&bar[XB_TOPGEN], 1u);
            else XB_SPIN(xb_ld(&bar[XB_TOPGEN]) == tg, bar);
            __builtin_amdgcn_fence(__ATOMIC_ACQUIRE, "agent");
            xb_add(&bar[XB_XGEN(b.x)], 1u);
            asm volatile("s_waitcnt vmcnt(0)" ::: "memory");
        } else {
            XB_SPIN(xb_ld(&bar[XB_XGEN(b.x)]) == gen, bar);
            __builtin_amdgcn_fence(__ATOMIC_ACQUIRE, "agent");
            asm volatile("s_waitcnt vmcnt(0)" ::: "memory");
        }
    }
    __syncthreads();
}

constexpr int LDS_BYTES = 131072 + 64 + 8192;
#ifndef REP_PREP
#define REP_PREP 1
#define REP_INPROJ 1
#define REP_ATTN 1
#define REP_MERGE 1
#define REP_BCOMB 1
#define REP_N2 1
#define REP_TOPK 1
#define REP_MOE1 1
#define REP_MOE2 1
#endif
#define PH(...) do { Params q = p; { size_t z_ = 0; asm volatile("" : "+s"(z_)); q.ws = p.ws + z_; } __VA_ARGS__; } while (0)
#define GRID_BAR() do { XcdBarrier b_; { size_t z_ = 0; asm volatile("" : "+s"(z_)); b_.bar = (unsigned*)(p.ws + z_ + OFF_CTL); } b_.x = xb_xcc_id(); b_.st = (volatile LAS unsigned*)(lds + 131072); xcd_barrier(b_); } while (0)
__global__ void __launch_bounds__(512, 2) mega_fwd(Params p) {
    extern __shared__ __attribute__((aligned(16))) unsigned char lds_raw[];
    LAS unsigned char* lds = (LAS unsigned char*)lds_raw;
    { volatile LAS unsigned* xbw = (volatile LAS unsigned*)(lds + 131072);
      if (threadIdx.x == 0) { xbw[0] = 0u; xbw[1] = 0u; xbw[2] = 0u; xbw[3] = 0u; }
      __syncthreads();
      (void)xcd_barrier_post((unsigned*)(p.ws + OFF_CTL), xbw); }
    PH(prep_phase(q, (LAS float*)lds); norm1_phase<0>(q, 0));
    GRID_BAR();
#define LAYER(l) do { \
        if ((l) != 0) { PH(norm1_phase<1>(q, (l))); GRID_BAR(); } \
        PH(f_inproj_phase(q, (l), lds)); GRID_BAR(); \
        PH(f_gate_tail_units(q, (l), lds); prep_expert_phase(q, (l), (LAS float*)lds); f_attn_phase(q, (l), lds, (l))); GRID_BAR(); \
        PH(bcombine_phase(q)); GRID_BAR(); \
        PH(f_merge_phase(q, (l), lds)); GRID_BAR(); \
        PH(f_out_phase(q, (l), lds)); GRID_BAR(); \
        PH(norm2_router_phase(q, (l), (LAS float*)lds)); GRID_BAR(); \
        PH(topk_phase(q, (LAS unsigned*)lds)); GRID_BAR(); \
        PH(f_moe1_phase(q, (l), lds)); GRID_BAR(); \
        PH(f_moe2_phase(q, (l), lds)); GRID_BAR(); } while (0)
    LAYER(0); LAYER(1); LAYER(2); LAYER(3);
#undef LAYER
    PH(norm1_phase<2>(q, 0));
}

extern "C" void kernel_launch(void* const* d_in, const int* in_sizes, int n_in, void* d_out, int out_size, void* d_ws, size_t ws_size, hipStream_t stream) {
    (void)in_sizes; (void)out_size;
    static int grid = 0;
    if (grid == 0) {
        if (n_in != 16 || ws_size < OFF_END) { grid = -1; return; }
        int dev = 0, cus = 0, per_cu = 0;
        if (hipGetDevice(&dev) != hipSuccess || hipDeviceGetAttribute(&cus, hipDeviceAttributeMultiprocessorCount, dev) != hipSuccess) { grid = -1; return; }
        if (hipFuncSetAttribute((const void*)mega_fwd, hipFuncAttributeMaxDynamicSharedMemorySize, LDS_BYTES) != hipSuccess) { grid = -1; return; }
        if (hipOccupancyMaxActiveBlocksPerMultiprocessor(&per_cu, (const void*)mega_fwd, 512, LDS_BYTES) != hipSuccess || per_cu < 1) { (void)hipGetLastError(); }
        grid = cus;
    }
    if (grid < 0) return;
    if (hipMemsetAsync((char*)d_ws + OFF_CTL, 0, 65536, stream) != hipSuccess) return;
    Params p{};
    p.x = (const float*)d_in[0]; p.w_in = (const float*)d_in[1]; p.b_gate = (const float*)d_in[2]; p.sink = (const float*)d_in[3]; p.rpb = (const float*)d_in[4];
    p.w_a = (const float*)d_in[5]; p.w_b = (const float*)d_in[6]; p.w_c = (const float*)d_in[7]; p.w_out = (const float*)d_in[8]; p.norm_mix = (const float*)d_in[9];
    p.norm_ffn = (const float*)d_in[10]; p.w_router = (const float*)d_in[11]; p.w_gate_e = (const float*)d_in[12]; p.w_up_e = (const float*)d_in[13]; p.w_down_e = (const float*)d_in[14];
    p.norm_final = (const float*)d_in[15]; p.out = (float*)d_out; p.ws = (unsigned char*)d_ws;
    hipLaunchKernelGGL(mega_fwd, dim3(grid), dim3(512), LDS_BYTES, stream, p);
}
```

```cpp
#include <hip/hip_runtime.h>
#include <stdint.h>

#define DI __device__ __forceinline__
#define LAS __attribute__((address_space(3)))
typedef unsigned short bf16_t;
typedef short bf16x8 __attribute__((ext_vector_type(8)));
typedef float f32x2 __attribute__((ext_vector_type(2)));
typedef float f32x4 __attribute__((ext_vector_type(4)));
typedef float f32x16 __attribute__((ext_vector_type(16)));
typedef unsigned u32x2 __attribute__((ext_vector_type(2)));
typedef unsigned u32x4 __attribute__((ext_vector_type(4)));

constexpr int NTOK = 16384, DM = 1024, SEQ = 4096, NBATCH = 4, NLAYER = 4, NEXP = 16, FF = 2048, CAP = 512, PROJ = 5632;
constexpr int QKW = 1792;
constexpr int VCH = 768;
constexpr int OCW = 768;
constexpr int NROWS_E = NBATCH * CAP * NEXP;

constexpr size_t OFF_CTL = 0;
constexpr size_t OFF_COS = 65536;
constexpr size_t OFF_SIN = OFF_COS + (size_t)SEQ * 32 * 4;
constexpr size_t OFF_W   = 2u << 20;
constexpr size_t WIN_B = (size_t)4864 * 1024 * 2, WV_B = (size_t)768 * 1024 * 2, WM_B = (size_t)1024 * 768 * 2, WO_B = (size_t)1024 * 1024 * 2;
constexpr size_t WGU_B = (size_t)NEXP * 4096 * 1024 * 2, WD_B = (size_t)NEXP * 1024 * 2048 * 2;
constexpr size_t LW_WIN = 0, LW_WV = LW_WIN + WIN_B, LW_WM = LW_WV + WV_B, LW_WO = LW_WM + WM_B, LW_WGU = LW_WO + WO_B, LW_WD = LW_WGU + WGU_B, LW = LW_WD + WD_B;
constexpr size_t OFF_X   = OFF_W + NLAYER * LW;
constexpr size_t OFF_XN  = OFF_X + (size_t)NTOK * DM * 4;
constexpr size_t OFF_QK  = OFF_XN + (size_t)NTOK * DM * 2;
constexpr size_t OFF_VT  = OFF_QK + (size_t)NTOK * QKW * 2;
constexpr size_t OFF_G   = OFF_VT + (size_t)VCH * NTOK * 2;
constexpr size_t OFF_OC  = OFF_G + (size_t)NTOK * 3072 * 2;
constexpr size_t OFF_OB3 = OFF_OC + (size_t)NTOK * OCW * 2;
constexpr size_t OFF_LSE = OFF_OB3 + (size_t)3 * NTOK * 128 * 2;
constexpr size_t OFF_MG  = OFF_LSE + (size_t)3 * NTOK * 2 * 4;
constexpr size_t OFF_AFF = OFF_MG + (size_t)NTOK * DM * 2;
constexpr size_t OFF_IDX = OFF_AFF + (size_t)NTOK * NEXP * 4;
constexpr size_t OFF_VAL = OFF_IDX + (size_t)NROWS_E * 4;
constexpr size_t OFF_INV = OFF_VAL + (size_t)NROWS_E * 4;
constexpr size_t OFF_HID = OFF_INV + (size_t)NTOK * NEXP * 4;
constexpr size_t OFF_Y   = OFF_HID + (size_t)NROWS_E * FF * 2;
constexpr size_t OFF_XN8 = OFF_Y + (size_t)NROWS_E * DM * 2;
constexpr size_t OFF_END = OFF_XN8 + (size_t)NTOK * DM;

struct Params {
    const float *x, *w_in, *b_gate, *sink, *rpb, *w_a, *w_b, *w_c, *w_out, *norm_mix, *norm_ffn, *w_router, *w_gate_e, *w_up_e, *w_down_e, *norm_final;
    float* out; unsigned char* ws;
};
DI float*  P_COS(const Params& p) { return (float*)(p.ws + OFF_COS); }
DI float*  P_SIN(const Params& p) { return (float*)(p.ws + OFF_SIN); }
DI bf16_t* P_W(const Params& p, int l, size_t off) { return (bf16_t*)(p.ws + OFF_W + (size_t)l * LW + off); }
DI bf16_t* P_X(const Params& p) { return (bf16_t*)(p.ws + OFF_X); }
DI bf16_t* P_XN(const Params& p) { return (bf16_t*)(p.ws + OFF_XN); }
DI bf16_t* P_QK(const Params& p) { return (bf16_t*)(p.ws + OFF_QK); }
DI bf16_t* P_VT(const Params& p) { return (bf16_t*)(p.ws + OFF_VT); }
DI unsigned char* P_G(const Params& p) { return p.ws + OFF_G; }
DI bf16_t* P_OC(const Params& p) { return (bf16_t*)(p.ws + OFF_OC); }
DI bf16_t* P_OB3(const Params& p) { return (bf16_t*)(p.ws + OFF_OB3); }
DI float*  P_LSE(const Params& p) { return (float*)(p.ws + OFF_LSE); }
DI bf16_t* P_MG(const Params& p) { return (bf16_t*)(p.ws + OFF_MG); }
DI float*  P_AFF(const Params& p) { return (float*)(p.ws + OFF_AFF); }
DI int*    P_IDX(const Params& p) { return (int*)(p.ws + OFF_IDX); }
DI float*  P_VAL(const Params& p) { return (float*)(p.ws + OFF_VAL); }
DI int*    P_INV(const Params& p) { return (int*)(p.ws + OFF_INV); }
DI bf16_t* P_HID(const Params& p) { return (bf16_t*)(p.ws + OFF_HID); }
DI bf16_t* P_Y(const Params& p) { return (bf16_t*)(p.ws + OFF_Y); }
DI unsigned char* P_XN8(const Params& p) { return p.ws + OFF_XN8; }

DI unsigned f2bf(float f) { unsigned u = __float_as_uint(f); return (u + 0x7fffu + ((u >> 16) & 1u)) >> 16; }
DI unsigned pk2(float lo, float hi) { return f2bf(lo) | (f2bf(hi) << 16); }
constexpr float W8_SCALE = 32.0f, H8_SCALE = 4.0f;
DI unsigned pk4_fp8(float a, float b, float c, float d) { unsigned w = 0u; w = __builtin_amdgcn_cvt_pk_fp8_f32(a, b, w, false); w = __builtin_amdgcn_cvt_pk_fp8_f32(c, d, w, true); return w; }
DI float bf2f(unsigned b) { return __uint_as_float(b << 16); }
DI float bflo(unsigned w) { return __uint_as_float(w << 16); }
DI float bfhi(unsigned w) { return __uint_as_float(w & 0xffff0000u); }
DI float shx(float v, int d, int lane) { return __uint_as_float((unsigned)__builtin_amdgcn_ds_bpermute((lane ^ d) << 2, (int)__float_as_uint(v))); }
DI unsigned shl_abs(unsigned v, int src_lane) { return (unsigned)__builtin_amdgcn_ds_bpermute(src_lane << 2, (int)v); }
DI int otid() { int t = threadIdx.x; asm volatile("" : "+v"(t)); return t; }
DI int pos16(int t) { return ((t & 15) << 8) | (t >> 4); }

constexpr int JOBS_PER_LAYER = 26432, SMALL_JOBS = 1856;
DI void prep_job(const Params& p, int l, int j, const float*& src, int& src_ld, bf16_t*& dst, int& dst_ld) {
    if (j < 1216) {
        const int nblk = j >> 3, kc = j & 7; int sc;
        if (nblk < 40) { const int t = nblk >> 3, sb = nblk & 7, bj = sb >> 2, wc = sb & 3, hr = 4 * t + wc;
            const int base = hr < 6 ? 64 * hr : hr < 8 ? 384 + 64 * (hr - 6) : hr < 14 ? 640 + 64 * (hr - 8) : 1024 + 64 * (hr - 14);
            sc = base + 32 * bj; }
        else if (nblk < 56) { const int c = 32 * (nblk - 40); sc = c < 256 ? 1792 + c : 2048 + (c - 256); }
        else sc = 2560 + 32 * (nblk - 56);
        src = p.w_in + (size_t)l * DM * PROJ + (size_t)(128 * kc) * PROJ + sc; src_ld = PROJ;
        dst = P_W(p, l, LW_WIN) + (size_t)(32 * nblk) * 1024 + 128 * kc; dst_ld = 1024; return;
    }
    j -= 1216;
    if (j < 192) {
        const int nblk = j >> 3, kc = j & 7, ch = 32 * nblk;
        const int sc = ch < 128 ? 512 + ch : ch < 256 ? 1408 + (ch - 128) : ch < 512 ? 2304 + (ch - 256) : 1536 + (ch - 512);
        src = p.w_in + (size_t)l * DM * PROJ + (size_t)(128 * kc) * PROJ + sc; src_ld = PROJ;
        dst = P_W(p, l, LW_WV) + (size_t)ch * 1024 + 128 * kc; dst_ld = 1024; return;
    }
    j -= 192;
    if (j < 192) {
        bf16_t* wm = P_W(p, l, LW_WM); src_ld = 1024; dst_ld = 768;
        if (j < 96) { const int nblk = j / 3, kc = j % 3; src = p.w_a + (size_t)l * 384 * 1024 + (size_t)(128 * kc) * 1024 + 32 * nblk; dst = wm + (size_t)(32 * nblk) * 768 + 128 * kc; }
        else if (j < 128) { const int nblk = j - 96; src = p.w_b + (size_t)l * 128 * 1024 + 32 * nblk; dst = wm + (size_t)(32 * nblk) * 768 + 384; }
        else { const int jj = j - 128, nblk = jj >> 1, kc = jj & 1; src = p.w_c + (size_t)l * 256 * 1024 + (size_t)(128 * kc) * 1024 + 32 * nblk; dst = wm + (size_t)(32 * nblk) * 768 + 512 + 128 * kc; }
        return;
    }
    j -= 192;
    if (j < 256) {
        const int nblk = j >> 3, kc = j & 7;
        src = p.w_out + (size_t)l * 1024 * 1024 + (size_t)(128 * kc) * 1024 + 32 * nblk; src_ld = 1024;
        dst = P_W(p, l, LW_WO) + (size_t)(32 * nblk) * 1024 + 128 * kc; dst_ld = 1024; return;
    }
    j -= 256;
    if (j < 16384) {
        const int e = j >> 10, r = j & 1023, nblk = r >> 3, kc = r & 7, row0 = 32 * nblk, pp = row0 >> 8, s = row0 & 255;
        const float* w = s < 128 ? p.w_gate_e : p.w_up_e; const int col = 128 * pp + (s & 127);
        src = w + ((size_t)(l * NEXP + e) * 1024 + 128 * kc) * 2048 + col; src_ld = 2048;
        dst = (bf16_t*)((unsigned char*)P_W(p, l, LW_WGU) + ((size_t)e * 4096 + row0) * 1024 + 128 * kc); dst_ld = 1024; return;
    }
    j -= 16384;
    {
        const int e = j >> 9, r = j & 511, nblk = r >> 4, kc = r & 15;
        src = p.w_down_e + ((size_t)(l * NEXP + e) * 2048 + 128 * kc) * 1024 + 32 * nblk; src_ld = 1024;
        dst = (bf16_t*)((unsigned char*)P_W(p, l, LW_WD) + ((size_t)e * 1024 + 32 * nblk) * 2048 + 128 * kc); dst_ld = 2048;
    }
}
DI void sincos_d(double a, double& s, double& c) {
    const double q = rint(a * 0.63661977236758134308);
    double r = fma(-q, 1.57079632679489655800e+00, a); r = fma(-q, 6.12323399573676603587e-17, r);
    const double r2 = r * r;
    double sp = 1.58969099521155010221e-10; sp = fma(sp, r2, -2.50507602534068634195e-08); sp = fma(sp, r2, 2.75573137070700676789e-06); sp = fma(sp, r2, -1.98412698298579493134e-04);
    sp = fma(sp, r2, 8.33333333332248946124e-03); sp = fma(sp, r2, -1.66666666666666324348e-01); const double sr = fma(r * r2, sp, r);
    double cp = -1.13596475577881948265e-11; cp = fma(cp, r2, 2.08757232129817482790e-09); cp = fma(cp, r2, -2.75573143513906633035e-07); cp = fma(cp, r2, 2.48015872894767294178e-05);
    cp = fma(cp, r2, -1.38888888888741095749e-03); cp = fma(cp, r2, 4.16666666666666019037e-02); const double cr = fma(r2 * r2, cp, fma(-0.5, r2, 1.0));
    const int qi = ((int)q) & 3;
    s = qi == 0 ? sr : qi == 1 ? cr : qi == 2 ? -sr : -cr;
    c = qi == 0 ? cr : qi == 1 ? -sr : qi == 2 ? -cr : sr;
}
DI void prep_phase(const Params& p, LAS float* scr) {
    const int tid = otid();
    for (int i = blockIdx.x * 512 + tid; i < SEQ * 32; i += gridDim.x * 512) {
        const int pos = i >> 5, j = i & 31;
        double fr = 1.0; for (int jj = 0; jj < j; ++jj) fr *= 0.7498942093324559;
        const float invf = (float)fr;
        const float ang = (float)pos * invf; double s, c; sincos_d((double)ang, s, c);
        P_COS(p)[i] = (float)c; P_SIN(p)[i] = (float)s;
    }
    const int total = NLAYER * SMALL_JOBS;
    int u = blockIdx.x;
    const float* src; bf16_t* dst; int src_ld, dst_ld, j = 0;
    f32x4 r0, r1;
    if (u < total) { const int l = u / SMALL_JOBS; j = u - l * SMALL_JOBS; prep_job(p, l, j, src, src_ld, dst, dst_ld);
        r0 = *(const f32x4*)(src + (size_t)(tid >> 3) * src_ld + 4 * (tid & 7)); r1 = *(const f32x4*)(src + (size_t)((tid + 512) >> 3) * src_ld + 4 * (tid & 7)); }
    int buf = 0;
    for (; u < total; u += gridDim.x) {
        LAS float* sc = scr + buf * (128 * 33);
        { const int k = tid >> 3, c4 = tid & 7;
          sc[k * 33 + 4 * c4 + 0] = r0[0]; sc[k * 33 + 4 * c4 + 1] = r0[1]; sc[k * 33 + 4 * c4 + 2] = r0[2]; sc[k * 33 + 4 * c4 + 3] = r0[3];
          sc[(k + 64) * 33 + 4 * c4 + 0] = r1[0]; sc[(k + 64) * 33 + 4 * c4 + 1] = r1[1]; sc[(k + 64) * 33 + 4 * c4 + 2] = r1[2]; sc[(k + 64) * 33 + 4 * c4 + 3] = r1[3]; }
        bf16_t* dcur = dst; const int dld = dst_ld, jcur = j;
        const int un = u + gridDim.x;
        if (un < total) { const int l = un / SMALL_JOBS; j = un - l * SMALL_JOBS; prep_job(p, l, j, src, src_ld, dst, dst_ld);
            r0 = *(const f32x4*)(src + (size_t)(tid >> 3) * src_ld + 4 * (tid & 7)); r1 = *(const f32x4*)(src + (size_t)((tid + 512) >> 3) * src_ld + 4 * (tid & 7)); }
        __syncthreads();
        { const int n = tid >> 4, k8 = (tid & 15) * 8;
          if (jcur >= 1856) {
            u32x2 w; w[0] = pk4_fp8(sc[(k8 + 0) * 33 + n] * W8_SCALE, sc[(k8 + 1) * 33 + n] * W8_SCALE, sc[(k8 + 2) * 33 + n] * W8_SCALE, sc[(k8 + 3) * 33 + n] * W8_SCALE);
            w[1] = pk4_fp8(sc[(k8 + 4) * 33 + n] * W8_SCALE, sc[(k8 + 5) * 33 + n] * W8_SCALE, sc[(k8 + 6) * 33 + n] * W8_SCALE, sc[(k8 + 7) * 33 + n] * W8_SCALE);
            *(u32x2*)((unsigned char*)dcur + (size_t)n * dld + k8) = w;
          } else { u32x4 w;
            w[0] = pk2(sc[(k8 + 0) * 33 + n], sc[(k8 + 1) * 33 + n]); w[1] = pk2(sc[(k8 + 2) * 33 + n], sc[(k8 + 3) * 33 + n]);
            w[2] = pk2(sc[(k8 + 4) * 33 + n], sc[(k8 + 5) * 33 + n]); w[3] = pk2(sc[(k8 + 6) * 33 + n], sc[(k8 + 7) * 33 + n]);
            *(u32x4*)(dcur + (size_t)n * dld + k8) = w; } }
        buf ^= 1;
    }
    __syncthreads();
}

template <bool GU> DI void expert_addr(const Params& p, int l, int x, const float*& src, unsigned char*& dst) {
    if (GU) { const int e = x >> 10, nblk = (x >> 3) & 127, kc = x & 7;
        const float* wsel = (nblk & 4) ? p.w_up_e : p.w_gate_e;
        src = wsel + ((size_t)(l * NEXP + e) * 1024 + 128 * kc) * 2048 + 128 * (nblk >> 3) + 32 * (nblk & 3);
        dst = (unsigned char*)P_W(p, l, LW_WGU) + ((size_t)e * 4096 + 32 * nblk) * 1024 + 128 * kc; }
    else { const int e = x >> 9, nblk = (x >> 4) & 31, kc = x & 15;
        src = p.w_down_e + ((size_t)(l * NEXP + e) * 2048 + 128 * kc) * 1024 + 32 * nblk;
        dst = (unsigned char*)P_W(p, l, LW_WD) + ((size_t)e * 1024 + 32 * nblk) * 2048 + 128 * kc; }
}
constexpr int NPREP = 128;
constexpr int TK_WGS = 192, TK_JOBS = 16 * TK_WGS;
template <bool GU> DI void prep_expert_loop(const Params& p, int l, LAS unsigned* img, int tid, int w, int nwg, int x0, int NJ) {
    constexpr int D = 8, SLD = GU ? 2048 : 1024, DLD = GU ? 1024 : 2048;
    f32x4 r[D][2];
    const float* src; unsigned char* dst;
    const int lo = (tid >> 3) * SLD + 4 * (tid & 7);
    const int kq = tid & 31, nq = (tid >> 5) & 7, half = tid >> 8;
    const unsigned selx = half ? 0x07030602u : 0x05010400u;
    const int oo = (4 * nq + 2 * half) * DLD + 4 * kq;
#pragma unroll
    for (int d = 0; d < D; ++d) { expert_addr<GU>(p, l, x0 + nwg * d + w, src, dst); r[d][0] = *(const f32x4*)(src + lo); r[d][1] = *(const f32x4*)(src + lo + 64 * SLD); }
#pragma unroll 1
    for (int i = 0; i < NJ; i += D) {
#pragma unroll
        for (int d = 0; d < D; ++d) {
            LAS unsigned* sc = img + (d & 1) * (128 * 9);
            { const int k = tid >> 3, c4 = tid & 7;
              sc[k * 9 + c4] = pk4_fp8(r[d][0][0] * W8_SCALE, r[d][0][1] * W8_SCALE, r[d][0][2] * W8_SCALE, r[d][0][3] * W8_SCALE);
              sc[(k + 64) * 9 + c4] = pk4_fp8(r[d][1][0] * W8_SCALE, r[d][1][1] * W8_SCALE, r[d][1][2] * W8_SCALE, r[d][1][3] * W8_SCALE); }
            { const int nx = min(i + d + D, NJ - 1);
              expert_addr<GU>(p, l, x0 + nwg * nx + w, src, dst); r[d][0] = *(const f32x4*)(src + lo); r[d][1] = *(const f32x4*)(src + lo + 64 * SLD); }
            expert_addr<GU>(p, l, x0 + nwg * (i + d) + w, src, dst);
            __syncthreads();
            { const unsigned a = sc[(4 * kq + 0) * 9 + nq], b = sc[(4 * kq + 1) * 9 + nq], c = sc[(4 * kq + 2) * 9 + nq], e = sc[(4 * kq + 3) * 9 + nq];
              const unsigned tl = __builtin_amdgcn_perm(b, a, selx), th = __builtin_amdgcn_perm(e, c, selx);
              *(unsigned*)(dst + oo) = __builtin_amdgcn_perm(th, tl, 0x05040100u); *(unsigned*)(dst + oo + DLD) = __builtin_amdgcn_perm(th, tl, 0x07060302u); }
        }
    }
}
DI void prep_expert_phase(const Params& p, int l, LAS float* scr) {
    if (blockIdx.x < 256 - NPREP) return;
    const int tid = otid(), w = blockIdx.x - (256 - NPREP);
    prep_expert_loop<true>(p, l, (LAS unsigned*)scr, tid, w, NPREP, 0, 16384 / NPREP);
    prep_expert_loop<false>(p, l, (LAS unsigned*)scr, tid, w, NPREP, TK_JOBS, (8192 - TK_JOBS) / NPREP);
    __syncthreads();
}
DI void prep_expert_topk(const Params& p, int l, LAS float* scr) {
    if (blockIdx.x < 256 - TK_WGS) return;
    prep_expert_loop<false>(p, l, (LAS unsigned*)scr, otid(), blockIdx.x - (256 - TK_WGS), TK_WGS, 0, TK_JOBS / TK_WGS);
    __syncthreads();
}

DI int eo4(int lane, int i) { return 8 * lane + 512 * (i >> 1) + 4 * (i & 1); }
DI void unpk8(f32x4& a, f32x4& b, const u32x4& w) { a[0] = bflo(w[0]); a[1] = bfhi(w[0]); a[2] = bflo(w[1]); a[3] = bfhi(w[1]); b[0] = bflo(w[2]); b[1] = bfhi(w[2]); b[2] = bflo(w[3]); b[3] = bfhi(w[3]); }
DI void add8(f32x4& a, f32x4& b, const u32x4& w) { a[0] += bflo(w[0]); a[1] += bfhi(w[0]); a[2] += bflo(w[1]); a[3] += bfhi(w[1]); b[0] += bflo(w[2]); b[1] += bfhi(w[2]); b[2] += bflo(w[3]); b[3] += bfhi(w[3]); }
DI u32x4 pk8(const f32x4& a, const f32x4& b) { u32x4 w; w[0] = pk2(a[0], a[1]); w[1] = pk2(a[2], a[3]); w[2] = pk2(b[0], b[1]); w[3] = pk2(b[2], b[3]); return w; }
template <int MODE> DI void norm1_phase(const Params& p, int l) {
    const int tid = otid(), lane = tid & 63, wid = tid >> 6;
    const float* gain = MODE == 2 ? p.norm_final : p.norm_mix + (size_t)l * DM;
    f32x4 g[4];
#pragma unroll
    for (int i = 0; i < 4; ++i) g[i] = *(const f32x4*)(gain + eo4(lane, i));
    const int nw = gridDim.x * 8;
    for (int row0 = blockIdx.x * 8 + wid; row0 < NTOK; row0 += 2 * nw) {
        const int row1 = row0 + nw;
        f32x4 v0[4], v1[4];
        if (MODE == 0) {
#pragma unroll
            for (int i = 0; i < 4; ++i) { v0[i] = *(const f32x4*)(p.x + (size_t)row0 * DM + eo4(lane, i)); v1[i] = *(const f32x4*)(p.x + (size_t)row1 * DM + eo4(lane, i)); }
        } else {
            u32x4 a[2], b[2];
#pragma unroll
            for (int j = 0; j < 2; ++j) { a[j] = *(const u32x4*)(P_X(p) + (size_t)row0 * DM + 8 * lane + 512 * j); b[j] = *(const u32x4*)(P_X(p) + (size_t)row1 * DM + 8 * lane + 512 * j); }
            const int c0 = lane < NEXP ? P_INV(p)[(size_t)row0 * NEXP + lane] : -1, c1 = lane < NEXP ? P_INV(p)[(size_t)row1 * NEXP + lane] : -1;
#pragma unroll
            for (int j = 0; j < 2; ++j) { unpk8(v0[2 * j], v0[2 * j + 1], a[j]); unpk8(v1[2 * j], v1[2 * j + 1], b[j]); }
            unsigned long long m0 = __ballot(c0 >= 0), m1 = __ballot(c1 >= 0);
            const bf16_t* ybase0 = P_Y(p) + (size_t)((row0 >> 12) * CAP) * DM; const bf16_t* ybase1 = P_Y(p) + (size_t)((row1 >> 12) * CAP) * DM;
            while (m0 | m1) {
                u32x4 w0[2], w1[2]; const bool h0 = m0 != 0ull, h1 = m1 != 0ull;
                if (h0) { const int e = __builtin_ctzll(m0); m0 &= m0 - 1ull; const int c = __builtin_amdgcn_readlane(c0, e); const bf16_t* yr = ybase0 + (size_t)(e * NBATCH * CAP + c) * DM;
#pragma unroll
                    for (int j = 0; j < 2; ++j) w0[j] = *(const u32x4*)(yr + 8 * lane + 512 * j); }
                if (h1) { const int e = __builtin_ctzll(m1); m1 &= m1 - 1ull; const int c = __builtin_amdgcn_readlane(c1, e); const bf16_t* yr = ybase1 + (size_t)(e * NBATCH * CAP + c) * DM;
#pragma unroll
                    for (int j = 0; j < 2; ++j) w1[j] = *(const u32x4*)(yr + 8 * lane + 512 * j); }
                if (h0) {
#pragma unroll
                    for (int j = 0; j < 2; ++j) add8(v0[2 * j], v0[2 * j + 1], w0[j]); }
                if (h1) {
#pragma unroll
                    for (int j = 0; j < 2; ++j) add8(v1[2 * j], v1[2 * j + 1], w1[j]); }
            }
        }
        if (MODE != 2) {
#pragma unroll
            for (int j = 0; j < 2; ++j) { *(u32x4*)(P_X(p) + (size_t)row0 * DM + 8 * lane + 512 * j) = pk8(v0[2 * j], v0[2 * j + 1]); *(u32x4*)(P_X(p) + (size_t)row1 * DM + 8 * lane + 512 * j) = pk8(v1[2 * j], v1[2 * j + 1]); }
        }
        float s0 = 0.f, s1 = 0.f;
#pragma unroll
        for (int i = 0; i < 4; ++i) { s0 += v0[i][0] * v0[i][0] + v0[i][1] * v0[i][1] + v0[i][2] * v0[i][2] + v0[i][3] * v0[i][3]; s1 += v1[i][0] * v1[i][0] + v1[i][1] * v1[i][1] + v1[i][2] * v1[i][2] + v1[i][3] * v1[i][3]; }
#pragma unroll
        for (int d = 32; d >= 1; d >>= 1) { s0 += shx(s0, d, lane); s1 += shx(s1, d, lane); }
        const float r0 = rsqrtf(s0 * (1.0f / DM) + 1e-6f), r1 = rsqrtf(s1 * (1.0f / DM) + 1e-6f);
#pragma unroll
        for (int i = 0; i < 4; ++i) { v0[i] = v0[i] * r0 * g[i]; v1[i] = v1[i] * r1 * g[i]; }
        if (MODE == 2) {
#pragma unroll
            for (int i = 0; i < 4; ++i) { *(f32x4*)(p.out + (size_t)row0 * DM + eo4(lane, i)) = v0[i]; *(f32x4*)(p.out + (size_t)row1 * DM + eo4(lane, i)) = v1[i]; }
        } else {
#pragma unroll
            for (int j = 0; j < 2; ++j) { *(u32x4*)(P_XN(p) + (size_t)row0 * DM + 8 * lane + 512 * j) = pk8(v0[2 * j], v0[2 * j + 1]); *(u32x4*)(P_XN(p) + (size_t)row1 * DM + 8 * lane + 512 * j) = pk8(v1[2 * j], v1[2 * j + 1]); }
        }
    }
}

DI float reduce16(const float (&a)[16], int lane) {
    float b8[8], b4[4], b2[2];
    { const bool hi = (lane & 32) != 0;
#pragma unroll
      for (int j = 0; j < 8; ++j) { const float snd = hi ? a[j] : a[j + 8], kp = hi ? a[j + 8] : a[j]; b8[j] = kp + shx(snd, 32, lane); } }
    { const bool hi = (lane & 16) != 0;
#pragma unroll
      for (int j = 0; j < 4; ++j) { const float snd = hi ? b8[j] : b8[j + 4], kp = hi ? b8[j + 4] : b8[j]; b4[j] = kp + shx(snd, 16, lane); } }
    { const bool hi = (lane & 8) != 0;
#pragma unroll
      for (int j = 0; j < 2; ++j) { const float snd = hi ? b4[j] : b4[j + 2], kp = hi ? b4[j + 2] : b4[j]; b2[j] = kp + shx(snd, 8, lane); } }
    float r;
    { const bool hi = (lane & 4) != 0; const float snd = hi ? b2[0] : b2[1], kp = hi ? b2[1] : b2[0]; r = kp + shx(snd, 4, lane); }
    r += shx(r, 2, lane); r += shx(r, 1, lane);
    return r;
}
DI void norm2_router_phase(const Params& p, int l, LAS float* wr) {
    const int tid = otid(), lane = tid & 63, wid = tid >> 6;
    for (int i = tid; i < DM * NEXP; i += 512) { const int d = i >> 4;
        wr[(i & 15) * DM + ((d >> 9) * 2 + ((d >> 2) & 1)) * 256 + 4 * ((d & 511) >> 3) + (d & 3)] = p.w_router[(size_t)l * DM * NEXP + i]; }
    __syncthreads();
    const float* gain = p.norm_ffn + (size_t)l * DM;
    f32x4 g[4];
#pragma unroll
    for (int i = 0; i < 4; ++i) g[i] = *(const f32x4*)(gain + eo4(lane, i));
    const int nw = gridDim.x * 8;
    for (int row0 = blockIdx.x * 8 + wid; row0 < NTOK; row0 += 2 * nw) {
        const int row1 = row0 + nw;
        f32x4 v0[4], v1[4]; float s0 = 0.f, s1 = 0.f;
        { u32x4 a[2], b[2];
#pragma unroll
          for (int j = 0; j < 2; ++j) { a[j] = *(const u32x4*)(P_X(p) + (size_t)row0 * DM + 8 * lane + 512 * j); b[j] = *(const u32x4*)(P_X(p) + (size_t)row1 * DM + 8 * lane + 512 * j); }
#pragma unroll
          for (int j = 0; j < 2; ++j) { unpk8(v0[2 * j], v0[2 * j + 1], a[j]); unpk8(v1[2 * j], v1[2 * j + 1], b[j]); } }
#pragma unroll
        for (int i = 0; i < 4; ++i) { s0 += v0[i][0] * v0[i][0] + v0[i][1] * v0[i][1] + v0[i][2] * v0[i][2] + v0[i][3] * v0[i][3]; s1 += v1[i][0] * v1[i][0] + v1[i][1] * v1[i][1] + v1[i][2] * v1[i][2] + v1[i][3] * v1[i][3]; }
#pragma unroll
        for (int d = 32; d >= 1; d >>= 1) { s0 += shx(s0, d, lane); s1 += shx(s1, d, lane); }
        const float r0 = rsqrtf(s0 * (1.0f / DM) + 1e-6f), r1 = rsqrtf(s1 * (1.0f / DM) + 1e-6f);
#pragma unroll
        for (int i = 0; i < 4; ++i) { v0[i] = v0[i] * r0 * g[i]; v1[i] = v1[i] * r1 * g[i]; }
#pragma unroll
        for (int j = 0; j < 2; ++j) { u32x2 w;
            w[0] = pk4_fp8(v0[2 * j][0], v0[2 * j][1], v0[2 * j][2], v0[2 * j][3]); w[1] = pk4_fp8(v0[2 * j + 1][0], v0[2 * j + 1][1], v0[2 * j + 1][2], v0[2 * j + 1][3]);
            *(u32x2*)(P_XN8(p) + (size_t)row0 * DM + 8 * lane + 512 * j) = w;
            w[0] = pk4_fp8(v1[2 * j][0], v1[2 * j][1], v1[2 * j][2], v1[2 * j][3]); w[1] = pk4_fp8(v1[2 * j + 1][0], v1[2 * j + 1][1], v1[2 * j + 1][2], v1[2 * j + 1][3]);
            *(u32x2*)(P_XN8(p) + (size_t)row1 * DM + 8 * lane + 512 * j) = w; }
        float a0[NEXP], a1[NEXP];
#pragma unroll
        for (int e = 0; e < NEXP; ++e) { float x0 = 0.f, x1 = 0.f;
#pragma unroll
            for (int i = 0; i < 4; ++i) { const f32x4 w = *(const LAS f32x4*)(wr + e * DM + 4 * lane + 256 * i);
                x0 += v0[i][0] * w[0] + v0[i][1] * w[1] + v0[i][2] * w[2] + v0[i][3] * w[3]; x1 += v1[i][0] * w[0] + v1[i][1] * w[1] + v1[i][2] * w[2] + v1[i][3] * w[3]; }
            a0[e] = x0; a1[e] = x1;
            if ((e & 3) == 3) __builtin_amdgcn_sched_barrier(0); }
        const float l0 = reduce16(a0, lane), l1 = reduce16(a1, lane);
        float m0 = l0, m1 = l1;
#pragma unroll
        for (int d = 32; d >= 4; d >>= 1) { m0 = fmaxf(m0, shx(m0, d, lane)); m1 = fmaxf(m1, shx(m1, d, lane)); }
        const float e0 = __expf(l0 - m0), e1 = __expf(l1 - m1); float d0 = e0, d1 = e1;
#pragma unroll
        for (int d = 32; d >= 4; d >>= 1) { d0 += shx(d0, d, lane); d1 += shx(d1, d, lane); }
        if ((lane & 3) == 0) { const int e = lane >> 2;
            P_AFF(p)[((size_t)((row0 >> 12) * NEXP + e)) * SEQ + (row0 & 4095)] = e0 / d0; P_AFF(p)[((size_t)((row1 >> 12) * NEXP + e)) * SEQ + (row1 & 4095)] = e1 / d1; }
    }
}

DI void topk_phase(const Params& p, LAS unsigned* lds) {
    const int tid = otid(), lane = tid & 63, wid = tid >> 6;
    LAS unsigned* hist = lds; LAS unsigned* sh = lds + 256; LAS unsigned* wtot = lds + 272;
    for (int be = blockIdx.x; be < NBATCH * NEXP; be += gridDim.x) {
        const int b = be >> 4, e = be & 15;
        const float* aff = P_AFF(p) + (size_t)be * SEQ + tid * 8;
        const f32x4 a0 = *(const f32x4*)aff, a1 = *(const f32x4*)(aff + 4);
        unsigned key[8];
#pragma unroll
        for (int i = 0; i < 4; ++i) { key[i] = __float_as_uint(a0[i]); key[4 + i] = __float_as_uint(a1[i]); }
        unsigned prefix = 0u, mask = 0u, krem = CAP;
        for (int pass = 3; pass >= 0; --pass) {
            const int shift = 8 * pass;
            if (tid < 256) hist[tid] = 0u;
            __syncthreads();
#pragma unroll
            for (int i = 0; i < 8; ++i) if ((key[i] & mask) == prefix) atomicAdd((unsigned*)&hist[(key[i] >> shift) & 255u], 1u);
            __syncthreads();
            if (wid == 0) {
                const unsigned h0 = hist[4 * lane], h1 = hist[4 * lane + 1], h2 = hist[4 * lane + 2], h3 = hist[4 * lane + 3], s = h0 + h1 + h2 + h3;
                unsigned suf = s;
#pragma unroll
                for (int d = 1; d < 64; d <<= 1) { const unsigned t = shl_abs(suf, (lane + d) & 63); if (lane + d < 64) suf += t; }
                const unsigned above = suf - s;
                if (above < krem && krem <= suf) {
                    unsigned a = above; unsigned bin, nk;
                    if (a + h3 >= krem) { bin = 4 * lane + 3; nk = krem - a; }
                    else { a += h3; if (a + h2 >= krem) { bin = 4 * lane + 2; nk = krem - a; }
                        else { a += h2; if (a + h1 >= krem) { bin = 4 * lane + 1; nk = krem - a; } else { a += h1; bin = 4 * lane; nk = krem - a; } } }
                    sh[0] = prefix | (bin << shift); sh[1] = nk;
                }
            }
            __syncthreads();
            prefix = sh[0]; krem = sh[1]; mask |= 0xFFu << shift;
            __syncthreads();
        }
        unsigned cg = 0u, ce = 0u;
#pragma unroll
        for (int i = 0; i < 8; ++i) { cg += key[i] > prefix ? 1u : 0u; ce += key[i] == prefix ? 1u : 0u; }
        unsigned pk = cg | (ce << 16), incl = pk;
#pragma unroll
        for (int d = 1; d < 64; d <<= 1) { const unsigned t = shl_abs(incl, (lane - d) & 63); if (lane >= d) incl += t; }
        if (lane == 63) wtot[wid] = incl;
        __syncthreads();
        unsigned woff = 0u;
#pragma unroll
        for (int w = 0; w < 8; ++w) woff += w < wid ? wtot[w] : 0u;
        const unsigned excl = woff + incl - pk;
        unsigned gtb = excl & 0xffffu, eqb = excl >> 16;
        int* idxo = P_IDX(p) + (size_t)(e * NBATCH + b) * CAP; float* valo = P_VAL(p) + (size_t)(e * NBATCH + b) * CAP;
        int* inv = P_INV(p) + ((size_t)b * SEQ + tid * 8) * NEXP + e;
#pragma unroll
        for (int i = 0; i < 8; ++i) {
            int slot = -1;
            if (key[i] > prefix) { slot = (int)(gtb + (eqb < krem ? eqb : krem)); ++gtb; }
            else if (key[i] == prefix) { if (eqb < krem) slot = (int)(gtb + eqb); ++eqb; }
            if (slot >= 0) { idxo[slot] = tid * 8 + i; valo[slot] = __uint_as_float(key[i]); }
            inv[(size_t)i * NEXP] = slot;
        }
        __syncthreads();
    }
}

namespace at {
constexpr int NUNIT_A = 1536, NUNIT_C = 1024, NUNIT_B = 1536, NUNIT = NUNIT_A + NUNIT_C + NUNIT_B;
DI unsigned cvt2(float lo, float hi) { typedef __bf16 bf2_t __attribute__((ext_vector_type(2))); const f32x2 v = {lo, hi}; const bf2_t b = __builtin_convertvector(v, bf2_t); return __builtin_bit_cast(unsigned, b); }
DI bf16x8 pack8(const f32x16& x, int s8) { u32x4 w; w[0] = cvt2(x[s8 + 0], x[s8 + 1]); w[1] = cvt2(x[s8 + 2], x[s8 + 3]); w[2] = cvt2(x[s8 + 4], x[s8 + 5]); w[3] = cvt2(x[s8 + 6], x[s8 + 7]); return __builtin_bit_cast(bf16x8, w); }
DI int koffmap(int r, bool g1) { return g1 ? 4 * (4 * ((r >> 3) & 1) + (r & 3)) + 2 * (r >> 4) + ((r >> 2) & 1) : (r & 16) + 8 * ((r >> 2) & 1) + 4 * ((r >> 3) & 1) + (r & 3); }

DI float xh_max(float v) { const auto r = __builtin_amdgcn_permlane32_swap(__float_as_uint(v), __float_as_uint(v), false, false); return fmaxf(__uint_as_float(r[0]), __uint_as_float(r[1])); }
DI float xh_sum(float v) { const auto r = __builtin_amdgcn_permlane32_swap(__float_as_uint(v), __float_as_uint(v), false, false); return __uint_as_float(r[0]) + __uint_as_float(r[1]); }
constexpr float LOG2E = 1.4426950408889634f, LN2 = 0.6931471805599453f;
struct QState { float m, den; f32x16 O0, O1; };
DI void softmax_tile(f32x16& S, QState& st, bf16x8& p0, bf16x8& p1) {
    float mx = fmaxf(S[0], S[1]);
#pragma unroll
    for (int i = 2; i < 16; i += 2) mx = fmaxf(mx, fmaxf(S[i], S[i + 1]));
    mx = xh_max(mx);
    const float mn = fmaxf(st.m, mx), alpha = __builtin_amdgcn_exp2f(st.m - mn);
    float ps = 0.f;
#pragma unroll
    for (int i = 0; i < 16; ++i) { S[i] = __builtin_amdgcn_exp2f(S[i] - mn); ps += S[i]; }
    ps = xh_sum(ps);
    st.den = st.den * alpha + ps; st.m = mn;
#pragma unroll
    for (int i = 0; i < 16; ++i) { st.O0[i] *= alpha; st.O1[i] *= alpha; }
    p0 = pack8(S, 0); p1 = pack8(S, 8);
}
template <int MODE> DI void mask_tile(f32x16& S, int tn, int NT, int q, int h, int t, int qrow, int sr_q, int sc_q, int kc0, int qcg, const LAS float* bt_head) {
    if (MODE == 3) {
        const bool rowok = t >= sr_q && t < sr_q + 8; const LAS float* bt = bt_head + (t - qrow + 7) * 31 + 15 - qcg;
#pragma unroll
        for (int i = 0; i < 16; ++i) { const int kc = kc0 + 16 * (i >> 3) + 8 * h + (i & 7); const bool ok = rowok && kc >= sc_q && kc < sc_q + 16;
            const int bi = ok ? kc : qcg; S[i] = ok ? S[i] + bt[bi] : -1e37f; }
    } else {
        const int edge = tn == 0 ? 1 : tn == NT - 1 ? 2 : 0;
        if (edge != 0) {
            int qq = MODE == 2 ? q - h : q - 8 * h; asm volatile("" : "+v"(qq));
            if (edge == 1) {
#pragma unroll
                for (int i = 0; i < 16; ++i) { const int kc_ = MODE == 2 ? 4 * (i & 7) + 2 * (i >> 3) : 16 * (i >> 3) + (i & 7); S[i] = kc_ >= qq ? S[i] : -1e37f; }
            } else {
#pragma unroll
                for (int i = 0; i < 16; ++i) { const int kc_ = MODE == 2 ? 4 * (i & 7) + 2 * (i >> 3) : 16 * (i >> 3) + (i & 7); S[i] = kc_ <= qq ? S[i] : -1e37f; }
            }
        }
    }
}
template <int MODE> DI void wave_unit(const Params& p, int l, int u, const LAS float* rpb_lds, LAS unsigned char* ring, int lane) {
    const int q = lane & 31, h = lane >> 5;
    const bf16_t* QK = P_QK(p); const bf16_t* VT = P_VT(p);
    int b, qcol, kcol, vch, dil = 1, rho = 0, Jq = 0, L = SEQ, vs0 = 0, g = 0, hs = 0, hq = 0;
    constexpr int W = MODE == 0 ? 128 : 64, NT = MODE == 0 ? 9 : 5;
    int qcg = 0, kc0 = 0, kr_lo = 0, kr_hi = 0, r00 = 0;
    if (MODE == 0) { const int gg = u % 3, qp = (u / 3) & 63, kvh = (u / 192) & 1; b = u / 384; hq = kvh * 3 + gg; qcol = 64 * hq; kcol = 384 + 64 * kvh; vch = 64 * kvh; Jq = 64 * qp; }
    else if (MODE == 1 || MODE == 2) { const int qt6 = u & 63; hs = (u >> 6) & 1; g = (u >> 7) % 3; b = u / 384; qcol = 512 + 128 * g + 64 * hs; kcol = 896 + 128 * g + 64 * hs;
        vch = g == 0 ? 128 + 64 * hs : g == 1 ? 512 + 64 * hs : 640 + 64 * hs;
        if (g == 0) { Jq = 64 * qt6; } else if (g == 1) { dil = 4; rho = qt6 >> 4; Jq = 64 * (qt6 & 15); L = 1024; } else { dil = 16; rho = qt6 >> 2; Jq = 64 * (qt6 & 3); L = 256; vs0 = rho * 256; } }
    else { const int qt6 = u & 63, hh = (u >> 6) & 3, gr4 = qt6 >> 2, cb = qt6 & 3; b = u >> 8; hq = hh; qcol = 1280 + 64 * hh; kcol = 1536 + 64 * hh; vch = 256 + 64 * hh;
        r00 = 4 * gr4; qcg = 16 * cb + (q & 15); kc0 = cb == 0 ? 0 : cb == 3 ? 32 : 16 * cb - 8;
        const int s0 = r00 - 4 < 0 ? 0 : r00 - 4 > 56 ? 56 : r00 - 4, s3 = r00 - 1 < 0 ? 0 : r00 - 1 > 56 ? 56 : r00 - 1; kr_lo = s0; kr_hi = s3 + 8; }
    int t_lo, t_hi; unsigned kdma[4], vdma[4], kstep_t, vstep_t;
    if (MODE == 3) { t_lo = kr_lo; t_hi = kr_hi; kstep_t = 64u * QKW; vstep_t = 64; }
    else { t_lo = (W - Jq + 31) >> 5; if (t_lo < 0) t_lo = 0; t_hi = (L + W - Jq) >> 5; if (t_hi > NT + 1) t_hi = NT + 1; kstep_t = 32u * dil * QKW; vstep_t = MODE == 2 ? 8 : 32; }
#pragma unroll
    for (int i = 0; i < 4; ++i) {
        const int r = 8 * i + (lane >> 3), c8 = (lane & 7) ^ ((r >> 1) & 7), ko = koffmap(r, MODE == 2);
        const int ktok = MODE == 3 ? b * SEQ + kc0 + ko : b * SEQ + (Jq - W + ko) * dil + rho;
        kdma[i] = (unsigned)ktok * QKW + kcol + 8 * c8;
        const int d = 16 * i + (lane >> 2), ch = (lane & 3) ^ ((d >> 2) & 3);
        const int vslot = MODE == 3 ? b * SEQ + kc0 + 8 * ch : MODE == 2 ? b * SEQ + ch * 1024 + rho * 256 + ((Jq - W) >> 2) : b * SEQ + vs0 + (Jq - W) + 8 * ch;
        vdma[i] = (unsigned)(vch + d) * NTOK + vslot;
    }
#define AT_DMA(t, buf) do { const unsigned kt_ = (unsigned)(t) * kstep_t, vt_ = (unsigned)(t) * vstep_t; LAS unsigned char* bb_ = ring + (buf) * 8192; \
        _Pragma("unroll") for (int i_ = 0; i_ < 4; ++i_) __builtin_amdgcn_global_load_lds((const unsigned*)(QK + (unsigned)(kdma[i_] + kt_)), (LAS unsigned*)(bb_ + i_ * 1024), 16, 0, 0); \
        _Pragma("unroll") for (int i_ = 0; i_ < 4; ++i_) __builtin_amdgcn_global_load_lds((const unsigned*)(VT + (unsigned)(vdma[i_] + vt_)), (LAS unsigned*)(bb_ + 4096 + i_ * 1024), 16, 0, 0); } while (0)
    AT_DMA(t_lo, 0);
    int kaddr[4], vaddr[2][2];
#pragma unroll
    for (int c = 0; c < 4; ++c) kaddr[c] = q * 128 + (((2 * c + h) ^ ((q >> 1) & 7)) << 4);
#pragma unroll
    for (int dh = 0; dh < 2; ++dh)
#pragma unroll
        for (int sx = 0; sx < 2; ++sx) vaddr[dh][sx] = 4096 + (32 * dh + q) * 64 + (((2 * sx + h) ^ ((q >> 2) & 3)) << 4);
    int tokq[2]; bf16x8 qf[2][4]; QState st[2];
#pragma unroll
    for (int n = 0; n < 2; ++n) {
        tokq[n] = MODE == 3 ? b * SEQ + (r00 + 2 * n + (q >> 4)) * 64 + qcg : b * SEQ + (Jq + 32 * n + q) * dil + rho;
        const bf16_t* qp = QK + (size_t)tokq[n] * QKW + qcol + 8 * h;
#pragma unroll
        for (int c = 0; c < 4; ++c) qf[n][c] = *(const bf16x8*)(qp + 16 * c);
        st[n].m = -1e30f; st[n].den = 0.f;
        if (MODE == 0) { st[n].m = p.sink[l * 6 + hq] * LOG2E; st[n].den = 1.0f; }
#pragma unroll
        for (int i = 0; i < 16; ++i) { st[n].O0[i] = 0.f; st[n].O1[i] = 0.f; }
    }
    int sc_q = 0, qrow0 = 0, qrow1 = 0, srq0 = 0, srq1 = 0, lo0 = 0, hi0 = 0, lo1 = 0, hi1 = 0;
    if (MODE == 3) { sc_q = qcg - 8 < 0 ? 0 : qcg - 8 > 48 ? 48 : qcg - 8;
        qrow0 = r00 + (q >> 4); qrow1 = qrow0 + 2; srq0 = qrow0 - 4 < 0 ? 0 : qrow0 - 4 > 56 ? 56 : qrow0 - 4; srq1 = qrow1 - 4 < 0 ? 0 : qrow1 - 4 > 56 ? 56 : qrow1 - 4;
        lo0 = r00 - 4 < 0 ? 0 : r00 - 4 > 56 ? 56 : r00 - 4; hi0 = (r00 - 3 < 0 ? 0 : r00 - 3 > 56 ? 56 : r00 - 3) + 8; lo1 = r00 - 2 < 0 ? 0 : r00 - 2 > 56 ? 56 : r00 - 2; hi1 = (r00 - 1 < 0 ? 0 : r00 - 1 > 56 ? 56 : r00 - 1) + 8; }
    const LAS float* bt_head = rpb_lds + hq * 465;
#define AT_S(S, n) do { _Pragma("unroll") for (int i_ = 0; i_ < 16; ++i_) S[i_] = 0.f; _Pragma("unroll") for (int c_ = 0; c_ < 4; ++c_) S = __builtin_amdgcn_mfma_f32_32x32x16_bf16(kf[c_], qf[n][c_], S, 0, 0, 0); } while (0)
#define AT_PV(n, p0, p1) do { st[n].O0 = __builtin_amdgcn_mfma_f32_32x32x16_bf16(vf[0][0], p0, st[n].O0, 0, 0, 0); st[n].O0 = __builtin_amdgcn_mfma_f32_32x32x16_bf16(vf[0][1], p1, st[n].O0, 0, 0, 0); \
        st[n].O1 = __builtin_amdgcn_mfma_f32_32x32x16_bf16(vf[1][0], p0, st[n].O1, 0, 0, 0); st[n].O1 = __builtin_amdgcn_mfma_f32_32x32x16_bf16(vf[1][1], p1, st[n].O1, 0, 0, 0); } while (0)
    for (int t = t_lo; t < t_hi; ++t) {
        const int buf = (t - t_lo) & 1;
        if (t + 1 < t_hi) { AT_DMA(t + 1, buf ^ 1); asm volatile("s_waitcnt vmcnt(8)" ::: "memory"); }
        else asm volatile("s_waitcnt vmcnt(0)" ::: "memory");
        const LAS unsigned char* bb = ring + buf * 8192;
        const bool act0 = MODE == 3 ? (t >= lo0 && t < hi0) : (t < NT), act1 = MODE == 3 ? (t >= lo1 && t < hi1) : (t >= 1);
        bf16x8 kf[4], vf[2][2];
#pragma unroll
        for (int c = 0; c < 4; ++c) kf[c] = *(const LAS bf16x8*)(bb + kaddr[c]);
        if (act0 && act1) {
            f32x16 S0, S1; AT_S(S0, 0); AT_S(S1, 1);
            mask_tile<MODE>(S0, t, NT, q, h, t, qrow0, srq0, sc_q, kc0, qcg, bt_head); mask_tile<MODE>(S1, t - 1, NT, q, h, t, qrow1, srq1, sc_q, kc0, qcg, bt_head);
            bf16x8 pa0, pa1, pb0, pb1;
            softmax_tile(S0, st[0], pa0, pa1); softmax_tile(S1, st[1], pb0, pb1);
            __builtin_amdgcn_sched_barrier(0);
#pragma unroll
            for (int dh = 0; dh < 2; ++dh)
#pragma unroll
                for (int sx = 0; sx < 2; ++sx) vf[dh][sx] = *(const LAS bf16x8*)(bb + vaddr[dh][sx]);
            AT_PV(0, pa0, pa1); AT_PV(1, pb0, pb1);
        } else if (act0) {
            f32x16 S0; AT_S(S0, 0);
#pragma unroll
            for (int dh = 0; dh < 2; ++dh)
#pragma unroll
                for (int sx = 0; sx < 2; ++sx) vf[dh][sx] = *(const LAS bf16x8*)(bb + vaddr[dh][sx]);
            mask_tile<MODE>(S0, t, NT, q, h, t, qrow0, srq0, sc_q, kc0, qcg, bt_head);
            bf16x8 pa0, pa1; softmax_tile(S0, st[0], pa0, pa1); AT_PV(0, pa0, pa1);
        } else if (act1) {
            f32x16 S1; AT_S(S1, 1);
#pragma unroll
            for (int dh = 0; dh < 2; ++dh)
#pragma unroll
                for (int sx = 0; sx < 2; ++sx) vf[dh][sx] = *(const LAS bf16x8*)(bb + vaddr[dh][sx]);
            mask_tile<MODE>(S1, t - 1, NT, q, h, t, qrow1, srq1, sc_q, kc0, qcg, bt_head);
            bf16x8 pb0, pb1; softmax_tile(S1, st[1], pb0, pb1); AT_PV(1, pb0, pb1);
        }
    }
#undef AT_DMA
#undef AT_S
#undef AT_PV
#pragma unroll
    for (int n = 0; n < 2; ++n) {
        const float rd = 1.0f / st[n].den;
        bf16_t* op;
        if (MODE == 1 || MODE == 2) { op = P_OB3(p) + ((size_t)g * NTOK + tokq[n]) * 128 + 64 * hs; if (h == 0) P_LSE(p)[((size_t)g * NTOK + tokq[n]) * 2 + hs] = (st[n].m + __log2f(st[n].den)) * LN2; }
        else op = P_OC(p) + (size_t)tokq[n] * OCW + (MODE == 0 ? 64 * hq : 512 + 64 * hq);
#pragma unroll
        for (int gq = 0; gq < 4; ++gq) {
            u32x2 w0, w1;
            w0[0] = cvt2(st[n].O0[4 * gq] * rd, st[n].O0[4 * gq + 1] * rd); w0[1] = cvt2(st[n].O0[4 * gq + 2] * rd, st[n].O0[4 * gq + 3] * rd);
            w1[0] = cvt2(st[n].O1[4 * gq] * rd, st[n].O1[4 * gq + 1] * rd); w1[1] = cvt2(st[n].O1[4 * gq + 2] * rd, st[n].O1[4 * gq + 3] * rd);
            *(u32x2*)(op + 8 * gq + 4 * h) = w0; *(u32x2*)(op + 32 + 8 * gq + 4 * h) = w1;
        }
    }
}
}
DI void f_attn_phase(const Params& p, int l, LAS unsigned char* lds, int slot) {
    const int tid = otid(), lane = tid & 63, wid = __builtin_amdgcn_readfirstlane(tid >> 6);
    LAS float* rpb_lds = (LAS float*)(lds + 131072 + 64);
    for (int i = tid; i < 4 * 465; i += 512) rpb_lds[i] = p.rpb[(size_t)l * 4 * 465 + i] * at::LOG2E;
    __syncthreads();
    LAS unsigned char* ring = lds + wid * 16384;
    const int x8 = blockIdx.x & 7;
    unsigned* ctr = (unsigned*)(p.ws + OFF_CTL + 16384) + 64 * (slot * 8 + x8);
    for (;;) {
        unsigned k = 0u;
        if (lane == 0) k = __hip_atomic_fetch_add(ctr, 1u, __ATOMIC_RELAXED, __HIP_MEMORY_SCOPE_AGENT);
        k = (unsigned)__builtin_amdgcn_readfirstlane((int)k);
        if (k >= 512u) break;
        int ln = lane; asm volatile("" : "+v"(ln));
        if (k < 192u) at::wave_unit<0>(p, l, x8 * 192 + (int)k, rpb_lds, ring, ln);
        else if (k < 320u) at::wave_unit<3>(p, l, x8 * 128 + (int)k - 192, rpb_lds, ring, ln);
        else { const int ub = x8 * 192 + (int)k - 320; if (((ub >> 7) % 3) == 1) at::wave_unit<2>(p, l, ub, rpb_lds, ring, ln); else at::wave_unit<1>(p, l, ub, rpb_lds, ring, ln); }
    }
    __syncthreads();
}

DI void bcombine_phase(const Params& p) {
    for (int i = blockIdx.x * 512 + otid(); i < NTOK * 16; i += gridDim.x * 512) {
        const int tok = i >> 4, part = i & 15, hs = part >> 3, d0 = (part & 7) * 8;
        const float l0 = P_LSE(p)[((size_t)0 * NTOK + tok) * 2 + hs], l1 = P_LSE(p)[((size_t)1 * NTOK + tok) * 2 + hs], l2 = P_LSE(p)[((size_t)2 * NTOK + tok) * 2 + hs];
        const float mx = fmaxf(l0, fmaxf(l1, l2)), e0 = __expf(l0 - mx), e1 = __expf(l1 - mx), e2 = __expf(l2 - mx), rs = 1.0f / (e0 + e1 + e2);
        const float a0 = e0 * rs, a1 = e1 * rs, a2 = e2 * rs;
        const u32x4 w0 = *(const u32x4*)(P_OB3(p) + ((size_t)0 * NTOK + tok) * 128 + 64 * hs + d0);
        const u32x4 w1 = *(const u32x4*)(P_OB3(p) + ((size_t)1 * NTOK + tok) * 128 + 64 * hs + d0);
        const u32x4 w2 = *(const u32x4*)(P_OB3(p) + ((size_t)2 * NTOK + tok) * 128 + 64 * hs + d0);
        u32x4 o;
#pragma unroll
        for (int j = 0; j < 4; ++j) o[j] = pk2(a0 * bflo(w0[j]) + a1 * bflo(w1[j]) + a2 * bflo(w2[j]), a0 * bfhi(w0[j]) + a1 * bfhi(w1[j]) + a2 * bfhi(w2[j]));
        *(u32x4*)(P_OC(p) + (size_t)tok * OCW + 384 + 64 * hs + d0) = o;
    }
}

namespace g8 {
constexpr int BM = 256, BK = 64, HALF = 128, HTB = HALF * BK * 2, NXCD = 8, WGM = 8;
DI int lds_byte(int r, int c) { const int st = (r >> 4) * 2 + (c >> 5), rr = r & 15, cc = c & 31, ob = rr * 64 + cc * 2; return st * 1024 + (ob ^ (((ob >> 9) & 1) << 5)); }
DI void stage_rc(int b, int& R, int& C) { const int st = b / 1024, sb = b % 1024, swz = sb ^ (((sb >> 9) & 1) << 5); R = (st >> 1) * 16 + swz / 64; C = (st & 1) * 32 + (swz % 64) / 2; }
DI int perm32(int rho) { const int n = rho >> 4, i = rho & 15; return 8 * (i >> 2) + 4 * n + (i & 3); }
struct Unit { int pm, pn, aux; };
struct StaticOrder {
    int nM, nN, nwg, G, c;
    DI void init(int M, int N, int G_, int c_) { nM = M / BM; nN = N / BM; nwg = nM * nN; G = G_; c = c_; }
    DI bool next(int i, Unit& u) const {
        const long L = (long)i * G + c; if (L >= nwg) return false;
        int wgid = (int)L; { const int q = nwg / NXCD, r = nwg % NXCD, xcd = wgid % NXCD, off = wgid / NXCD; wgid = (xcd < r ? xcd * (q + 1) : r * (q + 1) + (xcd - r) * q) + off; }
        const int nig = WGM * nN, gid = wgid / nig, fm = gid * WGM, gsz = (nM - fm) < WGM ? (nM - fm) : WGM;
        u.pm = fm + ((wgid % nig) % gsz); u.pn = (wgid % nig) / gsz; u.aux = 0; return true;
    }
};
typedef f32x4 Acc[2][2][4][2];
typedef int i32x4 __attribute__((ext_vector_type(4)));
typedef int i32x8 __attribute__((ext_vector_type(8)));
DI bf16x8 half8(const i32x8& v, int k) { const i32x4 x = k == 0 ? __builtin_shufflevector(v, v, 0, 1, 2, 3) : __builtin_shufflevector(v, v, 4, 5, 6, 7); return __builtin_bit_cast(bf16x8, x); }
DI i32x8 cat8(const bf16x8& a, const bf16x8& b) { const i32x4 x = __builtin_bit_cast(i32x4, a), y = __builtin_bit_cast(i32x4, b); return __builtin_shufflevector(x, y, 0, 1, 2, 3, 4, 5, 6, 7); }

template <class Desc, class Epi, class Sched, bool ALIGN_EPI>
DI void gemm_phase(LAS unsigned char* lds, const Desc& D, const Sched& S, const Epi& E) {
    const int tid = otid(), wid = __builtin_amdgcn_readfirstlane(tid >> 6), lane = tid & 63, wr = wid >> 2, wc = wid & 3, fr = lane & 15, fq = lane >> 4;
    int R0, C0, R1, C1; stage_rc(tid * 16, R0, C0); stage_rc(tid * 16 + 8192, R1, C1);
    const int Rb0 = Epi::PERM ? ((R0 & ~31) + perm32(R0 & 31)) : R0, Rb1 = Epi::PERM ? ((R1 & ~31) + perm32(R1 & 31)) : R1;
    constexpr unsigned LDA2 = Desc::lda * 2, LDB2 = Desc::ldb * 2;
    const size_t kstep = (size_t)(BK * 2);
    const unsigned ldsw = (unsigned)wid * 1024u;
    const int aoff = lds_byte(wr * 64 + fr, fq * 8), boff = lds_byte(wc * 32 + fr, fq * 8);
#define G8_SA(b, h) (((b) * 2 + (h)) * HTB)
#define G8_SB(b, h) ((4 + (b) * 2 + (h)) * HTB)
#define G8_STAGE(bufoff, gbase, o0, o1) do { \
        __builtin_amdgcn_global_load_lds((const unsigned*)((const char*)(gbase) + (o0)), (LAS unsigned*)(lds + (bufoff) + ldsw), 16, 0, 0); \
        __builtin_amdgcn_global_load_lds((const unsigned*)((const char*)(gbase) + (o1)), (LAS unsigned*)(lds + (bufoff) + ldsw + 8192), 16, 0, 0); } while (0)
#define G8_LDA(dst, b, h) do { _Pragma("unroll") for (int m = 0; m < 4; ++m) { const bf16x8 lo_ = *(const LAS bf16x8*)(lds + G8_SA(b, h) + aoff + m * 2048), hi_ = *(const LAS bf16x8*)(lds + G8_SA(b, h) + aoff + m * 2048 + 1024); dst[m] = cat8(lo_, hi_); } } while (0)
#define G8_LDB(dst, b, h) do { _Pragma("unroll") for (int n = 0; n < 2; ++n) { const bf16x8 lo_ = *(const LAS bf16x8*)(lds + G8_SB(b, h) + boff + n * 2048), hi_ = *(const LAS bf16x8*)(lds + G8_SB(b, h) + boff + n * 2048 + 1024); dst[n] = cat8(lo_, hi_); } } while (0)
#define G8_MMA(ai, bj, At, Bt) do { __builtin_amdgcn_s_setprio(1); _Pragma("unroll") for (int m = 0; m < 4; ++m) _Pragma("unroll") for (int n = 0; n < 2; ++n) _Pragma("unroll") for (int k = 0; k < 2; ++k) \
        acc[ai][bj][m][n] = __builtin_amdgcn_mfma_f32_16x16x32_bf16(half8(Bt[n], k), half8(At[m], k), acc[ai][bj][m][n], 0, 0, 0); __builtin_amdgcn_s_setprio(0); } while (0)
#define G8_MMA8(ai, bj, At, Bt) do { __builtin_amdgcn_s_setprio(1); _Pragma("unroll") for (int m = 0; m < 4; ++m) _Pragma("unroll") for (int n = 0; n < 2; ++n) \
        asm volatile("v_mfma_scale_f32_16x16x128_f8f6f4 %0, %1, %2, %0, %3, %3 op_sel_hi:[0,0,0]" : "+v"(acc[ai][bj][m][n]) : "v"(Bt[n]), "v"(At[m]), "v"(one_scale));     __builtin_amdgcn_s_setprio(0); } while (0)
#define G8_MM(ai, bj, At, Bt) do { if constexpr (Desc::FP8) G8_MMA8(ai, bj, At, Bt); else G8_MMA(ai, bj, At, Bt); } while (0)
#define G8_WAIT_V(n) asm volatile("s_waitcnt vmcnt(" #n ")" ::: "memory")
#define G8_WAIT_L(n) asm volatile("s_waitcnt lgkmcnt(" #n ")" ::: "memory")
#define G8_BAR __builtin_amdgcn_s_barrier()
#define G8_SCHED __builtin_amdgcn_sched_barrier(0)
#define G8_MKA(u, uidx, o) do { \
        o[0][0] = (unsigned)(Desc::GATHER ? D.a_row(u, uidx, R0) : R0) * LDA2 + (unsigned)C0 * 2u; o[0][1] = (unsigned)(Desc::GATHER ? D.a_row(u, uidx, R1) : R1) * LDA2 + (unsigned)C1 * 2u; \
        if (Desc::GATHER) { o[1][0] = (unsigned)D.a_row(u, uidx, HALF + R0) * LDA2 + (unsigned)C0 * 2u; o[1][1] = (unsigned)D.a_row(u, uidx, HALF + R1) * LDA2 + (unsigned)C1 * 2u; } } while (0)
#define G8_MKB(u, o, hs) do { const unsigned dl_ = (unsigned)D.dilB(u) * LDB2; hs = (unsigned)HALF * dl_; \
        o[0] = (unsigned)Rb0 * dl_ + (unsigned)C0 * 2u; o[1] = (unsigned)Rb1 * dl_ + (unsigned)C1 * 2u; } while (0)
#define G8_A1(o, i) (Desc::GATHER ? o[1][i] : o[0][i] + (unsigned)HALF * LDA2)
    Unit cur, nxt; int ui = 0;
    if (!S.next(0, cur)) return;
    Acc acc;
#pragma unroll
    for (int a = 0; a < 2; ++a)
#pragma unroll
        for (int b = 0; b < 2; ++b)
#pragma unroll
            for (int m = 0; m < 4; ++m)
#pragma unroll
                for (int n = 0; n < 2; ++n) acc[a][b][m][n] = (f32x4){0.f, 0.f, 0.f, 0.f};
    int one_scale = 0x7f7f7f7f; asm volatile("" : "+v"(one_scale));
    i32x8 At[4], B0[2], B1[2];
    unsigned cAo[2][2], cBo[2], nAo[2][2], nBo[2], cBh, nBh;
    G8_MKA(cur, 0, cAo); G8_MKB(cur, cBo, cBh); nBh = cBh;
    const char* cA = D.a_base(cur); const char* cB = D.b_base(cur);
    G8_STAGE(G8_SB(0, 0), cB, cBo[0], cBo[1]); G8_STAGE(G8_SB(0, 1), cB + cBh, cBo[0], cBo[1]); G8_STAGE(G8_SA(0, 0), cA, cAo[0][0], cAo[0][1]); G8_STAGE(G8_SA(0, 1), cA, G8_A1(cAo, 0), G8_A1(cAo, 1));
    if (wr == 1) G8_BAR;
    G8_WAIT_V(2); G8_BAR;
    G8_STAGE(G8_SB(1, 0), cB + kstep, cBo[0], cBo[1]); G8_STAGE(G8_SA(1, 0), cA + kstep, cAo[0][0], cAo[0][1]); G8_STAGE(G8_SB(1, 1), cB + kstep + cBh, cBo[0], cBo[1]);
    G8_WAIT_V(6); G8_BAR;
    for (;;) {
        const bool has_next = S.next(ui + 1, nxt);
        const char* nA = cA; const char* nB = cB;
        if (has_next) { nA = D.a_base(nxt); nB = D.b_base(nxt); }
        if (Desc::GATHER) { if (has_next) G8_MKA(nxt, ui + 1, nAo); else { nAo[0][0] = cAo[0][0]; nAo[0][1] = cAo[0][1]; nAo[1][0] = cAo[1][0]; nAo[1][1] = cAo[1][1]; } }
        if (Desc::VARB) { if (has_next) G8_MKB(nxt, nBo, nBh); else { nBo[0] = cBo[0]; nBo[1] = cBo[1]; nBh = cBh; } }
        const int nt = D.nt(cur);
#pragma unroll 1
        for (int t = 0; t < nt; t += 2) {
            const bool last = (t == nt - 2);
            const char* a1 = cA + (size_t)(t + 1) * kstep;
            const char* a2 = last ? nA : cA + (size_t)(t + 2) * kstep; const char* b2 = last ? nB : cB + (size_t)(t + 2) * kstep;
            const char* a3 = a2 + kstep; const char* b3 = b2 + kstep;
            const unsigned xa00 = (Desc::GATHER && last) ? nAo[0][0] : cAo[0][0], xa01 = (Desc::GATHER && last) ? nAo[0][1] : cAo[0][1];
            const unsigned xa10 = Desc::GATHER ? (last ? nAo[1][0] : cAo[1][0]) : xa00 + (unsigned)HALF * LDA2, xa11 = Desc::GATHER ? (last ? nAo[1][1] : cAo[1][1]) : xa01 + (unsigned)HALF * LDA2;
            const unsigned xb0 = (Desc::VARB && last) ? nBo[0] : cBo[0], xb1 = (Desc::VARB && last) ? nBo[1] : cBo[1], xbh = (Desc::VARB && last) ? nBh : cBh;
            G8_LDB(B0, 0, 0); G8_LDB(B1, 0, 1); G8_SCHED; G8_LDA(At, 0, 0); G8_STAGE(G8_SA(1, 1), a1, G8_A1(cAo, 0), G8_A1(cAo, 1));
            G8_WAIT_V(8); G8_WAIT_L(0); G8_BAR; G8_MM(0, 0, At, B0); G8_MM(0, 1, At, B1); G8_BAR; G8_SCHED;
            G8_LDA(At, 0, 1); G8_STAGE(G8_SB(0, 0), b2, xb0, xb1); G8_STAGE(G8_SB(0, 1), b2 + xbh, xb0, xb1); G8_STAGE(G8_SA(0, 0), a2, xa00, xa01);
            G8_WAIT_V(8); G8_WAIT_L(0); G8_BAR; G8_MM(1, 0, At, B0); G8_MM(1, 1, At, B1); G8_BAR; G8_SCHED;
            G8_LDB(B0, 1, 0); G8_LDB(B1, 1, 1); G8_SCHED; G8_LDA(At, 1, 0); G8_STAGE(G8_SA(0, 1), a2, xa10, xa11);
            G8_WAIT_V(8); G8_WAIT_L(0); G8_BAR; G8_MM(0, 0, At, B0); G8_MM(0, 1, At, B1); G8_BAR; G8_SCHED;
            G8_LDA(At, 1, 1); G8_STAGE(G8_SB(1, 0), b3, xb0, xb1); G8_STAGE(G8_SB(1, 1), b3 + xbh, xb0, xb1); G8_STAGE(G8_SA(1, 0), a3, xa00, xa01);
            G8_WAIT_V(8); G8_WAIT_L(0); G8_BAR; G8_MM(1, 0, At, B0); G8_MM(1, 1, At, B1); G8_BAR; G8_SCHED;
        }
        if constexpr (ALIGN_EPI) { if (wr == 0) G8_BAR; }
        if constexpr (Desc::FP8) asm volatile("s_nop 15\n\ts_nop 15" ::: "memory");
        E(acc, cur, wr, wc, fr, fq);
        if (!has_next) break;
#pragma unroll
        for (int a = 0; a < 2; ++a)
#pragma unroll
            for (int b = 0; b < 2; ++b)
#pragma unroll
                for (int m = 0; m < 4; ++m)
#pragma unroll
                    for (int n = 0; n < 2; ++n) acc[a][b][m][n] = (f32x4){0.f, 0.f, 0.f, 0.f};
        if constexpr (Desc::FP8) asm volatile("s_nop 7" ::: "memory");
        cur = nxt; cA = nA; cB = nB; ++ui;
        if (Desc::GATHER) { cAo[0][0] = nAo[0][0]; cAo[0][1] = nAo[0][1]; cAo[1][0] = nAo[1][0]; cAo[1][1] = nAo[1][1]; }
        if (Desc::VARB) { cBo[0] = nBo[0]; cBo[1] = nBo[1]; cBh = nBh; }
        if constexpr (ALIGN_EPI) { if (wr == 1) G8_BAR; }
    }
    G8_WAIT_V(0);
    if constexpr (!ALIGN_EPI) { if (wr == 0) G8_BAR; }
    G8_BAR;
#undef G8_SA
#undef G8_SB
#undef G8_STAGE
#undef G8_LDA
#undef G8_LDB
#undef G8_MMA
#undef G8_MMA8
#undef G8_MM
#undef G8_WAIT_V
#undef G8_WAIT_L
#undef G8_BAR
#undef G8_SCHED
#undef G8_MKA
#undef G8_MKB
#undef G8_A1
}
DI unsigned cvt2(float lo, float hi) { typedef __bf16 bf2_t __attribute__((ext_vector_type(2))); const f32x2 v = {lo, hi}; const bf2_t b = __builtin_convertvector(v, bf2_t); return __builtin_bit_cast(unsigned, b); }
DI u32x4 pack8(const f32x4& a, const f32x4& b) { u32x4 w; w[0] = cvt2(a[0], a[1]); w[1] = cvt2(a[2], a[3]); w[2] = cvt2(b[0], b[1]); w[3] = cvt2(b[2], b[3]); return w; }
DI float fsig(float x) { return __builtin_amdgcn_rcpf(1.0f + __expf(-x)); }

struct DescMoe1 { static constexpr bool GATHER = true, VARB = false, FP8 = true; static constexpr int lda = DM / 2, ldb = DM / 2; const bf16_t* XN8; const bf16_t* WGU; const LAS int* rowlist;
    DI const char* a_base(const Unit&) const { return (const char*)XN8; }
    DI const char* b_base(const Unit& u) const { return (const char*)WGU + ((size_t)(u.pm >> 3) * 4096 + (size_t)u.pn * 256) * DM; }
    DI int a_row(const Unit&, int uidx, int r) const { return rowlist[uidx * 256 + r]; }
    DI int nt(const Unit&) const { return DM / 128; } DI int dilB(const Unit&) const { return 1; } };
struct EpiSwiglu { static constexpr bool PERM = true; unsigned char* HID8;
    DI void operator()(const Acc& acc, const Unit& u, int wr, int wc, int fr, int fq) const {
        const int row0 = u.pm * BM + wr * 64 + fr, col0 = u.pn * 128 + wc * 32 + 8 * fq; constexpr float WI = 1.0f / W8_SCALE;
#pragma unroll
        for (int ai = 0; ai < 2; ++ai)
#pragma unroll
            for (int m = 0; m < 4; ++m) { f32x4 h0, h1;
#pragma unroll
                for (int j = 0; j < 4; ++j) { const float g0 = acc[ai][0][m][0][j] * WI, g1 = acc[ai][0][m][1][j] * WI;
                    h0[j] = g0 * fsig(g0) * acc[ai][1][m][0][j] * (WI * H8_SCALE); h1[j] = g1 * fsig(g1) * acc[ai][1][m][1][j] * (WI * H8_SCALE); }
                u32x2 w; w[0] = pk4_fp8(h0[0], h0[1], h0[2], h0[3]); w[1] = pk4_fp8(h1[0], h1[1], h1[2], h1[3]);
                *(u32x2*)(HID8 + (size_t)(row0 + ai * HALF + m * 16) * FF + col0) = w; }
    } };
struct DescMoe2 { static constexpr bool GATHER = false, VARB = false, FP8 = true; static constexpr int lda = FF / 2, ldb = FF / 2; const unsigned char* HID8; const bf16_t* WD;
    DI const char* a_base(const Unit& u) const { return (const char*)HID8 + (size_t)u.pm * 256 * FF; }
    DI const char* b_base(const Unit& u) const { return (const char*)WD + ((size_t)(u.pm >> 3) * 1024 + (size_t)u.pn * 256) * FF; }
    DI int a_row(const Unit&, int, int r) const { return r; }
    DI int nt(const Unit&) const { return FF / 128; } DI int dilB(const Unit&) const { return 1; } };
struct EpiY { static constexpr bool PERM = true; bf16_t* Y; const float* VAL;
    DI void operator()(const Acc& acc, const Unit& u, int wr, int wc, int fr, int fq) const {
        const int row0 = u.pm * BM + wr * 64 + fr, col0 = u.pn * BM + wc * 32 + 8 * fq;
        float vv[2][4];
#pragma unroll
        for (int ai = 0; ai < 2; ++ai)
#pragma unroll
            for (int m = 0; m < 4; ++m) vv[ai][m] = VAL[row0 + ai * HALF + m * 16];
#pragma unroll
        for (int ai = 0; ai < 2; ++ai)
#pragma unroll
            for (int m = 0; m < 4; ++m) { const int row = row0 + ai * HALF + m * 16; const float v = vv[ai][m] * (1.0f / (W8_SCALE * H8_SCALE));
#pragma unroll
                for (int bj = 0; bj < 2; ++bj) *(u32x4*)(Y + (size_t)row * DM + col0 + bj * HALF) = pack8(acc[ai][bj][m][0] * v, acc[ai][bj][m][1] * v); }
    } };
struct DescOut { static constexpr bool GATHER = false, VARB = false, FP8 = false; static constexpr int lda = DM, ldb = DM; const bf16_t* MG; const bf16_t* WO;
    DI const char* a_base(const Unit& u) const { return (const char*)(MG + (size_t)u.pm * 256 * DM); }
    DI const char* b_base(const Unit& u) const { return (const char*)(WO + (size_t)u.pn * 256 * DM); }
    DI int a_row(const Unit&, int, int r) const { return r; }
    DI int nt(const Unit&) const { return DM / BK; } DI int dilB(const Unit&) const { return 1; } };
struct EpiResid { static constexpr bool PERM = true; bf16_t* X;
    DI void operator()(const Acc& acc, const Unit& u, int wr, int wc, int fr, int fq) const {
        const int row0 = u.pm * BM + wr * 64 + fr, col0 = u.pn * BM + wc * 32 + 8 * fq;
#pragma unroll
        for (int ai = 0; ai < 2; ++ai) {
            u32x4 x[4][2];
#pragma unroll
            for (int m = 0; m < 4; ++m)
#pragma unroll
                for (int bj = 0; bj < 2; ++bj) x[m][bj] = *(const u32x4*)(X + (size_t)(row0 + ai * HALF + m * 16) * DM + col0 + bj * HALF);
#pragma unroll
            for (int m = 0; m < 4; ++m)
#pragma unroll
                for (int bj = 0; bj < 2; ++bj) { f32x4 v0 = acc[ai][bj][m][0], v1 = acc[ai][bj][m][1]; const u32x4 ww = x[m][bj];
                    v0[0] += bflo(ww[0]); v0[1] += bfhi(ww[0]); v0[2] += bflo(ww[1]); v0[3] += bfhi(ww[1]); v1[0] += bflo(ww[2]); v1[1] += bfhi(ww[2]); v1[2] += bflo(ww[3]); v1[3] += bfhi(ww[3]);
                    *(u32x4*)(X + (size_t)(row0 + ai * HALF + m * 16) * DM + col0 + bj * HALF) = pack8(v0, v1); }
            __builtin_amdgcn_sched_barrier(0);
        }
    } };
struct DescInproj { static constexpr bool GATHER = false, VARB = false, FP8 = false; static constexpr int lda = DM, ldb = DM; const bf16_t* XN; const bf16_t* WIN;
    DI const char* a_base(const Unit& u) const { return (const char*)(XN + (size_t)u.pm * 256 * DM); }
    DI const char* b_base(const Unit& u) const { return (const char*)(WIN + (size_t)u.pn * 256 * DM); }
    DI int a_row(const Unit&, int, int r) const { return r; }
    DI int nt(const Unit&) const { return DM / BK; } DI int dilB(const Unit&) const { return 1; } };
struct EpiInproj { static constexpr bool PERM = true; bf16_t* QK; unsigned char* G; const float* cosT; const float* sinT; const float* bgate;
    DI void operator()(const Acc& acc, const Unit& u, int wr, int wc, int fr, int fq) const {
        const int row0 = u.pm * BM + wr * 64 + fr;
        if (u.pn < 5) {
            const int hr = 4 * u.pn + wc; const float sc = (hr < 6 || (hr >= 8 && hr < 14)) ? 0.125f * 1.4426950408889634f : 1.0f;
#pragma unroll
            for (int ai = 0; ai < 2; ++ai) {
                f32x4 tc[4][2], ts[4][2];
#pragma unroll
                for (int m = 0; m < 4; ++m) { const int pos = (row0 + ai * HALF + m * 16) & (SEQ - 1);
                    tc[m][0] = *(const f32x4*)(cosT + pos * 32 + 8 * fq); tc[m][1] = *(const f32x4*)(cosT + pos * 32 + 8 * fq + 4); ts[m][0] = *(const f32x4*)(sinT + pos * 32 + 8 * fq); ts[m][1] = *(const f32x4*)(sinT + pos * 32 + 8 * fq + 4); }
#pragma unroll
                for (int m = 0; m < 4; ++m) { const int row = row0 + ai * HALF + m * 16;
                    const f32x4 c0 = tc[m][0], c1 = tc[m][1], s0 = ts[m][0], s1 = ts[m][1];
                    const f32x4 a0 = acc[ai][0][m][0], a1 = acc[ai][0][m][1], b0 = acc[ai][1][m][0], b1 = acc[ai][1][m][1];
                    bf16_t* o = QK + (size_t)row * QKW + 64 * hr + 8 * fq;
                    *(u32x4*)o = pack8((a0 * c0 - b0 * s0) * sc, (a1 * c1 - b1 * s1) * sc);
                    *(u32x4*)(o + 32) = pack8((b0 * c0 + a0 * s0) * sc, (b1 * c1 + a1 * s1) * sc); }
                __builtin_amdgcn_sched_barrier(0);
            }
        } else if (u.pn < 7) {
            const float sc = u.pn == 5 ? 0.125f * 1.4426950408889634f : 1.0f; const int col0 = 1280 + (u.pn - 5) * 256 + wc * 32 + 8 * fq;
#pragma unroll
            for (int ai = 0; ai < 2; ++ai)
#pragma unroll
                for (int m = 0; m < 4; ++m)
#pragma unroll
                    for (int bj = 0; bj < 2; ++bj) *(u32x4*)(QK + (size_t)(row0 + ai * HALF + m * 16) * QKW + col0 + bj * HALF) = pack8(acc[ai][bj][m][0] * sc, acc[ai][bj][m][1] * sc);
        } else {
            const int col0 = (u.pn - 7) * 256 + wc * 32 + 8 * fq;
            f32x4 bv[2][2];
#pragma unroll
            for (int bj = 0; bj < 2; ++bj)
#pragma unroll
                for (int n = 0; n < 2; ++n) bv[bj][n] = *(const f32x4*)(bgate + col0 + bj * HALF + 4 * n);
#pragma unroll
            for (int ai = 0; ai < 2; ++ai)
#pragma unroll
                for (int m = 0; m < 4; ++m)
#pragma unroll
                    for (int bj = 0; bj < 2; ++bj) { f32x4 v0 = acc[ai][bj][m][0] + bv[bj][0], v1 = acc[ai][bj][m][1] + bv[bj][1];
#pragma unroll
                        for (int j = 0; j < 4; ++j) { v0[j] = fsig(v0[j]) * 255.0f + 0.5f; v1[j] = fsig(v1[j]) * 255.0f + 0.5f; }
                        u32x2 w; w[0] = (unsigned)v0[0] | ((unsigned)v0[1] << 8) | ((unsigned)v0[2] << 16) | ((unsigned)v0[3] << 24); w[1] = (unsigned)v1[0] | ((unsigned)v1[1] << 8) | ((unsigned)v1[2] << 16) | ((unsigned)v1[3] << 24);
                        *(u32x2*)(G + (size_t)(row0 + ai * HALF + m * 16) * 3072 + col0 + bj * HALF) = w; }
        }
    } };
struct DescVT { static constexpr bool GATHER = false, VARB = true, FP8 = false; static constexpr int lda = DM, ldb = DM; const bf16_t* WV; const bf16_t* XN;
    DI const char* a_base(const Unit& u) const { return (const char*)(WV + (size_t)u.pm * 256 * DM); }
    DI const char* b_base(const Unit& u) const { return (const char*)(XN + (u.pm < 2 ? (size_t)u.pn * 256 : (size_t)((u.pn >> 4) * SEQ + (u.pn & 15))) * DM); }
    DI int a_row(const Unit&, int, int r) const { return r; }
    DI int nt(const Unit&) const { return DM / BK; } DI int dilB(const Unit& u) const { return u.pm < 2 ? 1 : 16; } };
struct EpiVT { static constexpr bool PERM = true; bf16_t* VT;
    DI void operator()(const Acc& acc, const Unit& u, int wr, int wc, int fr, int fq) const {
        const int row0 = u.pm * BM + wr * 64 + fr, col0 = u.pn * BM + wc * 32 + 8 * fq;
#pragma unroll
        for (int ai = 0; ai < 2; ++ai)
#pragma unroll
            for (int m = 0; m < 4; ++m)
#pragma unroll
                for (int bj = 0; bj < 2; ++bj) *(u32x4*)(VT + (size_t)(row0 + ai * HALF + m * 16) * NTOK + col0 + bj * HALF) = pack8(acc[ai][bj][m][0], acc[ai][bj][m][1]);
    } };
struct DescMerge { static constexpr bool GATHER = false, VARB = false, FP8 = false; static constexpr int lda = OCW, ldb = 768; const bf16_t* OC; const bf16_t* WM;
    DI int k0(const Unit& u) const { return u.aux == 0 ? 0 : u.aux == 1 ? 384 : 512; }
    DI const char* a_base(const Unit& u) const { return (const char*)(OC + (size_t)u.pm * 256 * OCW + k0(u)); }
    DI const char* b_base(const Unit& u) const { return (const char*)(WM + (size_t)u.pn * 256 * 768 + k0(u)); }
    DI int a_row(const Unit&, int, int r) const { return r; }
    DI int nt(const Unit& u) const { return u.aux == 0 ? 6 : u.aux == 1 ? 2 : 4; } DI int dilB(const Unit&) const { return 1; } };
struct MergeOrder { StaticOrder base;
    DI bool next(int i, Unit& u) const { const int q = i / 3; if (!base.next(q, u)) return false; u.aux = i - 3 * q; return true; } };
struct EpiMerge { static constexpr bool PERM = true; bf16_t* MG; const unsigned char* G;
    DI void operator()(const Acc& acc, const Unit& u, int wr, int wc, int fr, int fq) const {
        const int row0 = u.pm * BM + wr * 64 + fr, col0 = u.pn * BM + wc * 32 + 8 * fq;
#pragma unroll
        for (int ai = 0; ai < 2; ++ai) {
            u32x2 g[4][2]; u32x4 w[4][2];
#pragma unroll
            for (int m = 0; m < 4; ++m)
#pragma unroll
                for (int bj = 0; bj < 2; ++bj) { const int row = row0 + ai * HALF + m * 16, col = col0 + bj * HALF;
                    g[m][bj] = *(const u32x2*)(G + (size_t)row * 3072 + 1024 * u.aux + col);
                    if (u.aux != 0) w[m][bj] = *(const u32x4*)(MG + (size_t)row * DM + col); else w[m][bj] = (u32x4){0u, 0u, 0u, 0u}; }
#pragma unroll
            for (int m = 0; m < 4; ++m)
#pragma unroll
                for (int bj = 0; bj < 2; ++bj) { const int row = row0 + ai * HALF + m * 16, col = col0 + bj * HALF;
                    const u32x2 gg = g[m][bj]; const u32x4 ww = w[m][bj]; constexpr float GI = 1.0f / 255.0f;
                    f32x4 v0 = acc[ai][bj][m][0] * GI, v1 = acc[ai][bj][m][1] * GI;
                    v0[0] = v0[0] * (float)(gg[0] & 255u) + bflo(ww[0]); v0[1] = v0[1] * (float)((gg[0] >> 8) & 255u) + bfhi(ww[0]); v0[2] = v0[2] * (float)((gg[0] >> 16) & 255u) + bflo(ww[1]); v0[3] = v0[3] * (float)(gg[0] >> 24) + bfhi(ww[1]);
                    v1[0] = v1[0] * (float)(gg[1] & 255u) + bflo(ww[2]); v1[1] = v1[1] * (float)((gg[1] >> 8) & 255u) + bfhi(ww[2]); v1[2] = v1[2] * (float)((gg[1] >> 16) & 255u) + bflo(ww[3]); v1[3] = v1[3] * (float)(gg[1] >> 24) + bfhi(ww[3]);
                    *(u32x4*)(MG + (size_t)row * DM + col) = pack8(v0, v1); }
            __builtin_amdgcn_sched_barrier(0);
        }
    } };
}
DI void f_inproj_phase(const Params& p, int l, LAS unsigned char* lds) {
    { g8::StaticOrder S; S.init(NTOK, 4352, gridDim.x, blockIdx.x);
      g8::DescInproj D{P_XN(p), P_W(p, l, LW_WIN)}; g8::EpiInproj E{P_QK(p), P_G(p), P_COS(p), P_SIN(p), p.b_gate + (size_t)l * 3072};
      g8::gemm_phase<g8::DescInproj, g8::EpiInproj, g8::StaticOrder, true>(lds, D, S, E); }
    { g8::StaticOrder S; S.init(VCH, NTOK, gridDim.x, (blockIdx.x + gridDim.x - 64) % gridDim.x);
      g8::DescVT D{P_W(p, l, LW_WV), P_XN(p)}; g8::EpiVT E{P_VT(p)};
      g8::gemm_phase<g8::DescVT, g8::EpiVT, g8::StaticOrder, true>(lds, D, S, E); }
}
struct OneUnit { int pm, pn; DI bool next(int i, g8::Unit& u) const { if (i != 0) return false; u.pm = pm; u.pn = pn; u.aux = 0; return true; } };
DI void f_gate_tail_units(const Params& p, int l, LAS unsigned char* lds) {
    if (blockIdx.x < 128) {
        OneUnit S{(int)(blockIdx.x >> 1), 17 + (int)(blockIdx.x & 1)};
        g8::DescInproj D{P_XN(p), P_W(p, l, LW_WIN)}; g8::EpiInproj E{P_QK(p), P_G(p), P_COS(p), P_SIN(p), p.b_gate + (size_t)l * 3072};
        g8::gemm_phase<g8::DescInproj, g8::EpiInproj, OneUnit, false>(lds, D, S, E);
        __syncthreads();
    }
}
DI void f_merge_phase(const Params& p, int l, LAS unsigned char* lds) {
    g8::MergeOrder S; S.base.init(NTOK, DM, gridDim.x, blockIdx.x);
    g8::DescMerge D{P_OC(p), P_W(p, l, LW_WM)}; g8::EpiMerge E{P_MG(p), P_G(p)};
    g8::gemm_phase<g8::DescMerge, g8::EpiMerge, g8::MergeOrder, true>(lds, D, S, E);
}

DI void f_moe1_phase(const Params& p, int l, LAS unsigned char* lds) {
    g8::StaticOrder S; S.init(NROWS_E, 2 * FF, gridDim.x, blockIdx.x);
    LAS int* rowlist = (LAS int*)(lds + 131072 + 64);
    g8::Unit u;
    for (int i = 0; i < 8 && S.next(i, u); ++i)
        for (int r = otid(); r < 256; r += 512) rowlist[i * 256 + r] = ((u.pm >> 1) & 3) * SEQ + P_IDX(p)[u.pm * 256 + r];
    __syncthreads();
    g8::DescMoe1 D{(const bf16_t*)P_XN8(p), P_W(p, l, LW_WGU), rowlist}; g8::EpiSwiglu E{(unsigned char*)P_HID(p)};
    g8::gemm_phase<g8::DescMoe1, g8::EpiSwiglu, g8::StaticOrder, true>(lds, D, S, E);
}
DI void f_moe2_phase(const Params& p, int l, LAS unsigned char* lds) {
    g8::StaticOrder S; S.init(NROWS_E, DM, gridDim.x, blockIdx.x);
    g8::DescMoe2 D{(const unsigned char*)P_HID(p), P_W(p, l, LW_WD)}; g8::EpiY E{P_Y(p), P_VAL(p)};
    g8::gemm_phase<g8::DescMoe2, g8::EpiY, g8::StaticOrder, true>(lds, D, S, E);
}
DI void f_out_phase(const Params& p, int l, LAS unsigned char* lds) {
    g8::StaticOrder S; S.init(NTOK, DM, gridDim.x, blockIdx.x);
    g8::DescOut D{P_MG(p), P_W(p, l, LW_WO)}; g8::EpiResid E{P_X(p)};
    g8::gemm_phase<g8::DescOut, g8::EpiResid, g8::StaticOrder, false>(lds, D, S, E);
}

#define XB_TMO      128
#define XB_XCNT(j)  (256  + 64 * (j))
#define XB_XSUB(j)  (1280 + 64 * (j))
#define XB_XGEN(j)  (2304 + 64 * (j))
#define XB_TOP      3328
#define XB_TOPGEN   3392
#define XCD_BAR_WORDS 3456
#define XB_SPIN_CAP (1u << 22)

__device__ __forceinline__ unsigned xb_ld(unsigned* p)              { return __hip_atomic_load(p, __ATOMIC_RELAXED, __HIP_MEMORY_SCOPE_AGENT); }
__device__ __forceinline__ unsigned xb_add(unsigned* p, unsigned v) { return __hip_atomic_fetch_add(p, v, __ATOMIC_RELAXED, __HIP_MEMORY_SCOPE_AGENT); }
__device__ __forceinline__ unsigned xb_xcc_id() { return (unsigned)__builtin_amdgcn_s_getreg((3 << 11) | 20) & 0xFu; }
#define XB_SPIN(cond, bar) do { unsigned _sp = 0; while (cond) { __builtin_amdgcn_s_sleep(1); \
    if ((++_sp & 255u) == 0u) { if (xb_ld(&(bar)[XB_TMO])) break; if (_sp > XB_SPIN_CAP) { atomicAdd(&(bar)[XB_TMO], 1u); break; } } } } while (0)

struct XcdBarrier {
    unsigned* bar; unsigned x;
    volatile LAS unsigned* st;
};

__device__ __forceinline__ XcdBarrier xcd_barrier_post(unsigned* bar, volatile LAS unsigned* st) {
    XcdBarrier b; b.bar = bar; b.x = xb_xcc_id(); b.st = st;
    if (threadIdx.x == 0) (void)xb_add(&bar[XB_XCNT(b.x)], 1u);
    return b;
}
__device__ __forceinline__ void xcd_barrier_complete(unsigned* bar, unsigned x, unsigned& nloc, unsigned& nx) {
    const unsigned G = gridDim.x * gridDim.y * gridDim.z;
    unsigned sum, cnt, mine, sp = 0u;
    for (;;) {
        sum = 0u; cnt = 0u; mine = 0u;
#pragma unroll
        for (unsigned j = 0; j < 16; ++j) { const unsigned c = xb_ld(&bar[XB_XCNT(j)]); sum += c; cnt += (c > 0u) ? 1u : 0u; mine = (j == x) ? c : mine; }
        if (sum == G) break;
        __builtin_amdgcn_s_sleep(1);
        if ((++sp & 255u) == 0u) { if (xb_ld(&bar[XB_TMO])) break; if (sp > XB_SPIN_CAP) { atomicAdd(&bar[XB_TMO], 1u); break; } }
    }
    nloc = mine > 0u ? mine : 1u; nx = cnt > 0u ? cnt : 1u;
}

__device__ __forceinline__ void xcd_barrier(const XcdBarrier& b) {
    asm volatile("s_waitcnt vmcnt(0)" ::: "memory");
    __syncthreads();
    if (threadIdx.x == 0) {
        unsigned* bar = b.bar;
        __builtin_amdgcn_s_waitcnt(0);
        unsigned nloc = b.st[0], nx = b.st[1];
        if (nloc == 0u) { xcd_barrier_complete(bar, b.x, nloc, nx); b.st[0] = nloc; b.st[1] = nx; }
        const unsigned old = xb_add(&bar[XB_XSUB(b.x)], 1u);
        const unsigned gen = old / nloc;
        if (old + 1u == (gen + 1u) * nloc) {
            __builtin_amdgcn_fence(__ATOMIC_RELEASE, "agent");
            asm volatile("s_waitcnt vmcnt(0)" ::: "memory");
            const unsigned og = xb_add(&bar[XB_TOP], 1u);
            const unsigned tg = og / nx;
            if (og + 1u == (tg + 1u) * nx) xb_add(&bar[XB_TOPGEN], 1u);
            else XB_SPIN(xb_ld(&bar[XB_TOPGEN]) == tg, bar);
            __builtin_amdgcn_fence(__ATOMIC_ACQUIRE, "agent");
            xb_add(&bar[XB_XGEN(b.x)], 1u);
            asm volatile("s_waitcnt vmcnt(0)" ::: "memory");
        } else {
            XB_SPIN(xb_ld(&bar[XB_XGEN(b.x)]) == gen, bar);
            __builtin_amdgcn_fence(__ATOMIC_ACQUIRE, "agent");
            asm volatile("s_waitcnt vmcnt(0)" ::: "memory");
        }
    }
    __syncthreads();
}

constexpr int LDS_BYTES = 131072 + 64 + 8192;
#ifndef REP_PREP
#define REP_PREP 1
#define REP_INPROJ 1
#define REP_ATTN 1
#define REP_MERGE 1
#define REP_BCOMB 1
#define REP_N2 1
#define REP_TOPK 1
#define REP_MOE1 1
#define REP_MOE2 1
#endif
#define PH(...) do { Params q = p; { size_t z_ = 0; asm volatile("" : "+s"(z_)); q.ws = p.ws + z_; } __VA_ARGS__; } while (0)
#define GRID_BAR() do { XcdBarrier b_; { size_t z_ = 0; asm volatile("" : "+s"(z_)); b_.bar = (unsigned*)(p.ws + z_ + OFF_CTL); } b_.x = xb_xcc_id(); b_.st = (volatile LAS unsigned*)(lds + 131072); xcd_barrier(b_); } while (0)
__global__ void __launch_bounds__(512, 2) mega_fwd(Params p) {
    extern __shared__ __attribute__((aligned(16))) unsigned char lds_raw[];
    LAS unsigned char* lds = (LAS unsigned char*)lds_raw;
    { volatile LAS unsigned* xbw = (volatile LAS unsigned*)(lds + 131072);
      if (threadIdx.x == 0) { xbw[0] = 0u; xbw[1] = 0u; xbw[2] = 0u; xbw[3] = 0u; }
      __syncthreads();
      (void)xcd_barrier_post((unsigned*)(p.ws + OFF_CTL), xbw); }
    PH(prep_phase(q, (LAS float*)lds); norm1_phase<0>(q, 0));
    GRID_BAR();
#define LAYER(l) do { \
        if ((l) != 0) { PH(norm1_phase<1>(q, (l))); GRID_BAR(); } \
        PH(f_inproj_phase(q, (l), lds)); GRID_BAR(); \
        PH(f_gate_tail_units(q, (l), lds); prep_expert_phase(q, (l), (LAS float*)lds); f_attn_phase(q, (l), lds, (l))); GRID_BAR(); \
        PH(bcombine_phase(q)); GRID_BAR(); \
        PH(f_merge_phase(q, (l), lds)); GRID_BAR(); \
        PH(f_out_phase(q, (l), lds)); GRID_BAR(); \
        PH(norm2_router_phase(q, (l), (LAS float*)lds)); GRID_BAR(); \
        PH(topk_phase(q, (LAS unsigned*)lds); prep_expert_topk(q, (l), (LAS float*)lds)); GRID_BAR(); \
        PH(f_moe1_phase(q, (l), lds)); GRID_BAR(); \
        PH(f_moe2_phase(q, (l), lds)); GRID_BAR(); } while (0)
    LAYER(0); LAYER(1); LAYER(2); LAYER(3);
#undef LAYER
    PH(norm1_phase<2>(q, 0));
}

extern "C" void kernel_launch(void* const* d_in, const int* in_sizes, int n_in, void* d_out, int out_size, void* d_ws, size_t ws_size, hipStream_t stream) {
    (void)in_sizes; (void)out_size;
    static int grid = 0;
    if (grid == 0) {
        if (n_in != 16 || ws_size < OFF_END) { grid = -1; return; }
        int dev = 0, cus = 0, per_cu = 0;
        if (hipGetDevice(&dev) != hipSuccess || hipDeviceGetAttribute(&cus, hipDeviceAttributeMultiprocessorCount, dev) != hipSuccess) { grid = -1; return; }
        if (hipFuncSetAttribute((const void*)mega_fwd, hipFuncAttributeMaxDynamicSharedMemorySize, LDS_BYTES) != hipSuccess) { grid = -1; return; }
        if (hipOccupancyMaxActiveBlocksPerMultiprocessor(&per_cu, (const void*)mega_fwd, 512, LDS_BYTES) != hipSuccess || per_cu < 1) { (void)hipGetLastError(); }
        grid = cus;
    }
    if (grid < 0) return;
    if (hipMemsetAsync((char*)d_ws + OFF_CTL, 0, 65536, stream) != hipSuccess) return;
    Params p{};
    p.x = (const float*)d_in[0]; p.w_in = (const float*)d_in[1]; p.b_gate = (const float*)d_in[2]; p.sink = (const float*)d_in[3]; p.rpb = (const float*)d_in[4];
    p.w_a = (const float*)d_in[5]; p.w_b = (const float*)d_in[6]; p.w_c = (const float*)d_in[7]; p.w_out = (const float*)d_in[8]; p.norm_mix = (const float*)d_in[9];
    p.norm_ffn = (const float*)d_in[10]; p.w_router = (const float*)d_in[11]; p.w_gate_e = (const float*)d_in[12]; p.w_up_e = (const float*)d_in[13]; p.w_down_e = (const float*)d_in[14];
    p.norm_final = (const float*)d_in[15]; p.out = (float*)d_out; p.ws = (unsigned char*)d_ws;
    hipLaunchKernelGGL(mega_fwd, dim3(grid), dim3(512), LDS_BYTES, stream, p);
}
```

```cpp
#include <hip/hip_runtime.h>
#include <stdint.h>

#define DI __device__ __forceinline__
#define LAS __attribute__((address_space(3)))
typedef unsigned short bf16_t;
typedef short bf16x8 __attribute__((ext_vector_type(8)));
typedef float f32x2 __attribute__((ext_vector_type(2)));
typedef float f32x4 __attribute__((ext_vector_type(4)));
typedef float f32x16 __attribute__((ext_vector_type(16)));
typedef unsigned u32x2 __attribute__((ext_vector_type(2)));
typedef unsigned u32x4 __attribute__((ext_vector_type(4)));

constexpr int NTOK = 16384, DM = 1024, SEQ = 4096, NBATCH = 4, NLAYER = 4, NEXP = 16, FF = 2048, CAP = 512, PROJ = 5632;
constexpr int QKW = 1792;
constexpr int VCH = 768;
constexpr int OCW = 768;
constexpr int NROWS_E = NBATCH * CAP * NEXP;

constexpr size_t OFF_CTL = 0;
constexpr size_t OFF_COS = 65536;
constexpr size_t OFF_SIN = OFF_COS + (size_t)SEQ * 32 * 4;
constexpr size_t OFF_W   = 2u << 20;
constexpr size_t WIN_B = (size_t)4864 * 1024 * 2, WV_B = (size_t)768 * 1024 * 2, WM_B = (size_t)1024 * 768 * 2, WO_B = (size_t)1024 * 1024 * 2;
constexpr size_t WGU_B = (size_t)NEXP * 4096 * 1024 * 2, WD_B = (size_t)NEXP * 1024 * 2048 * 2;
constexpr size_t LW_WIN = 0, LW_WV = LW_WIN + WIN_B, LW_WM = LW_WV + WV_B, LW_WO = LW_WM + WM_B, LW_WGU = LW_WO + WO_B, LW_WD = LW_WGU + WGU_B, LW = LW_WD + WD_B;
constexpr size_t OFF_X   = OFF_W + NLAYER * LW;
constexpr size_t OFF_XN  = OFF_X + (size_t)NTOK * DM * 4;
constexpr size_t OFF_QK  = OFF_XN + (size_t)NTOK * DM * 2;
constexpr size_t OFF_VT  = OFF_QK + (size_t)NTOK * QKW * 2;
constexpr size_t OFF_G   = OFF_VT + (size_t)VCH * NTOK * 2;
constexpr size_t OFF_OC  = OFF_G + (size_t)NTOK * 3072 * 2;
constexpr size_t OFF_OB3 = OFF_OC + (size_t)NTOK * OCW * 2;
constexpr size_t OFF_LSE = OFF_OB3 + (size_t)3 * NTOK * 128 * 2;
constexpr size_t OFF_MG  = OFF_LSE + (size_t)3 * NTOK * 2 * 4;
constexpr size_t OFF_AFF = OFF_MG + (size_t)NTOK * DM * 2;
constexpr size_t OFF_IDX = OFF_AFF + (size_t)NTOK * NEXP * 4;
constexpr size_t OFF_VAL = OFF_IDX + (size_t)NROWS_E * 4;
constexpr size_t OFF_INV = OFF_VAL + (size_t)NROWS_E * 4;
constexpr size_t OFF_HID = OFF_INV + (size_t)NTOK * NEXP * 4;
constexpr size_t OFF_Y   = OFF_HID + (size_t)NROWS_E * FF * 2;
constexpr size_t OFF_XN8 = OFF_Y + (size_t)NROWS_E * DM * 2;
constexpr size_t OFF_END = OFF_XN8 + (size_t)NTOK * DM;

struct Params {
    const float *x, *w_in, *b_gate, *sink, *rpb, *w_a, *w_b, *w_c, *w_out, *norm_mix, *norm_ffn, *w_router, *w_gate_e, *w_up_e, *w_down_e, *norm_final;
    float* out; unsigned char* ws;
};
DI float*  P_COS(const Params& p) { return (float*)(p.ws + OFF_COS); }
DI float*  P_SIN(const Params& p) { return (float*)(p.ws + OFF_SIN); }
DI bf16_t* P_W(const Params& p, int l, size_t off) { return (bf16_t*)(p.ws + OFF_W + (size_t)l * LW + off); }
DI bf16_t* P_X(const Params& p) { return (bf16_t*)(p.ws + OFF_X); }
DI bf16_t* P_XN(const Params& p) { return (bf16_t*)(p.ws + OFF_XN); }
DI bf16_t* P_QK(const Params& p) { return (bf16_t*)(p.ws + OFF_QK); }
DI bf16_t* P_VT(const Params& p) { return (bf16_t*)(p.ws + OFF_VT); }
DI unsigned char* P_G(const Params& p) { return p.ws + OFF_G; }
DI bf16_t* P_OC(const Params& p) { return (bf16_t*)(p.ws + OFF_OC); }
DI bf16_t* P_OB3(const Params& p) { return (bf16_t*)(p.ws + OFF_OB3); }
DI float*  P_LSE(const Params& p) { return (float*)(p.ws + OFF_LSE); }
DI bf16_t* P_MG(const Params& p) { return (bf16_t*)(p.ws + OFF_MG); }
DI float*  P_AFF(const Params& p) { return (float*)(p.ws + OFF_AFF); }
DI int*    P_IDX(const Params& p) { return (int*)(p.ws + OFF_IDX); }
DI float*  P_VAL(const Params& p) { return (float*)(p.ws + OFF_VAL); }
DI int*    P_INV(const Params& p) { return (int*)(p.ws + OFF_INV); }
DI bf16_t* P_HID(const Params& p) { return (bf16_t*)(p.ws + OFF_HID); }
DI bf16_t* P_Y(const Params& p) { return (bf16_t*)(p.ws + OFF_Y); }
DI unsigned char* P_XN8(const Params& p) { return p.ws + OFF_XN8; }

DI unsigned f2bf(float f) { unsigned u = __float_as_uint(f); return (u + 0x7fffu + ((u >> 16) & 1u)) >> 16; }
DI unsigned pk2(float lo, float hi) { return f2bf(lo) | (f2bf(hi) << 16); }
constexpr float W8_SCALE = 32.0f, H8_SCALE = 4.0f;
DI unsigned pk4_fp8(float a, float b, float c, float d) { unsigned w = 0u; w = __builtin_amdgcn_cvt_pk_fp8_f32(a, b, w, false); w = __builtin_amdgcn_cvt_pk_fp8_f32(c, d, w, true); return w; }
DI float bf2f(unsigned b) { return __uint_as_float(b << 16); }
DI float bflo(unsigned w) { return __uint_as_float(w << 16); }
DI float bfhi(unsigned w) { return __uint_as_float(w & 0xffff0000u); }
DI float shx(float v, int d, int lane) { return __uint_as_float((unsigned)__builtin_amdgcn_ds_bpermute((lane ^ d) << 2, (int)__float_as_uint(v))); }
DI unsigned shl_abs(unsigned v, int src_lane) { return (unsigned)__builtin_amdgcn_ds_bpermute(src_lane << 2, (int)v); }
DI int otid() { int t = threadIdx.x; asm volatile("" : "+v"(t)); return t; }
DI int pos16(int t) { return ((t & 15) << 8) | (t >> 4); }

constexpr int JOBS_PER_LAYER = 26432, SMALL_JOBS = 1856;
DI void prep_job(const Params& p, int l, int j, const float*& src, int& src_ld, bf16_t*& dst, int& dst_ld) {
    if (j < 1216) {
        const int nblk = j >> 3, kc = j & 7; int sc;
        if (nblk < 40) { const int t = nblk >> 3, sb = nblk & 7, bj = sb >> 2, wc = sb & 3, hr = 4 * t + wc;
            const int base = hr < 6 ? 64 * hr : hr < 8 ? 384 + 64 * (hr - 6) : hr < 14 ? 640 + 64 * (hr - 8) : 1024 + 64 * (hr - 14);
            sc = base + 32 * bj; }
        else if (nblk < 56) { const int c = 32 * (nblk - 40); sc = c < 256 ? 1792 + c : 2048 + (c - 256); }
        else sc = 2560 + 32 * (nblk - 56);
        src = p.w_in + (size_t)l * DM * PROJ + (size_t)(128 * kc) * PROJ + sc; src_ld = PROJ;
        dst = P_W(p, l, LW_WIN) + (size_t)(32 * nblk) * 1024 + 128 * kc; dst_ld = 1024; return;
    }
    j -= 1216;
    if (j < 192) {
        const int nblk = j >> 3, kc = j & 7, ch = 32 * nblk;
        const int sc = ch < 128 ? 512 + ch : ch < 256 ? 1408 + (ch - 128) : ch < 512 ? 2304 + (ch - 256) : 1536 + (ch - 512);
        src = p.w_in + (size_t)l * DM * PROJ + (size_t)(128 * kc) * PROJ + sc; src_ld = PROJ;
        dst = P_W(p, l, LW_WV) + (size_t)ch * 1024 + 128 * kc; dst_ld = 1024; return;
    }
    j -= 192;
    if (j < 192) {
        bf16_t* wm = P_W(p, l, LW_WM); src_ld = 1024; dst_ld = 768;
        if (j < 96) { const int nblk = j / 3, kc = j % 3; src = p.w_a + (size_t)l * 384 * 1024 + (size_t)(128 * kc) * 1024 + 32 * nblk; dst = wm + (size_t)(32 * nblk) * 768 + 128 * kc; }
        else if (j < 128) { const int nblk = j - 96; src = p.w_b + (size_t)l * 128 * 1024 + 32 * nblk; dst = wm + (size_t)(32 * nblk) * 768 + 384; }
        else { const int jj = j - 128, nblk = jj >> 1, kc = jj & 1; src = p.w_c + (size_t)l * 256 * 1024 + (size_t)(128 * kc) * 1024 + 32 * nblk; dst = wm + (size_t)(32 * nblk) * 768 + 512 + 128 * kc; }
        return;
    }
    j -= 192;
    if (j < 256) {
        const int nblk = j >> 3, kc = j & 7;
        src = p.w_out + (size_t)l * 1024 * 1024 + (size_t)(128 * kc) * 1024 + 32 * nblk; src_ld = 1024;
        dst = P_W(p, l, LW_WO) + (size_t)(32 * nblk) * 1024 + 128 * kc; dst_ld = 1024; return;
    }
    j -= 256;
    if (j < 16384) {
        const int e = j >> 10, r = j & 1023, nblk = r >> 3, kc = r & 7, row0 = 32 * nblk, pp = row0 >> 8, s = row0 & 255;
        const float* w = s < 128 ? p.w_gate_e : p.w_up_e; const int col = 128 * pp + (s & 127);
        src = w + ((size_t)(l * NEXP + e) * 1024 + 128 * kc) * 2048 + col; src_ld = 2048;
        dst = (bf16_t*)((unsigned char*)P_W(p, l, LW_WGU) + ((size_t)e * 4096 + row0) * 1024 + 128 * kc); dst_ld = 1024; return;
    }
    j -= 16384;
    {
        const int e = j >> 9, r = j & 511, nblk = r >> 4, kc = r & 15;
        src = p.w_down_e + ((size_t)(l * NEXP + e) * 2048 + 128 * kc) * 1024 + 32 * nblk; src_ld = 1024;
        dst = (bf16_t*)((unsigned char*)P_W(p, l, LW_WD) + ((size_t)e * 1024 + 32 * nblk) * 2048 + 128 * kc); dst_ld = 2048;
    }
}
DI void sincos_d(double a, double& s, double& c) {
    const double q = rint(a * 0.63661977236758134308);
    double r = fma(-q, 1.57079632679489655800e+00, a); r = fma(-q, 6.12323399573676603587e-17, r);
    const double r2 = r * r;
    double sp = 1.58969099521155010221e-10; sp = fma(sp, r2, -2.50507602534068634195e-08); sp = fma(sp, r2, 2.75573137070700676789e-06); sp = fma(sp, r2, -1.98412698298579493134e-04);
    sp = fma(sp, r2, 8.33333333332248946124e-03); sp = fma(sp, r2, -1.66666666666666324348e-01); const double sr = fma(r * r2, sp, r);
    double cp = -1.13596475577881948265e-11; cp = fma(cp, r2, 2.08757232129817482790e-09); cp = fma(cp, r2, -2.75573143513906633035e-07); cp = fma(cp, r2, 2.48015872894767294178e-05);
    cp = fma(cp, r2, -1.38888888888741095749e-03); cp = fma(cp, r2, 4.16666666666666019037e-02); const double cr = fma(r2 * r2, cp, fma(-0.5, r2, 1.0));
    const int qi = ((int)q) & 3;
    s = qi == 0 ? sr : qi == 1 ? cr : qi == 2 ? -sr : -cr;
    c = qi == 0 ? cr : qi == 1 ? -sr : qi == 2 ? -cr : sr;
}
DI void prep_phase(const Params& p, LAS float* scr) {
    const int tid = otid();
    for (int i = blockIdx.x * 512 + tid; i < SEQ * 32; i += gridDim.x * 512) {
        const int pos = i >> 5, j = i & 31;
        double fr = 1.0; for (int jj = 0; jj < j; ++jj) fr *= 0.7498942093324559;
        const float invf = (float)fr;
        const float ang = (float)pos * invf; double s, c; sincos_d((double)ang, s, c);
        P_COS(p)[i] = (float)c; P_SIN(p)[i] = (float)s;
    }
    const int total = NLAYER * SMALL_JOBS;
    int u = blockIdx.x;
    const float* src; bf16_t* dst; int src_ld, dst_ld, j = 0;
    f32x4 r0, r1;
    if (u < total) { const int l = u / SMALL_JOBS; j = u - l * SMALL_JOBS; prep_job(p, l, j, src, src_ld, dst, dst_ld);
        r0 = *(const f32x4*)(src + (size_t)(tid >> 3) * src_ld + 4 * (tid & 7)); r1 = *(const f32x4*)(src + (size_t)((tid + 512) >> 3) * src_ld + 4 * (tid & 7)); }
    int buf = 0;
    for (; u < total; u += gridDim.x) {
        LAS float* sc = scr + buf * (128 * 33);
        { const int k = tid >> 3, c4 = tid & 7;
          sc[k * 33 + 4 * c4 + 0] = r0[0]; sc[k * 33 + 4 * c4 + 1] = r0[1]; sc[k * 33 + 4 * c4 + 2] = r0[2]; sc[k * 33 + 4 * c4 + 3] = r0[3];
          sc[(k + 64) * 33 + 4 * c4 + 0] = r1[0]; sc[(k + 64) * 33 + 4 * c4 + 1] = r1[1]; sc[(k + 64) * 33 + 4 * c4 + 2] = r1[2]; sc[(k + 64) * 33 + 4 * c4 + 3] = r1[3]; }
        bf16_t* dcur = dst; const int dld = dst_ld, jcur = j;
        const int un = u + gridDim.x;
        if (un < total) { const int l = un / SMALL_JOBS; j = un - l * SMALL_JOBS; prep_job(p, l, j, src, src_ld, dst, dst_ld);
            r0 = *(const f32x4*)(src + (size_t)(tid >> 3) * src_ld + 4 * (tid & 7)); r1 = *(const f32x4*)(src + (size_t)((tid + 512) >> 3) * src_ld + 4 * (tid & 7)); }
        __syncthreads();
        { const int n = tid >> 4, k8 = (tid & 15) * 8;
          if (jcur >= 1856) {
            u32x2 w; w[0] = pk4_fp8(sc[(k8 + 0) * 33 + n] * W8_SCALE, sc[(k8 + 1) * 33 + n] * W8_SCALE, sc[(k8 + 2) * 33 + n] * W8_SCALE, sc[(k8 + 3) * 33 + n] * W8_SCALE);
            w[1] = pk4_fp8(sc[(k8 + 4) * 33 + n] * W8_SCALE, sc[(k8 + 5) * 33 + n] * W8_SCALE, sc[(k8 + 6) * 33 + n] * W8_SCALE, sc[(k8 + 7) * 33 + n] * W8_SCALE);
            *(u32x2*)((unsigned char*)dcur + (size_t)n * dld + k8) = w;
          } else { u32x4 w;
            w[0] = pk2(sc[(k8 + 0) * 33 + n], sc[(k8 + 1) * 33 + n]); w[1] = pk2(sc[(k8 + 2) * 33 + n], sc[(k8 + 3) * 33 + n]);
            w[2] = pk2(sc[(k8 + 4) * 33 + n], sc[(k8 + 5) * 33 + n]); w[3] = pk2(sc[(k8 + 6) * 33 + n], sc[(k8 + 7) * 33 + n]);
            *(u32x4*)(dcur + (size_t)n * dld + k8) = w; } }
        buf ^= 1;
    }
    __syncthreads();
}

template <bool GU> DI void expert_addr(const Params& p, int l, int x, const float*& src, unsigned char*& dst) {
    if (GU) { const int e = x >> 10, nblk = (x >> 3) & 127, kc = x & 7;
        const float* wsel = (nblk & 4) ? p.w_up_e : p.w_gate_e;
        src = wsel + ((size_t)(l * NEXP + e) * 1024 + 128 * kc) * 2048 + 128 * (nblk >> 3) + 32 * (nblk & 3);
        dst = (unsigned char*)P_W(p, l, LW_WGU) + ((size_t)e * 4096 + 32 * nblk) * 1024 + 128 * kc; }
    else { const int e = x >> 9, nblk = (x >> 4) & 31, kc = x & 15;
        src = p.w_down_e + ((size_t)(l * NEXP + e) * 2048 + 128 * kc) * 1024 + 32 * nblk;
        dst = (unsigned char*)P_W(p, l, LW_WD) + ((size_t)e * 1024 + 32 * nblk) * 2048 + 128 * kc; }
}
constexpr int NPREP = 128;
constexpr int TK_WGS = 192, TK_JOBS = 40 * TK_WGS;
template <bool GU> DI void prep_expert_loop(const Params& p, int l, LAS unsigned* img, int tid, int w, int nwg, int x0, int NJ) {
    constexpr int D = 4, SLD = GU ? 2048 : 1024, DLD = GU ? 1024 : 2048;
    f32x4 r[D][2];
    const float* src; unsigned char* dst;
    const int lo = (tid >> 3) * SLD + 4 * (tid & 7);
    const int kq = tid & 31, nq = (tid >> 5) & 7, half = tid >> 8;
    const unsigned selx = half ? 0x07030602u : 0x05010400u;
    const int oo = (4 * nq + 2 * half) * DLD + 4 * kq;
#pragma unroll
    for (int d = 0; d < D; ++d) { expert_addr<GU>(p, l, x0 + nwg * d + w, src, dst); r[d][0] = *(const f32x4*)(src + lo); r[d][1] = *(const f32x4*)(src + lo + 64 * SLD); }
#pragma unroll 1
    for (int i = 0; i < NJ; i += D) {
#pragma unroll
        for (int d = 0; d < D; ++d) {
            LAS unsigned* sc = img + (d & 1) * (128 * 9);
            { const int k = tid >> 3, c4 = tid & 7;
              sc[k * 9 + c4] = pk4_fp8(r[d][0][0] * W8_SCALE, r[d][0][1] * W8_SCALE, r[d][0][2] * W8_SCALE, r[d][0][3] * W8_SCALE);
              sc[(k + 64) * 9 + c4] = pk4_fp8(r[d][1][0] * W8_SCALE, r[d][1][1] * W8_SCALE, r[d][1][2] * W8_SCALE, r[d][1][3] * W8_SCALE); }
            { const int nx = min(i + d + D, NJ - 1);
              expert_addr<GU>(p, l, x0 + nwg * nx + w, src, dst); r[d][0] = *(const f32x4*)(src + lo); r[d][1] = *(const f32x4*)(src + lo + 64 * SLD); }
            expert_addr<GU>(p, l, x0 + nwg * (i + d) + w, src, dst);
            __syncthreads();
            { const unsigned a = sc[(4 * kq + 0) * 9 + nq], b = sc[(4 * kq + 1) * 9 + nq], c = sc[(4 * kq + 2) * 9 + nq], e = sc[(4 * kq + 3) * 9 + nq];
              const unsigned tl = __builtin_amdgcn_perm(b, a, selx), th = __builtin_amdgcn_perm(e, c, selx);
              *(unsigned*)(dst + oo) = __builtin_amdgcn_perm(th, tl, 0x05040100u); *(unsigned*)(dst + oo + DLD) = __builtin_amdgcn_perm(th, tl, 0x07060302u); }
        }
    }
}
DI void prep_expert_phase(const Params& p, int l, LAS float* scr) {
    if (blockIdx.x < 256 - NPREP) return;
    const int tid = otid(), w = blockIdx.x - (256 - NPREP);
    prep_expert_loop<true>(p, l, (LAS unsigned*)scr, tid, w, NPREP, 0, 16384 / NPREP);
    prep_expert_loop<false>(p, l, (LAS unsigned*)scr, tid, w, NPREP, TK_JOBS, (8192 - TK_JOBS) / NPREP);
    __syncthreads();
}
DI void prep_expert_topk(const Params& p, int l, LAS float* scr) {
    if (blockIdx.x < 256 - TK_WGS) return;
    prep_expert_loop<false>(p, l, (LAS unsigned*)scr, otid(), blockIdx.x - (256 - TK_WGS), TK_WGS, 0, TK_JOBS / TK_WGS);
    __syncthreads();
}

DI int eo4(int lane, int i) { return 8 * lane + 512 * (i >> 1) + 4 * (i & 1); }
DI void unpk8(f32x4& a, f32x4& b, const u32x4& w) { a[0] = bflo(w[0]); a[1] = bfhi(w[0]); a[2] = bflo(w[1]); a[3] = bfhi(w[1]); b[0] = bflo(w[2]); b[1] = bfhi(w[2]); b[2] = bflo(w[3]); b[3] = bfhi(w[3]); }
DI void add8(f32x4& a, f32x4& b, const u32x4& w) { a[0] += bflo(w[0]); a[1] += bfhi(w[0]); a[2] += bflo(w[1]); a[3] += bfhi(w[1]); b[0] += bflo(w[2]); b[1] += bfhi(w[2]); b[2] += bflo(w[3]); b[3] += bfhi(w[3]); }
DI u32x4 pk8(const f32x4& a, const f32x4& b) { u32x4 w; w[0] = pk2(a[0], a[1]); w[1] = pk2(a[2], a[3]); w[2] = pk2(b[0], b[1]); w[3] = pk2(b[2], b[3]); return w; }
template <int MODE> DI void norm1_phase(const Params& p, int l) {
    const int tid = otid(), lane = tid & 63, wid = tid >> 6;
    const float* gain = MODE == 2 ? p.norm_final : p.norm_mix + (size_t)l * DM;
    f32x4 g[4];
#pragma unroll
    for (int i = 0; i < 4; ++i) g[i] = *(const f32x4*)(gain + eo4(lane, i));
    const int nw = gridDim.x * 8;
    for (int row0 = blockIdx.x * 8 + wid; row0 < NTOK; row0 += 2 * nw) {
        const int row1 = row0 + nw;
        f32x4 v0[4], v1[4];
        if (MODE == 0) {
#pragma unroll
            for (int i = 0; i < 4; ++i) { v0[i] = *(const f32x4*)(p.x + (size_t)row0 * DM + eo4(lane, i)); v1[i] = *(const f32x4*)(p.x + (size_t)row1 * DM + eo4(lane, i)); }
        } else {
            u32x4 a[2], b[2];
#pragma unroll
            for (int j = 0; j < 2; ++j) { a[j] = *(const u32x4*)(P_X(p) + (size_t)row0 * DM + 8 * lane + 512 * j); b[j] = *(const u32x4*)(P_X(p) + (size_t)row1 * DM + 8 * lane + 512 * j); }
            const int c0 = lane < NEXP ? P_INV(p)[(size_t)row0 * NEXP + lane] : -1, c1 = lane < NEXP ? P_INV(p)[(size_t)row1 * NEXP + lane] : -1;
#pragma unroll
            for (int j = 0; j < 2; ++j) { unpk8(v0[2 * j], v0[2 * j + 1], a[j]); unpk8(v1[2 * j], v1[2 * j + 1], b[j]); }
            unsigned long long m0 = __ballot(c0 >= 0), m1 = __ballot(c1 >= 0);
            const bf16_t* ybase0 = P_Y(p) + (size_t)((row0 >> 12) * CAP) * DM; const bf16_t* ybase1 = P_Y(p) + (size_t)((row1 >> 12) * CAP) * DM;
            while (m0 | m1) {
                u32x4 w0[2], w1[2]; const bool h0 = m0 != 0ull, h1 = m1 != 0ull;
                if (h0) { const int e = __builtin_ctzll(m0); m0 &= m0 - 1ull; const int c = __builtin_amdgcn_readlane(c0, e); const bf16_t* yr = ybase0 + (size_t)(e * NBATCH * CAP + c) * DM;
#pragma unroll
                    for (int j = 0; j < 2; ++j) w0[j] = *(const u32x4*)(yr + 8 * lane + 512 * j); }
                if (h1) { const int e = __builtin_ctzll(m1); m1 &= m1 - 1ull; const int c = __builtin_amdgcn_readlane(c1, e); const bf16_t* yr = ybase1 + (size_t)(e * NBATCH * CAP + c) * DM;
#pragma unroll
                    for (int j = 0; j < 2; ++j) w1[j] = *(const u32x4*)(yr + 8 * lane + 512 * j); }
                if (h0) {
#pragma unroll
                    for (int j = 0; j < 2; ++j) add8(v0[2 * j], v0[2 * j + 1], w0[j]); }
                if (h1) {
#pragma unroll
                    for (int j = 0; j < 2; ++j) add8(v1[2 * j], v1[2 * j + 1], w1[j]); }
            }
        }
        if (MODE != 2) {
#pragma unroll
            for (int j = 0; j < 2; ++j) { *(u32x4*)(P_X(p) + (size_t)row0 * DM + 8 * lane + 512 * j) = pk8(v0[2 * j], v0[2 * j + 1]); *(u32x4*)(P_X(p) + (size_t)row1 * DM + 8 * lane + 512 * j) = pk8(v1[2 * j], v1[2 * j + 1]); }
        }
        float s0 = 0.f, s1 = 0.f;
#pragma unroll
        for (int i = 0; i < 4; ++i) { s0 += v0[i][0] * v0[i][0] + v0[i][1] * v0[i][1] + v0[i][2] * v0[i][2] + v0[i][3] * v0[i][3]; s1 += v1[i][0] * v1[i][0] + v1[i][1] * v1[i][1] + v1[i][2] * v1[i][2] + v1[i][3] * v1[i][3]; }
#pragma unroll
        for (int d = 32; d >= 1; d >>= 1) { s0 += shx(s0, d, lane); s1 += shx(s1, d, lane); }
        const float r0 = rsqrtf(s0 * (1.0f / DM) + 1e-6f), r1 = rsqrtf(s1 * (1.0f / DM) + 1e-6f);
#pragma unroll
        for (int i = 0; i < 4; ++i) { v0[i] = v0[i] * r0 * g[i]; v1[i] = v1[i] * r1 * g[i]; }
        if (MODE == 2) {
#pragma unroll
            for (int i = 0; i < 4; ++i) { *(f32x4*)(p.out + (size_t)row0 * DM + eo4(lane, i)) = v0[i]; *(f32x4*)(p.out + (size_t)row1 * DM + eo4(lane, i)) = v1[i]; }
        } else {
#pragma unroll
            for (int j = 0; j < 2; ++j) { *(u32x4*)(P_XN(p) + (size_t)row0 * DM + 8 * lane + 512 * j) = pk8(v0[2 * j], v0[2 * j + 1]); *(u32x4*)(P_XN(p) + (size_t)row1 * DM + 8 * lane + 512 * j) = pk8(v1[2 * j], v1[2 * j + 1]); }
        }
    }
}

DI float reduce16(const float (&a)[16], int lane) {
    float b8[8], b4[4], b2[2];
    { const bool hi = (lane & 32) != 0;
#pragma unroll
      for (int j = 0; j < 8; ++j) { const float snd = hi ? a[j] : a[j + 8], kp = hi ? a[j + 8] : a[j]; b8[j] = kp + shx(snd, 32, lane); } }
    { const bool hi = (lane & 16) != 0;
#pragma unroll
      for (int j = 0; j < 4; ++j) { const float snd = hi ? b8[j] : b8[j + 4], kp = hi ? b8[j + 4] : b8[j]; b4[j] = kp + shx(snd, 16, lane); } }
    { const bool hi = (lane & 8) != 0;
#pragma unroll
      for (int j = 0; j < 2; ++j) { const float snd = hi ? b4[j] : b4[j + 2], kp = hi ? b4[j + 2] : b4[j]; b2[j] = kp + shx(snd, 8, lane); } }
    float r;
    { const bool hi = (lane & 4) != 0; const float snd = hi ? b2[0] : b2[1], kp = hi ? b2[1] : b2[0]; r = kp + shx(snd, 4, lane); }
    r += shx(r, 2, lane); r += shx(r, 1, lane);
    return r;
}
DI void norm2_router_phase(const Params& p, int l, LAS float* wr) {
    const int tid = otid(), lane = tid & 63, wid = tid >> 6;
    for (int i = tid; i < DM * NEXP; i += 512) { const int d = i >> 4;
        wr[(i & 15) * DM + ((d >> 9) * 2 + ((d >> 2) & 1)) * 256 + 4 * ((d & 511) >> 3) + (d & 3)] = p.w_router[(size_t)l * DM * NEXP + i]; }
    __syncthreads();
    const float* gain = p.norm_ffn + (size_t)l * DM;
    f32x4 g[4];
#pragma unroll
    for (int i = 0; i < 4; ++i) g[i] = *(const f32x4*)(gain + eo4(lane, i));
    const int nw = gridDim.x * 8;
    for (int row0 = blockIdx.x * 8 + wid; row0 < NTOK; row0 += 2 * nw) {
        const int row1 = row0 + nw;
        f32x4 v0[4], v1[4]; float s0 = 0.f, s1 = 0.f;
        { u32x4 a[2], b[2];
#pragma unroll
          for (int j = 0; j < 2; ++j) { a[j] = *(const u32x4*)(P_X(p) + (size_t)row0 * DM + 8 * lane + 512 * j); b[j] = *(const u32x4*)(P_X(p) + (size_t)row1 * DM + 8 * lane + 512 * j); }
#pragma unroll
          for (int j = 0; j < 2; ++j) { unpk8(v0[2 * j], v0[2 * j + 1], a[j]); unpk8(v1[2 * j], v1[2 * j + 1], b[j]); } }
#pragma unroll
        for (int i = 0; i < 4; ++i) { s0 += v0[i][0] * v0[i][0] + v0[i][1] * v0[i][1] + v0[i][2] * v0[i][2] + v0[i][3] * v0[i][3]; s1 += v1[i][0] * v1[i][0] + v1[i][1] * v1[i][1] + v1[i][2] * v1[i][2] + v1[i][3] * v1[i][3]; }
#pragma unroll
        for (int d = 32; d >= 1; d >>= 1) { s0 += shx(s0, d, lane); s1 += shx(s1, d, lane); }
        const float r0 = rsqrtf(s0 * (1.0f / DM) + 1e-6f), r1 = rsqrtf(s1 * (1.0f / DM) + 1e-6f);
#pragma unroll
        for (int i = 0; i < 4; ++i) { v0[i] = v0[i] * r0 * g[i]; v1[i] = v1[i] * r1 * g[i]; }
#pragma unroll
        for (int j = 0; j < 2; ++j) { u32x2 w;
            w[0] = pk4_fp8(v0[2 * j][0], v0[2 * j][1], v0[2 * j][2], v0[2 * j][3]); w[1] = pk4_fp8(v0[2 * j + 1][0], v0[2 * j + 1][1], v0[2 * j + 1][2], v0[2 * j + 1][3]);
            *(u32x2*)(P_XN8(p) + (size_t)row0 * DM + 8 * lane + 512 * j) = w;
            w[0] = pk4_fp8(v1[2 * j][0], v1[2 * j][1], v1[2 * j][2], v1[2 * j][3]); w[1] = pk4_fp8(v1[2 * j + 1][0], v1[2 * j + 1][1], v1[2 * j + 1][2], v1[2 * j + 1][3]);
            *(u32x2*)(P_XN8(p) + (size_t)row1 * DM + 8 * lane + 512 * j) = w; }
        float a0[NEXP], a1[NEXP];
#pragma unroll
        for (int e = 0; e < NEXP; ++e) { float x0 = 0.f, x1 = 0.f;
#pragma unroll
            for (int i = 0; i < 4; ++i) { const f32x4 w = *(const LAS f32x4*)(wr + e * DM + 4 * lane + 256 * i);
                x0 += v0[i][0] * w[0] + v0[i][1] * w[1] + v0[i][2] * w[2] + v0[i][3] * w[3]; x1 += v1[i][0] * w[0] + v1[i][1] * w[1] + v1[i][2] * w[2] + v1[i][3] * w[3]; }
            a0[e] = x0; a1[e] = x1;
            if ((e & 3) == 3) __builtin_amdgcn_sched_barrier(0); }
        const float l0 = reduce16(a0, lane), l1 = reduce16(a1, lane);
        float m0 = l0, m1 = l1;
#pragma unroll
        for (int d = 32; d >= 4; d >>= 1) { m0 = fmaxf(m0, shx(m0, d, lane)); m1 = fmaxf(m1, shx(m1, d, lane)); }
        const float e0 = __expf(l0 - m0), e1 = __expf(l1 - m1); float d0 = e0, d1 = e1;
#pragma unroll
        for (int d = 32; d >= 4; d >>= 1) { d0 += shx(d0, d, lane); d1 += shx(d1, d, lane); }
        if ((lane & 3) == 0) { const int e = lane >> 2;
            P_AFF(p)[((size_t)((row0 >> 12) * NEXP + e)) * SEQ + (row0 & 4095)] = e0 / d0; P_AFF(p)[((size_t)((row1 >> 12) * NEXP + e)) * SEQ + (row1 & 4095)] = e1 / d1; }
    }
}

DI void topk_phase(const Params& p, LAS unsigned* lds) {
    const int tid = otid(), lane = tid & 63, wid = tid >> 6;
    LAS unsigned* hist = lds; LAS unsigned* sh = lds + 256; LAS unsigned* wtot = lds + 272;
    for (int be = blockIdx.x; be < NBATCH * NEXP; be += gridDim.x) {
        const int b = be >> 4, e = be & 15;
        const float* aff = P_AFF(p) + (size_t)be * SEQ + tid * 8;
        const f32x4 a0 = *(const f32x4*)aff, a1 = *(const f32x4*)(aff + 4);
        unsigned key[8];
#pragma unroll
        for (int i = 0; i < 4; ++i) { key[i] = __float_as_uint(a0[i]); key[4 + i] = __float_as_uint(a1[i]); }
        unsigned prefix = 0u, mask = 0u, krem = CAP;
        for (int pass = 3; pass >= 0; --pass) {
            const int shift = 8 * pass;
            if (tid < 256) hist[tid] = 0u;
            __syncthreads();
#pragma unroll
            for (int i = 0; i < 8; ++i) if ((key[i] & mask) == prefix) atomicAdd((unsigned*)&hist[(key[i] >> shift) & 255u], 1u);
            __syncthreads();
            if (wid == 0) {
                const unsigned h0 = hist[4 * lane], h1 = hist[4 * lane + 1], h2 = hist[4 * lane + 2], h3 = hist[4 * lane + 3], s = h0 + h1 + h2 + h3;
                unsigned suf = s;
#pragma unroll
                for (int d = 1; d < 64; d <<= 1) { const unsigned t = shl_abs(suf, (lane + d) & 63); if (lane + d < 64) suf += t; }
                const unsigned above = suf - s;
                if (above < krem && krem <= suf) {
                    unsigned a = above; unsigned bin, nk;
                    if (a + h3 >= krem) { bin = 4 * lane + 3; nk = krem - a; }
                    else { a += h3; if (a + h2 >= krem) { bin = 4 * lane + 2; nk = krem - a; }
                        else { a += h2; if (a + h1 >= krem) { bin = 4 * lane + 1; nk = krem - a; } else { a += h1; bin = 4 * lane; nk = krem - a; } } }
                    sh[0] = prefix | (bin << shift); sh[1] = nk;
                }
            }
            __syncthreads();
            prefix = sh[0]; krem = sh[1]; mask |= 0xFFu << shift;
            __syncthreads();
        }
        unsigned cg = 0u, ce = 0u;
#pragma unroll
        for (int i = 0; i < 8; ++i) { cg += key[i] > prefix ? 1u : 0u; ce += key[i] == prefix ? 1u : 0u; }
        unsigned pk = cg | (ce << 16), incl = pk;
#pragma unroll
        for (int d = 1; d < 64; d <<= 1) { const unsigned t = shl_abs(incl, (lane - d) & 63); if (lane >= d) incl += t; }
        if (lane == 63) wtot[wid] = incl;
        __syncthreads();
        unsigned woff = 0u;
#pragma unroll
        for (int w = 0; w < 8; ++w) woff += w < wid ? wtot[w] : 0u;
        const unsigned excl = woff + incl - pk;
        unsigned gtb = excl & 0xffffu, eqb = excl >> 16;
        int* idxo = P_IDX(p) + (size_t)(e * NBATCH + b) * CAP; float* valo = P_VAL(p) + (size_t)(e * NBATCH + b) * CAP;
        int* inv = P_INV(p) + ((size_t)b * SEQ + tid * 8) * NEXP + e;
#pragma unroll
        for (int i = 0; i < 8; ++i) {
            int slot = -1;
            if (key[i] > prefix) { slot = (int)(gtb + (eqb < krem ? eqb : krem)); ++gtb; }
            else if (key[i] == prefix) { if (eqb < krem) slot = (int)(gtb + eqb); ++eqb; }
            if (slot >= 0) { idxo[slot] = tid * 8 + i; valo[slot] = __uint_as_float(key[i]); }
            inv[(size_t)i * NEXP] = slot;
        }
        __syncthreads();
    }
}

namespace at {
constexpr int NUNIT_A = 1536, NUNIT_C = 1024, NUNIT_B = 1536, NUNIT = NUNIT_A + NUNIT_C + NUNIT_B;
DI unsigned cvt2(float lo, float hi) { typedef __bf16 bf2_t __attribute__((ext_vector_type(2))); const f32x2 v = {lo, hi}; const bf2_t b = __builtin_convertvector(v, bf2_t); return __builtin_bit_cast(unsigned, b); }
DI bf16x8 pack8(const f32x16& x, int s8) { u32x4 w; w[0] = cvt2(x[s8 + 0], x[s8 + 1]); w[1] = cvt2(x[s8 + 2], x[s8 + 3]); w[2] = cvt2(x[s8 + 4], x[s8 + 5]); w[3] = cvt2(x[s8 + 6], x[s8 + 7]); return __builtin_bit_cast(bf16x8, w); }
DI int koffmap(int r, bool g1) { return g1 ? 4 * (4 * ((r >> 3) & 1) + (r & 3)) + 2 * (r >> 4) + ((r >> 2) & 1) : (r & 16) + 8 * ((r >> 2) & 1) + 4 * ((r >> 3) & 1) + (r & 3); }

DI float xh_max(float v) { const auto r = __builtin_amdgcn_permlane32_swap(__float_as_uint(v), __float_as_uint(v), false, false); return fmaxf(__uint_as_float(r[0]), __uint_as_float(r[1])); }
DI float xh_sum(float v) { const auto r = __builtin_amdgcn_permlane32_swap(__float_as_uint(v), __float_as_uint(v), false, false); return __uint_as_float(r[0]) + __uint_as_float(r[1]); }
constexpr float LOG2E = 1.4426950408889634f, LN2 = 0.6931471805599453f;
struct QState { float m, den; f32x16 O0, O1; };
DI void softmax_tile(f32x16& S, QState& st, bf16x8& p0, bf16x8& p1) {
    float mx = fmaxf(S[0], S[1]);
#pragma unroll
    for (int i = 2; i < 16; i += 2) mx = fmaxf(mx, fmaxf(S[i], S[i + 1]));
    mx = xh_max(mx);
    const float mn = fmaxf(st.m, mx), alpha = __builtin_amdgcn_exp2f(st.m - mn);
    float ps = 0.f;
#pragma unroll
    for (int i = 0; i < 16; ++i) { S[i] = __builtin_amdgcn_exp2f(S[i] - mn); ps += S[i]; }
    ps = xh_sum(ps);
    st.den = st.den * alpha + ps; st.m = mn;
#pragma unroll
    for (int i = 0; i < 16; ++i) { st.O0[i] *= alpha; st.O1[i] *= alpha; }
    p0 = pack8(S, 0); p1 = pack8(S, 8);
}
template <int MODE> DI void mask_tile(f32x16& S, int tn, int NT, int q, int h, int t, int qrow, int sr_q, int sc_q, int kc0, int qcg, const LAS float* bt_head) {
    if (MODE == 3) {
        const bool rowok = t >= sr_q && t < sr_q + 8; const LAS float* bt = bt_head + (t - qrow + 7) * 31 + 15 - qcg;
#pragma unroll
        for (int i = 0; i < 16; ++i) { const int kc = kc0 + 16 * (i >> 3) + 8 * h + (i & 7); const bool ok = rowok && kc >= sc_q && kc < sc_q + 16;
            const int bi = ok ? kc : qcg; S[i] = ok ? S[i] + bt[bi] : -1e37f; }
    } else {
        const int edge = tn == 0 ? 1 : tn == NT - 1 ? 2 : 0;
        if (edge != 0) {
            int qq = MODE == 2 ? q - h : q - 8 * h; asm volatile("" : "+v"(qq));
            if (edge == 1) {
#pragma unroll
                for (int i = 0; i < 16; ++i) { const int kc_ = MODE == 2 ? 4 * (i & 7) + 2 * (i >> 3) : 16 * (i >> 3) + (i & 7); S[i] = kc_ >= qq ? S[i] : -1e37f; }
            } else {
#pragma unroll
                for (int i = 0; i < 16; ++i) { const int kc_ = MODE == 2 ? 4 * (i & 7) + 2 * (i >> 3) : 16 * (i >> 3) + (i & 7); S[i] = kc_ <= qq ? S[i] : -1e37f; }
            }
        }
    }
}
template <int MODE> DI void wave_unit(const Params& p, int l, int u, const LAS float* rpb_lds, LAS unsigned char* ring, int lane) {
    const int q = lane & 31, h = lane >> 5;
    const bf16_t* QK = P_QK(p); const bf16_t* VT = P_VT(p);
    int b, qcol, kcol, vch, dil = 1, rho = 0, Jq = 0, L = SEQ, vs0 = 0, g = 0, hs = 0, hq = 0;
    constexpr int W = MODE == 0 ? 128 : 64, NT = MODE == 0 ? 9 : 5;
    int qcg = 0, kc0 = 0, kr_lo = 0, kr_hi = 0, r00 = 0;
    if (MODE == 0) { const int gg = u % 3, qp = (u / 3) & 63, kvh = (u / 192) & 1; b = u / 384; hq = kvh * 3 + gg; qcol = 64 * hq; kcol = 384 + 64 * kvh; vch = 64 * kvh; Jq = 64 * qp; }
    else if (MODE == 1 || MODE == 2) { const int qt6 = u & 63; hs = (u >> 6) & 1; g = (u >> 7) % 3; b = u / 384; qcol = 512 + 128 * g + 64 * hs; kcol = 896 + 128 * g + 64 * hs;
        vch = g == 0 ? 128 + 64 * hs : g == 1 ? 512 + 64 * hs : 640 + 64 * hs;
        if (g == 0) { Jq = 64 * qt6; } else if (g == 1) { dil = 4; rho = qt6 >> 4; Jq = 64 * (qt6 & 15); L = 1024; } else { dil = 16; rho = qt6 >> 2; Jq = 64 * (qt6 & 3); L = 256; vs0 = rho * 256; } }
    else { const int qt6 = u & 63, hh = (u >> 6) & 3, gr4 = qt6 >> 2, cb = qt6 & 3; b = u >> 8; hq = hh; qcol = 1280 + 64 * hh; kcol = 1536 + 64 * hh; vch = 256 + 64 * hh;
        r00 = 4 * gr4; qcg = 16 * cb + (q & 15); kc0 = cb == 0 ? 0 : cb == 3 ? 32 : 16 * cb - 8;
        const int s0 = r00 - 4 < 0 ? 0 : r00 - 4 > 56 ? 56 : r00 - 4, s3 = r00 - 1 < 0 ? 0 : r00 - 1 > 56 ? 56 : r00 - 1; kr_lo = s0; kr_hi = s3 + 8; }
    int t_lo, t_hi; unsigned kdma[4], vdma[4], kstep_t, vstep_t;
    if (MODE == 3) { t_lo = kr_lo; t_hi = kr_hi; kstep_t = 64u * QKW; vstep_t = 64; }
    else { t_lo = (W - Jq + 31) >> 5; if (t_lo < 0) t_lo = 0; t_hi = (L + W - Jq) >> 5; if (t_hi > NT + 1) t_hi = NT + 1; kstep_t = 32u * dil * QKW; vstep_t = MODE == 2 ? 8 : 32; }
#pragma unroll
    for (int i = 0; i < 4; ++i) {
        const int r = 8 * i + (lane >> 3), c8 = (lane & 7) ^ ((r >> 1) & 7), ko = koffmap(r, MODE == 2);
        const int ktok = MODE == 3 ? b * SEQ + kc0 + ko : b * SEQ + (Jq - W + ko) * dil + rho;
        kdma[i] = (unsigned)ktok * QKW + kcol + 8 * c8;
        const int d = 16 * i + (lane >> 2), ch = (lane & 3) ^ ((d >> 2) & 3);
        const int vslot = MODE == 3 ? b * SEQ + kc0 + 8 * ch : MODE == 2 ? b * SEQ + ch * 1024 + rho * 256 + ((Jq - W) >> 2) : b * SEQ + vs0 + (Jq - W) + 8 * ch;
        vdma[i] = (unsigned)(vch + d) * NTOK + vslot;
    }
#define AT_DMA(t, buf) do { const unsigned kt_ = (unsigned)(t) * kstep_t, vt_ = (unsigned)(t) * vstep_t; LAS unsigned char* bb_ = ring + (buf) * 8192; \
        _Pragma("unroll") for (int i_ = 0; i_ < 4; ++i_) __builtin_amdgcn_global_load_lds((const unsigned*)(QK + (unsigned)(kdma[i_] + kt_)), (LAS unsigned*)(bb_ + i_ * 1024), 16, 0, 0); \
        _Pragma("unroll") for (int i_ = 0; i_ < 4; ++i_) __builtin_amdgcn_global_load_lds((const unsigned*)(VT + (unsigned)(vdma[i_] + vt_)), (LAS unsigned*)(bb_ + 4096 + i_ * 1024), 16, 0, 0); } while (0)
    AT_DMA(t_lo, 0);
    int kaddr[4], vaddr[2][2];
#pragma unroll
    for (int c = 0; c < 4; ++c) kaddr[c] = q * 128 + (((2 * c + h) ^ ((q >> 1) & 7)) << 4);
#pragma unroll
    for (int dh = 0; dh < 2; ++dh)
#pragma unroll
        for (int sx = 0; sx < 2; ++sx) vaddr[dh][sx] = 4096 + (32 * dh + q) * 64 + (((2 * sx + h) ^ ((q >> 2) & 3)) << 4);
    int tokq[2]; bf16x8 qf[2][4]; QState st[2];
#pragma unroll
    for (int n = 0; n < 2; ++n) {
        tokq[n] = MODE == 3 ? b * SEQ + (r00 + 2 * n + (q >> 4)) * 64 + qcg : b * SEQ + (Jq + 32 * n + q) * dil + rho;
        const bf16_t* qp = QK + (size_t)tokq[n] * QKW + qcol + 8 * h;
#pragma unroll
        for (int c = 0; c < 4; ++c) qf[n][c] = *(const bf16x8*)(qp + 16 * c);
        st[n].m = -1e30f; st[n].den = 0.f;
        if (MODE == 0) { st[n].m = p.sink[l * 6 + hq] * LOG2E; st[n].den = 1.0f; }
#pragma unroll
        for (int i = 0; i < 16; ++i) { st[n].O0[i] = 0.f; st[n].O1[i] = 0.f; }
    }
    int sc_q = 0, qrow0 = 0, qrow1 = 0, srq0 = 0, srq1 = 0, lo0 = 0, hi0 = 0, lo1 = 0, hi1 = 0;
    if (MODE == 3) { sc_q = qcg - 8 < 0 ? 0 : qcg - 8 > 48 ? 48 : qcg - 8;
        qrow0 = r00 + (q >> 4); qrow1 = qrow0 + 2; srq0 = qrow0 - 4 < 0 ? 0 : qrow0 - 4 > 56 ? 56 : qrow0 - 4; srq1 = qrow1 - 4 < 0 ? 0 : qrow1 - 4 > 56 ? 56 : qrow1 - 4;
        lo0 = r00 - 4 < 0 ? 0 : r00 - 4 > 56 ? 56 : r00 - 4; hi0 = (r00 - 3 < 0 ? 0 : r00 - 3 > 56 ? 56 : r00 - 3) + 8; lo1 = r00 - 2 < 0 ? 0 : r00 - 2 > 56 ? 56 : r00 - 2; hi1 = (r00 - 1 < 0 ? 0 : r00 - 1 > 56 ? 56 : r00 - 1) + 8; }
    const LAS float* bt_head = rpb_lds + hq * 465;
#define AT_S(S, n) do { _Pragma("unroll") for (int i_ = 0; i_ < 16; ++i_) S[i_] = 0.f; _Pragma("unroll") for (int c_ = 0; c_ < 4; ++c_) S = __builtin_amdgcn_mfma_f32_32x32x16_bf16(kf[c_], qf[n][c_], S, 0, 0, 0); } while (0)
#define AT_PV(n, p0, p1) do { st[n].O0 = __builtin_amdgcn_mfma_f32_32x32x16_bf16(vf[0][0], p0, st[n].O0, 0, 0, 0); st[n].O0 = __builtin_amdgcn_mfma_f32_32x32x16_bf16(vf[0][1], p1, st[n].O0, 0, 0, 0); \
        st[n].O1 = __builtin_amdgcn_mfma_f32_32x32x16_bf16(vf[1][0], p0, st[n].O1, 0, 0, 0); st[n].O1 = __builtin_amdgcn_mfma_f32_32x32x16_bf16(vf[1][1], p1, st[n].O1, 0, 0, 0); } while (0)
    for (int t = t_lo; t < t_hi; ++t) {
        const int buf = (t - t_lo) & 1;
        if (t + 1 < t_hi) { AT_DMA(t + 1, buf ^ 1); asm volatile("s_waitcnt vmcnt(8)" ::: "memory"); }
        else asm volatile("s_waitcnt vmcnt(0)" ::: "memory");
        const LAS unsigned char* bb = ring + buf * 8192;
        const bool act0 = MODE == 3 ? (t >= lo0 && t < hi0) : (t < NT), act1 = MODE == 3 ? (t >= lo1 && t < hi1) : (t >= 1);
        bf16x8 kf[4], vf[2][2];
#pragma unroll
        for (int c = 0; c < 4; ++c) kf[c] = *(const LAS bf16x8*)(bb + kaddr[c]);
        if (act0 && act1) {
            f32x16 S0, S1; AT_S(S0, 0); AT_S(S1, 1);
            mask_tile<MODE>(S0, t, NT, q, h, t, qrow0, srq0, sc_q, kc0, qcg, bt_head); mask_tile<MODE>(S1, t - 1, NT, q, h, t, qrow1, srq1, sc_q, kc0, qcg, bt_head);
            bf16x8 pa0, pa1, pb0, pb1;
            softmax_tile(S0, st[0], pa0, pa1); softmax_tile(S1, st[1], pb0, pb1);
            __builtin_amdgcn_sched_barrier(0);
#pragma unroll
            for (int dh = 0; dh < 2; ++dh)
#pragma unroll
                for (int sx = 0; sx < 2; ++sx) vf[dh][sx] = *(const LAS bf16x8*)(bb + vaddr[dh][sx]);
            AT_PV(0, pa0, pa1); AT_PV(1, pb0, pb1);
        } else if (act0) {
            f32x16 S0; AT_S(S0, 0);
#pragma unroll
            for (int dh = 0; dh < 2; ++dh)
#pragma unroll
                for (int sx = 0; sx < 2; ++sx) vf[dh][sx] = *(const LAS bf16x8*)(bb + vaddr[dh][sx]);
            mask_tile<MODE>(S0, t, NT, q, h, t, qrow0, srq0, sc_q, kc0, qcg, bt_head);
            bf16x8 pa0, pa1; softmax_tile(S0, st[0], pa0, pa1); AT_PV(0, pa0, pa1);
        } else if (act1) {
            f32x16 S1; AT_S(S1, 1);
#pragma unroll
            for (int dh = 0; dh < 2; ++dh)
#pragma unroll
                for (int sx = 0; sx < 2; ++sx) vf[dh][sx] = *(const LAS bf16x8*)(bb + vaddr[dh][sx]);
            mask_tile<MODE>(S1, t - 1, NT, q, h, t, qrow1, srq1, sc_q, kc0, qcg, bt_head);
            bf16x8 pb0, pb1; softmax_tile(S1, st[1], pb0, pb1); AT_PV(1, pb0, pb1);
        }
    }
#undef AT_DMA
#undef AT_S
#undef AT_PV
#pragma unroll
    for (int n = 0; n < 2; ++n) {
        const float rd = 1.0f / st[n].den;
        bf16_t* op;
        if (MODE == 1 || MODE == 2) { op = P_OB3(p) + ((size_t)g * NTOK + tokq[n]) * 128 + 64 * hs; if (h == 0) P_LSE(p)[((size_t)g * NTOK + tokq[n]) * 2 + hs] = (st[n].m + __log2f(st[n].den)) * LN2; }
        else op = P_OC(p) + (size_t)tokq[n] * OCW + (MODE == 0 ? 64 * hq : 512 + 64 * hq);
#pragma unroll
        for (int gq = 0; gq < 4; ++gq) {
            u32x2 w0, w1;
            w0[0] = cvt2(st[n].O0[4 * gq] * rd, st[n].O0[4 * gq + 1] * rd); w0[1] = cvt2(st[n].O0[4 * gq + 2] * rd, st[n].O0[4 * gq + 3] * rd);
            w1[0] = cvt2(st[n].O1[4 * gq] * rd, st[n].O1[4 * gq + 1] * rd); w1[1] = cvt2(st[n].O1[4 * gq + 2] * rd, st[n].O1[4 * gq + 3] * rd);
            *(u32x2*)(op + 8 * gq + 4 * h) = w0; *(u32x2*)(op + 32 + 8 * gq + 4 * h) = w1;
        }
    }
}
}
DI void f_attn_phase(const Params& p, int l, LAS unsigned char* lds, int slot) {
    const int tid = otid(), lane = tid & 63, wid = __builtin_amdgcn_readfirstlane(tid >> 6);
    LAS float* rpb_lds = (LAS float*)(lds + 131072 + 64);
    for (int i = tid; i < 4 * 465; i += 512) rpb_lds[i] = p.rpb[(size_t)l * 4 * 465 + i] * at::LOG2E;
    __syncthreads();
    LAS unsigned char* ring = lds + wid * 16384;
    const int x8 = blockIdx.x & 7;
    unsigned* ctr = (unsigned*)(p.ws + OFF_CTL + 16384) + 64 * (slot * 8 + x8);
    for (;;) {
        unsigned k = 0u;
        if (lane == 0) k = __hip_atomic_fetch_add(ctr, 1u, __ATOMIC_RELAXED, __HIP_MEMORY_SCOPE_AGENT);
        k = (unsigned)__builtin_amdgcn_readfirstlane((int)k);
        if (k >= 512u) break;
        int ln = lane; asm volatile("" : "+v"(ln));
        if (k < 192u) at::wave_unit<0>(p, l, x8 * 192 + (int)k, rpb_lds, ring, ln);
        else if (k < 320u) at::wave_unit<3>(p, l, x8 * 128 + (int)k - 192, rpb_lds, ring, ln);
        else { const int ub = x8 * 192 + (int)k - 320; if (((ub >> 7) % 3) == 1) at::wave_unit<2>(p, l, ub, rpb_lds, ring, ln); else at::wave_unit<1>(p, l, ub, rpb_lds, ring, ln); }
    }
    __syncthreads();
}

DI void bcombine_phase(const Params& p) {
    for (int i = blockIdx.x * 512 + otid(); i < NTOK * 16; i += gridDim.x * 512) {
        const int tok = i >> 4, part = i & 15, hs = part >> 3, d0 = (part & 7) * 8;
        const float l0 = P_LSE(p)[((size_t)0 * NTOK + tok) * 2 + hs], l1 = P_LSE(p)[((size_t)1 * NTOK + tok) * 2 + hs], l2 = P_LSE(p)[((size_t)2 * NTOK + tok) * 2 + hs];
        const float mx = fmaxf(l0, fmaxf(l1, l2)), e0 = __expf(l0 - mx), e1 = __expf(l1 - mx), e2 = __expf(l2 - mx), rs = 1.0f / (e0 + e1 + e2);
        const float a0 = e0 * rs, a1 = e1 * rs, a2 = e2 * rs;
        const u32x4 w0 = *(const u32x4*)(P_OB3(p) + ((size_t)0 * NTOK + tok) * 128 + 64 * hs + d0);
        const u32x4 w1 = *(const u32x4*)(P_OB3(p) + ((size_t)1 * NTOK + tok) * 128 + 64 * hs + d0);
        const u32x4 w2 = *(const u32x4*)(P_OB3(p) + ((size_t)2 * NTOK + tok) * 128 + 64 * hs + d0);
        u32x4 o;
#pragma unroll
        for (int j = 0; j < 4; ++j) o[j] = pk2(a0 * bflo(w0[j]) + a1 * bflo(w1[j]) + a2 * bflo(w2[j]), a0 * bfhi(w0[j]) + a1 * bfhi(w1[j]) + a2 * bfhi(w2[j]));
        *(u32x4*)(P_OC(p) + (size_t)tok * OCW + 384 + 64 * hs + d0) = o;
    }
}

namespace g8 {
constexpr int BM = 256, BK = 64, HALF = 128, HTB = HALF * BK * 2, NXCD = 8, WGM = 8;
DI int lds_byte(int r, int c) { const int st = (r >> 4) * 2 + (c >> 5), rr = r & 15, cc = c & 31, ob = rr * 64 + cc * 2; return st * 1024 + (ob ^ (((ob >> 9) & 1) << 5)); }
DI void stage_rc(int b, int& R, int& C) { const int st = b / 1024, sb = b % 1024, swz = sb ^ (((sb >> 9) & 1) << 5); R = (st >> 1) * 16 + swz / 64; C = (st & 1) * 32 + (swz % 64) / 2; }
DI int perm32(int rho) { const int n = rho >> 4, i = rho & 15; return 8 * (i >> 2) + 4 * n + (i & 3); }
struct Unit { int pm, pn, aux; };
struct StaticOrder {
    int nM, nN, nwg, G, c;
    DI void init(int M, int N, int G_, int c_) { nM = M / BM; nN = N / BM; nwg = nM * nN; G = G_; c = c_; }
    DI bool next(int i, Unit& u) const {
        const long L = (long)i * G + c; if (L >= nwg) return false;
        int wgid = (int)L; { const int q = nwg / NXCD, r = nwg % NXCD, xcd = wgid % NXCD, off = wgid / NXCD; wgid = (xcd < r ? xcd * (q + 1) : r * (q + 1) + (xcd - r) * q) + off; }
        const int nig = WGM * nN, gid = wgid / nig, fm = gid * WGM, gsz = (nM - fm) < WGM ? (nM - fm) : WGM;
        u.pm = fm + ((wgid % nig) % gsz); u.pn = (wgid % nig) / gsz; u.aux = 0; return true;
    }
};
typedef f32x4 Acc[2][2][4][2];
typedef int i32x4 __attribute__((ext_vector_type(4)));
typedef int i32x8 __attribute__((ext_vector_type(8)));
DI bf16x8 half8(const i32x8& v, int k) { const i32x4 x = k == 0 ? __builtin_shufflevector(v, v, 0, 1, 2, 3) : __builtin_shufflevector(v, v, 4, 5, 6, 7); return __builtin_bit_cast(bf16x8, x); }
DI i32x8 cat8(const bf16x8& a, const bf16x8& b) { const i32x4 x = __builtin_bit_cast(i32x4, a), y = __builtin_bit_cast(i32x4, b); return __builtin_shufflevector(x, y, 0, 1, 2, 3, 4, 5, 6, 7); }

template <class Desc, class Epi, class Sched, bool ALIGN_EPI>
DI void gemm_phase(LAS unsigned char* lds, const Desc& D, const Sched& S, const Epi& E) {
    const int tid = otid(), wid = __builtin_amdgcn_readfirstlane(tid >> 6), lane = tid & 63, wr = wid >> 2, wc = wid & 3, fr = lane & 15, fq = lane >> 4;
    int R0, C0, R1, C1; stage_rc(tid * 16, R0, C0); stage_rc(tid * 16 + 8192, R1, C1);
    const int Rb0 = Epi::PERM ? ((R0 & ~31) + perm32(R0 & 31)) : R0, Rb1 = Epi::PERM ? ((R1 & ~31) + perm32(R1 & 31)) : R1;
    constexpr unsigned LDA2 = Desc::lda * 2, LDB2 = Desc::ldb * 2;
    const size_t kstep = (size_t)(BK * 2);
    const unsigned ldsw = (unsigned)wid * 1024u;
    const int aoff = lds_byte(wr * 64 + fr, fq * 8), boff = lds_byte(wc * 32 + fr, fq * 8);
#define G8_SA(b, h) (((b) * 2 + (h)) * HTB)
#define G8_SB(b, h) ((4 + (b) * 2 + (h)) * HTB)
#define G8_STAGE(bufoff, gbase, o0, o1) do { \
        __builtin_amdgcn_global_load_lds((const unsigned*)((const char*)(gbase) + (o0)), (LAS unsigned*)(lds + (bufoff) + ldsw), 16, 0, 0); \
        __builtin_amdgcn_global_load_lds((const unsigned*)((const char*)(gbase) + (o1)), (LAS unsigned*)(lds + (bufoff) + ldsw + 8192), 16, 0, 0); } while (0)
#define G8_LDA(dst, b, h) do { _Pragma("unroll") for (int m = 0; m < 4; ++m) { const bf16x8 lo_ = *(const LAS bf16x8*)(lds + G8_SA(b, h) + aoff + m * 2048), hi_ = *(const LAS bf16x8*)(lds + G8_SA(b, h) + aoff + m * 2048 + 1024); dst[m] = cat8(lo_, hi_); } } while (0)
#define G8_LDB(dst, b, h) do { _Pragma("unroll") for (int n = 0; n < 2; ++n) { const bf16x8 lo_ = *(const LAS bf16x8*)(lds + G8_SB(b, h) + boff + n * 2048), hi_ = *(const LAS bf16x8*)(lds + G8_SB(b, h) + boff + n * 2048 + 1024); dst[n] = cat8(lo_, hi_); } } while (0)
#define G8_MMA(ai, bj, At, Bt) do { __builtin_amdgcn_s_setprio(1); _Pragma("unroll") for (int m = 0; m < 4; ++m) _Pragma("unroll") for (int n = 0; n < 2; ++n) _Pragma("unroll") for (int k = 0; k < 2; ++k) \
        acc[ai][bj][m][n] = __builtin_amdgcn_mfma_f32_16x16x32_bf16(half8(Bt[n], k), half8(At[m], k), acc[ai][bj][m][n], 0, 0, 0); __builtin_amdgcn_s_setprio(0); } while (0)
#define G8_MMA8(ai, bj, At, Bt) do { __builtin_amdgcn_s_setprio(1); _Pragma("unroll") for (int m = 0; m < 4; ++m) _Pragma("unroll") for (int n = 0; n < 2; ++n) \
        asm volatile("v_mfma_scale_f32_16x16x128_f8f6f4 %0, %1, %2, %0, %3, %3 op_sel_hi:[0,0,0]" : "+v"(acc[ai][bj][m][n]) : "v"(Bt[n]), "v"(At[m]), "v"(one_scale));     __builtin_amdgcn_s_setprio(0); } while (0)
#define G8_MM(ai, bj, At, Bt) do { if constexpr (Desc::FP8) G8_MMA8(ai, bj, At, Bt); else G8_MMA(ai, bj, At, Bt); } while (0)
#define G8_WAIT_V(n) asm volatile("s_waitcnt vmcnt(" #n ")" ::: "memory")
#define G8_WAIT_L(n) asm volatile("s_waitcnt lgkmcnt(" #n ")" ::: "memory")
#define G8_BAR __builtin_amdgcn_s_barrier()
#define G8_SCHED __builtin_amdgcn_sched_barrier(0)
#define G8_MKA(u, uidx, o) do { \
        o[0][0] = (unsigned)(Desc::GATHER ? D.a_row(u, uidx, R0) : R0) * LDA2 + (unsigned)C0 * 2u; o[0][1] = (unsigned)(Desc::GATHER ? D.a_row(u, uidx, R1) : R1) * LDA2 + (unsigned)C1 * 2u; \
        if (Desc::GATHER) { o[1][0] = (unsigned)D.a_row(u, uidx, HALF + R0) * LDA2 + (unsigned)C0 * 2u; o[1][1] = (unsigned)D.a_row(u, uidx, HALF + R1) * LDA2 + (unsigned)C1 * 2u; } } while (0)
#define G8_MKB(u, o, hs) do { const unsigned dl_ = (unsigned)D.dilB(u) * LDB2; hs = (unsigned)HALF * dl_; \
        o[0] = (unsigned)Rb0 * dl_ + (unsigned)C0 * 2u; o[1] = (unsigned)Rb1 * dl_ + (unsigned)C1 * 2u; } while (0)
#define G8_A1(o, i) (Desc::GATHER ? o[1][i] : o[0][i] + (unsigned)HALF * LDA2)
    Unit cur, nxt; int ui = 0;
    if (!S.next(0, cur)) return;
    Acc acc;
#pragma unroll
    for (int a = 0; a < 2; ++a)
#pragma unroll
        for (int b = 0; b < 2; ++b)
#pragma unroll
            for (int m = 0; m < 4; ++m)
#pragma unroll
                for (int n = 0; n < 2; ++n) acc[a][b][m][n] = (f32x4){0.f, 0.f, 0.f, 0.f};
    int one_scale = 0x7f7f7f7f; asm volatile("" : "+v"(one_scale));
    i32x8 At[4], B0[2], B1[2];
    unsigned cAo[2][2], cBo[2], nAo[2][2], nBo[2], cBh, nBh;
    G8_MKA(cur, 0, cAo); G8_MKB(cur, cBo, cBh); nBh = cBh;
    const char* cA = D.a_base(cur); const char* cB = D.b_base(cur);
    G8_STAGE(G8_SB(0, 0), cB, cBo[0], cBo[1]); G8_STAGE(G8_SB(0, 1), cB + cBh, cBo[0], cBo[1]); G8_STAGE(G8_SA(0, 0), cA, cAo[0][0], cAo[0][1]); G8_STAGE(G8_SA(0, 1), cA, G8_A1(cAo, 0), G8_A1(cAo, 1));
    if (wr == 1) G8_BAR;
    G8_WAIT_V(2); G8_BAR;
    G8_STAGE(G8_SB(1, 0), cB + kstep, cBo[0], cBo[1]); G8_STAGE(G8_SA(1, 0), cA + kstep, cAo[0][0], cAo[0][1]); G8_STAGE(G8_SB(1, 1), cB + kstep + cBh, cBo[0], cBo[1]);
    G8_WAIT_V(6); G8_BAR;
    for (;;) {
        const bool has_next = S.next(ui + 1, nxt);
        const char* nA = cA; const char* nB = cB;
        if (has_next) { nA = D.a_base(nxt); nB = D.b_base(nxt); }
        if (Desc::GATHER) { if (has_next) G8_MKA(nxt, ui + 1, nAo); else { nAo[0][0] = cAo[0][0]; nAo[0][1] = cAo[0][1]; nAo[1][0] = cAo[1][0]; nAo[1][1] = cAo[1][1]; } }
        if (Desc::VARB) { if (has_next) G8_MKB(nxt, nBo, nBh); else { nBo[0] = cBo[0]; nBo[1] = cBo[1]; nBh = cBh; } }
        const int nt = D.nt(cur);
#pragma unroll 1
        for (int t = 0; t < nt; t += 2) {
            const bool last = (t == nt - 2);
            const char* a1 = cA + (size_t)(t + 1) * kstep;
            const char* a2 = last ? nA : cA + (size_t)(t + 2) * kstep; const char* b2 = last ? nB : cB + (size_t)(t + 2) * kstep;
            const char* a3 = a2 + kstep; const char* b3 = b2 + kstep;
            const unsigned xa00 = (Desc::GATHER && last) ? nAo[0][0] : cAo[0][0], xa01 = (Desc::GATHER && last) ? nAo[0][1] : cAo[0][1];
            const unsigned xa10 = Desc::GATHER ? (last ? nAo[1][0] : cAo[1][0]) : xa00 + (unsigned)HALF * LDA2, xa11 = Desc::GATHER ? (last ? nAo[1][1] : cAo[1][1]) : xa01 + (unsigned)HALF * LDA2;
            const unsigned xb0 = (Desc::VARB && last) ? nBo[0] : cBo[0], xb1 = (Desc::VARB && last) ? nBo[1] : cBo[1], xbh = (Desc::VARB && last) ? nBh : cBh;
            G8_LDB(B0, 0, 0); G8_LDB(B1, 0, 1); G8_SCHED; G8_LDA(At, 0, 0); G8_STAGE(G8_SA(1, 1), a1, G8_A1(cAo, 0), G8_A1(cAo, 1));
            G8_WAIT_V(8); G8_WAIT_L(0); G8_BAR; G8_MM(0, 0, At, B0); G8_MM(0, 1, At, B1); G8_BAR; G8_SCHED;
            G8_LDA(At, 0, 1); G8_STAGE(G8_SB(0, 0), b2, xb0, xb1); G8_STAGE(G8_SB(0, 1), b2 + xbh, xb0, xb1); G8_STAGE(G8_SA(0, 0), a2, xa00, xa01);
            G8_WAIT_V(8); G8_WAIT_L(0); G8_BAR; G8_MM(1, 0, At, B0); G8_MM(1, 1, At, B1); G8_BAR; G8_SCHED;
            G8_LDB(B0, 1, 0); G8_LDB(B1, 1, 1); G8_SCHED; G8_LDA(At, 1, 0); G8_STAGE(G8_SA(0, 1), a2, xa10, xa11);
            G8_WAIT_V(8); G8_WAIT_L(0); G8_BAR; G8_MM(0, 0, At, B0); G8_MM(0, 1, At, B1); G8_BAR; G8_SCHED;
            G8_LDA(At, 1, 1); G8_STAGE(G8_SB(1, 0), b3, xb0, xb1); G8_STAGE(G8_SB(1, 1), b3 + xbh, xb0, xb1); G8_STAGE(G8_SA(1, 0), a3, xa00, xa01);
            G8_WAIT_V(8); G8_WAIT_L(0); G8_BAR; G8_MM(1, 0, At, B0); G8_MM(1, 1, At, B1); G8_BAR; G8_SCHED;
        }
        if constexpr (ALIGN_EPI) { if (wr == 0) G8_BAR; }
        if constexpr (Desc::FP8) asm volatile("s_nop 15\n\ts_nop 15" ::: "memory");
        E(acc, cur, wr, wc, fr, fq);
        if (!has_next) break;
#pragma unroll
        for (int a = 0; a < 2; ++a)
#pragma unroll
            for (int b = 0; b < 2; ++b)
#pragma unroll
                for (int m = 0; m < 4; ++m)
#pragma unroll
                    for (int n = 0; n < 2; ++n) acc[a][b][m][n] = (f32x4){0.f, 0.f, 0.f, 0.f};
        if constexpr (Desc::FP8) asm volatile("s_nop 7" ::: "memory");
        cur = nxt; cA = nA; cB = nB; ++ui;
        if (Desc::GATHER) { cAo[0][0] = nAo[0][0]; cAo[0][1] = nAo[0][1]; cAo[1][0] = nAo[1][0]; cAo[1][1] = nAo[1][1]; }
        if (Desc::VARB) { cBo[0] = nBo[0]; cBo[1] = nBo[1]; cBh = nBh; }
        if constexpr (ALIGN_EPI) { if (wr == 1) G8_BAR; }
    }
    G8_WAIT_V(0);
    if constexpr (!ALIGN_EPI) { if (wr == 0) G8_BAR; }
    G8_BAR;
#undef G8_SA
#undef G8_SB
#undef G8_STAGE
#undef G8_LDA
#undef G8_LDB
#undef G8_MMA
#undef G8_MMA8
#undef G8_MM
#undef G8_WAIT_V
#undef G8_WAIT_L
#undef G8_BAR
#undef G8_SCHED
#undef G8_MKA
#undef G8_MKB
#undef G8_A1
}
DI unsigned cvt2(float lo, float hi) { typedef __bf16 bf2_t __attribute__((ext_vector_type(2))); const f32x2 v = {lo, hi}; const bf2_t b = __builtin_convertvector(v, bf2_t); return __builtin_bit_cast(unsigned, b); }
DI u32x4 pack8(const f32x4& a, const f32x4& b) { u32x4 w; w[0] = cvt2(a[0], a[1]); w[1] = cvt2(a[2], a[3]); w[2] = cvt2(b[0], b[1]); w[3] = cvt2(b[2], b[3]); return w; }
DI float fsig(float x) { return __builtin_amdgcn_rcpf(1.0f + __expf(-x)); }

struct DescMoe1 { static constexpr bool GATHER = true, VARB = false, FP8 = true; static constexpr int lda = DM / 2, ldb = DM / 2; const bf16_t* XN8; const bf16_t* WGU; const LAS int* rowlist;
    DI const char* a_base(const Unit&) const { return (const char*)XN8; }
    DI const char* b_base(const Unit& u) const { return (const char*)WGU + ((size_t)(u.pm >> 3) * 4096 + (size_t)u.pn * 256) * DM; }
    DI int a_row(const Unit&, int uidx, int r) const { return rowlist[uidx * 256 + r]; }
    DI int nt(const Unit&) const { return DM / 128; } DI int dilB(const Unit&) const { return 1; } };
struct EpiSwiglu { static constexpr bool PERM = true; unsigned char* HID8;
    DI void operator()(const Acc& acc, const Unit& u, int wr, int wc, int fr, int fq) const {
        const int row0 = u.pm * BM + wr * 64 + fr, col0 = u.pn * 128 + wc * 32 + 8 * fq; constexpr float WI = 1.0f / W8_SCALE;
#pragma unroll
        for (int ai = 0; ai < 2; ++ai)
#pragma unroll
            for (int m = 0; m < 4; ++m) { f32x4 h0, h1;
#pragma unroll
                for (int j = 0; j < 4; ++j) { const float g0 = acc[ai][0][m][0][j] * WI, g1 = acc[ai][0][m][1][j] * WI;
                    h0[j] = g0 * fsig(g0) * acc[ai][1][m][0][j] * (WI * H8_SCALE); h1[j] = g1 * fsig(g1) * acc[ai][1][m][1][j] * (WI * H8_SCALE); }
                u32x2 w; w[0] = pk4_fp8(h0[0], h0[1], h0[2], h0[3]); w[1] = pk4_fp8(h1[0], h1[1], h1[2], h1[3]);
                *(u32x2*)(HID8 + (size_t)(row0 + ai * HALF + m * 16) * FF + col0) = w; }
    } };
struct DescMoe2 { static constexpr bool GATHER = false, VARB = false, FP8 = true; static constexpr int lda = FF / 2, ldb = FF / 2; const unsigned char* HID8; const bf16_t* WD;
    DI const char* a_base(const Unit& u) const { return (const char*)HID8 + (size_t)u.pm * 256 * FF; }
    DI const char* b_base(const Unit& u) const { return (const char*)WD + ((size_t)(u.pm >> 3) * 1024 + (size_t)u.pn * 256) * FF; }
    DI int a_row(const Unit&, int, int r) const { return r; }
    DI int nt(const Unit&) const { return FF / 128; } DI int dilB(const Unit&) const { return 1; } };
struct EpiY { static constexpr bool PERM = true; bf16_t* Y; const float* VAL;
    DI void operator()(const Acc& acc, const Unit& u, int wr, int wc, int fr, int fq) const {
        const int row0 = u.pm * BM + wr * 64 + fr, col0 = u.pn * BM + wc * 32 + 8 * fq;
        float vv[2][4];
#pragma unroll
        for (int ai = 0; ai < 2; ++ai)
#pragma unroll
            for (int m = 0; m < 4; ++m) vv[ai][m] = VAL[row0 + ai * HALF + m * 16];
#pragma unroll
        for (int ai = 0; ai < 2; ++ai)
#pragma unroll
            for (int m = 0; m < 4; ++m) { const int row = row0 + ai * HALF + m * 16; const float v = vv[ai][m] * (1.0f / (W8_SCALE * H8_SCALE));
#pragma unroll
                for (int bj = 0; bj < 2; ++bj) *(u32x4*)(Y + (size_t)row * DM + col0 + bj * HALF) = pack8(acc[ai][bj][m][0] * v, acc[ai][bj][m][1] * v); }
    } };
struct DescOut { static constexpr bool GATHER = false, VARB = false, FP8 = false; static constexpr int lda = DM, ldb = DM; const bf16_t* MG; const bf16_t* WO;
    DI const char* a_base(const Unit& u) const { return (const char*)(MG + (size_t)u.pm * 256 * DM); }
    DI const char* b_base(const Unit& u) const { return (const char*)(WO + (size_t)u.pn * 256 * DM); }
    DI int a_row(const Unit&, int, int r) const { return r; }
    DI int nt(const Unit&) const { return DM / BK; } DI int dilB(const Unit&) const { return 1; } };
struct EpiResid { static constexpr bool PERM = true; bf16_t* X;
    DI void operator()(const Acc& acc, const Unit& u, int wr, int wc, int fr, int fq) const {
        const int row0 = u.pm * BM + wr * 64 + fr, col0 = u.pn * BM + wc * 32 + 8 * fq;
#pragma unroll
        for (int ai = 0; ai < 2; ++ai) {
            u32x4 x[4][2];
#pragma unroll
            for (int m = 0; m < 4; ++m)
#pragma unroll
                for (int bj = 0; bj < 2; ++bj) x[m][bj] = *(const u32x4*)(X + (size_t)(row0 + ai * HALF + m * 16) * DM + col0 + bj * HALF);
#pragma unroll
            for (int m = 0; m < 4; ++m)
#pragma unroll
                for (int bj = 0; bj < 2; ++bj) { f32x4 v0 = acc[ai][bj][m][0], v1 = acc[ai][bj][m][1]; const u32x4 ww = x[m][bj];
                    v0[0] += bflo(ww[0]); v0[1] += bfhi(ww[0]); v0[2] += bflo(ww[1]); v0[3] += bfhi(ww[1]); v1[0] += bflo(ww[2]); v1[1] += bfhi(ww[2]); v1[2] += bflo(ww[3]); v1[3] += bfhi(ww[3]);
                    *(u32x4*)(X + (size_t)(row0 + ai * HALF + m * 16) * DM + col0 + bj * HALF) = pack8(v0, v1); }
            __builtin_amdgcn_sched_barrier(0);
        }
    } };
struct DescInproj { static constexpr bool GATHER = false, VARB = false, FP8 = false; static constexpr int lda = DM, ldb = DM; const bf16_t* XN; const bf16_t* WIN;
    DI const char* a_base(const Unit& u) const { return (const char*)(XN + (size_t)u.pm * 256 * DM); }
    DI const char* b_base(const Unit& u) const { return (const char*)(WIN + (size_t)u.pn * 256 * DM); }
    DI int a_row(const Unit&, int, int r) const { return r; }
    DI int nt(const Unit&) const { return DM / BK; } DI int dilB(const Unit&) const { return 1; } };
struct EpiInproj { static constexpr bool PERM = true; bf16_t* QK; unsigned char* G; const float* cosT; const float* sinT; const float* bgate;
    DI void operator()(const Acc& acc, const Unit& u, int wr, int wc, int fr, int fq) const {
        const int row0 = u.pm * BM + wr * 64 + fr;
        if (u.pn < 5) {
            const int hr = 4 * u.pn + wc; const float sc = (hr < 6 || (hr >= 8 && hr < 14)) ? 0.125f * 1.4426950408889634f : 1.0f;
#pragma unroll
            for (int ai = 0; ai < 2; ++ai) {
                f32x4 tc[4][2], ts[4][2];
#pragma unroll
                for (int m = 0; m < 4; ++m) { const int pos = (row0 + ai * HALF + m * 16) & (SEQ - 1);
                    tc[m][0] = *(const f32x4*)(cosT + pos * 32 + 8 * fq); tc[m][1] = *(const f32x4*)(cosT + pos * 32 + 8 * fq + 4); ts[m][0] = *(const f32x4*)(sinT + pos * 32 + 8 * fq); ts[m][1] = *(const f32x4*)(sinT + pos * 32 + 8 * fq + 4); }
#pragma unroll
                for (int m = 0; m < 4; ++m) { const int row = row0 + ai * HALF + m * 16;
                    const f32x4 c0 = tc[m][0], c1 = tc[m][1], s0 = ts[m][0], s1 = ts[m][1];
                    const f32x4 a0 = acc[ai][0][m][0], a1 = acc[ai][0][m][1], b0 = acc[ai][1][m][0], b1 = acc[ai][1][m][1];
                    bf16_t* o = QK + (size_t)row * QKW + 64 * hr + 8 * fq;
                    *(u32x4*)o = pack8((a0 * c0 - b0 * s0) * sc, (a1 * c1 - b1 * s1) * sc);
                    *(u32x4*)(o + 32) = pack8((b0 * c0 + a0 * s0) * sc, (b1 * c1 + a1 * s1) * sc); }
                __builtin_amdgcn_sched_barrier(0);
            }
        } else if (u.pn < 7) {
            const float sc = u.pn == 5 ? 0.125f * 1.4426950408889634f : 1.0f; const int col0 = 1280 + (u.pn - 5) * 256 + wc * 32 + 8 * fq;
#pragma unroll
            for (int ai = 0; ai < 2; ++ai)
#pragma unroll
                for (int m = 0; m < 4; ++m)
#pragma unroll
                    for (int bj = 0; bj < 2; ++bj) *(u32x4*)(QK + (size_t)(row0 + ai * HALF + m * 16) * QKW + col0 + bj * HALF) = pack8(acc[ai][bj][m][0] * sc, acc[ai][bj][m][1] * sc);
        } else {
            const int col0 = (u.pn - 7) * 256 + wc * 32 + 8 * fq;
            f32x4 bv[2][2];
#pragma unroll
            for (int bj = 0; bj < 2; ++bj)
#pragma unroll
                for (int n = 0; n < 2; ++n) bv[bj][n] = *(const f32x4*)(bgate + col0 + bj * HALF + 4 * n);
#pragma unroll
            for (int ai = 0; ai < 2; ++ai)
#pragma unroll
                for (int m = 0; m < 4; ++m)
#pragma unroll
                    for (int bj = 0; bj < 2; ++bj) { f32x4 v0 = acc[ai][bj][m][0] + bv[bj][0], v1 = acc[ai][bj][m][1] + bv[bj][1];
#pragma unroll
                        for (int j = 0; j < 4; ++j) { v0[j] = fsig(v0[j]) * 255.0f + 0.5f; v1[j] = fsig(v1[j]) * 255.0f + 0.5f; }
                        u32x2 w; w[0] = (unsigned)v0[0] | ((unsigned)v0[1] << 8) | ((unsigned)v0[2] << 16) | ((unsigned)v0[3] << 24); w[1] = (unsigned)v1[0] | ((unsigned)v1[1] << 8) | ((unsigned)v1[2] << 16) | ((unsigned)v1[3] << 24);
                        *(u32x2*)(G + (size_t)(row0 + ai * HALF + m * 16) * 3072 + col0 + bj * HALF) = w; }
        }
    } };
struct DescVT { static constexpr bool GATHER = false, VARB = true, FP8 = false; static constexpr int lda = DM, ldb = DM; const bf16_t* WV; const bf16_t* XN;
    DI const char* a_base(const Unit& u) const { return (const char*)(WV + (size_t)u.pm * 256 * DM); }
    DI const char* b_base(const Unit& u) const { return (const char*)(XN + (u.pm < 2 ? (size_t)u.pn * 256 : (size_t)((u.pn >> 4) * SEQ + (u.pn & 15))) * DM); }
    DI int a_row(const Unit&, int, int r) const { return r; }
    DI int nt(const Unit&) const { return DM / BK; } DI int dilB(const Unit& u) const { return u.pm < 2 ? 1 : 16; } };
struct EpiVT { static constexpr bool PERM = true; bf16_t* VT;
    DI void operator()(const Acc& acc, const Unit& u, int wr, int wc, int fr, int fq) const {
        const int row0 = u.pm * BM + wr * 64 + fr, col0 = u.pn * BM + wc * 32 + 8 * fq;
#pragma unroll
        for (int ai = 0; ai < 2; ++ai)
#pragma unroll
            for (int m = 0; m < 4; ++m)
#pragma unroll
                for (int bj = 0; bj < 2; ++bj) *(u32x4*)(VT + (size_t)(row0 + ai * HALF + m * 16) * NTOK + col0 + bj * HALF) = pack8(acc[ai][bj][m][0], acc[ai][bj][m][1]);
    } };
struct DescMerge { static constexpr bool GATHER = false, VARB = false, FP8 = false; static constexpr int lda = OCW, ldb = 768; const bf16_t* OC; const bf16_t* WM;
    DI int k0(const Unit& u) const { return u.aux == 0 ? 0 : u.aux == 1 ? 384 : 512; }
    DI const char* a_base(const Unit& u) const { return (const char*)(OC + (size_t)u.pm * 256 * OCW + k0(u)); }
    DI const char* b_base(const Unit& u) const { return (const char*)(WM + (size_t)u.pn * 256 * 768 + k0(u)); }
    DI int a_row(const Unit&, int, int r) const { return r; }
    DI int nt(const Unit& u) const { return u.aux == 0 ? 6 : u.aux == 1 ? 2 : 4; } DI int dilB(const Unit&) const { return 1; } };
struct MergeOrder { StaticOrder base;
    DI bool next(int i, Unit& u) const { const int q = i / 3; if (!base.next(q, u)) return false; u.aux = i - 3 * q; return true; } };
struct EpiMerge { static constexpr bool PERM = true; bf16_t* MG; const unsigned char* G;
    DI void operator()(const Acc& acc, const Unit& u, int wr, int wc, int fr, int fq) const {
        const int row0 = u.pm * BM + wr * 64 + fr, col0 = u.pn * BM + wc * 32 + 8 * fq;
#pragma unroll
        for (int ai = 0; ai < 2; ++ai) {
            u32x2 g[4][2]; u32x4 w[4][2];
#pragma unroll
            for (int m = 0; m < 4; ++m)
#pragma unroll
                for (int bj = 0; bj < 2; ++bj) { const int row = row0 + ai * HALF + m * 16, col = col0 + bj * HALF;
                    g[m][bj] = *(const u32x2*)(G + (size_t)row * 3072 + 1024 * u.aux + col);
                    if (u.aux != 0) w[m][bj] = *(const u32x4*)(MG + (size_t)row * DM + col); else w[m][bj] = (u32x4){0u, 0u, 0u, 0u}; }
#pragma unroll
            for (int m = 0; m < 4; ++m)
#pragma unroll
                for (int bj = 0; bj < 2; ++bj) { const int row = row0 + ai * HALF + m * 16, col = col0 + bj * HALF;
                    const u32x2 gg = g[m][bj]; const u32x4 ww = w[m][bj]; constexpr float GI = 1.0f / 255.0f;
                    f32x4 v0 = acc[ai][bj][m][0] * GI, v1 = acc[ai][bj][m][1] * GI;
                    v0[0] = v0[0] * (float)(gg[0] & 255u) + bflo(ww[0]); v0[1] = v0[1] * (float)((gg[0] >> 8) & 255u) + bfhi(ww[0]); v0[2] = v0[2] * (float)((gg[0] >> 16) & 255u) + bflo(ww[1]); v0[3] = v0[3] * (float)(gg[0] >> 24) + bfhi(ww[1]);
                    v1[0] = v1[0] * (float)(gg[1] & 255u) + bflo(ww[2]); v1[1] = v1[1] * (float)((gg[1] >> 8) & 255u) + bfhi(ww[2]); v1[2] = v1[2] * (float)((gg[1] >> 16) & 255u) + bflo(ww[3]); v1[3] = v1[3] * (float)(gg[1] >> 24) + bfhi(ww[3]);
                    *(u32x4*)(MG + (size_t)row * DM + col) = pack8(v0, v1); }
            __builtin_amdgcn_sched_barrier(0);
        }
    } };
}
DI void f_inproj_phase(const Params& p, int l, LAS unsigned char* lds) {
    { g8::StaticOrder S; S.init(NTOK, 4352, gridDim.x, blockIdx.x);
      g8::DescInproj D{P_XN(p), P_W(p, l, LW_WIN)}; g8::EpiInproj E{P_QK(p), P_G(p), P_COS(p), P_SIN(p), p.b_gate + (size_t)l * 3072};
      g8::gemm_phase<g8::DescInproj, g8::EpiInproj, g8::StaticOrder, true>(lds, D, S, E); }
    { g8::StaticOrder S; S.init(VCH, NTOK, gridDim.x, (blockIdx.x + gridDim.x - 64) % gridDim.x);
      g8::DescVT D{P_W(p, l, LW_WV), P_XN(p)}; g8::EpiVT E{P_VT(p)};
      g8::gemm_phase<g8::DescVT, g8::EpiVT, g8::StaticOrder, true>(lds, D, S, E); }
}
struct OneUnit { int pm, pn; DI bool next(int i, g8::Unit& u) const { if (i != 0) return false; u.pm = pm; u.pn = pn; u.aux = 0; return true; } };
DI void f_gate_tail_units(const Params& p, int l, LAS unsigned char* lds) {
    if (blockIdx.x < 128) {
        OneUnit S{(int)(blockIdx.x >> 1), 17 + (int)(blockIdx.x & 1)};
        g8::DescInproj D{P_XN(p), P_W(p, l, LW_WIN)}; g8::EpiInproj E{P_QK(p), P_G(p), P_COS(p), P_SIN(p), p.b_gate + (size_t)l * 3072};
        g8::gemm_phase<g8::DescInproj, g8::EpiInproj, OneUnit, false>(lds, D, S, E);
        __syncthreads();
    }
}
DI void f_merge_phase(const Params& p, int l, LAS unsigned char* lds) {
    g8::MergeOrder S; S.base.init(NTOK, DM, gridDim.x, blockIdx.x);
    g8::DescMerge D{P_OC(p), P_W(p, l, LW_WM)}; g8::EpiMerge E{P_MG(p), P_G(p)};
    g8::gemm_phase<g8::DescMerge, g8::EpiMerge, g8::MergeOrder, true>(lds, D, S, E);
}

DI void f_moe1_phase(const Params& p, int l, LAS unsigned char* lds) {
    g8::StaticOrder S; S.init(NROWS_E, 2 * FF, gridDim.x, blockIdx.x);
    LAS int* rowlist = (LAS int*)(lds + 131072 + 64);
    g8::Unit u;
    for (int i = 0; i < 8 && S.next(i, u); ++i)
        for (int r = otid(); r < 256; r += 512) rowlist[i * 256 + r] = ((u.pm >> 1) & 3) * SEQ + P_IDX(p)[u.pm * 256 + r];
    __syncthreads();
    g8::DescMoe1 D{(const bf16_t*)P_XN8(p), P_W(p, l, LW_WGU), rowlist}; g8::EpiSwiglu E{(unsigned char*)P_HID(p)};
    g8::gemm_phase<g8::DescMoe1, g8::EpiSwiglu, g8::StaticOrder, true>(lds, D, S, E);
}
DI void f_moe2_phase(const Params& p, int l, LAS unsigned char* lds) {
    g8::StaticOrder S; S.init(NROWS_E, DM, gridDim.x, blockIdx.x);
    g8::DescMoe2 D{(const unsigned char*)P_HID(p), P_W(p, l, LW_WD)}; g8::EpiY E{P_Y(p), P_VAL(p)};
    g8::gemm_phase<g8::DescMoe2, g8::EpiY, g8::StaticOrder, true>(lds, D, S, E);
}
DI void f_out_phase(const Params& p, int l, LAS unsigned char* lds) {
    g8::StaticOrder S; S.init(NTOK, DM, gridDim.x, blockIdx.x);
    g8::DescOut D{P_MG(p), P_W(p, l, LW_WO)}; g8::EpiResid E{P_X(p)};
    g8::gemm_phase<g8::DescOut, g8::EpiResid, g8::StaticOrder, false>(lds, D, S, E);
}

#define XB_TMO      128
#define XB_XCNT(j)  (256  + 64 * (j))
#define XB_XSUB(j)  (1280 + 64 * (j))
#define XB_XGEN(j)  (2304 + 64 * (j))
#define XB_TOP      3328
#define XB_TOPGEN   3392
#define XCD_BAR_WORDS 3456
#define XB_SPIN_CAP (1u << 22)

__device__ __forceinline__ unsigned xb_ld(unsigned* p)              { return __hip_atomic_load(p, __ATOMIC_RELAXED, __HIP_MEMORY_SCOPE_AGENT); }
__device__ __forceinline__ unsigned xb_add(unsigned* p, unsigned v) { return __hip_atomic_fetch_add(p, v, __ATOMIC_RELAXED, __HIP_MEMORY_SCOPE_AGENT); }
__device__ __forceinline__ unsigned xb_xcc_id() { return (unsigned)__builtin_amdgcn_s_getreg((3 << 11) | 20) & 0xFu; }
#define XB_SPIN(cond, bar) do { unsigned _sp = 0; while (cond) { __builtin_amdgcn_s_sleep(1); \
    if ((++_sp & 255u) == 0u) { if (xb_ld(&(bar)[XB_TMO])) break; if (_sp > XB_SPIN_CAP) { atomicAdd(&(bar)[XB_TMO], 1u); break; } } } } while (0)

struct XcdBarrier {
    unsigned* bar; unsigned x;
    volatile LAS unsigned* st;
};

__device__ __forceinline__ XcdBarrier xcd_barrier_post(unsigned* bar, volatile LAS unsigned* st) {
    XcdBarrier b; b.bar = bar; b.x = xb_xcc_id(); b.st = st;
    if (threadIdx.x == 0) (void)xb_add(&bar[XB_XCNT(b.x)], 1u);
    return b;
}
__device__ __forceinline__ void xcd_barrier_complete(unsigned* bar, unsigned x, unsigned& nloc, unsigned& nx) {
    const unsigned G = gridDim.x * gridDim.y * gridDim.z;
    unsigned sum, cnt, mine, sp = 0u;
    for (;;) {
        sum = 0u; cnt = 0u; mine = 0u;
#pragma unroll
        for (unsigned j = 0; j < 16; ++j) { const unsigned c = xb_ld(&bar[XB_XCNT(j)]); sum += c; cnt += (c > 0u) ? 1u : 0u; mine = (j == x) ? c : mine; }
        if (sum == G) break;
        __builtin_amdgcn_s_sleep(1);
        if ((++sp & 255u) == 0u) { if (xb_ld(&bar[XB_TMO])) break; if (sp > XB_SPIN_CAP) { atomicAdd(&bar[XB_TMO], 1u); break; } }
    }
    nloc = mine > 0u ? mine : 1u; nx = cnt > 0u ? cnt : 1u;
}

__device__ __forceinline__ void xcd_barrier(const XcdBarrier& b) {
    asm volatile("s_waitcnt vmcnt(0)" ::: "memory");
    __syncthreads();
    if (threadIdx.x == 0) {
        unsigned* bar = b.bar;
        __builtin_amdgcn_s_waitcnt(0);
        unsigned nloc = b.st[0], nx = b.st[1];
        if (nloc == 0u) { xcd_barrier_complete(bar, b.x, nloc, nx); b.st[0] = nloc; b.st[1] = nx; }
        const unsigned old = xb_add(&bar[XB_XSUB(b.x)], 1u);
        const unsigned gen = old / nloc;
        if (old + 1u == (gen + 1u) * nloc) {
            __builtin_amdgcn_fence(__ATOMIC_RELEASE, "agent");
            asm volatile("s_waitcnt vmcnt(0)" ::: "memory");
            const unsigned og = xb_add(&bar[XB_TOP], 1u);
            const unsigned tg = og / nx;
            if (og + 1u == (tg + 1u) * nx) xb_add(&bar[XB_TOPGEN], 1u);
            else XB_SPIN(xb_ld(&bar[XB_TOPGEN]) == tg, bar);
            __builtin_amdgcn_fence(__ATOMIC_ACQUIRE, "agent");
            xb_add(&bar[XB_XGEN(b.x)], 1u);
            asm volatile("s_waitcnt vmcnt(0)" ::: "memory");
        } else {
            XB_SPIN(xb_ld(&bar[XB_XGEN(b.x)]) == gen, bar);
            __builtin_amdgcn_fence(__ATOMIC_ACQUIRE, "agent");
            asm volatile("s_waitcnt vmcnt(0)" ::: "memory");
        }
    }
    __syncthreads();
}

constexpr int LDS_BYTES = 131072 + 64 + 8192;
#ifndef REP_PREP
#define REP_PREP 1
#define REP_INPROJ 1
#define REP_ATTN 1
#define REP_MERGE 1
#define REP_BCOMB 1
#define REP_N2 1
#define REP_TOPK 1
#define REP_MOE1 1
#define REP_MOE2 1
#endif
#define PH(...) do { Params q = p; { size_t z_ = 0; asm volatile("" : "+s"(z_)); q.ws = p.ws + z_; } __VA_ARGS__; } while (0)
#define GRID_BAR() do { XcdBarrier b_; { size_t z_ = 0; asm volatile("" : "+s"(z_)); b_.bar = (unsigned*)(p.ws + z_ + OFF_CTL); } b_.x = xb_xcc_id(); b_.st = (volatile LAS unsigned*)(lds + 131072); xcd_barrier(b_); } while (0)
__global__ void __launch_bounds__(512, 2) mega_fwd(Params p) {
    extern __shared__ __attribute__((aligned(16))) unsigned char lds_raw[];
    LAS unsigned char* lds = (LAS unsigned char*)lds_raw;
    { volatile LAS unsigned* xbw = (volatile LAS unsigned*)(lds + 131072);
      if (threadIdx.x == 0) { xbw[0] = 0u; xbw[1] = 0u; xbw[2] = 0u; xbw[3] = 0u; }
      __syncthreads();
      (void)xcd_barrier_post((unsigned*)(p.ws + OFF_CTL), xbw); }
    PH(prep_phase(q, (LAS float*)lds); norm1_phase<0>(q, 0));
    GRID_BAR();
#define LAYER(l) do { \
        if ((l) != 0) { PH(norm1_phase<1>(q, (l))); GRID_BAR(); } \
        PH(f_inproj_phase(q, (l), lds)); GRID_BAR(); \
        PH(f_gate_tail_units(q, (l), lds); prep_expert_phase(q, (l), (LAS float*)lds); f_attn_phase(q, (l), lds, (l))); GRID_BAR(); \
        PH(bcombine_phase(q)); GRID_BAR(); \
        PH(f_merge_phase(q, (l), lds)); GRID_BAR(); \
        PH(f_out_phase(q, (l), lds)); GRID_BAR(); \
        PH(norm2_router_phase(q, (l), (LAS float*)lds)); GRID_BAR(); \
        PH(topk_phase(q, (LAS unsigned*)lds); prep_expert_topk(q, (l), (LAS float*)lds)); GRID_BAR(); \
        PH(f_moe1_phase(q, (l), lds)); GRID_BAR(); \
        PH(f_moe2_phase(q, (l), lds)); GRID_BAR(); } while (0)
    LAYER(0); LAYER(1); LAYER(2); LAYER(3);
#undef LAYER
    PH(norm1_phase<2>(q, 0));
}

extern "C" void kernel_launch(void* const* d_in, const int* in_sizes, int n_in, void* d_out, int out_size, void* d_ws, size_t ws_size, hipStream_t stream) {
    (void)in_sizes; (void)out_size;
    static int grid = 0;
    if (grid == 0) {
        if (n_in != 16 || ws_size < OFF_END) { grid = -1; return; }
        int dev = 0, cus = 0, per_cu = 0;
        if (hipGetDevice(&dev) != hipSuccess || hipDeviceGetAttribute(&cus, hipDeviceAttributeMultiprocessorCount, dev) != hipSuccess) { grid = -1; return; }
        if (hipFuncSetAttribute((const void*)mega_fwd, hipFuncAttributeMaxDynamicSharedMemorySize, LDS_BYTES) != hipSuccess) { grid = -1; return; }
        if (hipOccupancyMaxActiveBlocksPerMultiprocessor(&per_cu, (const void*)mega_fwd, 512, LDS_BYTES) != hipSuccess || per_cu < 1) { (void)hipGetLastError(); }
        grid = cus;
    }
    if (grid < 0) return;
    if (hipMemsetAsync((char*)d_ws + OFF_CTL, 0, 65536, stream) != hipSuccess) return;
    Params p{};
    p.x = (const float*)d_in[0]; p.w_in = (const float*)d_in[1]; p.b_gate = (const float*)d_in[2]; p.sink = (const float*)d_in[3]; p.rpb = (const float*)d_in[4];
    p.w_a = (const float*)d_in[5]; p.w_b = (const float*)d_in[6]; p.w_c = (const float*)d_in[7]; p.w_out = (const float*)d_in[8]; p.norm_mix = (const float*)d_in[9];
    p.norm_ffn = (const float*)d_in[10]; p.w_router = (const float*)d_in[11]; p.w_gate_e = (const float*)d_in[12]; p.w_up_e = (const float*)d_in[13]; p.w_down_e = (const float*)d_in[14];
    p.norm_final = (const float*)d_in[15]; p.out = (float*)d_out; p.ws = (unsigned char*)d_ws;
    hipLaunchKernelGGL(mega_fwd, dim3(grid), dim3(512), LDS_BYTES, stream, p);
}
```

```cpp
#include <hip/hip_runtime.h>
#include <stdint.h>

#define DI __device__ __forceinline__
#define LAS __attribute__((address_space(3)))
typedef unsigned short bf16_t;
typedef short bf16x8 __attribute__((ext_vector_type(8)));
typedef float f32x2 __attribute__((ext_vector_type(2)));
typedef float f32x4 __attribute__((ext_vector_type(4)));
typedef float f32x16 __attribute__((ext_vector_type(16)));
typedef unsigned u32x2 __attribute__((ext_vector_type(2)));
typedef unsigned u32x4 __attribute__((ext_vector_type(4)));

constexpr int NTOK = 16384, DM = 1024, SEQ = 4096, NBATCH = 4, NLAYER = 4, NEXP = 16, FF = 2048, CAP = 512, PROJ = 5632;
constexpr int QKW = 1792;
constexpr int VCH = 768;
constexpr int OCW = 768;
constexpr int NROWS_E = NBATCH * CAP * NEXP;

constexpr size_t OFF_CTL = 0;
constexpr size_t OFF_COS = 65536;
constexpr size_t OFF_SIN = OFF_COS + (size_t)SEQ * 32 * 4;
constexpr size_t OFF_W   = 2u << 20;
constexpr size_t WIN_B = (size_t)4864 * 1024 * 2, WV_B = (size_t)768 * 1024 * 2, WM_B = (size_t)1024 * 768 * 2, WO_B = (size_t)1024 * 1024 * 2;
constexpr size_t WGU_B = (size_t)NEXP * 4096 * 1024 * 2, WD_B = (size_t)NEXP * 1024 * 2048 * 2;
constexpr size_t LW_WIN = 0, LW_WV = LW_WIN + WIN_B, LW_WM = LW_WV + WV_B, LW_WO = LW_WM + WM_B, LW_WGU = LW_WO + WO_B, LW_WD = LW_WGU + WGU_B, LW = LW_WD + WD_B;
constexpr size_t OFF_X   = OFF_W + NLAYER * LW;
constexpr size_t OFF_XN  = OFF_X + (size_t)NTOK * DM * 4;
constexpr size_t OFF_QK  = OFF_XN + (size_t)NTOK * DM * 2;
constexpr size_t OFF_VT  = OFF_QK + (size_t)NTOK * QKW * 2;
constexpr size_t OFF_G   = OFF_VT + (size_t)VCH * NTOK * 2;
constexpr size_t OFF_OC  = OFF_G + (size_t)NTOK * 3072 * 2;
constexpr size_t OFF_OB3 = OFF_OC + (size_t)NTOK * OCW * 2;
constexpr size_t OFF_LSE = OFF_OB3 + (size_t)3 * NTOK * 128 * 2;
constexpr size_t OFF_MG  = OFF_LSE + (size_t)3 * NTOK * 2 * 4;
constexpr size_t OFF_AFF = OFF_MG + (size_t)NTOK * DM * 2;
constexpr size_t OFF_IDX = OFF_AFF + (size_t)NTOK * NEXP * 4;
constexpr size_t OFF_VAL = OFF_IDX + (size_t)NROWS_E * 4;
constexpr size_t OFF_INV = OFF_VAL + (size_t)NROWS_E * 4;
constexpr size_t OFF_HID = OFF_INV + (size_t)NTOK * NEXP * 4;
constexpr size_t OFF_Y   = OFF_HID + (size_t)NROWS_E * FF * 2;
constexpr size_t OFF_XN8 = OFF_Y + (size_t)NROWS_E * DM * 2;
constexpr size_t OFF_END = OFF_XN8 + (size_t)NTOK * DM;

struct Params {
    const float *x, *w_in, *b_gate, *sink, *rpb, *w_a, *w_b, *w_c, *w_out, *norm_mix, *norm_ffn, *w_router, *w_gate_e, *w_up_e, *w_down_e, *norm_final;
    float* out; unsigned char* ws;
};
DI float*  P_COS(const Params& p) { return (float*)(p.ws + OFF_COS); }
DI float*  P_SIN(const Params& p) { return (float*)(p.ws + OFF_SIN); }
DI bf16_t* P_W(const Params& p, int l, size_t off) { return (bf16_t*)(p.ws + OFF_W + (size_t)l * LW + off); }
DI bf16_t* P_X(const Params& p) { return (bf16_t*)(p.ws + OFF_X); }
DI bf16_t* P_XN(const Params& p) { return (bf16_t*)(p.ws + OFF_XN); }
DI bf16_t* P_QK(const Params& p) { return (bf16_t*)(p.ws + OFF_QK); }
DI bf16_t* P_VT(const Params& p) { return (bf16_t*)(p.ws + OFF_VT); }
DI unsigned char* P_G(const Params& p) { return p.ws + OFF_G; }
DI bf16_t* P_OC(const Params& p) { return (bf16_t*)(p.ws + OFF_OC); }
DI bf16_t* P_OB3(const Params& p) { return (bf16_t*)(p.ws + OFF_OB3); }
DI float*  P_LSE(const Params& p) { return (float*)(p.ws + OFF_LSE); }
DI bf16_t* P_MG(const Params& p) { return (bf16_t*)(p.ws + OFF_MG); }
DI float*  P_AFF(const Params& p) { return (float*)(p.ws + OFF_AFF); }
DI int*    P_IDX(const Params& p) { return (int*)(p.ws + OFF_IDX); }
DI float*  P_VAL(const Params& p) { return (float*)(p.ws + OFF_VAL); }
DI int*    P_INV(const Params& p) { return (int*)(p.ws + OFF_INV); }
DI bf16_t* P_HID(const Params& p) { return (bf16_t*)(p.ws + OFF_HID); }
DI bf16_t* P_Y(const Params& p) { return (bf16_t*)(p.ws + OFF_Y); }
DI unsigned char* P_XN8(const Params& p) { return p.ws + OFF_XN8; }

DI unsigned f2bf(float f) { unsigned u = __float_as_uint(f); return (u + 0x7fffu + ((u >> 16) & 1u)) >> 16; }
DI unsigned pk2(float lo, float hi) { return f2bf(lo) | (f2bf(hi) << 16); }
constexpr float W8_SCALE = 32.0f, H8_SCALE = 4.0f;
DI unsigned pk4_fp8(float a, float b, float c, float d) { unsigned w = 0u; w = __builtin_amdgcn_cvt_pk_fp8_f32(a, b, w, false); w = __builtin_amdgcn_cvt_pk_fp8_f32(c, d, w, true); return w; }
DI float bf2f(unsigned b) { return __uint_as_float(b << 16); }
DI float bflo(unsigned w) { return __uint_as_float(w << 16); }
DI float bfhi(unsigned w) { return __uint_as_float(w & 0xffff0000u); }
DI float shx(float v, int d, int lane) { return __uint_as_float((unsigned)__builtin_amdgcn_ds_bpermute((lane ^ d) << 2, (int)__float_as_uint(v))); }
DI unsigned shl_abs(unsigned v, int src_lane) { return (unsigned)__builtin_amdgcn_ds_bpermute(src_lane << 2, (int)v); }
DI int otid() { int t = threadIdx.x; asm volatile("" : "+v"(t)); return t; }
DI int pos16(int t) { return ((t & 15) << 8) | (t >> 4); }

constexpr int JOBS_PER_LAYER = 26432, SMALL_JOBS = 1856;
DI void prep_job(const Params& p, int l, int j, const float*& src, int& src_ld, bf16_t*& dst, int& dst_ld) {
    if (j < 1216) {
        const int nblk = j >> 3, kc = j & 7; int sc;
        if (nblk < 40) { const int t = nblk >> 3, sb = nblk & 7, bj = sb >> 2, wc = sb & 3, hr = 4 * t + wc;
            const int base = hr < 6 ? 64 * hr : hr < 8 ? 384 + 64 * (hr - 6) : hr < 14 ? 640 + 64 * (hr - 8) : 1024 + 64 * (hr - 14);
            sc = base + 32 * bj; }
        else if (nblk < 56) { const int c = 32 * (nblk - 40); sc = c < 256 ? 1792 + c : 2048 + (c - 256); }
        else sc = 2560 + 32 * (nblk - 56);
        src = p.w_in + (size_t)l * DM * PROJ + (size_t)(128 * kc) * PROJ + sc; src_ld = PROJ;
        dst = P_W(p, l, LW_WIN) + (size_t)(32 * nblk) * 1024 + 128 * kc; dst_ld = 1024; return;
    }
    j -= 1216;
    if (j < 192) {
        const int nblk = j >> 3, kc = j & 7, ch = 32 * nblk;
        const int sc = ch < 128 ? 512 + ch : ch < 256 ? 1408 + (ch - 128) : ch < 512 ? 2304 + (ch - 256) : 1536 + (ch - 512);
        src = p.w_in + (size_t)l * DM * PROJ + (size_t)(128 * kc) * PROJ + sc; src_ld = PROJ;
        dst = P_W(p, l, LW_WV) + (size_t)ch * 1024 + 128 * kc; dst_ld = 1024; return;
    }
    j -= 192;
    if (j < 192) {
        bf16_t* wm = P_W(p, l, LW_WM); src_ld = 1024; dst_ld = 768;
        if (j < 96) { const int nblk = j / 3, kc = j % 3; src = p.w_a + (size_t)l * 384 * 1024 + (size_t)(128 * kc) * 1024 + 32 * nblk; dst = wm + (size_t)(32 * nblk) * 768 + 128 * kc; }
        else if (j < 128) { const int nblk = j - 96; src = p.w_b + (size_t)l * 128 * 1024 + 32 * nblk; dst = wm + (size_t)(32 * nblk) * 768 + 384; }
        else { const int jj = j - 128, nblk = jj >> 1, kc = jj & 1; src = p.w_c + (size_t)l * 256 * 1024 + (size_t)(128 * kc) * 1024 + 32 * nblk; dst = wm + (size_t)(32 * nblk) * 768 + 512 + 128 * kc; }
        return;
    }
    j -= 192;
    if (j < 256) {
        const int nblk = j >> 3, kc = j & 7;
        src = p.w_out + (size_t)l * 1024 * 1024 + (size_t)(128 * kc) * 1024 + 32 * nblk; src_ld = 1024;
        dst = P_W(p, l, LW_WO) + (size_t)(32 * nblk) * 1024 + 128 * kc; dst_ld = 1024; return;
    }
    j -= 256;
    if (j < 16384) {
        const int e = j >> 10, r = j & 1023, nblk = r >> 3, kc = r & 7, row0 = 32 * nblk, pp = row0 >> 8, s = row0 & 255;
        const float* w = s < 128 ? p.w_gate_e : p.w_up_e; const int col = 128 * pp + (s & 127);
        src = w + ((size_t)(l * NEXP + e) * 1024 + 128 * kc) * 2048 + col; src_ld = 2048;
        dst = (bf16_t*)((unsigned char*)P_W(p, l, LW_WGU) + ((size_t)e * 4096 + row0) * 1024 + 128 * kc); dst_ld = 1024; return;
    }
    j -= 16384;
    {
        const int e = j >> 9, r = j & 511, nblk = r >> 4, kc = r & 15;
        src = p.w_down_e + ((size_t)(l * NEXP + e) * 2048 + 128 * kc) * 1024 + 32 * nblk; src_ld = 1024;
        dst = (bf16_t*)((unsigned char*)P_W(p, l, LW_WD) + ((size_t)e * 1024 + 32 * nblk) * 2048 + 128 * kc); dst_ld = 2048;
    }
}
DI void sincos_d(double a, double& s, double& c) {
    const double q = rint(a * 0.63661977236758134308);
    double r = fma(-q, 1.57079632679489655800e+00, a); r = fma(-q, 6.12323399573676603587e-17, r);
    const double r2 = r * r;
    double sp = 1.58969099521155010221e-10; sp = fma(sp, r2, -2.50507602534068634195e-08); sp = fma(sp, r2, 2.75573137070700676789e-06); sp = fma(sp, r2, -1.98412698298579493134e-04);
    sp = fma(sp, r2, 8.33333333332248946124e-03); sp = fma(sp, r2, -1.66666666666666324348e-01); const double sr = fma(r * r2, sp, r);
    double cp = -1.13596475577881948265e-11; cp = fma(cp, r2, 2.08757232129817482790e-09); cp = fma(cp, r2, -2.75573143513906633035e-07); cp = fma(cp, r2, 2.48015872894767294178e-05);
    cp = fma(cp, r2, -1.38888888888741095749e-03); cp = fma(cp, r2, 4.16666666666666019037e-02); const double cr = fma(r2 * r2, cp, fma(-0.5, r2, 1.0));
    const int qi = ((int)q) & 3;
    s = qi == 0 ? sr : qi == 1 ? cr : qi == 2 ? -sr : -cr;
    c = qi == 0 ? cr : qi == 1 ? -sr : qi == 2 ? -cr : sr;
}
DI void prep_phase(const Params& p, LAS float* scr) {
    const int tid = otid();
    for (int i = blockIdx.x * 512 + tid; i < SEQ * 32; i += gridDim.x * 512) {
        const int pos = i >> 5, j = i & 31;
        double fr = 1.0; for (int jj = 0; jj < j; ++jj) fr *= 0.7498942093324559;
        const float invf = (float)fr;
        const float ang = (float)pos * invf; double s, c; sincos_d((double)ang, s, c);
        P_COS(p)[i] = (float)c; P_SIN(p)[i] = (float)s;
    }
    const int total = NLAYER * SMALL_JOBS;
    int u = blockIdx.x;
    const float* src; bf16_t* dst; int src_ld, dst_ld, j = 0;
    f32x4 r0, r1;
    if (u < total) { const int l = u / SMALL_JOBS; j = u - l * SMALL_JOBS; prep_job(p, l, j, src, src_ld, dst, dst_ld);
        r0 = *(const f32x4*)(src + (size_t)(tid >> 3) * src_ld + 4 * (tid & 7)); r1 = *(const f32x4*)(src + (size_t)((tid + 512) >> 3) * src_ld + 4 * (tid & 7)); }
    int buf = 0;
    for (; u < total; u += gridDim.x) {
        LAS float* sc = scr + buf * (128 * 33);
        { const int k = tid >> 3, c4 = tid & 7;
          sc[k * 33 + 4 * c4 + 0] = r0[0]; sc[k * 33 + 4 * c4 + 1] = r0[1]; sc[k * 33 + 4 * c4 + 2] = r0[2]; sc[k * 33 + 4 * c4 + 3] = r0[3];
          sc[(k + 64) * 33 + 4 * c4 + 0] = r1[0]; sc[(k + 64) * 33 + 4 * c4 + 1] = r1[1]; sc[(k + 64) * 33 + 4 * c4 + 2] = r1[2]; sc[(k + 64) * 33 + 4 * c4 + 3] = r1[3]; }
        bf16_t* dcur = dst; const int dld = dst_ld, jcur = j;
        const int un = u + gridDim.x;
        if (un < total) { const int l = un / SMALL_JOBS; j = un - l * SMALL_JOBS; prep_job(p, l, j, src, src_ld, dst, dst_ld);
            r0 = *(const f32x4*)(src + (size_t)(tid >> 3) * src_ld + 4 * (tid & 7)); r1 = *(const f32x4*)(src + (size_t)((tid + 512) >> 3) * src_ld + 4 * (tid & 7)); }
        __syncthreads();
        { const int n = tid >> 4, k8 = (tid & 15) * 8;
          if (jcur >= 1856) {
            u32x2 w; w[0] = pk4_fp8(sc[(k8 + 0) * 33 + n] * W8_SCALE, sc[(k8 + 1) * 33 + n] * W8_SCALE, sc[(k8 + 2) * 33 + n] * W8_SCALE, sc[(k8 + 3) * 33 + n] * W8_SCALE);
            w[1] = pk4_fp8(sc[(k8 + 4) * 33 + n] * W8_SCALE, sc[(k8 + 5) * 33 + n] * W8_SCALE, sc[(k8 + 6) * 33 + n] * W8_SCALE, sc[(k8 + 7) * 33 + n] * W8_SCALE);
            *(u32x2*)((unsigned char*)dcur + (size_t)n * dld + k8) = w;
          } else { u32x4 w;
            w[0] = pk2(sc[(k8 + 0) * 33 + n], sc[(k8 + 1) * 33 + n]); w[1] = pk2(sc[(k8 + 2) * 33 + n], sc[(k8 + 3) * 33 + n]);
            w[2] = pk2(sc[(k8 + 4) * 33 + n], sc[(k8 + 5) * 33 + n]); w[3] = pk2(sc[(k8 + 6) * 33 + n], sc[(k8 + 7) * 33 + n]);
            *(u32x4*)(dcur + (size_t)n * dld + k8) = w; } }
        buf ^= 1;
    }
    __syncthreads();
}

template <bool GU> DI void expert_addr(const Params& p, int l, int x, const float*& src, unsigned char*& dst) {
    if (GU) { const int e = x >> 10, nblk = (x >> 3) & 127, kc = x & 7;
        const float* wsel = (nblk & 4) ? p.w_up_e : p.w_gate_e;
        src = wsel + ((size_t)(l * NEXP + e) * 1024 + 128 * kc) * 2048 + 128 * (nblk >> 3) + 32 * (nblk & 3);
        dst = (unsigned char*)P_W(p, l, LW_WGU) + ((size_t)e * 4096 + 32 * nblk) * 1024 + 128 * kc; }
    else { const int e = x >> 9, nblk = (x >> 4) & 31, kc = x & 15;
        src = p.w_down_e + ((size_t)(l * NEXP + e) * 2048 + 128 * kc) * 1024 + 32 * nblk;
        dst = (unsigned char*)P_W(p, l, LW_WD) + ((size_t)e * 1024 + 32 * nblk) * 2048 + 128 * kc; }
}
constexpr int NPREP = 128;
constexpr int TK_WGS = 192, TK_JOBS = 40 * TK_WGS;
template <bool GU> DI void prep_expert_loop(const Params& p, int l, LAS unsigned* img, int tid, int w, int nwg, int x0, int NJ) {
    constexpr int D = 4, SLD = GU ? 2048 : 1024, DLD = GU ? 1024 : 2048;
    f32x4 r[D][2];
    const float* src; unsigned char* dst;
    const int lo = (tid >> 3) * SLD + 4 * (tid & 7);
    const int kq = tid & 31, nq = (tid >> 5) & 7, half = tid >> 8;
    const unsigned selx = half ? 0x07030602u : 0x05010400u;
    const int oo = (4 * nq + 2 * half) * DLD + 4 * kq;
#pragma unroll
    for (int d = 0; d < D; ++d) { expert_addr<GU>(p, l, x0 + nwg * d + w, src, dst); r[d][0] = *(const f32x4*)(src + lo); r[d][1] = *(const f32x4*)(src + lo + 64 * SLD); }
#pragma unroll 1
    for (int i = 0; i < NJ; i += D) {
#pragma unroll
        for (int d = 0; d < D; ++d) {
            LAS unsigned* sc = img + (d & 1) * (128 * 9);
            { const int k = tid >> 3, c4 = tid & 7;
              sc[k * 9 + c4] = pk4_fp8(r[d][0][0] * W8_SCALE, r[d][0][1] * W8_SCALE, r[d][0][2] * W8_SCALE, r[d][0][3] * W8_SCALE);
              sc[(k + 64) * 9 + c4] = pk4_fp8(r[d][1][0] * W8_SCALE, r[d][1][1] * W8_SCALE, r[d][1][2] * W8_SCALE, r[d][1][3] * W8_SCALE); }
            { const int nx = min(i + d + D, NJ - 1);
              expert_addr<GU>(p, l, x0 + nwg * nx + w, src, dst); r[d][0] = *(const f32x4*)(src + lo); r[d][1] = *(const f32x4*)(src + lo + 64 * SLD); }
            expert_addr<GU>(p, l, x0 + nwg * (i + d) + w, src, dst);
            __syncthreads();
            { const unsigned a = sc[(4 * kq + 0) * 9 + nq], b = sc[(4 * kq + 1) * 9 + nq], c = sc[(4 * kq + 2) * 9 + nq], e = sc[(4 * kq + 3) * 9 + nq];
              const unsigned tl = __builtin_amdgcn_perm(b, a, selx), th = __builtin_amdgcn_perm(e, c, selx);
              *(unsigned*)(dst + oo) = __builtin_amdgcn_perm(th, tl, 0x05040100u); *(unsigned*)(dst + oo + DLD) = __builtin_amdgcn_perm(th, tl, 0x07060302u); }
        }
    }
}
DI void prep_expert_phase(const Params& p, int l, LAS float* scr) {
    if (blockIdx.x < 256 - NPREP) return;
    const int tid = otid(), w = blockIdx.x - (256 - NPREP);
    prep_expert_loop<true>(p, l, (LAS unsigned*)scr, tid, w, NPREP, 0, 16384 / NPREP);
    prep_expert_loop<false>(p, l, (LAS unsigned*)scr, tid, w, NPREP, TK_JOBS, (8192 - TK_JOBS) / NPREP);
    __syncthreads();
}
DI void prep_expert_topk(const Params& p, int l, LAS float* scr) {
    if (blockIdx.x < 256 - TK_WGS) return;
    prep_expert_loop<false>(p, l, (LAS unsigned*)scr, otid(), blockIdx.x - (256 - TK_WGS), TK_WGS, 0, TK_JOBS / TK_WGS);
    __syncthreads();
}

DI int eo4(int lane, int i) { return 8 * lane + 512 * (i >> 1) + 4 * (i & 1); }
DI void unpk8(f32x4& a, f32x4& b, const u32x4& w) { a[0] = bflo(w[0]); a[1] = bfhi(w[0]); a[2] = bflo(w[1]); a[3] = bfhi(w[1]); b[0] = bflo(w[2]); b[1] = bfhi(w[2]); b[2] = bflo(w[3]); b[3] = bfhi(w[3]); }
DI void add8(f32x4& a, f32x4& b, const u32x4& w) { a[0] += bflo(w[0]); a[1] += bfhi(w[0]); a[2] += bflo(w[1]); a[3] += bfhi(w[1]); b[0] += bflo(w[2]); b[1] += bfhi(w[2]); b[2] += bflo(w[3]); b[3] += bfhi(w[3]); }
DI u32x4 pk8(const f32x4& a, const f32x4& b) { u32x4 w; w[0] = pk2(a[0], a[1]); w[1] = pk2(a[2], a[3]); w[2] = pk2(b[0], b[1]); w[3] = pk2(b[2], b[3]); return w; }
template <int MODE> DI void norm1_phase(const Params& p, int l) {
    const int tid = otid(), lane = tid & 63, wid = tid >> 6;
    const float* gain = MODE == 2 ? p.norm_final : p.norm_mix + (size_t)l * DM;
    f32x4 g[4];
#pragma unroll
    for (int i = 0; i < 4; ++i) g[i] = *(const f32x4*)(gain + eo4(lane, i));
    const int nw = gridDim.x * 8;
    for (int row0 = blockIdx.x * 8 + wid; row0 < NTOK; row0 += 2 * nw) {
        const int row1 = row0 + nw;
        f32x4 v0[4], v1[4];
        if (MODE == 0) {
#pragma unroll
            for (int i = 0; i < 4; ++i) { v0[i] = *(const f32x4*)(p.x + (size_t)row0 * DM + eo4(lane, i)); v1[i] = *(const f32x4*)(p.x + (size_t)row1 * DM + eo4(lane, i)); }
        } else {
            u32x4 a[2], b[2];
#pragma unroll
            for (int j = 0; j < 2; ++j) { a[j] = *(const u32x4*)(P_X(p) + (size_t)row0 * DM + 8 * lane + 512 * j); b[j] = *(const u32x4*)(P_X(p) + (size_t)row1 * DM + 8 * lane + 512 * j); }
            const int c0 = lane < NEXP ? P_INV(p)[(size_t)row0 * NEXP + lane] : -1, c1 = lane < NEXP ? P_INV(p)[(size_t)row1 * NEXP + lane] : -1;
#pragma unroll
            for (int j = 0; j < 2; ++j) { unpk8(v0[2 * j], v0[2 * j + 1], a[j]); unpk8(v1[2 * j], v1[2 * j + 1], b[j]); }
            unsigned long long m0 = __ballot(c0 >= 0), m1 = __ballot(c1 >= 0);
            const bf16_t* ybase0 = P_Y(p) + (size_t)((row0 >> 12) * CAP) * DM; const bf16_t* ybase1 = P_Y(p) + (size_t)((row1 >> 12) * CAP) * DM;
            while (m0 | m1) {
                u32x4 w0[2], w1[2]; const bool h0 = m0 != 0ull, h1 = m1 != 0ull;
                if (h0) { const int e = __builtin_ctzll(m0); m0 &= m0 - 1ull; const int c = __builtin_amdgcn_readlane(c0, e); const bf16_t* yr = ybase0 + (size_t)(e * NBATCH * CAP + c) * DM;
#pragma unroll
                    for (int j = 0; j < 2; ++j) w0[j] = *(const u32x4*)(yr + 8 * lane + 512 * j); }
                if (h1) { const int e = __builtin_ctzll(m1); m1 &= m1 - 1ull; const int c = __builtin_amdgcn_readlane(c1, e); const bf16_t* yr = ybase1 + (size_t)(e * NBATCH * CAP + c) * DM;
#pragma unroll
                    for (int j = 0; j < 2; ++j) w1[j] = *(const u32x4*)(yr + 8 * lane + 512 * j); }
                if (h0) {
#pragma unroll
                    for (int j = 0; j < 2; ++j) add8(v0[2 * j], v0[2 * j + 1], w0[j]); }
                if (h1) {
#pragma unroll
                    for (int j = 0; j < 2; ++j) add8(v1[2 * j], v1[2 * j + 1], w1[j]); }
            }
        }
        if (MODE != 2) {
#pragma unroll
            for (int j = 0; j < 2; ++j) { *(u32x4*)(P_X(p) + (size_t)row0 * DM + 8 * lane + 512 * j) = pk8(v0[2 * j], v0[2 * j + 1]); *(u32x4*)(P_X(p) + (size_t)row1 * DM + 8 * lane + 512 * j) = pk8(v1[2 * j], v1[2 * j + 1]); }
        }
        float s0 = 0.f, s1 = 0.f;
#pragma unroll
        for (int i = 0; i < 4; ++i) { s0 += v0[i][0] * v0[i][0] + v0[i][1] * v0[i][1] + v0[i][2] * v0[i][2] + v0[i][3] * v0[i][3]; s1 += v1[i][0] * v1[i][0] + v1[i][1] * v1[i][1] + v1[i][2] * v1[i][2] + v1[i][3] * v1[i][3]; }
#pragma unroll
        for (int d = 32; d >= 1; d >>= 1) { s0 += shx(s0, d, lane); s1 += shx(s1, d, lane); }
        const float r0 = rsqrtf(s0 * (1.0f / DM) + 1e-6f), r1 = rsqrtf(s1 * (1.0f / DM) + 1e-6f);
#pragma unroll
        for (int i = 0; i < 4; ++i) { v0[i] = v0[i] * r0 * g[i]; v1[i] = v1[i] * r1 * g[i]; }
        if (MODE == 2) {
#pragma unroll
            for (int i = 0; i < 4; ++i) { *(f32x4*)(p.out + (size_t)row0 * DM + eo4(lane, i)) = v0[i]; *(f32x4*)(p.out + (size_t)row1 * DM + eo4(lane, i)) = v1[i]; }
        } else {
#pragma unroll
            for (int j = 0; j < 2; ++j) { *(u32x4*)(P_XN(p) + (size_t)row0 * DM + 8 * lane + 512 * j) = pk8(v0[2 * j], v0[2 * j + 1]); *(u32x4*)(P_XN(p) + (size_t)row1 * DM + 8 * lane + 512 * j) = pk8(v1[2 * j], v1[2 * j + 1]); }
        }
    }
}

DI float reduce16(const float (&a)[16], int lane) {
    float b8[8], b4[4], b2[2];
    { const bool hi = (lane & 32) != 0;
#pragma unroll
      for (int j = 0; j < 8; ++j) { const float snd = hi ? a[j] : a[j + 8], kp = hi ? a[j + 8] : a[j]; b8[j] = kp + shx(snd, 32, lane); } }
    { const bool hi = (lane & 16) != 0;
#pragma unroll
      for (int j = 0; j < 4; ++j) { const float snd = hi ? b8[j] : b8[j + 4], kp = hi ? b8[j + 4] : b8[j]; b4[j] = kp + shx(snd, 16, lane); } }
    { const bool hi = (lane & 8) != 0;
#pragma unroll
      for (int j = 0; j < 2; ++j) { const float snd = hi ? b4[j] : b4[j + 2], kp = hi ? b4[j + 2] : b4[j]; b2[j] = kp + shx(snd, 8, lane); } }
    float r;
    { const bool hi = (lane & 4) != 0; const float snd = hi ? b2[0] : b2[1], kp = hi ? b2[1] : b2[0]; r = kp + shx(snd, 4, lane); }
    r += shx(r, 2, lane); r += shx(r, 1, lane);
    return r;
}
DI void norm2_router_phase(const Params& p, int l, LAS float* wr) {
    const int tid = otid(), lane = tid & 63, wid = tid >> 6;
    for (int i = tid; i < DM * NEXP; i += 512) { const int d = i >> 4;
        wr[(i & 15) * DM + ((d >> 9) * 2 + ((d >> 2) & 1)) * 256 + 4 * ((d & 511) >> 3) + (d & 3)] = p.w_router[(size_t)l * DM * NEXP + i]; }
    __syncthreads();
    const float* gain = p.norm_ffn + (size_t)l * DM;
    f32x4 g[4];
#pragma unroll
    for (int i = 0; i < 4; ++i) g[i] = *(const f32x4*)(gain + eo4(lane, i));
    const int nw = gridDim.x * 8;
    for (int row0 = blockIdx.x * 8 + wid; row0 < NTOK; row0 += 2 * nw) {
        const int row1 = row0 + nw;
        f32x4 v0[4], v1[4]; float s0 = 0.f, s1 = 0.f;
        { u32x4 a[2], b[2];
#pragma unroll
          for (int j = 0; j < 2; ++j) { a[j] = *(const u32x4*)(P_X(p) + (size_t)row0 * DM + 8 * lane + 512 * j); b[j] = *(const u32x4*)(P_X(p) + (size_t)row1 * DM + 8 * lane + 512 * j); }
#pragma unroll
          for (int j = 0; j < 2; ++j) { unpk8(v0[2 * j], v0[2 * j + 1], a[j]); unpk8(v1[2 * j], v1[2 * j + 1], b[j]); } }
#pragma unroll
        for (int i = 0; i < 4; ++i) { s0 += v0[i][0] * v0[i][0] + v0[i][1] * v0[i][1] + v0[i][2] * v0[i][2] + v0[i][3] * v0[i][3]; s1 += v1[i][0] * v1[i][0] + v1[i][1] * v1[i][1] + v1[i][2] * v1[i][2] + v1[i][3] * v1[i][3]; }
#pragma unroll
        for (int d = 32; d >= 1; d >>= 1) { s0 += shx(s0, d, lane); s1 += shx(s1, d, lane); }
        const float r0 = rsqrtf(s0 * (1.0f / DM) + 1e-6f), r1 = rsqrtf(s1 * (1.0f / DM) + 1e-6f);
#pragma unroll
        for (int i = 0; i < 4; ++i) { v0[i] = v0[i] * r0 * g[i]; v1[i] = v1[i] * r1 * g[i]; }
#pragma unroll
        for (int j = 0; j < 2; ++j) { u32x2 w;
            w[0] = pk4_fp8(v0[2 * j][0], v0[2 * j][1], v0[2 * j][2], v0[2 * j][3]); w[1] = pk4_fp8(v0[2 * j + 1][0], v0[2 * j + 1][1], v0[2 * j + 1][2], v0[2 * j + 1][3]);
            *(u32x2*)(P_XN8(p) + (size_t)row0 * DM + 8 * lane + 512 * j) = w;
            w[0] = pk4_fp8(v1[2 * j][0], v1[2 * j][1], v1[2 * j][2], v1[2 * j][3]); w[1] = pk4_fp8(v1[2 * j + 1][0], v1[2 * j + 1][1], v1[2 * j + 1][2], v1[2 * j + 1][3]);
            *(u32x2*)(P_XN8(p) + (size_t)row1 * DM + 8 * lane + 512 * j) = w; }
        float a0[NEXP], a1[NEXP];
#pragma unroll
        for (int e = 0; e < NEXP; ++e) { float x0 = 0.f, x1 = 0.f;
#pragma unroll
            for (int i = 0; i < 4; ++i) { const f32x4 w = *(const LAS f32x4*)(wr + e * DM + 4 * lane + 256 * i);
                x0 += v0[i][0] * w[0] + v0[i][1] * w[1] + v0[i][2] * w[2] + v0[i][3] * w[3]; x1 += v1[i][0] * w[0] + v1[i][1] * w[1] + v1[i][2] * w[2] + v1[i][3] * w[3]; }
            a0[e] = x0; a1[e] = x1;
            if ((e & 3) == 3) __builtin_amdgcn_sched_barrier(0); }
        const float l0 = reduce16(a0, lane), l1 = reduce16(a1, lane);
        float m0 = l0, m1 = l1;
#pragma unroll
        for (int d = 32; d >= 4; d >>= 1) { m0 = fmaxf(m0, shx(m0, d, lane)); m1 = fmaxf(m1, shx(m1, d, lane)); }
        const float e0 = __expf(l0 - m0), e1 = __expf(l1 - m1); float d0 = e0, d1 = e1;
#pragma unroll
        for (int d = 32; d >= 4; d >>= 1) { d0 += shx(d0, d, lane); d1 += shx(d1, d, lane); }
        if ((lane & 3) == 0) { const int e = lane >> 2;
            P_AFF(p)[((size_t)((row0 >> 12) * NEXP + e)) * SEQ + (row0 & 4095)] = e0 / d0; P_AFF(p)[((size_t)((row1 >> 12) * NEXP + e)) * SEQ + (row1 & 4095)] = e1 / d1; }
    }
}

DI void topk_phase(const Params& p, LAS unsigned* lds) {
    const int tid = otid(), lane = tid & 63, wid = tid >> 6;
    LAS unsigned* hist = lds; LAS unsigned* sh = lds + 256; LAS unsigned* wtot = lds + 272;
    for (int be = blockIdx.x; be < NBATCH * NEXP; be += gridDim.x) {
        const int b = be >> 4, e = be & 15;
        const float* aff = P_AFF(p) + (size_t)be * SEQ + tid * 8;
        const f32x4 a0 = *(const f32x4*)aff, a1 = *(const f32x4*)(aff + 4);
        unsigned key[8];
#pragma unroll
        for (int i = 0; i < 4; ++i) { key[i] = __float_as_uint(a0[i]); key[4 + i] = __float_as_uint(a1[i]); }
        unsigned prefix = 0u, mask = 0u, krem = CAP;
        for (int pass = 3; pass >= 0; --pass) {
            const int shift = 8 * pass;
            if (tid < 256) hist[tid] = 0u;
            __syncthreads();
#pragma unroll
            for (int i = 0; i < 8; ++i) if ((key[i] & mask) == prefix) atomicAdd((unsigned*)&hist[(key[i] >> shift) & 255u], 1u);
            __syncthreads();
            if (wid == 0) {
                const unsigned h0 = hist[4 * lane], h1 = hist[4 * lane + 1], h2 = hist[4 * lane + 2], h3 = hist[4 * lane + 3], s = h0 + h1 + h2 + h3;
                unsigned suf = s;
#pragma unroll
                for (int d = 1; d < 64; d <<= 1) { const unsigned t = shl_abs(suf, (lane + d) & 63); if (lane + d < 64) suf += t; }
                const unsigned above = suf - s;
                if (above < krem && krem <= suf) {
                    unsigned a = above; unsigned bin, nk;
                    if (a + h3 >= krem) { bin = 4 * lane + 3; nk = krem - a; }
                    else { a += h3; if (a + h2 >= krem) { bin = 4 * lane + 2; nk = krem - a; }
                        else { a += h2; if (a + h1 >= krem) { bin = 4 * lane + 1; nk = krem - a; } else { a += h1; bin = 4 * lane; nk = krem - a; } } }
                    sh[0] = prefix | (bin << shift); sh[1] = nk;
                }
            }
            __syncthreads();
            prefix = sh[0]; krem = sh[1]; mask |= 0xFFu << shift;
            __syncthreads();
        }
        unsigned cg = 0u, ce = 0u;
#pragma unroll
        for (int i = 0; i < 8; ++i) { cg += key[i] > prefix ? 1u : 0u; ce += key[i] == prefix ? 1u : 0u; }
        unsigned pk = cg | (ce << 16), incl = pk;
#pragma unroll
        for (int d = 1; d < 64; d <<= 1) { const unsigned t = shl_abs(incl, (lane - d) & 63); if (lane >= d) incl += t; }
        if (lane == 63) wtot[wid] = incl;
        __syncthreads();
        unsigned woff = 0u;
#pragma unroll
        for (int w = 0; w < 8; ++w) woff += w < wid ? wtot[w] : 0u;
        const unsigned excl = woff + incl - pk;
        unsigned gtb = excl & 0xffffu, eqb = excl >> 16;
        int* idxo = P_IDX(p) + (size_t)(e * NBATCH + b) * CAP; float* valo = P_VAL(p) + (size_t)(e * NBATCH + b) * CAP;
        int* inv = P_INV(p) + ((size_t)b * SEQ + tid * 8) * NEXP + e;
#pragma unroll
        for (int i = 0; i < 8; ++i) {
            int slot = -1;
            if (key[i] > prefix) { slot = (int)(gtb + (eqb < krem ? eqb : krem)); ++gtb; }
            else if (key[i] == prefix) { if (eqb < krem) slot = (int)(gtb + eqb); ++eqb; }
            if (slot >= 0) { idxo[slot] = tid * 8 + i; valo[slot] = __uint_as_float(key[i]); }
            inv[(size_t)i * NEXP] = slot;
        }
        __syncthreads();
    }
}

namespace at {
constexpr int NUNIT_A = 1536, NUNIT_C = 1024, NUNIT_B = 1536, NUNIT = NUNIT_A + NUNIT_C + NUNIT_B;
DI unsigned cvt2(float lo, float hi) { typedef __bf16 bf2_t __attribute__((ext_vector_type(2))); const f32x2 v = {lo, hi}; const bf2_t b = __builtin_convertvector(v, bf2_t); return __builtin_bit_cast(unsigned, b); }
DI bf16x8 pack8(const f32x16& x, int s8) { u32x4 w; w[0] = cvt2(x[s8 + 0], x[s8 + 1]); w[1] = cvt2(x[s8 + 2], x[s8 + 3]); w[2] = cvt2(x[s8 + 4], x[s8 + 5]); w[3] = cvt2(x[s8 + 6], x[s8 + 7]); return __builtin_bit_cast(bf16x8, w); }
DI int koffmap(int r, bool g1) { return g1 ? 4 * (4 * ((r >> 3) & 1) + (r & 3)) + 2 * (r >> 4) + ((r >> 2) & 1) : (r & 16) + 8 * ((r >> 2) & 1) + 4 * ((r >> 3) & 1) + (r & 3); }

DI float xh_max(float v) { const auto r = __builtin_amdgcn_permlane32_swap(__float_as_uint(v), __float_as_uint(v), false, false); return fmaxf(__uint_as_float(r[0]), __uint_as_float(r[1])); }
DI float xh_sum(float v) { const auto r = __builtin_amdgcn_permlane32_swap(__float_as_uint(v), __float_as_uint(v), false, false); return __uint_as_float(r[0]) + __uint_as_float(r[1]); }
constexpr float LOG2E = 1.4426950408889634f, LN2 = 0.6931471805599453f;
struct QState { float m, den; f32x16 O0, O1; };
DI void softmax_tile(f32x16& S, QState& st, bf16x8& p0, bf16x8& p1) {
    float mx = fmaxf(S[0], S[1]);
#pragma unroll
    for (int i = 2; i < 16; i += 2) mx = fmaxf(mx, fmaxf(S[i], S[i + 1]));
    mx = xh_max(mx);
    const float mn = fmaxf(st.m, mx), alpha = __builtin_amdgcn_exp2f(st.m - mn);
    float ps = 0.f;
#pragma unroll
    for (int i = 0; i < 16; ++i) { S[i] = __builtin_amdgcn_exp2f(S[i] - mn); ps += S[i]; }
    ps = xh_sum(ps);
    st.den = st.den * alpha + ps; st.m = mn;
#pragma unroll
    for (int i = 0; i < 16; ++i) { st.O0[i] *= alpha; st.O1[i] *= alpha; }
    p0 = pack8(S, 0); p1 = pack8(S, 8);
}
template <int MODE> DI void mask_tile(f32x16& S, int tn, int NT, int q, int h, int t, int qrow, int sr_q, int sc_q, int kc0, int qcg, const LAS float* bt_head) {
    if (MODE == 3) {
        const bool rowok = t >= sr_q && t < sr_q + 8; const LAS float* bt = bt_head + (t - qrow + 7) * 31 + 15 - qcg;
#pragma unroll
        for (int i = 0; i < 16; ++i) { const int kc = kc0 + 16 * (i >> 3) + 8 * h + (i & 7); const bool ok = rowok && kc >= sc_q && kc < sc_q + 16;
            const int bi = ok ? kc : qcg; S[i] = ok ? S[i] + bt[bi] : -1e37f; }
    } else {
        const int edge = tn == 0 ? 1 : tn == NT - 1 ? 2 : 0;
        if (edge != 0) {
            int qq = MODE == 2 ? q - h : q - 8 * h; asm volatile("" : "+v"(qq));
            if (edge == 1) {
#pragma unroll
                for (int i = 0; i < 16; ++i) { const int kc_ = MODE == 2 ? 4 * (i & 7) + 2 * (i >> 3) : 16 * (i >> 3) + (i & 7); S[i] = kc_ >= qq ? S[i] : -1e37f; }
            } else {
#pragma unroll
                for (int i = 0; i < 16; ++i) { const int kc_ = MODE == 2 ? 4 * (i & 7) + 2 * (i >> 3) : 16 * (i >> 3) + (i & 7); S[i] = kc_ <= qq ? S[i] : -1e37f; }
            }
        }
    }
}
template <int MODE> DI void wave_unit(const Params& p, int l, int u, const LAS float* rpb_lds, LAS unsigned char* ring, int lane) {
    const int q = lane & 31, h = lane >> 5;
    const bf16_t* QK = P_QK(p); const bf16_t* VT = P_VT(p);
    int b, qcol, kcol, vch, dil = 1, rho = 0, Jq = 0, L = SEQ, vs0 = 0, g = 0, hs = 0, hq = 0;
    constexpr int W = MODE == 0 ? 128 : 64, NT = MODE == 0 ? 9 : 5;
    int qcg = 0, kc0 = 0, kr_lo = 0, kr_hi = 0, r00 = 0;
    if (MODE == 0) { const int gg = u % 3, qp = (u / 3) & 63, kvh = (u / 192) & 1; b = u / 384; hq = kvh * 3 + gg; qcol = 64 * hq; kcol = 384 + 64 * kvh; vch = 64 * kvh; Jq = 64 * qp; }
    else if (MODE == 1 || MODE == 2) { const int qt6 = u & 63; hs = (u >> 6) & 1; g = (u >> 7) % 3; b = u / 384; qcol = 512 + 128 * g + 64 * hs; kcol = 896 + 128 * g + 64 * hs;
        vch = g == 0 ? 128 + 64 * hs : g == 1 ? 512 + 64 * hs : 640 + 64 * hs;
        if (g == 0) { Jq = 64 * qt6; } else if (g == 1) { dil = 4; rho = qt6 >> 4; Jq = 64 * (qt6 & 15); L = 1024; } else { dil = 16; rho = qt6 >> 2; Jq = 64 * (qt6 & 3); L = 256; vs0 = rho * 256; } }
    else { const int qt6 = u & 63, hh = (u >> 6) & 3, gr4 = qt6 >> 2, cb = qt6 & 3; b = u >> 8; hq = hh; qcol = 1280 + 64 * hh; kcol = 1536 + 64 * hh; vch = 256 + 64 * hh;
        r00 = 4 * gr4; qcg = 16 * cb + (q & 15); kc0 = cb == 0 ? 0 : cb == 3 ? 32 : 16 * cb - 8;
        const int s0 = r00 - 4 < 0 ? 0 : r00 - 4 > 56 ? 56 : r00 - 4, s3 = r00 - 1 < 0 ? 0 : r00 - 1 > 56 ? 56 : r00 - 1; kr_lo = s0; kr_hi = s3 + 8; }
    int t_lo, t_hi; unsigned kdma[4], vdma[4], kstep_t, vstep_t;
    if (MODE == 3) { t_lo = kr_lo; t_hi = kr_hi; kstep_t = 64u * QKW; vstep_t = 64; }
    else { t_lo = (W - Jq + 31) >> 5; if (t_lo < 0) t_lo = 0; t_hi = (L + W - Jq) >> 5; if (t_hi > NT + 1) t_hi = NT + 1; kstep_t = 32u * dil * QKW; vstep_t = MODE == 2 ? 8 : 32; }
#pragma unroll
    for (int i = 0; i < 4; ++i) {
        const int r = 8 * i + (lane >> 3), c8 = (lane & 7) ^ ((r >> 1) & 7), ko = koffmap(r, MODE == 2);
        const int ktok = MODE == 3 ? b * SEQ + kc0 + ko : b * SEQ + (Jq - W + ko) * dil + rho;
        kdma[i] = (unsigned)ktok * QKW + kcol + 8 * c8;
        const int d = 16 * i + (lane >> 2), ch = (lane & 3) ^ ((d >> 2) & 3);
        const int vslot = MODE == 3 ? b * SEQ + kc0 + 8 * ch : MODE == 2 ? b * SEQ + ch * 1024 + rho * 256 + ((Jq - W) >> 2) : b * SEQ + vs0 + (Jq - W) + 8 * ch;
        vdma[i] = (unsigned)(vch + d) * NTOK + vslot;
    }
#define AT_DMA(t, buf) do { const unsigned kt_ = (unsigned)(t) * kstep_t, vt_ = (unsigned)(t) * vstep_t; LAS unsigned char* bb_ = ring + (buf) * 8192; \
        _Pragma("unroll") for (int i_ = 0; i_ < 4; ++i_) __builtin_amdgcn_global_load_lds((const unsigned*)(QK + (unsigned)(kdma[i_] + kt_)), (LAS unsigned*)(bb_ + i_ * 1024), 16, 0, 0); \
        _Pragma("unroll") for (int i_ = 0; i_ < 4; ++i_) __builtin_amdgcn_global_load_lds((const unsigned*)(VT + (unsigned)(vdma[i_] + vt_)), (LAS unsigned*)(bb_ + 4096 + i_ * 1024), 16, 0, 0); } while (0)
    AT_DMA(t_lo, 0);
    int kaddr[4], vaddr[2][2];
#pragma unroll
    for (int c = 0; c < 4; ++c) kaddr[c] = q * 128 + (((2 * c + h) ^ ((q >> 1) & 7)) << 4);
#pragma unroll
    for (int dh = 0; dh < 2; ++dh)
#pragma unroll
        for (int sx = 0; sx < 2; ++sx) vaddr[dh][sx] = 4096 + (32 * dh + q) * 64 + (((2 * sx + h) ^ ((q >> 2) & 3)) << 4);
    int tokq[2]; bf16x8 qf[2][4]; QState st[2];
#pragma unroll
    for (int n = 0; n < 2; ++n) {
        tokq[n] = MODE == 3 ? b * SEQ + (r00 + 2 * n + (q >> 4)) * 64 + qcg : b * SEQ + (Jq + 32 * n + q) * dil + rho;
        const bf16_t* qp = QK + (size_t)tokq[n] * QKW + qcol + 8 * h;
#pragma unroll
        for (int c = 0; c < 4; ++c) qf[n][c] = *(const bf16x8*)(qp + 16 * c);
        st[n].m = -1e30f; st[n].den = 0.f;
        if (MODE == 0) { st[n].m = p.sink[l * 6 + hq] * LOG2E; st[n].den = 1.0f; }
#pragma unroll
        for (int i = 0; i < 16; ++i) { st[n].O0[i] = 0.f; st[n].O1[i] = 0.f; }
    }
    int sc_q = 0, qrow0 = 0, qrow1 = 0, srq0 = 0, srq1 = 0, lo0 = 0, hi0 = 0, lo1 = 0, hi1 = 0;
    if (MODE == 3) { sc_q = qcg - 8 < 0 ? 0 : qcg - 8 > 48 ? 48 : qcg - 8;
        qrow0 = r00 + (q >> 4); qrow1 = qrow0 + 2; srq0 = qrow0 - 4 < 0 ? 0 : qrow0 - 4 > 56 ? 56 : qrow0 - 4; srq1 = qrow1 - 4 < 0 ? 0 : qrow1 - 4 > 56 ? 56 : qrow1 - 4;
        lo0 = r00 - 4 < 0 ? 0 : r00 - 4 > 56 ? 56 : r00 - 4; hi0 = (r00 - 3 < 0 ? 0 : r00 - 3 > 56 ? 56 : r00 - 3) + 8; lo1 = r00 - 2 < 0 ? 0 : r00 - 2 > 56 ? 56 : r00 - 2; hi1 = (r00 - 1 < 0 ? 0 : r00 - 1 > 56 ? 56 : r00 - 1) + 8; }
    const LAS float* bt_head = rpb_lds + hq * 465;
#define AT_S(S, n) do { _Pragma("unroll") for (int i_ = 0; i_ < 16; ++i_) S[i_] = 0.f; _Pragma("unroll") for (int c_ = 0; c_ < 4; ++c_) S = __builtin_amdgcn_mfma_f32_32x32x16_bf16(kf[c_], qf[n][c_], S, 0, 0, 0); } while (0)
#define AT_PV(n, p0, p1) do { st[n].O0 = __builtin_amdgcn_mfma_f32_32x32x16_bf16(vf[0][0], p0, st[n].O0, 0, 0, 0); st[n].O0 = __builtin_amdgcn_mfma_f32_32x32x16_bf16(vf[0][1], p1, st[n].O0, 0, 0, 0); \
        st[n].O1 = __builtin_amdgcn_mfma_f32_32x32x16_bf16(vf[1][0], p0, st[n].O1, 0, 0, 0); st[n].O1 = __builtin_amdgcn_mfma_f32_32x32x16_bf16(vf[1][1], p1, st[n].O1, 0, 0, 0); } while (0)
    for (int t = t_lo; t < t_hi; ++t) {
        const int buf = (t - t_lo) & 1;
        if (t + 1 < t_hi) { AT_DMA(t + 1, buf ^ 1); asm volatile("s_waitcnt vmcnt(8)" ::: "memory"); }
        else asm volatile("s_waitcnt vmcnt(0)" ::: "memory");
        const LAS unsigned char* bb = ring + buf * 8192;
        const bool act0 = MODE == 3 ? (t >= lo0 && t < hi0) : (t < NT), act1 = MODE == 3 ? (t >= lo1 && t < hi1) : (t >= 1);
        bf16x8 kf[4], vf[2][2];
#pragma unroll
        for (int c = 0; c < 4; ++c) kf[c] = *(const LAS bf16x8*)(bb + kaddr[c]);
        if (act0 && act1) {
            f32x16 S0, S1; AT_S(S0, 0); AT_S(S1, 1);
            mask_tile<MODE>(S0, t, NT, q, h, t, qrow0, srq0, sc_q, kc0, qcg, bt_head); mask_tile<MODE>(S1, t - 1, NT, q, h, t, qrow1, srq1, sc_q, kc0, qcg, bt_head);
            bf16x8 pa0, pa1, pb0, pb1;
            softmax_tile(S0, st[0], pa0, pa1); softmax_tile(S1, st[1], pb0, pb1);
            __builtin_amdgcn_sched_barrier(0);
#pragma unroll
            for (int dh = 0; dh < 2; ++dh)
#pragma unroll
                for (int sx = 0; sx < 2; ++sx) vf[dh][sx] = *(const LAS bf16x8*)(bb + vaddr[dh][sx]);
            AT_PV(0, pa0, pa1); AT_PV(1, pb0, pb1);
        } else if (act0) {
            f32x16 S0; AT_S(S0, 0);
#pragma unroll
            for (int dh = 0; dh < 2; ++dh)
#pragma unroll
                for (int sx = 0; sx < 2; ++sx) vf[dh][sx] = *(const LAS bf16x8*)(bb + vaddr[dh][sx]);
            mask_tile<MODE>(S0, t, NT, q, h, t, qrow0, srq0, sc_q, kc0, qcg, bt_head);
            bf16x8 pa0, pa1; softmax_tile(S0, st[0], pa0, pa1); AT_PV(0, pa0, pa1);
        } else if (act1) {
            f32x16 S1; AT_S(S1, 1);
#pragma unroll
            for (int dh = 0; dh < 2; ++dh)
#pragma unroll
                for (int sx = 0; sx < 2; ++sx) vf[dh][sx] = *(const LAS bf16x8*)(bb + vaddr[dh][sx]);
            mask_tile<MODE>(S1, t - 1, NT, q, h, t, qrow1, srq1, sc_q, kc0, qcg, bt_head);
            bf16x8 pb0, pb1; softmax_tile(S1, st[1], pb0, pb1); AT_PV(1, pb0, pb1);
        }
    }
#undef AT_DMA
#undef AT_S
#undef AT_PV
#pragma unroll
    for (int n = 0; n < 2; ++n) {
        const float rd = 1.0f / st[n].den;
        bf16_t* op;
        if (MODE == 1 || MODE == 2) { op = P_OB3(p) + ((size_t)g * NTOK + tokq[n]) * 128 + 64 * hs; if (h == 0) P_LSE(p)[((size_t)g * NTOK + tokq[n]) * 2 + hs] = (st[n].m + __log2f(st[n].den)) * LN2; }
        else op = P_OC(p) + (size_t)tokq[n] * OCW + (MODE == 0 ? 64 * hq : 512 + 64 * hq);
#pragma unroll
        for (int gq = 0; gq < 4; ++gq) {
            u32x2 w0, w1;
            w0[0] = cvt2(st[n].O0[4 * gq] * rd, st[n].O0[4 * gq + 1] * rd); w0[1] = cvt2(st[n].O0[4 * gq + 2] * rd, st[n].O0[4 * gq + 3] * rd);
            w1[0] = cvt2(st[n].O1[4 * gq] * rd, st[n].O1[4 * gq + 1] * rd); w1[1] = cvt2(st[n].O1[4 * gq + 2] * rd, st[n].O1[4 * gq + 3] * rd);
            *(u32x2*)(op + 8 * gq + 4 * h) = w0; *(u32x2*)(op + 32 + 8 * gq + 4 * h) = w1;
        }
    }
}
}
DI void f_attn_phase(const Params& p, int l, LAS unsigned char* lds, int slot) {
    const int tid = otid(), lane = tid & 63, wid = __builtin_amdgcn_readfirstlane(tid >> 6);
    LAS float* rpb_lds = (LAS float*)(lds + 131072 + 64);
    for (int i = tid; i < 4 * 465; i += 512) rpb_lds[i] = p.rpb[(size_t)l * 4 * 465 + i] * at::LOG2E;
    __syncthreads();
    LAS unsigned char* ring = lds + wid * 16384;
    const int x8 = blockIdx.x & 7;
    unsigned* ctr = (unsigned*)(p.ws + OFF_CTL + 16384) + 64 * (slot * 8 + x8);
    for (;;) {
        unsigned k = 0u;
        if (lane == 0) k = __hip_atomic_fetch_add(ctr, 1u, __ATOMIC_RELAXED, __HIP_MEMORY_SCOPE_AGENT);
        k = (unsigned)__builtin_amdgcn_readfirstlane((int)k);
        if (k >= 512u) break;
        int ln = lane; asm volatile("" : "+v"(ln));
        if (k < 192u) at::wave_unit<0>(p, l, x8 * 192 + (int)k, rpb_lds, ring, ln);
        else if (k < 320u) at::wave_unit<3>(p, l, x8 * 128 + (int)k - 192, rpb_lds, ring, ln);
        else { const int ub = x8 * 192 + (int)k - 320; if (((ub >> 7) % 3) == 1) at::wave_unit<2>(p, l, ub, rpb_lds, ring, ln); else at::wave_unit<1>(p, l, ub, rpb_lds, ring, ln); }
    }
    __syncthreads();
}

DI void bcombine_phase(const Params& p) {
    for (int i = blockIdx.x * 512 + otid(); i < NTOK * 16; i += gridDim.x * 512) {
        const int tok = i >> 4, part = i & 15, hs = part >> 3, d0 = (part & 7) * 8;
        const float l0 = P_LSE(p)[((size_t)0 * NTOK + tok) * 2 + hs], l1 = P_LSE(p)[((size_t)1 * NTOK + tok) * 2 + hs], l2 = P_LSE(p)[((size_t)2 * NTOK + tok) * 2 + hs];
        const float mx = fmaxf(l0, fmaxf(l1, l2)), e0 = __expf(l0 - mx), e1 = __expf(l1 - mx), e2 = __expf(l2 - mx), rs = 1.0f / (e0 + e1 + e2);
        const float a0 = e0 * rs, a1 = e1 * rs, a2 = e2 * rs;
        const u32x4 w0 = *(const u32x4*)(P_OB3(p) + ((size_t)0 * NTOK + tok) * 128 + 64 * hs + d0);
        const u32x4 w1 = *(const u32x4*)(P_OB3(p) + ((size_t)1 * NTOK + tok) * 128 + 64 * hs + d0);
        const u32x4 w2 = *(const u32x4*)(P_OB3(p) + ((size_t)2 * NTOK + tok) * 128 + 64 * hs + d0);
        u32x4 o;
#pragma unroll
        for (int j = 0; j < 4; ++j) o[j] = pk2(a0 * bflo(w0[j]) + a1 * bflo(w1[j]) + a2 * bflo(w2[j]), a0 * bfhi(w0[j]) + a1 * bfhi(w1[j]) + a2 * bfhi(w2[j]));
        *(u32x4*)(P_OC(p) + (size_t)tok * OCW + 384 + 64 * hs + d0) = o;
    }
}

namespace g8 {
constexpr int BM = 256, BK = 64, HALF = 128, HTB = HALF * BK * 2, NXCD = 8, WGM = 8;
DI int lds_byte(int r, int c) { const int st = (r >> 4) * 2 + (c >> 5), rr = r & 15, cc = c & 31, ob = rr * 64 + cc * 2; return st * 1024 + (ob ^ (((ob >> 9) & 1) << 5)); }
DI void stage_rc(int b, int& R, int& C) { const int st = b / 1024, sb = b % 1024, swz = sb ^ (((sb >> 9) & 1) << 5); R = (st >> 1) * 16 + swz / 64; C = (st & 1) * 32 + (swz % 64) / 2; }
DI int perm32(int rho) { const int n = rho >> 4, i = rho & 15; return 8 * (i >> 2) + 4 * n + (i & 3); }
struct Unit { int pm, pn, aux; };
struct StaticOrder {
    int nM, nN, nwg, G, c;
    DI void init(int M, int N, int G_, int c_) { nM = M / BM; nN = N / BM; nwg = nM * nN; G = G_; c = c_; }
    DI bool next(int i, Unit& u) const {
        const long L = (long)i * G + c; if (L >= nwg) return false;
        int wgid = (int)L; { const int q = nwg / NXCD, r = nwg % NXCD, xcd = wgid % NXCD, off = wgid / NXCD; wgid = (xcd < r ? xcd * (q + 1) : r * (q + 1) + (xcd - r) * q) + off; }
        const int nig = WGM * nN, gid = wgid / nig, fm = gid * WGM, gsz = (nM - fm) < WGM ? (nM - fm) : WGM;
        u.pm = fm + ((wgid % nig) % gsz); u.pn = (wgid % nig) / gsz; u.aux = 0; return true;
    }
};
typedef f32x4 Acc[2][2][4][2];
typedef int i32x4 __attribute__((ext_vector_type(4)));
typedef int i32x8 __attribute__((ext_vector_type(8)));
DI bf16x8 half8(const i32x8& v, int k) { const i32x4 x = k == 0 ? __builtin_shufflevector(v, v, 0, 1, 2, 3) : __builtin_shufflevector(v, v, 4, 5, 6, 7); return __builtin_bit_cast(bf16x8, x); }
DI i32x8 cat8(const bf16x8& a, const bf16x8& b) { const i32x4 x = __builtin_bit_cast(i32x4, a), y = __builtin_bit_cast(i32x4, b); return __builtin_shufflevector(x, y, 0, 1, 2, 3, 4, 5, 6, 7); }

template <class Desc, class Epi, class Sched, bool ALIGN_EPI>
DI void gemm_phase(LAS unsigned char* lds, const Desc& D, const Sched& S, const Epi& E) {
    const int tid = otid(), wid = __builtin_amdgcn_readfirstlane(tid >> 6), lane = tid & 63, wr = wid >> 2, wc = wid & 3, fr = lane & 15, fq = lane >> 4;
    int R0, C0, R1, C1; stage_rc(tid * 16, R0, C0); stage_rc(tid * 16 + 8192, R1, C1);
    const int Rb0 = Epi::PERM ? ((R0 & ~31) + perm32(R0 & 31)) : R0, Rb1 = Epi::PERM ? ((R1 & ~31) + perm32(R1 & 31)) : R1;
    constexpr unsigned LDA2 = Desc::lda * 2, LDB2 = Desc::ldb * 2;
    const size_t kstep = (size_t)(BK * 2);
    const unsigned ldsw = (unsigned)wid * 1024u;
    const int aoff = lds_byte(wr * 64 + fr, fq * 8), boff = lds_byte(wc * 32 + fr, fq * 8);
#define G8_SA(b, h) (((b) * 2 + (h)) * HTB)
#define G8_SB(b, h) ((4 + (b) * 2 + (h)) * HTB)
#define G8_STAGE(bufoff, gbase, o0, o1) do { \
        __builtin_amdgcn_global_load_lds((const unsigned*)((const char*)(gbase) + (o0)), (LAS unsigned*)(lds + (bufoff) + ldsw), 16, 0, 0); \
        __builtin_amdgcn_global_load_lds((const unsigned*)((const char*)(gbase) + (o1)), (LAS unsigned*)(lds + (bufoff) + ldsw + 8192), 16, 0, 0); } while (0)
#define G8_LDA(dst, b, h) do { _Pragma("unroll") for (int m = 0; m < 4; ++m) { const bf16x8 lo_ = *(const LAS bf16x8*)(lds + G8_SA(b, h) + aoff + m * 2048), hi_ = *(const LAS bf16x8*)(lds + G8_SA(b, h) + aoff + m * 2048 + 1024); dst[m] = cat8(lo_, hi_); } } while (0)
#define G8_LDB(dst, b, h) do { _Pragma("unroll") for (int n = 0; n < 2; ++n) { const bf16x8 lo_ = *(const LAS bf16x8*)(lds + G8_SB(b, h) + boff + n * 2048), hi_ = *(const LAS bf16x8*)(lds + G8_SB(b, h) + boff + n * 2048 + 1024); dst[n] = cat8(lo_, hi_); } } while (0)
#define G8_MMA(ai, bj, At, Bt) do { __builtin_amdgcn_s_setprio(1); _Pragma("unroll") for (int m = 0; m < 4; ++m) _Pragma("unroll") for (int n = 0; n < 2; ++n) _Pragma("unroll") for (int k = 0; k < 2; ++k) \
        acc[ai][bj][m][n] = __builtin_amdgcn_mfma_f32_16x16x32_bf16(half8(Bt[n], k), half8(At[m], k), acc[ai][bj][m][n], 0, 0, 0); __builtin_amdgcn_s_setprio(0); } while (0)
#define G8_MMA8(ai, bj, At, Bt) do { __builtin_amdgcn_s_setprio(1); _Pragma("unroll") for (int m = 0; m < 4; ++m) _Pragma("unroll") for (int n = 0; n < 2; ++n) \
        asm volatile("v_mfma_scale_f32_16x16x128_f8f6f4 %0, %1, %2, %0, %3, %3 op_sel_hi:[0,0,0]" : "+v"(acc[ai][bj][m][n]) : "v"(Bt[n]), "v"(At[m]), "v"(one_scale));     __builtin_amdgcn_s_setprio(0); } while (0)
#define G8_MM(ai, bj, At, Bt) do { if constexpr (Desc::FP8) G8_MMA8(ai, bj, At, Bt); else G8_MMA(ai, bj, At, Bt); } while (0)
#define G8_WAIT_V(n) asm volatile("s_waitcnt vmcnt(" #n ")" ::: "memory")
#define G8_WAIT_L(n) asm volatile("s_waitcnt lgkmcnt(" #n ")" ::: "memory")
#define G8_BAR __builtin_amdgcn_s_barrier()
#define G8_SCHED __builtin_amdgcn_sched_barrier(0)
#define G8_MKA(u, uidx, o) do { \
        o[0][0] = (unsigned)(Desc::GATHER ? D.a_row(u, uidx, R0) : R0) * LDA2 + (unsigned)C0 * 2u; o[0][1] = (unsigned)(Desc::GATHER ? D.a_row(u, uidx, R1) : R1) * LDA2 + (unsigned)C1 * 2u; \
        if (Desc::GATHER) { o[1][0] = (unsigned)D.a_row(u, uidx, HALF + R0) * LDA2 + (unsigned)C0 * 2u; o[1][1] = (unsigned)D.a_row(u, uidx, HALF + R1) * LDA2 + (unsigned)C1 * 2u; } } while (0)
#define G8_MKB(u, o, hs) do { const unsigned dl_ = (unsigned)D.dilB(u) * LDB2; hs = (unsigned)HALF * dl_; \
        o[0] = (unsigned)Rb0 * dl_ + (unsigned)C0 * 2u; o[1] = (unsigned)Rb1 * dl_ + (unsigned)C1 * 2u; } while (0)
#define G8_A1(o, i) (Desc::GATHER ? o[1][i] : o[0][i] + (unsigned)HALF * LDA2)
    Unit cur, nxt; int ui = 0;
    if (!S.next(0, cur)) return;
    Acc acc;
#pragma unroll
    for (int a = 0; a < 2; ++a)
#pragma unroll
        for (int b = 0; b < 2; ++b)
#pragma unroll
            for (int m = 0; m < 4; ++m)
#pragma unroll
                for (int n = 0; n < 2; ++n) acc[a][b][m][n] = (f32x4){0.f, 0.f, 0.f, 0.f};
    int one_scale = 0x7f7f7f7f; asm volatile("" : "+v"(one_scale));
    i32x8 At[4], B0[2], B1[2];
    unsigned cAo[2][2], cBo[2], nAo[2][2], nBo[2], cBh, nBh;
    G8_MKA(cur, 0, cAo); G8_MKB(cur, cBo, cBh); nBh = cBh;
    const char* cA = D.a_base(cur); const char* cB = D.b_base(cur);
    G8_STAGE(G8_SB(0, 0), cB, cBo[0], cBo[1]); G8_STAGE(G8_SB(0, 1), cB + cBh, cBo[0], cBo[1]); G8_STAGE(G8_SA(0, 0), cA, cAo[0][0], cAo[0][1]); G8_STAGE(G8_SA(0, 1), cA, G8_A1(cAo, 0), G8_A1(cAo, 1));
    if (wr == 1) G8_BAR;
    G8_WAIT_V(2); G8_BAR;
    G8_STAGE(G8_SB(1, 0), cB + kstep, cBo[0], cBo[1]); G8_STAGE(G8_SA(1, 0), cA + kstep, cAo[0][0], cAo[0][1]); G8_STAGE(G8_SB(1, 1), cB + kstep + cBh, cBo[0], cBo[1]);
    G8_WAIT_V(6); G8_BAR;
    for (;;) {
        const bool has_next = S.next(ui + 1, nxt);
        const char* nA = cA; const char* nB = cB;
        if (has_next) { nA = D.a_base(nxt); nB = D.b_base(nxt); }
        if (Desc::GATHER) { if (has_next) G8_MKA(nxt, ui + 1, nAo); else { nAo[0][0] = cAo[0][0]; nAo[0][1] = cAo[0][1]; nAo[1][0] = cAo[1][0]; nAo[1][1] = cAo[1][1]; } }
        if (Desc::VARB) { if (has_next) G8_MKB(nxt, nBo, nBh); else { nBo[0] = cBo[0]; nBo[1] = cBo[1]; nBh = cBh; } }
        const int nt = D.nt(cur);
#pragma unroll 1
        for (int t = 0; t < nt; t += 2) {
            const bool last = (t == nt - 2);
            const char* a1 = cA + (size_t)(t + 1) * kstep;
            const char* a2 = last ? nA : cA + (size_t)(t + 2) * kstep; const char* b2 = last ? nB : cB + (size_t)(t + 2) * kstep;
            const char* a3 = a2 + kstep; const char* b3 = b2 + kstep;
            const unsigned xa00 = (Desc::GATHER && last) ? nAo[0][0] : cAo[0][0], xa01 = (Desc::GATHER && last) ? nAo[0][1] : cAo[0][1];
            const unsigned xa10 = Desc::GATHER ? (last ? nAo[1][0] : cAo[1][0]) : xa00 + (unsigned)HALF * LDA2, xa11 = Desc::GATHER ? (last ? nAo[1][1] : cAo[1][1]) : xa01 + (unsigned)HALF * LDA2;
            const unsigned xb0 = (Desc::VARB && last) ? nBo[0] : cBo[0], xb1 = (Desc::VARB && last) ? nBo[1] : cBo[1], xbh = (Desc::VARB && last) ? nBh : cBh;
            G8_LDB(B0, 0, 0); G8_LDB(B1, 0, 1); G8_SCHED; G8_LDA(At, 0, 0); G8_STAGE(G8_SA(1, 1), a1, G8_A1(cAo, 0), G8_A1(cAo, 1));
            G8_WAIT_V(8); G8_WAIT_L(0); G8_BAR; G8_MM(0, 0, At, B0); G8_MM(0, 1, At, B1); G8_BAR; G8_SCHED;
            G8_LDA(At, 0, 1); G8_STAGE(G8_SB(0, 0), b2, xb0, xb1); G8_STAGE(G8_SB(0, 1), b2 + xbh, xb0, xb1); G8_STAGE(G8_SA(0, 0), a2, xa00, xa01);
            G8_WAIT_V(8); G8_WAIT_L(0); G8_BAR; G8_MM(1, 0, At, B0); G8_MM(1, 1, At, B1); G8_BAR; G8_SCHED;
            G8_LDB(B0, 1, 0); G8_LDB(B1, 1, 1); G8_SCHED; G8_LDA(At, 1, 0); G8_STAGE(G8_SA(0, 1), a2, xa10, xa11);
            G8_WAIT_V(8); G8_WAIT_L(0); G8_BAR; G8_MM(0, 0, At, B0); G8_MM(0, 1, At, B1); G8_BAR; G8_SCHED;
            G8_LDA(At, 1, 1); G8_STAGE(G8_SB(1, 0), b3, xb0, xb1); G8_STAGE(G8_SB(1, 1), b3 + xbh, xb0, xb1); G8_STAGE(G8_SA(1, 0), a3, xa00, xa01);
            G8_WAIT_V(8); G8_WAIT_L(0); G8_BAR; G8_MM(1, 0, At, B0); G8_MM(1, 1, At, B1); G8_BAR; G8_SCHED;
        }
        if constexpr (ALIGN_EPI) { if (wr == 0) G8_BAR; }
        if constexpr (Desc::FP8) asm volatile("s_nop 15\n\ts_nop 15" ::: "memory");
        E(acc, cur, wr, wc, fr, fq);
        if (!has_next) break;
#pragma unroll
        for (int a = 0; a < 2; ++a)
#pragma unroll
            for (int b = 0; b < 2; ++b)
#pragma unroll
                for (int m = 0; m < 4; ++m)
#pragma unroll
                    for (int n = 0; n < 2; ++n) acc[a][b][m][n] = (f32x4){0.f, 0.f, 0.f, 0.f};
        if constexpr (Desc::FP8) asm volatile("s_nop 7" ::: "memory");
        cur = nxt; cA = nA; cB = nB; ++ui;
        if (Desc::GATHER) { cAo[0][0] = nAo[0][0]; cAo[0][1] = nAo[0][1]; cAo[1][0] = nAo[1][0]; cAo[1][1] = nAo[1][1]; }
        if (Desc::VARB) { cBo[0] = nBo[0]; cBo[1] = nBo[1]; cBh = nBh; }
        if constexpr (ALIGN_EPI) { if (wr == 1) G8_BAR; }
    }
    G8_WAIT_V(0);
    if constexpr (!ALIGN_EPI) { if (wr == 0) G8_BAR; }
    G8_BAR;
#undef G8_SA
#undef G8_SB
#undef G8_STAGE
#undef G8_LDA
#undef G8_LDB
#undef G8_MMA
#undef G8_MMA8
#undef G8_MM
#undef G8_WAIT_V
#undef G8_WAIT_L
#undef G8_BAR
#undef G8_SCHED
#undef G8_MKA
#undef G8_MKB
#undef G8_A1
}
DI unsigned cvt2(float lo, float hi) { typedef __bf16 bf2_t __attribute__((ext_vector_type(2))); const f32x2 v = {lo, hi}; const bf2_t b = __builtin_convertvector(v, bf2_t); return __builtin_bit_cast(unsigned, b); }
DI u32x4 pack8(const f32x4& a, const f32x4& b) { u32x4 w; w[0] = cvt2(a[0], a[1]); w[1] = cvt2(a[2], a[3]); w[2] = cvt2(b[0], b[1]); w[3] = cvt2(b[2], b[3]); return w; }
DI float fsig(float x) { return __builtin_amdgcn_rcpf(1.0f + __expf(-x)); }

struct DescMoe1 { static constexpr bool GATHER = true, VARB = false, FP8 = true; static constexpr int lda = DM / 2, ldb = DM / 2; const bf16_t* XN8; const bf16_t* WGU; const LAS int* rowlist;
    DI const char* a_base(const Unit&) const { return (const char*)XN8; }
    DI const char* b_base(const Unit& u) const { return (const char*)WGU + ((size_t)(u.pm >> 3) * 4096 + (size_t)u.pn * 256) * DM; }
    DI int a_row(const Unit&, int uidx, int r) const { return rowlist[uidx * 256 + r]; }
    DI int nt(const Unit&) const { return DM / 128; } DI int dilB(const Unit&) const { return 1; } };
struct EpiSwiglu { static constexpr bool PERM = true; unsigned char* HID8;
    DI void operator()(const Acc& acc, const Unit& u, int wr, int wc, int fr, int fq) const {
        const int row0 = u.pm * BM + wr * 64 + fr, col0 = u.pn * 128 + wc * 32 + 8 * fq; constexpr float WI = 1.0f / W8_SCALE;
#pragma unroll
        for (int ai = 0; ai < 2; ++ai)
#pragma unroll
            for (int m = 0; m < 4; ++m) {
                constexpr float C1 = -WI * 1.4426950408889634f, KI = 1.0f / (WI * WI * H8_SCALE);
                const f32x4 ag0 = acc[ai][0][m][0], ag1 = acc[ai][0][m][1], au0 = acc[ai][1][m][0], au1 = acc[ai][1][m][1];
                f32x4 e0 = ag0 * C1, e1 = ag1 * C1;
#pragma unroll
                for (int j = 0; j < 4; ++j) { e0[j] = __builtin_amdgcn_exp2f(e0[j]); e1[j] = __builtin_amdgcn_exp2f(e1[j]); }
                f32x4 d0 = e0 * KI + KI, d1 = e1 * KI + KI;
#pragma unroll
                for (int j = 0; j < 4; ++j) { d0[j] = __builtin_amdgcn_rcpf(d0[j]); d1[j] = __builtin_amdgcn_rcpf(d1[j]); }
                const f32x4 h0 = (ag0 * au0) * d0, h1 = (ag1 * au1) * d1;
                u32x2 w; w[0] = pk4_fp8(h0[0], h0[1], h0[2], h0[3]); w[1] = pk4_fp8(h1[0], h1[1], h1[2], h1[3]);
                *(u32x2*)(HID8 + (size_t)(row0 + ai * HALF + m * 16) * FF + col0) = w; }
    } };
struct DescMoe2 { static constexpr bool GATHER = false, VARB = false, FP8 = true; static constexpr int lda = FF / 2, ldb = FF / 2; const unsigned char* HID8; const bf16_t* WD;
    DI const char* a_base(const Unit& u) const { return (const char*)HID8 + (size_t)u.pm * 256 * FF; }
    DI const char* b_base(const Unit& u) const { return (const char*)WD + ((size_t)(u.pm >> 3) * 1024 + (size_t)u.pn * 256) * FF; }
    DI int a_row(const Unit&, int, int r) const { return r; }
    DI int nt(const Unit&) const { return FF / 128; } DI int dilB(const Unit&) const { return 1; } };
struct EpiY { static constexpr bool PERM = true; bf16_t* Y; const float* VAL;
    DI void operator()(const Acc& acc, const Unit& u, int wr, int wc, int fr, int fq) const {
        const int row0 = u.pm * BM + wr * 64 + fr, col0 = u.pn * BM + wc * 32 + 8 * fq;
        float vv[2][4];
#pragma unroll
        for (int ai = 0; ai < 2; ++ai)
#pragma unroll
            for (int m = 0; m < 4; ++m) vv[ai][m] = VAL[row0 + ai * HALF + m * 16];
#pragma unroll
        for (int ai = 0; ai < 2; ++ai)
#pragma unroll
            for (int m = 0; m < 4; ++m) { const int row = row0 + ai * HALF + m * 16; const float v = vv[ai][m] * (1.0f / (W8_SCALE * H8_SCALE));
#pragma unroll
                for (int bj = 0; bj < 2; ++bj) *(u32x4*)(Y + (size_t)row * DM + col0 + bj * HALF) = pack8(acc[ai][bj][m][0] * v, acc[ai][bj][m][1] * v); }
    } };
struct DescOut { static constexpr bool GATHER = false, VARB = false, FP8 = false; static constexpr int lda = DM, ldb = DM; const bf16_t* MG; const bf16_t* WO;
    DI const char* a_base(const Unit& u) const { return (const char*)(MG + (size_t)u.pm * 256 * DM); }
    DI const char* b_base(const Unit& u) const { return (const char*)(WO + (size_t)u.pn * 256 * DM); }
    DI int a_row(const Unit&, int, int r) const { return r; }
    DI int nt(const Unit&) const { return DM / BK; } DI int dilB(const Unit&) const { return 1; } };
struct EpiResid { static constexpr bool PERM = true; bf16_t* X;
    DI void operator()(const Acc& acc, const Unit& u, int wr, int wc, int fr, int fq) const {
        const int row0 = u.pm * BM + wr * 64 + fr, col0 = u.pn * BM + wc * 32 + 8 * fq;
#pragma unroll
        for (int ai = 0; ai < 2; ++ai) {
            u32x4 x[4][2];
#pragma unroll
            for (int m = 0; m < 4; ++m)
#pragma unroll
                for (int bj = 0; bj < 2; ++bj) x[m][bj] = *(const u32x4*)(X + (size_t)(row0 + ai * HALF + m * 16) * DM + col0 + bj * HALF);
#pragma unroll
            for (int m = 0; m < 4; ++m)
#pragma unroll
                for (int bj = 0; bj < 2; ++bj) { f32x4 v0 = acc[ai][bj][m][0], v1 = acc[ai][bj][m][1]; const u32x4 ww = x[m][bj];
                    v0[0] += bflo(ww[0]); v0[1] += bfhi(ww[0]); v0[2] += bflo(ww[1]); v0[3] += bfhi(ww[1]); v1[0] += bflo(ww[2]); v1[1] += bfhi(ww[2]); v1[2] += bflo(ww[3]); v1[3] += bfhi(ww[3]);
                    *(u32x4*)(X + (size_t)(row0 + ai * HALF + m * 16) * DM + col0 + bj * HALF) = pack8(v0, v1); }
            __builtin_amdgcn_sched_barrier(0);
        }
    } };
struct DescInproj { static constexpr bool GATHER = false, VARB = false, FP8 = false; static constexpr int lda = DM, ldb = DM; const bf16_t* XN; const bf16_t* WIN;
    DI const char* a_base(const Unit& u) const { return (const char*)(XN + (size_t)u.pm * 256 * DM); }
    DI const char* b_base(const Unit& u) const { return (const char*)(WIN + (size_t)u.pn * 256 * DM); }
    DI int a_row(const Unit&, int, int r) const { return r; }
    DI int nt(const Unit&) const { return DM / BK; } DI int dilB(const Unit&) const { return 1; } };
struct EpiInproj { static constexpr bool PERM = true; bf16_t* QK; unsigned char* G; const float* cosT; const float* sinT; const float* bgate;
    DI void operator()(const Acc& acc, const Unit& u, int wr, int wc, int fr, int fq) const {
        const int row0 = u.pm * BM + wr * 64 + fr;
        if (u.pn < 5) {
            const int hr = 4 * u.pn + wc; const float sc = (hr < 6 || (hr >= 8 && hr < 14)) ? 0.125f * 1.4426950408889634f : 1.0f;
#pragma unroll
            for (int ai = 0; ai < 2; ++ai) {
                f32x4 tc[4][2], ts[4][2];
#pragma unroll
                for (int m = 0; m < 4; ++m) { const int pos = (row0 + ai * HALF + m * 16) & (SEQ - 1);
                    tc[m][0] = *(const f32x4*)(cosT + pos * 32 + 8 * fq); tc[m][1] = *(const f32x4*)(cosT + pos * 32 + 8 * fq + 4); ts[m][0] = *(const f32x4*)(sinT + pos * 32 + 8 * fq); ts[m][1] = *(const f32x4*)(sinT + pos * 32 + 8 * fq + 4); }
#pragma unroll
                for (int m = 0; m < 4; ++m) { const int row = row0 + ai * HALF + m * 16;
                    const f32x4 c0 = tc[m][0], c1 = tc[m][1], s0 = ts[m][0], s1 = ts[m][1];
                    const f32x4 a0 = acc[ai][0][m][0], a1 = acc[ai][0][m][1], b0 = acc[ai][1][m][0], b1 = acc[ai][1][m][1];
                    bf16_t* o = QK + (size_t)row * QKW + 64 * hr + 8 * fq;
                    *(u32x4*)o = pack8((a0 * c0 - b0 * s0) * sc, (a1 * c1 - b1 * s1) * sc);
                    *(u32x4*)(o + 32) = pack8((b0 * c0 + a0 * s0) * sc, (b1 * c1 + a1 * s1) * sc); }
                __builtin_amdgcn_sched_barrier(0);
            }
        } else if (u.pn < 7) {
            const float sc = u.pn == 5 ? 0.125f * 1.4426950408889634f : 1.0f; const int col0 = 1280 + (u.pn - 5) * 256 + wc * 32 + 8 * fq;
#pragma unroll
            for (int ai = 0; ai < 2; ++ai)
#pragma unroll
                for (int m = 0; m < 4; ++m)
#pragma unroll
                    for (int bj = 0; bj < 2; ++bj) *(u32x4*)(QK + (size_t)(row0 + ai * HALF + m * 16) * QKW + col0 + bj * HALF) = pack8(acc[ai][bj][m][0] * sc, acc[ai][bj][m][1] * sc);
        } else {
            const int col0 = (u.pn - 7) * 256 + wc * 32 + 8 * fq;
            f32x4 bv[2][2];
#pragma unroll
            for (int bj = 0; bj < 2; ++bj)
#pragma unroll
                for (int n = 0; n < 2; ++n) bv[bj][n] = *(const f32x4*)(bgate + col0 + bj * HALF + 4 * n) * -1.4426950408889634f;
#pragma unroll
            for (int ai = 0; ai < 2; ++ai)
#pragma unroll
                for (int m = 0; m < 4; ++m)
#pragma unroll
                    for (int bj = 0; bj < 2; ++bj) { f32x4 v0 = acc[ai][bj][m][0] * -1.4426950408889634f + bv[bj][0], v1 = acc[ai][bj][m][1] * -1.4426950408889634f + bv[bj][1];
#pragma unroll
                        for (int j = 0; j < 4; ++j) { v0[j] = __builtin_amdgcn_exp2f(v0[j]); v1[j] = __builtin_amdgcn_exp2f(v1[j]); }
                        v0 = v0 * (1.0f / 255.0f) + (1.0f / 255.0f); v1 = v1 * (1.0f / 255.0f) + (1.0f / 255.0f);
#pragma unroll
                        for (int j = 0; j < 4; ++j) { v0[j] = __builtin_amdgcn_rcpf(v0[j]); v1[j] = __builtin_amdgcn_rcpf(v1[j]); }
                        v0 = v0 + 0.5f; v1 = v1 + 0.5f;
                        u32x2 w; w[0] = (unsigned)v0[0] | ((unsigned)v0[1] << 8) | ((unsigned)v0[2] << 16) | ((unsigned)v0[3] << 24); w[1] = (unsigned)v1[0] | ((unsigned)v1[1] << 8) | ((unsigned)v1[2] << 16) | ((unsigned)v1[3] << 24);
                        *(u32x2*)(G + (size_t)(row0 + ai * HALF + m * 16) * 3072 + col0 + bj * HALF) = w; }
        }
    } };
struct DescVT { static constexpr bool GATHER = false, VARB = true, FP8 = false; static constexpr int lda = DM, ldb = DM; const bf16_t* WV; const bf16_t* XN;
    DI const char* a_base(const Unit& u) const { return (const char*)(WV + (size_t)u.pm * 256 * DM); }
    DI const char* b_base(const Unit& u) const { return (const char*)(XN + (u.pm < 2 ? (size_t)u.pn * 256 : (size_t)((u.pn >> 4) * SEQ + (u.pn & 15))) * DM); }
    DI int a_row(const Unit&, int, int r) const { return r; }
    DI int nt(const Unit&) const { return DM / BK; } DI int dilB(const Unit& u) const { return u.pm < 2 ? 1 : 16; } };
struct EpiVT { static constexpr bool PERM = true; bf16_t* VT;
    DI void operator()(const Acc& acc, const Unit& u, int wr, int wc, int fr, int fq) const {
        const int row0 = u.pm * BM + wr * 64 + fr, col0 = u.pn * BM + wc * 32 + 8 * fq;
#pragma unroll
        for (int ai = 0; ai < 2; ++ai)
#pragma unroll
            for (int m = 0; m < 4; ++m)
#pragma unroll
                for (int bj = 0; bj < 2; ++bj) *(u32x4*)(VT + (size_t)(row0 + ai * HALF + m * 16) * NTOK + col0 + bj * HALF) = pack8(acc[ai][bj][m][0], acc[ai][bj][m][1]);
    } };
struct DescMerge { static constexpr bool GATHER = false, VARB = false, FP8 = false; static constexpr int lda = OCW, ldb = 768; const bf16_t* OC; const bf16_t* WM;
    DI int k0(const Unit& u) const { return u.aux == 0 ? 0 : u.aux == 1 ? 384 : 512; }
    DI const char* a_base(const Unit& u) const { return (const char*)(OC + (size_t)u.pm * 256 * OCW + k0(u)); }
    DI const char* b_base(const Unit& u) const { return (const char*)(WM + (size_t)u.pn * 256 * 768 + k0(u)); }
    DI int a_row(const Unit&, int, int r) const { return r; }
    DI int nt(const Unit& u) const { return u.aux == 0 ? 6 : u.aux == 1 ? 2 : 4; } DI int dilB(const Unit&) const { return 1; } };
struct MergeOrder { StaticOrder base;
    DI bool next(int i, Unit& u) const { const int q = i / 3; if (!base.next(q, u)) return false; u.aux = i - 3 * q; return true; } };
struct EpiMerge { static constexpr bool PERM = true; bf16_t* MG; const unsigned char* G;
    DI void operator()(const Acc& acc, const Unit& u, int wr, int wc, int fr, int fq) const {
        const int row0 = u.pm * BM + wr * 64 + fr, col0 = u.pn * BM + wc * 32 + 8 * fq;
#pragma unroll
        for (int ai = 0; ai < 2; ++ai) {
            u32x2 g[4][2]; u32x4 w[4][2];
#pragma unroll
            for (int m = 0; m < 4; ++m)
#pragma unroll
                for (int bj = 0; bj < 2; ++bj) { const int row = row0 + ai * HALF + m * 16, col = col0 + bj * HALF;
                    g[m][bj] = *(const u32x2*)(G + (size_t)row * 3072 + 1024 * u.aux + col);
                    if (u.aux != 0) w[m][bj] = *(const u32x4*)(MG + (size_t)row * DM + col); else w[m][bj] = (u32x4){0u, 0u, 0u, 0u}; }
#pragma unroll
            for (int m = 0; m < 4; ++m)
#pragma unroll
                for (int bj = 0; bj < 2; ++bj) { const int row = row0 + ai * HALF + m * 16, col = col0 + bj * HALF;
                    const u32x2 gg = g[m][bj]; const u32x4 ww = w[m][bj]; constexpr float GI = 1.0f / 255.0f;
                    f32x4 v0 = acc[ai][bj][m][0] * GI, v1 = acc[ai][bj][m][1] * GI;
                    v0[0] = v0[0] * (float)(gg[0] & 255u) + bflo(ww[0]); v0[1] = v0[1] * (float)((gg[0] >> 8) & 255u) + bfhi(ww[0]); v0[2] = v0[2] * (float)((gg[0] >> 16) & 255u) + bflo(ww[1]); v0[3] = v0[3] * (float)(gg[0] >> 24) + bfhi(ww[1]);
                    v1[0] = v1[0] * (float)(gg[1] & 255u) + bflo(ww[2]); v1[1] = v1[1] * (float)((gg[1] >> 8) & 255u) + bfhi(ww[2]); v1[2] = v1[2] * (float)((gg[1] >> 16) & 255u) + bflo(ww[3]); v1[3] = v1[3] * (float)(gg[1] >> 24) + bfhi(ww[3]);
                    *(u32x4*)(MG + (size_t)row * DM + col) = pack8(v0, v1); }
            __builtin_amdgcn_sched_barrier(0);
        }
    } };
}
DI void f_inproj_phase(const Params& p, int l, LAS unsigned char* lds) {
    { g8::StaticOrder S; S.init(NTOK, 4352, gridDim.x, blockIdx.x);
      g8::DescInproj D{P_XN(p), P_W(p, l, LW_WIN)}; g8::EpiInproj E{P_QK(p), P_G(p), P_COS(p), P_SIN(p), p.b_gate + (size_t)l * 3072};
      g8::gemm_phase<g8::DescInproj, g8::EpiInproj, g8::StaticOrder, true>(lds, D, S, E); }
    { g8::StaticOrder S; S.init(VCH, NTOK, gridDim.x, (blockIdx.x + gridDim.x - 64) % gridDim.x);
      g8::DescVT D{P_W(p, l, LW_WV), P_XN(p)}; g8::EpiVT E{P_VT(p)};
      g8::gemm_phase<g8::DescVT, g8::EpiVT, g8::StaticOrder, true>(lds, D, S, E); }
}
struct OneUnit { int pm, pn; DI bool next(int i, g8::Unit& u) const { if (i != 0) return false; u.pm = pm; u.pn = pn; u.aux = 0; return true; } };
DI void f_gate_tail_units(const Params& p, int l, LAS unsigned char* lds) {
    if (blockIdx.x < 128) {
        OneUnit S{(int)(blockIdx.x >> 1), 17 + (int)(blockIdx.x & 1)};
        g8::DescInproj D{P_XN(p), P_W(p, l, LW_WIN)}; g8::EpiInproj E{P_QK(p), P_G(p), P_COS(p), P_SIN(p), p.b_gate + (size_t)l * 3072};
        g8::gemm_phase<g8::DescInproj, g8::EpiInproj, OneUnit, false>(lds, D, S, E);
        __syncthreads();
    }
}
DI void f_merge_phase(const Params& p, int l, LAS unsigned char* lds) {
    g8::MergeOrder S; S.base.init(NTOK, DM, gridDim.x, blockIdx.x);
    g8::DescMerge D{P_OC(p), P_W(p, l, LW_WM)}; g8::EpiMerge E{P_MG(p), P_G(p)};
    g8::gemm_phase<g8::DescMerge, g8::EpiMerge, g8::MergeOrder, true>(lds, D, S, E);
}

DI void f_moe1_phase(const Params& p, int l, LAS unsigned char* lds) {
    g8::StaticOrder S; S.init(NROWS_E, 2 * FF, gridDim.x, blockIdx.x);
    LAS int* rowlist = (LAS int*)(lds + 131072 + 64);
    g8::Unit u;
    for (int i = 0; i < 8 && S.next(i, u); ++i)
        for (int r = otid(); r < 256; r += 512) rowlist[i * 256 + r] = ((u.pm >> 1) & 3) * SEQ + P_IDX(p)[u.pm * 256 + r];
    __syncthreads();
    g8::DescMoe1 D{(const bf16_t*)P_XN8(p), P_W(p, l, LW_WGU), rowlist}; g8::EpiSwiglu E{(unsigned char*)P_HID(p)};
    g8::gemm_phase<g8::DescMoe1, g8::EpiSwiglu, g8::StaticOrder, true>(lds, D, S, E);
}
DI void f_moe2_phase(const Params& p, int l, LAS unsigned char* lds) {
    g8::StaticOrder S; S.init(NROWS_E, DM, gridDim.x, blockIdx.x);
    g8::DescMoe2 D{(const unsigned char*)P_HID(p), P_W(p, l, LW_WD)}; g8::EpiY E{P_Y(p), P_VAL(p)};
    g8::gemm_phase<g8::DescMoe2, g8::EpiY, g8::StaticOrder, true>(lds, D, S, E);
}
DI void f_out_phase(const Params& p, int l, LAS unsigned char* lds) {
    g8::StaticOrder S; S.init(NTOK, DM, gridDim.x, blockIdx.x);
    g8::DescOut D{P_MG(p), P_W(p, l, LW_WO)}; g8::EpiResid E{P_X(p)};
    g8::gemm_phase<g8::DescOut, g8::EpiResid, g8::StaticOrder, false>(lds, D, S, E);
}

#define XB_TMO      128
#define XB_XCNT(j)  (256  + 64 * (j))
#define XB_XSUB(j)  (1280 + 64 * (j))
#define XB_XGEN(j)  (2304 + 64 * (j))
#define XB_TOP      3328
#define XB_TOPGEN   3392
#define XCD_BAR_WORDS 3456
#define XB_SPIN_CAP (1u << 22)

__device__ __forceinline__ unsigned xb_ld(unsigned* p)              { return __hip_atomic_load(p, __ATOMIC_RELAXED, __HIP_MEMORY_SCOPE_AGENT); }
__device__ __forceinline__ unsigned xb_add(unsigned* p, unsigned v) { return __hip_atomic_fetch_add(p, v, __ATOMIC_RELAXED, __HIP_MEMORY_SCOPE_AGENT); }
__device__ __forceinline__ unsigned xb_xcc_id() { return (unsigned)__builtin_amdgcn_s_getreg((3 << 11) | 20) & 0xFu; }
#define XB_SPIN(cond, bar) do { unsigned _sp = 0; while (cond) { __builtin_amdgcn_s_sleep(1); \
    if ((++_sp & 255u) == 0u) { if (xb_ld(&(bar)[XB_TMO])) break; if (_sp > XB_SPIN_CAP) { atomicAdd(&(bar)[XB_TMO], 1u); break; } } } } while (0)

struct XcdBarrier {
    unsigned* bar; unsigned x;
    volatile LAS unsigned* st;
};

__device__ __forceinline__ XcdBarrier xcd_barrier_post(unsigned* bar, volatile LAS unsigned* st) {
    XcdBarrier b; b.bar = bar; b.x = xb_xcc_id(); b.st = st;
    if (threadIdx.x == 0) (void)xb_add(&bar[XB_XCNT(b.x)], 1u);
    return b;
}
__device__ __forceinline__ void xcd_barrier_complete(unsigned* bar, unsigned x, unsigned& nloc, unsigned& nx) {
    const unsigned G = gridDim.x * gridDim.y * gridDim.z;
    unsigned sum, cnt, mine, sp = 0u;
    for (;;) {
        sum = 0u; cnt = 0u; mine = 0u;
#pragma unroll
        for (unsigned j = 0; j < 16; ++j) { const unsigned c = xb_ld(&bar[XB_XCNT(j)]); sum += c; cnt += (c > 0u) ? 1u : 0u; mine = (j == x) ? c : mine; }
        if (sum == G) break;
        __builtin_amdgcn_s_sleep(1);
        if ((++sp & 255u) == 0u) { if (xb_ld(&bar[XB_TMO])) break; if (sp > XB_SPIN_CAP) { atomicAdd(&bar[XB_TMO], 1u); break; } }
    }
    nloc = mine > 0u ? mine : 1u; nx = cnt > 0u ? cnt : 1u;
}

__device__ __forceinline__ void xcd_barrier(const XcdBarrier& b) {
    asm volatile("s_waitcnt vmcnt(0)" ::: "memory");
    __syncthreads();
    if (threadIdx.x == 0) {
        unsigned* bar = b.bar;
        __builtin_amdgcn_s_waitcnt(0);
        unsigned nloc = b.st[0], nx = b.st[1];
        if (nloc == 0u) { xcd_barrier_complete(bar, b.x, nloc, nx); b.st[0] = nloc; b.st[1] = nx; }
        const unsigned old = xb_add(&bar[XB_XSUB(b.x)], 1u);
        const unsigned gen = old / nloc;
        if (old + 1u == (gen + 1u) * nloc) {
            __builtin_amdgcn_fence(__ATOMIC_RELEASE, "agent");
            asm volatile("s_waitcnt vmcnt(0)" ::: "memory");
            const unsigned og = xb_add(&bar[XB_TOP], 1u);
            const unsigned tg = og / nx;
            if (og + 1u == (tg + 1u) * nx) xb_add(&bar[XB_TOPGEN], 1u);
            else XB_SPIN(xb_ld(&bar[XB_TOPGEN]) == tg, bar);
            __builtin_amdgcn_fence(__ATOMIC_ACQUIRE, "agent");
            xb_add(&bar[XB_XGEN(b.x)], 1u);
            asm volatile("s_waitcnt vmcnt(0)" ::: "memory");
        } else {
            XB_SPIN(xb_ld(&bar[XB_XGEN(b.x)]) == gen, bar);
            __builtin_amdgcn_fence(__ATOMIC_ACQUIRE, "agent");
            asm volatile("s_waitcnt vmcnt(0)" ::: "memory");
        }
    }
    __syncthreads();
}

constexpr int LDS_BYTES = 131072 + 64 + 8192;
#ifndef REP_PREP
#define REP_PREP 1
#define REP_INPROJ 1
#define REP_ATTN 1
#define REP_MERGE 1
#define REP_BCOMB 1
#define REP_N2 1
#define REP_TOPK 1
#define REP_MOE1 1
#define REP_MOE2 1
#endif
#define PH(...) do { Params q = p; { size_t z_ = 0; asm volatile("" : "+s"(z_)); q.ws = p.ws + z_; } __VA_ARGS__; } while (0)
#define GRID_BAR() do { XcdBarrier b_; { size_t z_ = 0; asm volatile("" : "+s"(z_)); b_.bar = (unsigned*)(p.ws + z_ + OFF_CTL); } b_.x = xb_xcc_id(); b_.st = (volatile LAS unsigned*)(lds + 131072); xcd_barrier(b_); } while (0)
__global__ void __launch_bounds__(512, 2) mega_fwd(Params p) {
    extern __shared__ __attribute__((aligned(16))) unsigned char lds_raw[];
    LAS unsigned char* lds = (LAS unsigned char*)lds_raw;
    { volatile LAS unsigned* xbw = (volatile LAS unsigned*)(lds + 131072);
      if (threadIdx.x == 0) { xbw[0] = 0u; xbw[1] = 0u; xbw[2] = 0u; xbw[3] = 0u; }
      __syncthreads();
      (void)xcd_barrier_post((unsigned*)(p.ws + OFF_CTL), xbw); }
    PH(prep_phase(q, (LAS float*)lds); norm1_phase<0>(q, 0));
    GRID_BAR();
#define LAYER(l) do { \
        if ((l) != 0) { PH(norm1_phase<1>(q, (l))); GRID_BAR(); } \
        PH(f_inproj_phase(q, (l), lds)); GRID_BAR(); \
        PH(f_gate_tail_units(q, (l), lds); prep_expert_phase(q, (l), (LAS float*)lds); f_attn_phase(q, (l), lds, (l))); GRID_BAR(); \
        PH(bcombine_phase(q)); GRID_BAR(); \
        PH(f_merge_phase(q, (l), lds)); GRID_BAR(); \
        PH(f_out_phase(q, (l), lds)); GRID_BAR(); \
        PH(norm2_router_phase(q, (l), (LAS float*)lds)); GRID_BAR(); \
        PH(topk_phase(q, (LAS unsigned*)lds); prep_expert_topk(q, (l), (LAS float*)lds)); GRID_BAR(); \
        PH(f_moe1_phase(q, (l), lds)); GRID_BAR(); \
        PH(f_moe2_phase(q, (l), lds)); GRID_BAR(); } while (0)
    LAYER(0); LAYER(1); LAYER(2); LAYER(3);
#undef LAYER
    PH(norm1_phase<2>(q, 0));
}

extern "C" void kernel_launch(void* const* d_in, const int* in_sizes, int n_in, void* d_out, int out_size, void* d_ws, size_t ws_size, hipStream_t stream) {
    (void)in_sizes; (void)out_size;
    static int grid = 0;
    if (grid == 0) {
        if (n_in != 16 || ws_size < OFF_END) { grid = -1; return; }
        int dev = 0, cus = 0, per_cu = 0;
        if (hipGetDevice(&dev) != hipSuccess || hipDeviceGetAttribute(&cus, hipDeviceAttributeMultiprocessorCount, dev) != hipSuccess) { grid = -1; return; }
        if (hipFuncSetAttribute((const void*)mega_fwd, hipFuncAttributeMaxDynamicSharedMemorySize, LDS_BYTES) != hipSuccess) { grid = -1; return; }
        if (hipOccupancyMaxActiveBlocksPerMultiprocessor(&per_cu, (const void*)mega_fwd, 512, LDS_BYTES) != hipSuccess || per_cu < 1) { (void)hipGetLastError(); }
        grid = cus;
    }
    if (grid < 0) return;
    if (hipMemsetAsync((char*)d_ws + OFF_CTL, 0, 65536, stream) != hipSuccess) return;
    Params p{};
    p.x = (const float*)d_in[0]; p.w_in = (const float*)d_in[1]; p.b_gate = (const float*)d_in[2]; p.sink = (const float*)d_in[3]; p.rpb = (const float*)d_in[4];
    p.w_a = (const float*)d_in[5]; p.w_b = (const float*)d_in[6]; p.w_c = (const float*)d_in[7]; p.w_out = (const float*)d_in[8]; p.norm_mix = (const float*)d_in[9];
    p.norm_ffn = (const float*)d_in[10]; p.w_router = (const float*)d_in[11]; p.w_gate_e = (const float*)d_in[12]; p.w_up_e = (const float*)d_in[13]; p.w_down_e = (const float*)d_in[14];
    p.norm_final = (const float*)d_in[15]; p.out = (float*)d_out; p.ws = (unsigned char*)d_ws;
    hipLaunchKernelGGL(mega_fwd, dim3(grid), dim3(512), LDS_BYTES, stream, p);
}
```
